# Optimizing an MI355X kernel written in HIP

```python
import math
import jax
import jax.numpy as jnp
from jax import lax
import numpy as np

D_MODEL = 1024
BATCH = 2
SEQ = 8192
DEPTH = 2
DEC_BATCH = 16
DEC_SEQ = 4096
PAST_LEN = 128

BRANCH_W = 512
N_BRANCH = 4
RWKV_HEADS = 8
RWKV_HD = 64
W_LORA = 64
A_LORA = 64
G_LORA = 128
DIFF_HEADS = 4
DIFF_HD = 64
DIFF_VD = 128
ROPE_DIM = DIFF_HD // 4
ROPE_THETA = 500000.0
Q_BLOCK = 128
FNET_GROUPS = 4
FNET_GD = BRANCH_W // FNET_GROUPS
POOL_GROUPS = 4
POOL_GD = BRANCH_W // POOL_GROUPS
POOL_WINDOWS = (2, 4, 8, 16)
D_FF = 2816
LN_EPS = 1e-5
LNX_EPS = 64e-5
RMS_EPS = 1e-5

RWKV_COLS = 3 * BRANCH_W + 2 * W_LORA + 2 * A_LORA + G_LORA
DIFF_COLS = 2 * DIFF_HEADS * 2 * DIFF_HD + DIFF_HEADS * DIFF_VD
FNET_COLS = BRANCH_W
POOL_COLS = BRANCH_W
GATE_COLS = N_BRANCH * D_MODEL
OFF_DIFF = RWKV_COLS
OFF_FNET = OFF_DIFF + DIFF_COLS
OFF_POOL = OFF_FNET + FNET_COLS
OFF_GATE = OFF_POOL + POOL_COLS
N_IN = OFF_GATE + GATE_COLS

kernel_name = 'hybrid_rwkv7_diffattn_fnet_pool_encoder'


def layer_norm(x, g=None, b=None, eps=LN_EPS):
    xf = x.astype(jnp.float32)
    mu = jnp.mean(xf, axis=-1, keepdims=True)
    var = jnp.mean(jnp.square(xf - mu), axis=-1, keepdims=True)
    y = (xf - mu) * lax.rsqrt(var + eps)
    if g is not None:
        y = y * g.astype(jnp.float32) + b.astype(jnp.float32)
    return y.astype(x.dtype)


def swiglu(h, w_in, w_out):
    u = h @ w_in
    a, b = jnp.split(u, 2, axis=-1)
    return (jax.nn.silu(a) * b) @ w_out


def centred_shift(t):
    tp = jnp.pad(t, ((0, 0), (1, 1), (0, 0)))
    return 0.5 * (tp[:, :-2] + tp[:, 2:])


def wkv7_scan(r, w, k, v, kk, a, reverse):
    B, S, H, N = r.shape
    tm = lambda t: jnp.swapaxes(t, 0, 1)

    def step(state, inp):
        r_t, w_t, k_t, v_t, kk_t, a_t = inp
        sa = jnp.einsum('bhvk,bhk->bhv', state, -kk_t)
        state = (state * w_t[:, :, None, :]
                 + sa[..., None] * (kk_t * a_t)[:, :, None, :]
                 + v_t[..., None] * k_t[:, :, None, :])
        y = jnp.einsum('bhvk,bhk->bhv', state, r_t)
        return state, y

    s0 = jnp.zeros((B, H, N, N), jnp.float32)
    _, ys = lax.scan(step, s0, (tm(r), tm(w), tm(k), tm(v), tm(kk), tm(a)), reverse=reverse)
    return tm(ys)


def rwkv7_mixer(p, mu, w0, w2, a0, a2, g2, k_k, k_a, r_k, lnx_g, lnx_b):
    dt = p.dtype
    B, S, _ = p.shape
    p = p.astype(jnp.float32)
    p = p + (centred_shift(p) - p) * mu
    sizes = (BRANCH_W, BRANCH_W, BRANCH_W, W_LORA, W_LORA, A_LORA, A_LORA)
    r, k, v, w1f, w1b, a1f, a1b, g1 = jnp.split(p, list(np.cumsum(sizes)), axis=-1)
    heads = lambda t: t.reshape(B, S, RWKV_HEADS, RWKV_HD)
    kk = heads(k * k_k)
    kk = kk / jnp.maximum(jnp.sqrt(jnp.sum(kk * kk, axis=-1, keepdims=True)), 1e-12)
    y = 0.0
    k_sum = 0.0
    for d, (w1, a1) in enumerate(((w1f, a1f), (w1b, a1b))):
        w_log = -jax.nn.softplus(-(w0[d] + jnp.tanh(w1) @ w2[d])) - 0.5
        decay = jnp.exp(-jnp.exp(w_log))
        a = jax.nn.sigmoid(a0[d] + a1 @ a2[d])
        k_d = k * (1.0 + (a - 1.0) * k_a)
        y = y + wkv7_scan(heads(r), heads(decay), heads(k_d), heads(v), kk, heads(a), reverse=(d == 1))
        k_sum = k_sum + k_d
    ym = jnp.mean(y, axis=-1, keepdims=True)
    yv = jnp.mean(jnp.square(y - ym), axis=-1, keepdims=True)
    y = ((y - ym) * lax.rsqrt(yv + LNX_EPS)).reshape(B, S, BRANCH_W) * lnx_g + lnx_b
    bonus = jnp.sum(heads(r * (0.5 * k_sum) * r_k), axis=-1, keepdims=True) * heads(v)
    y = y + bonus.reshape(B, S, BRANCH_W)
    g = jax.nn.sigmoid(g1) @ g2
    return (y * g).astype(dt)


def rope_tables(S):
    inv = ROPE_THETA ** (-jnp.arange(0, ROPE_DIM, 2, dtype=jnp.float32) / ROPE_DIM)
    ang = jnp.arange(S, dtype=jnp.float32)[:, None] * inv[None, :]
    return jnp.cos(ang), jnp.sin(ang)


def apply_partial_rope(x, cos, sin):
    half = ROPE_DIM // 2
    c = cos[None, :, None, None, :]
    s = sin[None, :, None, None, :]
    xr = x[..., :ROPE_DIM].astype(jnp.float32)
    x1, x2 = xr[..., :half], xr[..., half:]
    rot = jnp.concatenate([x1 * c - x2 * s, x1 * s + x2 * c], axis=-1).astype(x.dtype)
    return jnp.concatenate([rot, x[..., ROPE_DIM:]], axis=-1)


def diff_attention(p, lam, norm_g, lam_init):
    B, S, _ = p.shape
    H = DIFF_HEADS
    nq = H * 2 * DIFF_HD
    q = p[..., :nq].reshape(B, S, H, 2, DIFF_HD)
    k = p[..., nq:2 * nq].reshape(B, S, H, 2, DIFF_HD)
    v = p[..., 2 * nq:].reshape(B, S, H, DIFF_VD)
    cos, sin = rope_tables(S)
    q = apply_partial_rope(q, cos, sin)
    k = apply_partial_rope(k, cos, sin)
    q = q.transpose(0, 2, 3, 1, 4) * (DIFF_HD ** -0.5)
    k = k.transpose(0, 2, 3, 1, 4)
    v = v.transpose(0, 2, 1, 3)
    lf = lam.astype(jnp.float32)
    lam_full = jnp.exp(jnp.sum(lf[0] * lf[1])) - jnp.exp(jnp.sum(lf[2] * lf[3])) + lam_init
    nb = S // Q_BLOCK
    qb = q.reshape(B, H, 2, nb, Q_BLOCK, DIFF_HD).transpose(3, 0, 1, 2, 4, 5)

    def attend(qblk):
        s = jnp.einsum('bhjqd,bhjkd->bhjqk', qblk, k, preferred_element_type=jnp.float32)
        pr = jax.nn.softmax(s, axis=-1)
        a = pr[:, :, 0] - lam_full * pr[:, :, 1]
        return jnp.einsum('bhqk,bhkv->bhqv', a.astype(v.dtype), v)

    o = lax.map(attend, qb)
    o = o.transpose(1, 0, 3, 2, 4).reshape(B, S, H, DIFF_VD).astype(jnp.float32)
    o = o * lax.rsqrt(jnp.mean(o * o, axis=-1, keepdims=True) + RMS_EPS) * norm_g * (1.0 - lam_init)
    return o.reshape(B, S, H * DIFF_VD).astype(p.dtype)


def fourier_mixer(p):
    B, S, _ = p.shape
    xg = p.reshape(B, S, FNET_GROUPS, FNET_GD).astype(jnp.float32)
    f = jnp.fft.fftn(xg, axes=(1, 3), norm='ortho').real
    return f.reshape(B, S, FNET_COLS).astype(p.dtype)


def pool_mixer(p, scale):
    B, S, _ = p.shape
    xg = p.reshape(B, S, POOL_GROUPS, POOL_GD).astype(jnp.float32)
    cs = jnp.concatenate([jnp.zeros((B, 1, POOL_GROUPS, POOL_GD), jnp.float32), jnp.cumsum(xg, axis=1)], axis=1)
    half = jnp.array([w // 2 for w in POOL_WINDOWS], jnp.int32)[None, :]
    t = jnp.arange(S, dtype=jnp.int32)[:, None]
    lo = jnp.clip(t - half, 0, S)
    hi = jnp.clip(t + half, 0, S)
    gi = jnp.arange(POOL_GROUPS, dtype=jnp.int32)[None, :]
    win_sum = cs[:, hi, gi, :] - cs[:, lo, gi, :]
    count = (hi - lo).astype(jnp.float32)[None, :, :, None]
    pooled = win_sum / count - xg
    return (pooled.reshape(B, S, POOL_COLS) * scale).astype(p.dtype)


def encoder_layer(x, c, lam_init, ada_w, ada_b, ln_g, ln_b, ffa_w_in, ffa_w_out, ffb_w_in, ffb_w_out,
                  w_in, rwkv_mu, rwkv_w0, rwkv_w2, rwkv_a0, rwkv_a2, rwkv_g2, rwkv_kk, rwkv_ka, rwkv_rk,
                  rwkv_lnx_g, rwkv_lnx_b, diff_lam, diff_norm_g, pool_scale, w_branch, w_out):
    B, S, D = x.shape
    alpha = (2.0 * DEPTH) ** 0.25
    mod = (jax.nn.silu(c) @ ada_w + ada_b).reshape(B, 9, 1, D)

    def modulate(t, j):
        return layer_norm(t) * (1.0 + mod[:, 3 * j + 1]) + mod[:, 3 * j]

    def post(t, update, j):
        return layer_norm(alpha * t + (1.0 + mod[:, 3 * j + 2]) * update, ln_g[j], ln_b[j])

    x = post(x, 0.5 * swiglu(modulate(x, 0), ffa_w_in, ffa_w_out), 0)
    h = modulate(x, 1)
    p = h @ w_in
    y_rwkv = rwkv7_mixer(p[..., :OFF_DIFF], rwkv_mu, rwkv_w0, rwkv_w2, rwkv_a0, rwkv_a2, rwkv_g2,
                         rwkv_kk, rwkv_ka, rwkv_rk, rwkv_lnx_g, rwkv_lnx_b)
    y_diff = diff_attention(p[..., OFF_DIFF:OFF_FNET], diff_lam, diff_norm_g, lam_init)
    y_fnet = fourier_mixer(p[..., OFF_FNET:OFF_POOL])
    y_pool = pool_mixer(p[..., OFF_POOL:OFF_GATE], pool_scale)
    gates = jax.nn.sigmoid(p[..., OFF_GATE:].astype(jnp.float32)).astype(x.dtype).reshape(B, S, N_BRANCH, D)
    branches = jnp.stack([y_rwkv, y_diff, y_fnet, y_pool], axis=2)
    proj = jnp.einsum('bsnc,ncd->bsnd', branches, w_branch)
    merged = jnp.sum(gates * proj, axis=2)
    x = post(x, merged @ w_out, 1)
    x = post(x, 0.5 * swiglu(modulate(x, 2), ffb_w_in, ffb_w_out), 2)
    return x


def setup_inputs(seed: int = 0) -> dict:
    key = jax.random.key(seed)
    ks = jax.random.split(key, 32)
    f32 = jnp.float32
    nrm = lambda k, shape, s: jax.random.normal(k, shape, f32) * s
    beta = (8.0 * DEPTH) ** -0.25
    D = D_MODEL
    return {
        'x_prompt': nrm(ks[0], (BATCH, SEQ, D), 1.0),
        'x_sample': nrm(ks[1], (DEC_BATCH, DEC_SEQ, D), 1.0),
        'c_prompt': nrm(ks[2], (BATCH, D), 1.0),
        'c_sample': nrm(ks[3], (DEC_BATCH, D), 1.0),
        'ada_w': nrm(ks[4], (DEPTH, D, 9 * D), 0.1 * D ** -0.5),
        'ada_b': nrm(ks[5], (DEPTH, 9 * D), 0.01),
        'ln_g': 1.0 + nrm(ks[6], (DEPTH, 3, D), 0.05),
        'ln_b': nrm(ks[7], (DEPTH, 3, D), 0.02),
        'ffa_w_in': nrm(ks[8], (DEPTH, D, 2 * D_FF), D ** -0.5),
        'ffa_w_out': nrm(ks[9], (DEPTH, D_FF, D), beta * D_FF ** -0.5),
        'ffb_w_in': nrm(ks[10], (DEPTH, D, 2 * D_FF), D ** -0.5),
        'ffb_w_out': nrm(ks[11], (DEPTH, D_FF, D), beta * D_FF ** -0.5),
        'w_in': nrm(ks[12], (DEPTH, D, N_IN), D ** -0.5),
        'rwkv_mu': jax.random.uniform(ks[13], (DEPTH, RWKV_COLS), f32),
        'rwkv_w0': nrm(ks[14], (DEPTH, 2, BRANCH_W), 0.5),
        'rwkv_w2': nrm(ks[15], (DEPTH, 2, W_LORA, BRANCH_W), 0.5 * W_LORA ** -0.5),
        'rwkv_a0': nrm(ks[16], (DEPTH, 2, BRANCH_W), 0.3),
        'rwkv_a2': nrm(ks[17], (DEPTH, 2, A_LORA, BRANCH_W), 0.5 * A_LORA ** -0.5),
        'rwkv_g2': nrm(ks[18], (DEPTH, G_LORA, BRANCH_W), G_LORA ** -0.5),
        'rwkv_kk': 0.85 + nrm(ks[19], (DEPTH, BRANCH_W), 0.05),
        'rwkv_ka': 1.0 + nrm(ks[20], (DEPTH, BRANCH_W), 0.05),
        'rwkv_rk': nrm(ks[21], (DEPTH, BRANCH_W), 0.3),
        'rwkv_lnx_g': 1.0 + nrm(ks[22], (DEPTH, BRANCH_W), 0.05),
        'rwkv_lnx_b': nrm(ks[23], (DEPTH, BRANCH_W), 0.02),
        'diff_lam': nrm(ks[24], (DEPTH, 4, DIFF_HD), 0.1),
        'diff_norm_g': 1.0 + nrm(ks[25], (DEPTH, DIFF_VD), 0.05),
        'pool_scale': 1.0 + nrm(ks[26], (DEPTH, POOL_COLS), 0.1),
        'w_branch': nrm(ks[27], (DEPTH, N_BRANCH, BRANCH_W, D), BRANCH_W ** -0.5),
        'w_out': nrm(ks[28], (DEPTH, D, D), beta * D ** -0.5),
    }


def reference(x_prompt, x_sample, c_prompt, c_sample, ada_w, ada_b, ln_g, ln_b, ffa_w_in, ffa_w_out,
              ffb_w_in, ffb_w_out, w_in, rwkv_mu, rwkv_w0, rwkv_w2, rwkv_a0, rwkv_a2, rwkv_g2, rwkv_kk,
              rwkv_ka, rwkv_rk, rwkv_lnx_g, rwkv_lnx_b, diff_lam, diff_norm_g, pool_scale, w_branch, w_out):
    def run(x, c):
        for l in range(DEPTH):
            lam_init = 0.8 - 0.6 * math.exp(-0.3 * l)
            x = encoder_layer(x, c, lam_init, ada_w[l], ada_b[l], ln_g[l], ln_b[l], ffa_w_in[l], ffa_w_out[l],
                              ffb_w_in[l], ffb_w_out[l], w_in[l], rwkv_mu[l], rwkv_w0[l], rwkv_w2[l],
                              rwkv_a0[l], rwkv_a2[l], rwkv_g2[l], rwkv_kk[l], rwkv_ka[l], rwkv_rk[l],
                              rwkv_lnx_g[l], rwkv_lnx_b[l], diff_lam[l], diff_norm_g[l], pool_scale[l],
                              w_branch[l], w_out[l])
        return x

    y_prompt = run(x_prompt, c_prompt)
    y_sample = run(x_sample, c_sample)
    return (y_prompt, y_sample)
```

```cpp
#include <hip/hip_runtime.h>
#include <hip/hip_cooperative_groups.h>
#include <cstdio>
#include <cstdint>
namespace cg = cooperative_groups;

typedef unsigned short bf16_t;
typedef _Float16 f16;
typedef short bf16x8 __attribute__((ext_vector_type(8)));
typedef float f32x4 __attribute__((ext_vector_type(4)));
typedef unsigned u32x4 __attribute__((ext_vector_type(4)));
typedef unsigned u32x2 __attribute__((ext_vector_type(2)));

#ifndef ONE_LAUNCH
#define ONE_LAUNCH 1
#endif

constexpr int TP = 40960;
constexpr int NPASS = 2;
constexpr int NSEQ = 9;
constexpr int MT = TP / 128;
constexpr int N_IN_FULL = 8576;
constexpr float ALPHA = 1.41421356237f;

constexpr size_t OW_FA_IN = 0, OW_FA_OUT = 5767168, OW_FB_IN = 8650752, OW_FB_OUT = 14417920, OW_WIN = 17301504,
                 OW_WBR = 26083328, OW_WOUT = 28180480, OW_W2T = 29229056, OW_A2T = 29294592, OW_G2T = 29360128, WL_TOTAL = 29425664;
constexpr size_t WS_W = 0, WS_TW = 117702656, WS_MOD = 117735424, WS_HMOD = 119062528, WS_R = 202948608;
constexpr size_t R_RAW = 0, R_LIN = 157286400, R_WA = 188743680, R_G = 356515840, R_Q = 398458880, R_K = 440401920, R_VT = 482344960,
                 R_YFB = 524288000, R_ZC = 608174080, R_POOLP = 650117120, R_YB = 692060160, R_ACT = 0, R_MERGED = 0;
constexpr size_t SZ512 = (size_t)TP * 512;

struct Params { const float* in[29]; float* out; unsigned char* ws; };
struct Ctx { int tid, bid, nblk; };

__device__ __forceinline__ bf16_t f2bf(float f) { unsigned u = __float_as_uint(f); u += 0x7fffu + ((u >> 16) & 1u); return (bf16_t)(u >> 16); }
__device__ __forceinline__ float bf2f(bf16_t b) { return __uint_as_float(((unsigned)b) << 16); }
__device__ __forceinline__ unsigned pack2bf(float a, float b) { return (unsigned)f2bf(a) | ((unsigned)f2bf(b) << 16); }
__device__ __forceinline__ float wsum(float v) {
#pragma unroll
    for (int o = 32; o > 0; o >>= 1) v += __shfl_xor(v, o);
    return v;
}
__device__ __forceinline__ float sigmoidf_(float x) { return 1.0f / (1.0f + __expf(-x)); }
template <int CTRL> __device__ __forceinline__ float dppf(float v) { return __int_as_float(__builtin_amdgcn_update_dpp(0, __float_as_int(v), CTRL, 0xF, 0xF, true)); }
__device__ __forceinline__ float red8(float v) { v += dppf<0xB1>(v); v += dppf<0x4E>(v); v += dppf<0x141>(v); return v; }

__device__ __forceinline__ int grow_of(int pass, int lt) { return lt < 8192 ? pass * 8192 + lt : 16384 + pass * 32768 + (lt - 8192); }
__device__ __forceinline__ int brow_of(int pass, int lt) { return lt < 8192 ? pass : 2 + pass * 8 + ((lt - 8192) >> 12); }
__device__ __forceinline__ int pos_of(int lt) { return lt < 8192 ? lt : ((lt - 8192) & 4095); }
__device__ __forceinline__ int seqbase_of(int sq) { return sq == 0 ? 0 : 8192 + (sq - 1) * 4096; }
__device__ __forceinline__ int seqlen_of(int sq) { return sq == 0 ? 8192 : 4096; }

__device__ __forceinline__ bf16_t* wl(const Params& P, int layer) { return (bf16_t*)(P.ws + WS_W) + (size_t)layer * WL_TOTAL; }

template <int NJ, bool SWAP>
__device__ __forceinline__ void gemm_core(const Ctx& C, f32x4 (&acc)[4][NJ], const bf16_t* __restrict__ A, int lda, const bf16_t* __restrict__ B, int ldb, int K, unsigned char* smem) {
    const int tid = C.tid, lane = tid & 63, wave = tid >> 6, wm = wave >> 1, wn = wave & 1, fr = lane & 15, fq = lane >> 4;
    u32x4 ra[4], rb[NJ];
#pragma unroll
    for (int i = 0; i < 4; ++i)
#pragma unroll
        for (int j = 0; j < NJ; ++j) acc[i][j] = (f32x4){0.f, 0.f, 0.f, 0.f};
    const int lrow = tid >> 3, lkc = (tid & 7) * 8;
#pragma unroll
    for (int i = 0; i < 4; ++i) ra[i] = *(const u32x4*)(A + (size_t)(lrow + 32 * i) * lda + lkc);
#pragma unroll
    for (int i = 0; i < NJ; ++i) rb[i] = *(const u32x4*)(B + (size_t)(lrow + 32 * i) * ldb + lkc);
    for (int k0 = 0; k0 < K; k0 += 64) {
        __syncthreads();
#pragma unroll
        for (int i = 0; i < 4; ++i) *(u32x4*)(smem + (lrow + 32 * i) * 144 + lkc * 2) = ra[i];
#pragma unroll
        for (int i = 0; i < NJ; ++i) *(u32x4*)(smem + 18432 + (lrow + 32 * i) * 144 + lkc * 2) = rb[i];
        __syncthreads();
        if (k0 + 64 < K) {
#pragma unroll
            for (int i = 0; i < 4; ++i) ra[i] = *(const u32x4*)(A + (size_t)(lrow + 32 * i) * lda + k0 + 64 + lkc);
#pragma unroll
            for (int i = 0; i < NJ; ++i) rb[i] = *(const u32x4*)(B + (size_t)(lrow + 32 * i) * ldb + k0 + 64 + lkc);
        }
#pragma unroll
        for (int ks = 0; ks < 2; ++ks) {
            bf16x8 af[4], bfr[NJ];
#pragma unroll
            for (int i = 0; i < 4; ++i) af[i] = *(const bf16x8*)(smem + (wm * 64 + i * 16 + fr) * 144 + (ks * 32 + fq * 8) * 2);
#pragma unroll
            for (int j = 0; j < NJ; ++j) bfr[j] = *(const bf16x8*)(smem + 18432 + (wn * NJ * 16 + j * 16 + fr) * 144 + (ks * 32 + fq * 8) * 2);
#pragma unroll
            for (int i = 0; i < 4; ++i)
#pragma unroll
                for (int j = 0; j < NJ; ++j)
                    acc[i][j] = SWAP ? __builtin_amdgcn_mfma_f32_16x16x32_bf16(bfr[j], af[i], acc[i][j], 0, 0, 0)
                                     : __builtin_amdgcn_mfma_f32_16x16x32_bf16(af[i], bfr[j], acc[i][j], 0, 0, 0);
        }
    }
}

struct ConvJob { const float* src; int ld, K, nbegin, ncount, map; bf16_t* dst; };
__device__ __forceinline__ ConvJob conv_job(const Params& P, int j) {
    const int l = j >> 4, q = j & 15; bf16_t* W = wl(P, l); ConvJob c; c.map = 0; c.nbegin = 0;
    switch (q) {
        case 0: c.src = P.in[8] + (size_t)l * 1024 * 5632; c.ld = 5632; c.K = 1024; c.ncount = 5632; c.dst = W + OW_FA_IN; c.map = 1; break;
        case 1: c.src = P.in[9] + (size_t)l * 2816 * 1024; c.ld = 1024; c.K = 2816; c.ncount = 1024; c.dst = W + OW_FA_OUT; break;
        case 2: c.src = P.in[10] + (size_t)l * 1024 * 5632; c.ld = 5632; c.K = 1024; c.ncount = 5632; c.dst = W + OW_FB_IN; c.map = 1; break;
        case 3: c.src = P.in[11] + (size_t)l * 2816 * 1024; c.ld = 1024; c.K = 2816; c.ncount = 1024; c.dst = W + OW_FB_OUT; break;
        case 4: c.src = P.in[12] + (size_t)l * 1024 * 8576; c.ld = 8576; c.K = 1024; c.ncount = 3456; c.dst = W + OW_WIN; break;
        case 5: c.src = P.in[12] + (size_t)l * 1024 * 8576; c.ld = 8576; c.K = 1024; c.nbegin = 3968; c.ncount = 4608; c.dst = W + OW_WIN + (size_t)3968 * 1024; break;
        case 6: case 7: case 8: case 9: { const int n = q - 6; c.src = P.in[27] + (size_t)(l * 4 + n) * 512 * 1024; c.ld = 1024; c.K = 512; c.ncount = 1024; c.dst = W + OW_WBR + (size_t)n * 1024 * 512; } break;
        case 10: c.src = P.in[28] + (size_t)l * 1024 * 1024; c.ld = 1024; c.K = 1024; c.ncount = 1024; c.dst = W + OW_WOUT; break;
        case 11: case 12: { const int d = q - 11; c.src = P.in[15] + (size_t)(l * 2 + d) * 64 * 512; c.ld = 512; c.K = 64; c.ncount = 512; c.dst = W + OW_W2T + (size_t)d * 512 * 64; } break;
        case 13: case 14: { const int d = q - 13; c.src = P.in[17] + (size_t)(l * 2 + d) * 64 * 512; c.ld = 512; c.K = 64; c.ncount = 512; c.dst = W + OW_A2T + (size_t)d * 512 * 64; } break;
        default: c.src = P.in[18] + (size_t)l * 128 * 512; c.ld = 512; c.K = 128; c.ncount = 512; c.dst = W + OW_G2T; break;
    }
    return c;
}

__device__ __forceinline__ void prep_phase(const Ctx& C, const Params& P, unsigned char* smem) {
    const int tid = C.tid;
    {
        int total = 0;
        for (int j = 0; j < 32; ++j) { ConvJob c = conv_job(P, j); total += (c.K >> 6) * (c.ncount >> 6); }
        float* tile = (float*)smem;
        const int tx = tid & 63, ty = tid >> 6;
        for (int t = C.bid; t < total; t += C.nblk) {
            int tt = t, j = 0; ConvJob c = conv_job(P, 0);
            for (;;) { const int n = (c.K >> 6) * (c.ncount >> 6); if (tt < n) break; tt -= n; ++j; c = conv_job(P, j); }
            const int nkt = c.K >> 6, kt = tt % nkt, nt = tt / nkt, k0 = kt * 64, n0 = nt * 64;
            int col = c.nbegin + n0 + tx;
            if (c.map) { const int np = n0 + tx, blk = np >> 5, w = np & 31, f = blk * 16 + (w & 15); col = (w < 16) ? f : 2816 + f; }
            __syncthreads();
#pragma unroll 4
            for (int i = 0; i < 16; ++i) { const int kk = ty + 4 * i; tile[kk * 65 + tx] = c.src[(size_t)(k0 + kk) * c.ld + col]; }
            __syncthreads();
#pragma unroll 4
            for (int i = 0; i < 16; ++i) { const int nn = ty + 4 * i; c.dst[(size_t)(n0 + nn) * c.K + k0 + tx] = f2bf(tile[tx * 65 + nn]); }
        }
        __syncthreads();
    }
    {
        float* wt = (float*)smem;
        float* cosT = (float*)(smem + 64 * 129 * 4);
        for (int it = C.bid; it < 2 * 4 * 16; it += C.nblk) {
            const int l = it >> 6, g = (it >> 4) & 3, kc = it & 15, k0 = kc * 64;
            const float* src = P.in[12] + (size_t)l * 1024 * 8576 + 3456 + g * 128;
            __syncthreads();
            for (int e = tid; e < 64 * 128; e += 256) { const int kk = e >> 7, c = e & 127; wt[kk * 129 + c] = src[(size_t)(k0 + kk) * 8576 + c]; }
            if (tid < 128) cosT[tid] = cospif((float)tid * (1.0f / 64.0f));
            __syncthreads();
            bf16_t* dst = wl(P, l) + OW_WIN + (size_t)(3456 + g * 128) * 1024;
            const int kk = tid & 63;
            for (int i = 0; i < 32; ++i) {
                const int j2 = (tid >> 6) + 4 * i, cc = j2 >> 1, part = j2 & 1;
                float s = 0.f;
                if (cc == 0) {
                    if (part == 0) { for (int c = 0; c < 128; ++c) s += wt[kk * 129 + c]; }
                    else { for (int c = 0; c < 128; ++c) s += (c & 1) ? -wt[kk * 129 + c] : wt[kk * 129 + c]; }
                } else if (part == 0) {
                    for (int c = 0; c < 128; ++c) s += wt[kk * 129 + c] * cosT[(cc * c) & 127];
                } else {
                    for (int c = 0; c < 128; ++c) s -= wt[kk * 129 + c] * cosT[(cc * c - 32) & 127];
                }
                dst[(size_t)j2 * 1024 + k0 + kk] = f2bf(s);
            }
        }
        __syncthreads();
    }
    {
        float2* tw = (float2*)(P.ws + WS_TW);
        for (int m = C.bid * 256 + tid; m < 4096; m += C.nblk * 256) { const float x = (float)m * (1.0f / 4096.0f); tw[m] = make_float2(cospif(x), -sinpif(x)); }
    }
    {
        float* sc = (float*)smem;
        float* red = (float*)(smem + 18 * 512 * 4);
        float* mod = (float*)(P.ws + WS_MOD);
        for (int it = C.bid; it < 2 * 144; it += C.nblk) {
            const int l = it / 144, n0 = (it % 144) * 64, nl = tid & 63, ks = tid >> 6;
            const float* aw = P.in[4] + (size_t)l * 1024 * 9216;
            float acc[18];
#pragma unroll
            for (int b = 0; b < 18; ++b) acc[b] = 0.f;
            for (int half = 0; half < 2; ++half) {
                __syncthreads();
                for (int e = tid; e < 18 * 512; e += 256) {
                    const int b = e >> 9, kk = e & 511, k = half * 512 + kk;
                    const float cv = b < 2 ? P.in[2][b * 1024 + k] : P.in[3][(b - 2) * 1024 + k];
                    sc[e] = cv / (1.0f + __expf(-cv));
                }
                __syncthreads();
                for (int kk = ks * 128; kk < ks * 128 + 128; ++kk) {
                    const float w = aw[(size_t)(half * 512 + kk) * 9216 + n0 + nl];
#pragma unroll
                    for (int b = 0; b < 18; ++b) acc[b] += sc[b * 512 + kk] * w;
                }
            }
            __syncthreads();
#pragma unroll
            for (int b = 0; b < 18; ++b) red[(ks * 18 + b) * 64 + nl] = acc[b];
            __syncthreads();
            for (int e = tid; e < 18 * 64; e += 256) {
                const int b = e >> 6, n = e & 63;
                const float s = red[(0 * 18 + b) * 64 + n] + red[(1 * 18 + b) * 64 + n] + red[(2 * 18 + b) * 64 + n] + red[(3 * 18 + b) * 64 + n];
                mod[((size_t)l * 18 + b) * 9216 + n0 + n] = s + P.in[5][(size_t)l * 9216 + n0 + n];
            }
        }
        __syncthreads();
    }
}

__device__ __forceinline__ void norm_phase(const Ctx& C, const Params& P, int pass, const float* lng, const float* lnb, int mod_layer, int j, bool from_input) {
    const int lane = C.tid & 63, wave = C.tid >> 6;
    bf16_t* hmod = (bf16_t*)(P.ws + WS_HMOD);
    const float* mod = (const float*)(P.ws + WS_MOD);
    for (int lt = C.bid * 4 + wave; lt < TP; lt += C.nblk * 4) {
        const int gr = grow_of(pass, lt), b = brow_of(pass, lt);
        const float* src = from_input ? (gr < 16384 ? P.in[0] + (size_t)gr * 1024 : P.in[1] + (size_t)(gr - 16384) * 1024) : P.out + (size_t)gr * 1024;
        float4 v[4];
#pragma unroll
        for (int i = 0; i < 4; ++i) v[i] = *(const float4*)(src + i * 256 + lane * 4);
        if (lng) {
            float s = 0.f;
#pragma unroll
            for (int i = 0; i < 4; ++i) s += (v[i].x + v[i].y) + (v[i].z + v[i].w);
            const float mu = wsum(s) * (1.0f / 1024.0f);
            float q = 0.f;
#pragma unroll
            for (int i = 0; i < 4; ++i) { const float a = v[i].x - mu, bb = v[i].y - mu, c = v[i].z - mu, d = v[i].w - mu; q += a * a + bb * bb + c * c + d * d; }
            const float rs = rsqrtf(wsum(q) * (1.0f / 1024.0f) + 1e-5f);
#pragma unroll
            for (int i = 0; i < 4; ++i) {
                const float4 g = *(const float4*)(lng + i * 256 + lane * 4), bb = *(const float4*)(lnb + i * 256 + lane * 4);
                v[i].x = (v[i].x - mu) * rs * g.x + bb.x; v[i].y = (v[i].y - mu) * rs * g.y + bb.y; v[i].z = (v[i].z - mu) * rs * g.z + bb.z; v[i].w = (v[i].w - mu) * rs * g.w + bb.w;
            }
        }
        if (lng || from_input) {
#pragma unroll
            for (int i = 0; i < 4; ++i) *(float4*)(P.out + (size_t)gr * 1024 + i * 256 + lane * 4) = v[i];
        }
        if (j >= 0) {
            float s = 0.f;
#pragma unroll
            for (int i = 0; i < 4; ++i) s += (v[i].x + v[i].y) + (v[i].z + v[i].w);
            const float mu = wsum(s) * (1.0f / 1024.0f);
            float q = 0.f;
#pragma unroll
            for (int i = 0; i < 4; ++i) { const float a = v[i].x - mu, bb = v[i].y - mu, c = v[i].z - mu, d = v[i].w - mu; q += a * a + bb * bb + c * c + d * d; }
            const float rs = rsqrtf(wsum(q) * (1.0f / 1024.0f) + 1e-5f);
            const float* mb = mod + ((size_t)mod_layer * 18 + b) * 9216 + (size_t)(3 * j) * 1024;
#pragma unroll
            for (int i = 0; i < 4; ++i) {
                const float4 sh = *(const float4*)(mb + i * 256 + lane * 4), scl = *(const float4*)(mb + 1024 + i * 256 + lane * 4);
                const float h0 = (v[i].x - mu) * rs * (1.f + scl.x) + sh.x, h1 = (v[i].y - mu) * rs * (1.f + scl.y) + sh.y;
                const float h2 = (v[i].z - mu) * rs * (1.f + scl.z) + sh.z, h3 = (v[i].w - mu) * rs * (1.f + scl.w) + sh.w;
                uint2 o; o.x = pack2bf(h0, h1); o.y = pack2bf(h2, h3);
                *(uint2*)(hmod + (size_t)lt * 1024 + i * 256 + lane * 4) = o;
            }
        }
    }
}

__device__ __forceinline__ void ffn_up_phase(const Ctx& C, const Params& P, const bf16_t* Wt, unsigned char* smem) {
    const bf16_t* hmod = (const bf16_t*)(P.ws + WS_HMOD);
    bf16_t* act = (bf16_t*)(P.ws + WS_R + R_ACT);
    const int lane = C.tid & 63, wave = C.tid >> 6, wm = wave >> 1, wn = wave & 1, fr = lane & 15, fq = lane >> 4;
    for (int t = C.bid; t < MT * 44; t += C.nblk) {
        const int tm = t / 44, tn = t % 44;
        f32x4 acc[4][4];
        gemm_core<4, true>(C, acc, hmod + (size_t)tm * 128 * 1024, 1024, Wt + (size_t)tn * 128 * 1024, 1024, 1024, smem);
#pragma unroll
        for (int i = 0; i < 4; ++i) {
            const int m = tm * 128 + wm * 64 + i * 16 + fr;
#pragma unroll
            for (int jj = 0; jj < 2; ++jj) {
                const int np = tn * 128 + wn * 64 + jj * 32, f = (np >> 5) * 16 + fq * 4;
                const f32x4 a = acc[i][2 * jj], b = acc[i][2 * jj + 1];
                float o[4];
#pragma unroll
                for (int r = 0; r < 4; ++r) o[r] = a[r] / (1.0f + __expf(-a[r])) * b[r];
                uint2 w; w.x = pack2bf(o[0], o[1]); w.y = pack2bf(o[2], o[3]);
                *(uint2*)(act + (size_t)m * 2816 + f) = w;
            }
        }
    }
}

__device__ __forceinline__ void resid_gemm_phase(const Ctx& C, const Params& P, int pass, const bf16_t* A, int K, const bf16_t* Wt, int layer, int j, float scale, unsigned char* smem) {
    const float* mod = (const float*)(P.ws + WS_MOD);
    const int lane = C.tid & 63, wave = C.tid >> 6, wm = wave >> 1, wn = wave & 1, fr = lane & 15, fq = lane >> 4;
    for (int t = C.bid; t < MT * 8; t += C.nblk) {
        const int tm = t >> 3, tn = t & 7;
        f32x4 acc[4][4];
        gemm_core<4, true>(C, acc, A + (size_t)tm * 128 * K, K, Wt + (size_t)tn * 128 * K, K, K, smem);
#pragma unroll
        for (int i = 0; i < 4; ++i) {
            const int lt = tm * 128 + wm * 64 + i * 16 + fr;
            const int gr = grow_of(pass, lt), b = brow_of(pass, lt);
            const float* gate = mod + ((size_t)layer * 18 + b) * 9216 + (size_t)(3 * j + 2) * 1024;
#pragma unroll
            for (int jn = 0; jn < 4; ++jn) {
                const int n = tn * 128 + wn * 64 + jn * 16 + fq * 4;
                float4* xp = (float4*)(P.out + (size_t)gr * 1024 + n);
                const float4 x = *xp, g = *(const float4*)(gate + n);
                float4 o;
                o.x = ALPHA * x.x + (1.f + g.x) * scale * acc[i][jn][0]; o.y = ALPHA * x.y + (1.f + g.y) * scale * acc[i][jn][1];
                o.z = ALPHA * x.z + (1.f + g.z) * scale * acc[i][jn][2]; o.w = ALPHA * x.w + (1.f + g.w) * scale * acc[i][jn][3];
                *xp = o;
            }
        }
    }
}

__device__ __forceinline__ void win_phase(const Ctx& C, const Params& P, int layer, unsigned char* smem) {
    const bf16_t* hmod = (const bf16_t*)(P.ws + WS_HMOD);
    const bf16_t* Wt = wl(P, layer) + OW_WIN;
    unsigned char* R = P.ws + WS_R;
    f16* raw = (f16*)(R + R_RAW); bf16_t* Qb = (bf16_t*)(R + R_Q); bf16_t* Kb = (bf16_t*)(R + R_K); bf16_t* Vt = (bf16_t*)(R + R_VT);
    f16* Zc = (f16*)(R + R_ZC); f16* poolp = (f16*)(R + R_POOLP);
    const int lane = C.tid & 63, wave = C.tid >> 6, wm = wave >> 1, wn = wave & 1, fr = lane & 15, fq = lane >> 4;
    for (int t = C.bid; t < MT * 35; t += C.nblk) {
        const int tm = t / 35, tn = t % 35;
        const int lt_t = tm * 128, sq = lt_t < 8192 ? 0 : 1 + ((lt_t - 8192) >> 12), lt0 = seqbase_of(sq), S = seqlen_of(sq);
        f32x4 acc[4][4];
        const bf16_t* Ap = hmod + (size_t)tm * 128 * 1024; const bf16_t* Bp = Wt + (size_t)tn * 128 * 1024;
        if (tn >= 23 && tn < 27) {
            gemm_core<4, false>(C, acc, Ap, 1024, Bp, 1024, 1024, smem);
#pragma unroll
            for (int i = 0; i < 4; ++i) {
                const int lt = tm * 128 + wm * 64 + i * 16 + fq * 4, pos = lt - lt0;
#pragma unroll
                for (int jn = 0; jn < 4; ++jn) {
                    const int nv = (tn - 23) * 128 + wn * 64 + jn * 16 + fr;
                    uint2 w; w.x = pack2bf(acc[i][jn][0], acc[i][jn][1]); w.y = pack2bf(acc[i][jn][2], acc[i][jn][3]);
                    *(uint2*)(Vt + (size_t)lt0 * 512 + (size_t)nv * S + pos) = w;
                }
            }
        } else {
            gemm_core<4, true>(C, acc, Ap, 1024, Bp, 1024, 1024, smem);
#pragma unroll
            for (int i = 0; i < 4; ++i) {
                const int lt = tm * 128 + wm * 64 + i * 16 + fr, pos = lt - lt0;
#pragma unroll
                for (int jn = 0; jn < 4; ++jn) {
                    const int n = tn * 128 + wn * 64 + jn * 16 + fq * 4;
                    f32x4 v = acc[i][jn];
                    if (tn < 15) {
                        typedef f16 f16x4 __attribute__((ext_vector_type(4)));
                        f16x4 h; h[0] = (f16)v[0]; h[1] = (f16)v[1]; h[2] = (f16)v[2]; h[3] = (f16)v[3];
                        *(f16x4*)(raw + (size_t)lt * 1920 + n) = h;
                    } else if (tn < 23) {
                        const int nq = (n - 1920) & 511, hc = nq >> 6, d = nq & 63;
                        if (jn == 0) {
#pragma unroll
                            for (int r = 0; r < 4; ++r) {
                                const int ii = (fq & 1) * 4 + r;
                                const float inv = powf(500000.0f, -(float)ii * 0.125f);
                                const float ang = (float)pos * inv;
                                double rev = (double)ang * 0.15915494309189535; rev -= floor(rev);
                                const float rr = (float)rev;
                                const float cs = __builtin_amdgcn_cosf(rr), sn = __builtin_amdgcn_sinf(rr);
                                const float other = __shfl_xor(v[r], 32);
                                v[r] = (fq < 2) ? (v[r] * cs - other * sn) : (other * sn + v[r] * cs);
                            }
                        }
                        bf16_t* dst = (tn < 19) ? Qb : Kb;
                        const float sc = (tn < 19) ? 0.125f * 1.44269504088896f : 1.0f;
                        uint2 w; w.x = pack2bf(v[0] * sc, v[1] * sc); w.y = pack2bf(v[2] * sc, v[3] * sc);
                        *(uint2*)(dst + (size_t)lt0 * 512 + ((size_t)hc * S + pos) * 64 + d) = w;
                    } else if (tn < 31) {
                        const int nz = n - 3456, g = nz >> 7, cc = (nz & 127) >> 1;
                        typedef f16 f16x2 __attribute__((ext_vector_type(2)));
                        f16x2 z0, z1; z0[0] = (f16)v[0]; z0[1] = (f16)v[1]; z1[0] = (f16)v[2]; z1[1] = (f16)v[3];
                        f16x2* zb = (f16x2*)Zc + (size_t)lt0 * 256;
                        zb[(size_t)(g * 64 + cc) * S + pos] = z0;
                        zb[(size_t)(g * 64 + cc + 1) * S + pos] = z1;
                    } else {
                        typedef f16 f16x4 __attribute__((ext_vector_type(4)));
                        f16x4 h; h[0] = (f16)v[0]; h[1] = (f16)v[1]; h[2] = (f16)v[2]; h[3] = (f16)v[3];
                        *(f16x4*)(poolp + (size_t)lt * 512 + (n - 3968)) = h;
                    }
                }
            }
        }
    }
}

__device__ __forceinline__ float shiftv(const f16* __restrict__ raw, int lt, int t, int S, int col, float mu) {
    const float p = (float)raw[(size_t)lt * 1920 + col];
    const float pr = t > 0 ? (float)raw[(size_t)(lt - 1) * 1920 + col] : 0.f;
    const float nx = t < S - 1 ? (float)raw[(size_t)(lt + 1) * 1920 + col] : 0.f;
    return p + (0.5f * (pr + nx) - p) * mu;
}

__device__ __forceinline__ void lin_pool_phase(const Ctx& C, const Params& P, int layer) {
    unsigned char* R = P.ws + WS_R;
    const f16* raw = (const f16*)(R + R_RAW); bf16_t* lin = (bf16_t*)(R + R_LIN);
    const f16* poolp = (const f16*)(R + R_POOLP); bf16_t* ypool = (bf16_t*)(R + R_YB) + 3 * SZ512;
    const float* mu = P.in[13] + (size_t)layer * 1920; const float* pscale = P.in[26] + (size_t)layer * 512;
    const int gsz = C.nblk * 256, gid = C.bid * 256 + C.tid;
    for (int e = gid; e < TP * 384; e += gsz) {
        const int lt = e / 384, c = e % 384, col = 1536 + c;
        const int pos = pos_of(lt), S = lt < 8192 ? 8192 : 4096;
        float v = shiftv(raw, lt, pos, S, col, mu[col]);
        if (c < 128) v = tanhf(v); else if (c >= 256) v = sigmoidf_(v);
        lin[(size_t)lt * 384 + c] = f2bf(v);
    }
    for (int e = gid; e < TP * 512; e += gsz) {
        const int lt = e >> 9, c = e & 511, g = c >> 7, half = 1 << g;
        const int pos = pos_of(lt), S = lt < 8192 ? 8192 : 4096;
        const int lo = max(pos - half, 0), hi = min(pos + half, S);
        float s = 0.f;
        for (int tt = lo; tt < hi; ++tt) s += (float)poolp[(size_t)(lt - pos + tt) * 512 + c];
        const float x = (float)poolp[(size_t)lt * 512 + c];
        ypool[(size_t)lt * 512 + c] = f2bf((s / (float)(hi - lo) - x) * pscale[c]);
    }
}

__device__ __forceinline__ void lora_phase(const Ctx& C, const Params& P, int layer, unsigned char* smem) {
    unsigned char* R = P.ws + WS_R;
    const bf16_t* lin = (const bf16_t*)(R + R_LIN); f16* wa = (f16*)(R + R_WA); f16* gbuf = (f16*)(R + R_G);
    const bf16_t* W = wl(P, layer);
    const int lane = C.tid & 63, wave = C.tid >> 6, wm = wave >> 1, wn = wave & 1, fr = lane & 15, fq = lane >> 4;
    for (int t = C.bid; t < 5 * MT * 4; t += C.nblk) {
        const int which = t / (MT * 4), tt = t % (MT * 4), tm = tt >> 2, tn = tt & 3;
        const bf16_t* Bt; int K, acol; const float* bias = nullptr; f16* dst;
        if (which < 2) { Bt = W + OW_W2T + (size_t)which * 512 * 64; K = 64; acol = which * 64; bias = P.in[14] + (size_t)(layer * 2 + which) * 512; dst = wa + (size_t)which * SZ512; }
        else if (which < 4) { const int d = which - 2; Bt = W + OW_A2T + (size_t)d * 512 * 64; K = 64; acol = 128 + d * 64; bias = P.in[16] + (size_t)(layer * 2 + d) * 512; dst = wa + (size_t)which * SZ512; }
        else { Bt = W + OW_G2T; K = 128; acol = 256; dst = gbuf; }
        f32x4 acc[4][4];
        gemm_core<4, true>(C, acc, lin + (size_t)tm * 128 * 384 + acol, 384, Bt + (size_t)tn * 128 * K, K, K, smem);
#pragma unroll
        for (int i = 0; i < 4; ++i) {
            const int lt = tm * 128 + wm * 64 + i * 16 + fr;
#pragma unroll
            for (int jn = 0; jn < 4; ++jn) {
                const int n = tn * 128 + wn * 64 + jn * 16 + fq * 4;
                typedef f16 f16x4 __attribute__((ext_vector_type(4)));
                f16x4 h;
#pragma unroll
                for (int r = 0; r < 4; ++r) {
                    float v = acc[i][jn][r];
                    if (which < 2) {
                        const float z = bias[n + r] + v, nz = -z;
                        const float sp = fmaxf(nz, 0.f) + log1pf(expf(-fabsf(nz)));
                        v = expf(-expf(-sp - 0.5f));
                    } else if (which < 4) { v = 1.0f / (1.0f + expf(-(bias[n + r] + v))); }
                    h[r] = (f16)v;
                }
                *(f16x4*)(dst + (size_t)lt * 512 + n) = h;
            }
        }
    }
}

__device__ __forceinline__ void attn_items(const Ctx& C, const Params& P, int layer, unsigned char* smem) {
    unsigned char* R = P.ws + WS_R;
    const bf16_t* Qall = (const bf16_t*)(R + R_Q); const bf16_t* Kall = (const bf16_t*)(R + R_K); const bf16_t* Vall = (const bf16_t*)(R + R_VT);
    bf16_t* ydiff = (bf16_t*)(R + R_YB) + 1 * SZ512;
    const int tid = C.tid, lane = tid & 63, wave = tid >> 6, comp = wave & 1, rg = wave >> 1, fr = lane & 15, fq = lane >> 4;
    const float lam_init = layer == 0 ? 0.2f : (0.8f - 0.6f * 0.7408182206817179f);
    float lam_full;
    {
        const float* lm = P.in[24] + (size_t)layer * 256;
        float s1 = 0.f, s2 = 0.f;
        for (int i = 0; i < 64; ++i) { s1 += lm[i] * lm[64 + i]; s2 += lm[128 + i] * lm[192 + i]; }
        lam_full = expf(s1) - expf(s2) + lam_init;
    }
    const float* normg = P.in[25] + (size_t)layer * 128;
    for (int item = C.bid; item < 2560; item += C.nblk) {
        int sq, h, qb;
        if (item < 512) { sq = 0; h = item >> 7; qb = item & 127; } else { const int i2 = item - 512; sq = 1 + (i2 >> 8); h = (i2 >> 6) & 3; qb = i2 & 63; }
        const int lt0 = seqbase_of(sq), S = seqlen_of(sq);
        const bf16_t* Qb = Qall + (size_t)lt0 * 512; const bf16_t* Kb = Kall + (size_t)lt0 * 512; const bf16_t* Vb = Vall + (size_t)lt0 * 512 + (size_t)h * 128 * S;
        const int q0 = qb * 64 + rg * 32;
        bf16x8 bq[2][2];
#pragma unroll
        for (int qs = 0; qs < 2; ++qs)
#pragma unroll
            for (int ks = 0; ks < 2; ++ks) bq[qs][ks] = *(const bf16x8*)(Qb + ((size_t)(h * 2 + comp) * S + q0 + qs * 16 + fr) * 64 + ks * 32 + fq * 8);
        float m_run[2] = {-1e30f, -1e30f}, l_run[2] = {0.f, 0.f};
        f32x4 O[8][2];
#pragma unroll
        for (int a = 0; a < 8; ++a) { O[a][0] = (f32x4){0.f, 0.f, 0.f, 0.f}; O[a][1] = (f32x4){0.f, 0.f, 0.f, 0.f}; }
        u32x4 rk[4], rv[4];
        const int lrow = tid >> 3, lkc = (tid & 7) * 8;
#pragma unroll
        for (int i = 0; i < 4; ++i) {
            const int row = lrow + 32 * i, cm = row >> 6, key = row & 63;
            rk[i] = *(const u32x4*)(Kb + ((size_t)(h * 2 + cm) * S + key) * 64 + lkc);
            rv[i] = *(const u32x4*)(Vb + (size_t)row * S + lkc);
        }
        for (int kt0 = 0; kt0 < S; kt0 += 64) {
            __syncthreads();
#pragma unroll
            for (int i = 0; i < 4; ++i) {
                const int row = lrow + 32 * i;
                *(u32x4*)(smem + row * 144 + lkc * 2) = rk[i];
                *(u32x4*)(smem + 18432 + row * 144 + lkc * 2) = rv[i];
            }
            __syncthreads();
            if (kt0 + 64 < S) {
#pragma unroll
                for (int i = 0; i < 4; ++i) {
                    const int row = lrow + 32 * i, cm = row >> 6, key = row & 63;
                    rk[i] = *(const u32x4*)(Kb + ((size_t)(h * 2 + cm) * S + kt0 + 64 + key) * 64 + lkc);
                    rv[i] = *(const u32x4*)(Vb + (size_t)row * S + kt0 + 64 + lkc);
                }
            }
            f32x4 st[4][2];
#pragma unroll
            for (int t = 0; t < 4; ++t) {
                st[t][0] = (f32x4){0.f, 0.f, 0.f, 0.f}; st[t][1] = (f32x4){0.f, 0.f, 0.f, 0.f};
#pragma unroll
                for (int ks = 0; ks < 2; ++ks) {
                    const bf16x8 kf = *(const bf16x8*)(smem + (comp * 64 + t * 16 + fr) * 144 + (ks * 32 + fq * 8) * 2);
                    st[t][0] = __builtin_amdgcn_mfma_f32_16x16x32_bf16(kf, bq[0][ks], st[t][0], 0, 0, 0);
                    st[t][1] = __builtin_amdgcn_mfma_f32_16x16x32_bf16(kf, bq[1][ks], st[t][1], 0, 0, 0);
                }
            }
            bf16x8 pb[2][2];
#pragma unroll
            for (int qs = 0; qs < 2; ++qs) {
                float mx = -1e30f;
#pragma unroll
                for (int t = 0; t < 4; ++t)
#pragma unroll
                    for (int r = 0; r < 4; ++r) mx = fmaxf(mx, st[t][qs][r]);
                mx = fmaxf(mx, __shfl_xor(mx, 16)); mx = fmaxf(mx, __shfl_xor(mx, 32));
                const float mnew = fmaxf(m_run[qs], mx);
                const float alpha = __builtin_amdgcn_exp2f(m_run[qs] - mnew);
                m_run[qs] = mnew;
                float ls = 0.f;
                float pv[4][4];
#pragma unroll
                for (int t = 0; t < 4; ++t)
#pragma unroll
                    for (int r = 0; r < 4; ++r) { pv[t][r] = __builtin_amdgcn_exp2f(st[t][qs][r] - mnew); ls += pv[t][r]; }
                l_run[qs] = l_run[qs] * alpha + ls;
#pragma unroll
                for (int a = 0; a < 8; ++a) O[a][qs] = O[a][qs] * alpha;
#pragma unroll
                for (int u = 0; u < 2; ++u) {
                    union { bf16x8 v; unsigned w[4]; } pk;
                    pk.w[0] = pack2bf(pv[2 * u][0], pv[2 * u][1]); pk.w[1] = pack2bf(pv[2 * u][2], pv[2 * u][3]);
                    pk.w[2] = pack2bf(pv[2 * u + 1][0], pv[2 * u + 1][1]); pk.w[3] = pack2bf(pv[2 * u + 1][2], pv[2 * u + 1][3]);
                    pb[qs][u] = pk.v;
                }
            }
#pragma unroll
            for (int u = 0; u < 2; ++u)
#pragma unroll
                for (int a = 0; a < 8; ++a) {
                    union { bf16x8 v; uint2 h[2]; } vf;
                    vf.h[0] = *(const uint2*)(smem + 18432 + (a * 16 + fr) * 144 + (u * 32 + fq * 4) * 2);
                    vf.h[1] = *(const uint2*)(smem + 18432 + (a * 16 + fr) * 144 + (u * 32 + 16 + fq * 4) * 2);
                    O[a][0] = __builtin_amdgcn_mfma_f32_16x16x32_bf16(vf.v, pb[0][u], O[a][0], 0, 0, 0);
                    O[a][1] = __builtin_amdgcn_mfma_f32_16x16x32_bf16(vf.v, pb[1][u], O[a][1], 0, 0, 0);
                }
        }
#pragma unroll
        for (int qs = 0; qs < 2; ++qs) {
            float l = l_run[qs]; l += __shfl_xor(l, 16); l += __shfl_xor(l, 32);
            const float inv = 1.0f / l;
#pragma unroll
            for (int a = 0; a < 8; ++a) O[a][qs] = O[a][qs] * inv;
        }
        __syncthreads();
        float* Ox = (float*)smem;
        if (comp == 1) {
#pragma unroll
            for (int qs = 0; qs < 2; ++qs)
#pragma unroll
                for (int a = 0; a < 8; ++a)
#pragma unroll
                    for (int r = 0; r < 4; ++r) Ox[(rg * 128 + a * 16 + fq * 4 + r) * 32 + qs * 16 + fr] = O[a][qs][r];
        }
        __syncthreads();
        if (comp == 0) {
#pragma unroll
            for (int qs = 0; qs < 2; ++qs) {
                float ss = 0.f;
#pragma unroll
                for (int a = 0; a < 8; ++a)
#pragma unroll
                    for (int r = 0; r < 4; ++r) {
                        const float o = O[a][qs][r] - lam_full * Ox[(rg * 128 + a * 16 + fq * 4 + r) * 32 + qs * 16 + fr];
                        O[a][qs][r] = o; ss += o * o;
                    }
                ss += __shfl_xor(ss, 16); ss += __shfl_xor(ss, 32);
                const float sc = rsqrtf(ss * (1.0f / 128.0f) + 1e-5f) * (1.0f - lam_init);
                const int lt = lt0 + q0 + qs * 16 + fr;
#pragma unroll
                for (int a = 0; a < 8; ++a) {
                    const int dv = a * 16 + fq * 4;
                    const float4 g = *(const float4*)(normg + dv);
                    uint2 w; w.x = pack2bf(O[a][qs][0] * sc * g.x, O[a][qs][1] * sc * g.y); w.y = pack2bf(O[a][qs][2] * sc * g.z, O[a][qs][3] * sc * g.w);
                    *(uint2*)(ydiff + (size_t)lt * 512 + h * 128 + dv) = w;
                }
            }
        }
    }
    __syncthreads();
}

__device__ __forceinline__ void fft_items(const Ctx& C, const Params& P, unsigned char* smem) {
    unsigned char* R = P.ws + WS_R;
    typedef f16 f16x2 __attribute__((ext_vector_type(2)));
    const f16x2* Zall = (const f16x2*)(R + R_ZC);
    bf16_t* yf = (bf16_t*)(R + R_YB) + 2 * SZ512;
    const float2* tw = (const float2*)(P.ws + WS_TW);
    float2* sm = (float2*)smem;
    const int tid = C.tid;
    for (int item = C.bid; item < NSEQ * 256; item += C.nblk) {
        const int sq = item >> 8, col = item & 255, g = col >> 6, cc = col & 63;
        const int lt0 = seqbase_of(sq), S = seqlen_of(sq), lg = sq == 0 ? 13 : 12;
        const f16x2* z = Zall + (size_t)lt0 * 256 + (size_t)col * S;
        __syncthreads();
        for (int s = tid; s < S; s += 256) { const f16x2 v = z[s]; sm[__brev((unsigned)s) >> (32 - lg)] = make_float2((float)v[0], (float)v[1]); }
        __syncthreads();
        for (int st = 0; st < lg; ++st) {
            const int half = 1 << st, tshift = 12 - st;
            for (int b = tid; b < (S >> 1); b += 256) {
                const int j = b & (half - 1), i0 = ((b >> st) << (st + 1)) + j, i1 = i0 + half;
                const float2 w = tw[j << tshift], u = sm[i0], x = sm[i1];
                const float2 tv = make_float2(w.x * x.x - w.y * x.y, w.x * x.y + w.y * x.x);
                sm[i0] = make_float2(u.x + tv.x, u.y + tv.y); sm[i1] = make_float2(u.x - tv.x, u.y - tv.y);
            }
            __syncthreads();
        }
        const float nrm = rsqrtf((float)S * 128.0f);
        for (int k = tid; k < S; k += 256) {
            const float2 a = sm[k], b = sm[(S - k) & (S - 1)];
            bf16_t* row = yf + (size_t)(lt0 + k) * 512 + g * 128;
            if (cc == 0) { row[0] = f2bf(0.5f * (a.x + b.x) * nrm); row[64] = f2bf(0.5f * (a.y + b.y) * nrm); }
            else { row[cc] = f2bf(a.x * nrm); row[128 - cc] = f2bf(b.x * nrm); }
        }
    }
    __syncthreads();
}

__device__ __forceinline__ void scan_items(const Ctx& C, const Params& P, int layer, unsigned char* smem) {
    unsigned char* R = P.ws + WS_R;
    const f16* raw = (const f16*)(R + R_RAW); const f16* wa = (const f16*)(R + R_WA); f16* yfb = (f16*)(R + R_YFB);
    const float* mu = P.in[13] + (size_t)layer * 1920; const float* k_k = P.in[19] + (size_t)layer * 512; const float* k_a = P.in[20] + (size_t)layer * 512;
    constexpr int CH = 32;
    float* vec = (float*)smem;
    float* vbuf = (float*)(smem + 40960);
    float* ybuf = (float*)(smem + 45056);
    const int tid = C.tid, lane = tid & 63, wave = tid >> 6;
    const int row = tid >> 3, q = tid & 7;
    for (int item = C.bid; item < NSEQ * 32; item += C.nblk) {
        const int sq = item >> 5, h = (item >> 2) & 7, d = (item >> 1) & 1, rgp = item & 1;
        const int lt0 = seqbase_of(sq), S = seqlen_of(sq);
        const int c = h * 64 + lane;
        const float mu_r = mu[c], mu_k = mu[512 + c], kkw = k_k[c], kaw = k_a[c];
        const int vcol = 1024 + h * 64 + rgp * 32 + (lane & 31); const float mu_v = mu[vcol];
        const f16* wdec = wa + (size_t)d * SZ512; const f16* aact = wa + (size_t)(2 + d) * SZ512;
        f16* ydst = yfb + (size_t)d * SZ512;
        float s[8];
#pragma unroll
        for (int j = 0; j < 8; ++j) s[j] = 0.f;
        for (int c0 = 0; c0 <= S; c0 += CH) {
            if (c0 > 0) {
#pragma unroll
                for (int ii = 0; ii < 4; ++ii) {
                    const int i = (tid >> 5) + 8 * ii, rr = tid & 31, tstep = c0 - CH + i;
                    const int t = d == 0 ? tstep : S - 1 - tstep;
                    ydst[(size_t)(lt0 + t) * 512 + h * 64 + rgp * 32 + rr] = (f16)ybuf[i * 32 + rr];
                }
            }
            if (c0 < S) {
#pragma unroll 2
                for (int ii = 0; ii < 8; ++ii) {
                    const int i = wave + 4 * ii, tstep = c0 + i;
                    const int t = d == 0 ? tstep : S - 1 - tstep, lt = lt0 + t;
                    const float r = shiftv(raw, lt, t, S, c, mu_r);
                    const float k = shiftv(raw, lt, t, S, 512 + c, mu_k);
                    const float kr = k * kkw;
                    const float nn = fmaxf(sqrtf(wsum(kr * kr)), 1e-12f);
                    const float kk = kr / nn;
                    const float a = (float)aact[(size_t)lt * 512 + c], w = (float)wdec[(size_t)lt * 512 + c];
                    vec[(0 * CH + i) * 64 + lane] = kk;
                    vec[(1 * CH + i) * 64 + lane] = w;
                    vec[(2 * CH + i) * 64 + lane] = kk * a;
                    vec[(3 * CH + i) * 64 + lane] = k * (1.0f + (a - 1.0f) * kaw);
                    vec[(4 * CH + i) * 64 + lane] = r;
                    if (lane < 32) vbuf[i * 32 + lane] = shiftv(raw, lt, t, S, vcol, mu_v);
                }
            }
            __syncthreads();
            if (c0 < S) {
#pragma unroll 2
                for (int i = 0; i < CH; ++i) {
                    const float4* vp = (const float4*)(vec + i * 64 + q * 8);
                    const float4 kk0 = vp[0], kk1 = vp[1];
                    const float4 w0 = vp[CH * 16], w1 = vp[CH * 16 + 1];
                    const float4 b0 = vp[2 * CH * 16], b1 = vp[2 * CH * 16 + 1];
                    const float4 kd0 = vp[3 * CH * 16], kd1 = vp[3 * CH * 16 + 1];
                    const float4 r0 = vp[4 * CH * 16], r1 = vp[4 * CH * 16 + 1];
                    const float vv = vbuf[i * 32 + row];
                    float sa = s[0] * kk0.x + s[1] * kk0.y + s[2] * kk0.z + s[3] * kk0.w + s[4] * kk1.x + s[5] * kk1.y + s[6] * kk1.z + s[7] * kk1.w;
                    sa = -red8(sa);
                    s[0] = s[0] * w0.x + sa * b0.x + vv * kd0.x; s[1] = s[1] * w0.y + sa * b0.y + vv * kd0.y;
                    s[2] = s[2] * w0.z + sa * b0.z + vv * kd0.z; s[3] = s[3] * w0.w + sa * b0.w + vv * kd0.w;
                    s[4] = s[4] * w1.x + sa * b1.x + vv * kd1.x; s[5] = s[5] * w1.y + sa * b1.y + vv * kd1.y;
                    s[6] = s[6] * w1.z + sa * b1.z + vv * kd1.z; s[7] = s[7] * w1.w + sa * b1.w + vv * kd1.w;
                    float y = s[0] * r0.x + s[1] * r0.y + s[2] * r0.z + s[3] * r0.w + s[4] * r1.x + s[5] * r1.y + s[6] * r1.z + s[7] * r1.w;
                    y = red8(y);
                    if (q == 0) ybuf[i * 32 + row] = y;
                }
            }
            __syncthreads();
        }
    }
}

__device__ __forceinline__ void finish_phase(const Ctx& C, const Params& P, int layer) {
    unsigned char* R = P.ws + WS_R;
    const f16* raw = (const f16*)(R + R_RAW); const f16* wa = (const f16*)(R + R_WA); const f16* gbuf = (const f16*)(R + R_G); const f16* yfb = (const f16*)(R + R_YFB);
    bf16_t* yr = (bf16_t*)(R + R_YB);
    const float* mu = P.in[13] + (size_t)layer * 1920; const float* k_a = P.in[20] + (size_t)layer * 512; const float* r_k = P.in[21] + (size_t)layer * 512;
    const float* lg = P.in[22] + (size_t)layer * 512; const float* lb = P.in[23] + (size_t)layer * 512;
    const int lane = C.tid & 63, wave = C.tid >> 6;
    for (int it = C.bid * 4 + wave; it < TP * 8; it += C.nblk * 4) {
        const int lt = it >> 3, h = it & 7, c = h * 64 + lane;
        const int pos = pos_of(lt), S = lt < 8192 ? 8192 : 4096;
        const float r = shiftv(raw, lt, pos, S, c, mu[c]), k = shiftv(raw, lt, pos, S, 512 + c, mu[512 + c]), v = shiftv(raw, lt, pos, S, 1024 + c, mu[1024 + c]);
        const float af = (float)wa[2 * SZ512 + (size_t)lt * 512 + c], ab = (float)wa[3 * SZ512 + (size_t)lt * 512 + c];
        const float ka = k_a[c];
        const float ksum = k * (1.f + (af - 1.f) * ka) + k * (1.f + (ab - 1.f) * ka);
        const float y = (float)yfb[(size_t)lt * 512 + c] + (float)yfb[SZ512 + (size_t)lt * 512 + c];
        const float ym = wsum(y) * (1.0f / 64.0f);
        const float dy = y - ym;
        const float yv = wsum(dy * dy) * (1.0f / 64.0f);
        const float yn = dy * rsqrtf(yv + 64e-5f) * lg[c] + lb[c];
        const float bonus = wsum(r * (0.5f * ksum) * r_k[c]) * v;
        const float g = (float)gbuf[(size_t)lt * 512 + c];
        yr[(size_t)lt * 512 + c] = f2bf((yn + bonus) * g);
    }
}

__device__ __forceinline__ void merge_phase(const Ctx& C, const Params& P, int layer, unsigned char* smem) {
    unsigned char* R = P.ws + WS_R;
    const bf16_t* hmod = (const bf16_t*)(P.ws + WS_HMOD); const bf16_t* yb = (const bf16_t*)(R + R_YB); bf16_t* merged = (bf16_t*)(R + R_MERGED);
    const bf16_t* W = wl(P, layer);
    const int lane = C.tid & 63, wave = C.tid >> 6, wm = wave >> 1, wn = wave & 1, fr = lane & 15, fq = lane >> 4;
    for (int t = C.bid; t < MT * 16; t += C.nblk) {
        const int tm = t >> 4, tn = t & 15;
        f32x4 m[4][2];
#pragma unroll
        for (int i = 0; i < 4; ++i) { m[i][0] = (f32x4){0.f, 0.f, 0.f, 0.f}; m[i][1] = (f32x4){0.f, 0.f, 0.f, 0.f}; }
        for (int n = 0; n < 4; ++n) {
            f32x4 ag[4][2], ap[4][2];
            gemm_core<2, true>(C, ag, hmod + (size_t)tm * 128 * 1024, 1024, W + OW_WIN + (size_t)(4480 + n * 1024 + tn * 64) * 1024, 1024, 1024, smem);
#pragma unroll
            for (int i = 0; i < 4; ++i)
#pragma unroll
                for (int j = 0; j < 2; ++j)
#pragma unroll
                    for (int r = 0; r < 4; ++r) ag[i][j][r] = sigmoidf_(ag[i][j][r]);
            gemm_core<2, true>(C, ap, yb + (size_t)n * SZ512 + (size_t)tm * 128 * 512, 512, W + OW_WBR + (size_t)n * 1024 * 512 + (size_t)(tn * 64) * 512, 512, 512, smem);
#pragma unroll
            for (int i = 0; i < 4; ++i)
#pragma unroll
                for (int j = 0; j < 2; ++j) m[i][j] += ag[i][j] * ap[i][j];
        }
#pragma unroll
        for (int i = 0; i < 4; ++i) {
            const int lt = tm * 128 + wm * 64 + i * 16 + fr;
#pragma unroll
            for (int j = 0; j < 2; ++j) {
                const int n = tn * 64 + wn * 32 + j * 16 + fq * 4;
                uint2 w; w.x = pack2bf(m[i][j][0], m[i][j][1]); w.y = pack2bf(m[i][j][2], m[i][j][3]);
                *(uint2*)(merged + (size_t)lt * 1024 + n) = w;
            }
        }
    }
}

constexpr int PH_PER_LAYER = 15, PH_PER_PASS = 2 * PH_PER_LAYER + 1, NPHASE = 1 + NPASS * PH_PER_PASS;

__global__ void __launch_bounds__(256, 2) mk_forward(Params P0, int ph_lo, int ph_hi) {
    __shared__ __attribute__((aligned(16))) unsigned char smem[65536];
    for (int ph = ph_lo; ph < ph_hi; ++ph) {
        if (ph > ph_lo) cg::this_grid().sync();
        int z = 0; asm volatile("" : "+s"(z));
        Ctx C; C.tid = (int)threadIdx.x + z; C.bid = (int)blockIdx.x + z; C.nblk = (int)gridDim.x + z;
        Params P;
#pragma unroll
        for (int i = 0; i < 29; ++i) P.in[i] = P0.in[i] + z;
        P.out = P0.out + z; P.ws = P0.ws + z;
        if (ph == 0) { prep_phase(C, P, smem); continue; }
        const int q = ph - 1, pass = q / PH_PER_PASS, r = q % PH_PER_PASS;
        if (r == PH_PER_PASS - 1) { norm_phase(C, P, pass, P.in[6] + (size_t)(1 * 3 + 2) * 1024, P.in[7] + (size_t)(1 * 3 + 2) * 1024, 0, -1, false); continue; }
        const int layer = r / PH_PER_LAYER, lp = r % PH_PER_LAYER;
        const bf16_t* W = wl(P, layer);
        const float* lng = P.in[6] + (size_t)layer * 3 * 1024; const float* lnb = P.in[7] + (size_t)layer * 3 * 1024;
        unsigned char* R = P.ws + WS_R;
        switch (lp) {
            case 0:
                if (layer == 0) norm_phase(C, P, pass, nullptr, nullptr, 0, 0, true);
                else norm_phase(C, P, pass, P.in[6] + (size_t)((layer - 1) * 3 + 2) * 1024, P.in[7] + (size_t)((layer - 1) * 3 + 2) * 1024, layer, 0, false);
                break;
            case 1: ffn_up_phase(C, P, W + OW_FA_IN, smem); break;
            case 2: resid_gemm_phase(C, P, pass, (const bf16_t*)(R + R_ACT), 2816, W + OW_FA_OUT, layer, 0, 0.5f, smem); break;
            case 3: norm_phase(C, P, pass, lng, lnb, layer, 1, false); break;
            case 4: win_phase(C, P, layer, smem); break;
            case 5: lin_pool_phase(C, P, layer); break;
            case 6: lora_phase(C, P, layer, smem); break;
            case 7: attn_items(C, P, layer, smem); fft_items(C, P, smem); break;
            case 8: scan_items(C, P, layer, smem); break;
            case 9: finish_phase(C, P, layer); break;
            case 10: merge_phase(C, P, layer, smem); break;
            case 11: resid_gemm_phase(C, P, pass, (const bf16_t*)(R + R_MERGED), 1024, W + OW_WOUT, layer, 1, 1.0f, smem); break;
            case 12: norm_phase(C, P, pass, lng + 1024, lnb + 1024, layer, 2, false); break;
            case 13: ffn_up_phase(C, P, W + OW_FB_IN, smem); break;
            default: resid_gemm_phase(C, P, pass, (const bf16_t*)(R + R_ACT), 2816, W + OW_FB_OUT, layer, 2, 0.5f, smem); break;
        }
    }
}

extern "C" void kernel_launch(void* const* d_in, const int* in_sizes, int n_in, void* d_out, int out_size, void* d_ws, size_t ws_size, hipStream_t stream) {
    static int grid_blocks = 0;
    if (!grid_blocks) {
        int dev = 0, cus = 0, per_cu = 0;
        hipGetDevice(&dev);
        hipDeviceGetAttribute(&cus, hipDeviceAttributeMultiprocessorCount, dev);
        hipOccupancyMaxActiveBlocksPerMultiprocessor(&per_cu, mk_forward, 256, 0);
        if (per_cu < 1) per_cu = 1;
        if (per_cu > 2) per_cu = 2;
        grid_blocks = cus * per_cu;
    }
    Params p{};
    for (int i = 0; i < 29; ++i) p.in[i] = (const float*)d_in[i];
    p.out = (float*)d_out; p.ws = (unsigned char*)d_ws;
#if ONE_LAUNCH
    int lo = 0, hi = NPHASE;
    void* args[] = {&p, &lo, &hi};
    hipError_t e = hipLaunchCooperativeKernel((void*)mk_forward, dim3(grid_blocks), dim3(256), args, 0, stream);
    if (e != hipSuccess) fprintf(stderr, "cooperative launch failed: %s (grid %d)\n", hipGetErrorString(e), grid_blocks);
#else
    for (int ph = 0; ph < NPHASE; ++ph) {
        int lo = ph, hi = ph + 1;
        void* args[] = {&p, &lo, &hi};
        hipLaunchCooperativeKernel((void*)mk_forward, dim3(grid_blocks), dim3(256), args, 0, stream);
    }
#endif
}
```

```cpp
#include <hip/hip_runtime.h>
#include <hip/hip_cooperative_groups.h>
#include <cstdio>
#include <cstdint>
namespace cg = cooperative_groups;

typedef unsigned short bf16_t;
typedef _Float16 f16;
typedef short bf16x8 __attribute__((ext_vector_type(8)));
typedef float f32x4 __attribute__((ext_vector_type(4)));
typedef unsigned u32x4 __attribute__((ext_vector_type(4)));
typedef unsigned u32x2 __attribute__((ext_vector_type(2)));

#ifndef ONE_LAUNCH
#define ONE_LAUNCH 1
#endif
#ifndef PROBE_MASK
#define PROBE_MASK 0
#endif

constexpr int TP = 40960;
constexpr int NPASS = 2;
constexpr int NSEQ = 9;
constexpr int MT = TP / 128;
constexpr int N_IN_FULL = 8576;
constexpr float ALPHA = 1.41421356237f;

constexpr size_t OW_FA_IN = 0, OW_FA_OUT = 5767168, OW_FB_IN = 8650752, OW_FB_OUT = 14417920, OW_WIN = 17301504,
                 OW_WBR = 26083328, OW_WOUT = 28180480, OW_W2T = 29229056, OW_A2T = 29294592, OW_G2T = 29360128, WL_TOTAL = 29425664;
constexpr size_t WS_W = 0, WS_TW = 117702656, WS_MOD = 117735424, WS_HMOD = 119062528, WS_R = 202948608, WS_INVN = 1062780928, WS_CTR = 1064091648;
constexpr size_t R_RAW = 0, R_LIN = 157286400, R_WA = 188743680, R_G = 356515840, R_Q = 398458880, R_K = 440401920, R_VT = 482344960,
                 R_YFB = 524288000, R_ZC = 608174080, R_POOLP = 650117120, R_YB = 692060160, R_ACT = 0, R_MERGED = 0;
constexpr size_t SZ512 = (size_t)TP * 512;

struct Params { const float* in[29]; float* out; unsigned char* ws; };
struct Ctx { int tid, bid, nblk, wave_s; };
__device__ __forceinline__ int tid_now(int wave_s, int z) { return wave_s * 64 + (int)__builtin_amdgcn_mbcnt_hi(~0u, __builtin_amdgcn_mbcnt_lo(~0u, (unsigned)z)); }
typedef const float* const __attribute__((address_space(4)))* ptrtab_t;
struct PV { ptrtab_t tab; float* out; unsigned char* ws;
    __device__ __forceinline__ const float* inp(int i) const { return tab[i]; } };
constexpr int NT = 512, NWV = 8;
extern __shared__ __attribute__((aligned(16))) unsigned char dyn_smem[];
constexpr int LDS_BYTES = 131072;

__device__ __forceinline__ bf16_t f2bf(float f) { unsigned u = __float_as_uint(f); u += 0x7fffu + ((u >> 16) & 1u); return (bf16_t)(u >> 16); }
__device__ __forceinline__ float bf2f(bf16_t b) { return __uint_as_float(((unsigned)b) << 16); }
__device__ __forceinline__ unsigned pack2bf(float a, float b) { return (unsigned)f2bf(a) | ((unsigned)f2bf(b) << 16); }
__device__ __forceinline__ float wsum(float v) {
#pragma unroll
    for (int o = 32; o > 0; o >>= 1) v += __shfl_xor(v, o);
    return v;
}
__device__ __forceinline__ float sigmoidf_(float x) { return 1.0f / (1.0f + __expf(-x)); }
template <int CTRL> __device__ __forceinline__ float dppf(float v) { return __int_as_float(__builtin_amdgcn_update_dpp(0, __float_as_int(v), CTRL, 0xF, 0xF, true)); }
__device__ __forceinline__ float red8(float v) { v += dppf<0xB1>(v); v += dppf<0x4E>(v); v += dppf<0x141>(v); return v; }

__device__ __forceinline__ int grow_of(int pass, int lt) { return lt < 8192 ? pass * 8192 + lt : 16384 + pass * 32768 + (lt - 8192); }
__device__ __forceinline__ int brow_of(int pass, int lt) { return lt < 8192 ? pass : 2 + pass * 8 + ((lt - 8192) >> 12); }
__device__ __forceinline__ int pos_of(int lt) { return lt < 8192 ? lt : ((lt - 8192) & 4095); }
__device__ __forceinline__ int seqbase_of(int sq) { return sq == 0 ? 0 : 8192 + (sq - 1) * 4096; }
__device__ __forceinline__ int seqlen_of(int sq) { return sq == 0 ? 8192 : 4096; }

__device__ __forceinline__ bf16_t* wl(const PV& P, int layer) { return (bf16_t*)(P.ws + WS_W) + (size_t)layer * WL_TOTAL; }

template <int NJ, bool SWAP>
__device__ __forceinline__ void gemm_core(const Ctx& C, f32x4 (&acc)[4][NJ], const bf16_t* __restrict__ A, int lda, const bf16_t* __restrict__ B, int ldb, int K, unsigned char* smem) {
    const int tid = C.tid & 255, lane = tid & 63, wave = tid >> 6, wm = wave >> 1, wn = wave & 1, fr = lane & 15, fq = lane >> 4;
    smem += (C.tid >> 8) * 36864;
    u32x4 ra[4], rb[NJ];
#pragma unroll
    for (int i = 0; i < 4; ++i)
#pragma unroll
        for (int j = 0; j < NJ; ++j) acc[i][j] = (f32x4){0.f, 0.f, 0.f, 0.f};
    const int lrow = tid >> 3, lkc = (tid & 7) * 8;
#pragma unroll
    for (int i = 0; i < 4; ++i) ra[i] = *(const u32x4*)(A + (size_t)(lrow + 32 * i) * lda + lkc);
#pragma unroll
    for (int i = 0; i < NJ; ++i) rb[i] = *(const u32x4*)(B + (size_t)(lrow + 32 * i) * ldb + lkc);
    for (int k0 = 0; k0 < K; k0 += 64) {
        __syncthreads();
#pragma unroll
        for (int i = 0; i < 4; ++i) *(u32x4*)(smem + (lrow + 32 * i) * 144 + lkc * 2) = ra[i];
#pragma unroll
        for (int i = 0; i < NJ; ++i) *(u32x4*)(smem + 18432 + (lrow + 32 * i) * 144 + lkc * 2) = rb[i];
        __syncthreads();
        if (k0 + 64 < K) {
#pragma unroll
            for (int i = 0; i < 4; ++i) ra[i] = *(const u32x4*)(A + (size_t)(lrow + 32 * i) * lda + k0 + 64 + lkc);
#pragma unroll
            for (int i = 0; i < NJ; ++i) rb[i] = *(const u32x4*)(B + (size_t)(lrow + 32 * i) * ldb + k0 + 64 + lkc);
        }
#pragma unroll
        for (int ks = 0; ks < 2; ++ks) {
            bf16x8 af[4], bfr[NJ];
#pragma unroll
            for (int i = 0; i < 4; ++i) af[i] = *(const bf16x8*)(smem + (wm * 64 + i * 16 + fr) * 144 + (ks * 32 + fq * 8) * 2);
#pragma unroll
            for (int j = 0; j < NJ; ++j) bfr[j] = *(const bf16x8*)(smem + 18432 + (wn * NJ * 16 + j * 16 + fr) * 144 + (ks * 32 + fq * 8) * 2);
#pragma unroll
            for (int i = 0; i < 4; ++i)
#pragma unroll
                for (int j = 0; j < NJ; ++j)
                    acc[i][j] = SWAP ? __builtin_amdgcn_mfma_f32_16x16x32_bf16(bfr[j], af[i], acc[i][j], 0, 0, 0)
                                     : __builtin_amdgcn_mfma_f32_16x16x32_bf16(af[i], bfr[j], acc[i][j], 0, 0, 0);
        }
    }
}


namespace g256 {
constexpr int BK = 64, HALF = 128, HT = HALF * BK;
__device__ __forceinline__ int lds_byte(int r, int c) { int st = (r >> 4) * 2 + (c >> 5), rr = r & 15, cc = c & 31, ob = rr * 64 + cc * 2; return st * 1024 + (ob ^ (((ob >> 9) & 1) << 5)); }
__device__ __forceinline__ void stage_rc(unsigned b, unsigned& R, unsigned& Cc) { const unsigned st = b >> 10, sb = b & 1023u, swz = sb ^ (((sb >> 9) & 1u) << 5); R = (st >> 1) * 16u + (swz >> 6); Cc = (st & 1u) * 32u + ((swz & 63u) >> 1); }
}
__device__ __forceinline__ void gemm256(const Ctx& C, f32x4 (&acc)[2][2][4][2], const bf16_t* __restrict__ A, const bf16_t* __restrict__ Bt, const int K, const int brow, const int bcol) {
    using namespace g256;
    bf16_t* shm = (bf16_t*)dyn_smem;
    const int tidx = C.tid;
    #define SA(b,h) (shm+((b)*2+(h))*HT)
    #define SB(b,h) (shm+(4+(b)*2+(h))*HT)
    #define STAGE(Pp,BASE,br,kt) do{const char* _ub=(const char*)((BASE)+(long)(br)*K+(long)(kt)*BK); asm volatile("" : "+s"(_ub)); \
        __builtin_amdgcn_global_load_lds((const unsigned*)(_ub+goff0), \
          (__attribute__((address_space(3))) unsigned*)((__attribute__((address_space(3))) char*)(Pp)+tidx*16),16,0,0); \
        __builtin_amdgcn_global_load_lds((const unsigned*)(_ub+goff1), \
          (__attribute__((address_space(3))) unsigned*)((__attribute__((address_space(3))) char*)(Pp)+tidx*16+8192),16,0,0);}while(0)
    #define LDA(dst,b,h) for(int m=0;m<4;++m)for(int k=0;k<2;++k) \
      dst[m][k]=*reinterpret_cast<const bf16x8*>(a_ptr+((b)*2+(h))*16384+m*2048+k*1024)
    #define LDB(dst,b,h) for(int n=0;n<2;++n)for(int k=0;k<2;++k) \
      dst[n][k]=*reinterpret_cast<const bf16x8*>(b_ptr+((b)*2+(h))*16384+n*2048+k*1024)
    #define MMA(ai,bj,Atx,Btx) do{__builtin_amdgcn_s_setprio(1); \
      for(int m=0;m<4;++m)for(int n=0;n<2;++n)for(int k=0;k<2;++k) \
        acc[ai][bj][m][n]=__builtin_amdgcn_mfma_f32_16x16x32_bf16(Btx[n][k],Atx[m][k],acc[ai][bj][m][n],0,0,0); \
      __builtin_amdgcn_s_setprio(0);}while(0)
    #define WAIT_V(n) asm volatile("s_waitcnt vmcnt(" #n ")":::"memory")
    #define WAIT_L(n) asm volatile("s_waitcnt lgkmcnt(" #n ")":::"memory")
    #define BAR __builtin_amdgcn_s_barrier()
    #define SCHED __builtin_amdgcn_sched_barrier(0)
    const int wid = tidx >> 6, lane = tidx & 63, wr = wid >> 2, wc = wid & 3, fr = lane & 15, fq = lane >> 4;
    const int swz = (fr * 64 + fq * 16) ^ ((fr >> 3) << 5);
    const char* a_ptr = (const char*)dyn_smem + wr * 8192 + swz;
    const char* b_ptr = (const char*)dyn_smem + 65536 + wc * 4096 + swz;
#pragma unroll
    for (int a = 0; a < 2; ++a)
#pragma unroll
        for (int b = 0; b < 2; ++b)
#pragma unroll
            for (int m = 0; m < 4; ++m) { acc[a][b][m][0] = (f32x4){0.f, 0.f, 0.f, 0.f}; acc[a][b][m][1] = (f32x4){0.f, 0.f, 0.f, 0.f}; }
    bf16x8 At[4][2], B0[2][2], B1[2][2];
    const int nt = K / BK;
    unsigned goff0, goff1;
    { unsigned r0, c0, r1, c1; stage_rc((unsigned)tidx * 16u, r0, c0); stage_rc((unsigned)tidx * 16u + 8192u, r1, c1); goff0 = (r0 * (unsigned)K + c0) * 2u; goff1 = (r1 * (unsigned)K + c1) * 2u; }
    WAIT_V(0); __syncthreads();
    STAGE(SB(0,0),Bt,bcol,0); STAGE(SA(0,0),A,brow,0);
    STAGE(SB(0,1),Bt,bcol+HALF,0); STAGE(SA(0,1),A,brow+HALF,0);
    if(wr==1)BAR;
    WAIT_V(4); BAR;
    STAGE(SB(1,0),Bt,bcol,1); STAGE(SA(1,0),A,brow,1); STAGE(SB(1,1),Bt,bcol+HALF,1);
    WAIT_V(6); BAR;
    for(int t=0;t<nt-2;t+=2){
      LDB(B0,0,0); SCHED; LDA(At,0,0); STAGE(SA(1,1),A,brow+HALF,t+1);
      WAIT_L(8); BAR; WAIT_L(0); MMA(0,0,At,B0); BAR; SCHED;
      LDB(B1,0,1); STAGE(SB(0,0),Bt,bcol,t+2);
      BAR; WAIT_L(0); MMA(0,1,At,B1); BAR;
      LDA(At,0,1); STAGE(SA(0,0),A,brow,t+2);
      BAR; WAIT_L(0); MMA(1,0,At,B0); BAR; SCHED;
      STAGE(SB(0,1),Bt,bcol+HALF,t+2);
      WAIT_V(6); BAR; MMA(1,1,At,B1); BAR;
      LDB(B0,1,0); SCHED; LDA(At,1,0); STAGE(SA(0,1),A,brow+HALF,t+2);
      WAIT_L(8); BAR; WAIT_L(0); MMA(0,0,At,B0); BAR; SCHED;
      LDB(B1,1,1); STAGE(SB(1,0),Bt,bcol,t+3);
      BAR; WAIT_L(0); MMA(0,1,At,B1); BAR;
      LDA(At,1,1); STAGE(SA(1,0),A,brow,t+3);
      BAR; WAIT_L(0); MMA(1,0,At,B0); BAR; SCHED;
      STAGE(SB(1,1),Bt,bcol+HALF,t+3);
      WAIT_V(6); BAR; MMA(1,1,At,B1); BAR;
    }
    { LDB(B0,0,0); LDA(At,0,0); STAGE(SA(1,1),A,brow+HALF,nt-1);
      BAR; WAIT_L(0); MMA(0,0,At,B0); BAR;
      LDB(B1,0,1); BAR; WAIT_L(0); MMA(0,1,At,B1); BAR;
      LDA(At,0,1); WAIT_V(4); BAR; WAIT_L(0); MMA(1,0,At,B0); MMA(1,1,At,B1); BAR; }
    { LDB(B0,1,0); LDA(At,1,0); WAIT_V(2); BAR; WAIT_L(0); MMA(0,0,At,B0); BAR;
      LDB(B1,1,1); WAIT_V(0); BAR; WAIT_L(0); MMA(0,1,At,B1); BAR;
      LDA(At,1,1); BAR; WAIT_L(0); MMA(1,0,At,B0); MMA(1,1,At,B1); BAR; }
    if(wr==0)BAR;
    #undef SA
    #undef SB
    #undef STAGE
    #undef LDA
    #undef LDB
    #undef MMA
    #undef WAIT_V
    #undef WAIT_L
    #undef BAR
    #undef SCHED
}
__device__ __forceinline__ bool tile_order(int i, int G, int c, int nM, int nN, int& pm, int& pn) {
    const int nwg = nM * nN; const long L = (long)i * G + c; if (L >= nwg) return false;
    int wgid = (int)L; { const int q = nwg / 8, r = nwg % 8, xcd = wgid % 8, off = wgid / 8; wgid = (xcd < r ? xcd * (q + 1) : r * (q + 1) + (xcd - r) * q) + off; }
    const int nig = 8 * nN, gid = wgid / nig, fm = gid * 8, gsz = (nM - fm) < 8 ? (nM - fm) : 8;
    pm = fm + ((wgid % nig) % gsz); pn = (wgid % nig) / gsz; return true;
}

struct ConvJob { const float* src; int ld, K, nbegin, ncount, map; bf16_t* dst; };
__device__ __forceinline__ ConvJob conv_job(const PV& P, int j) {
    const int l = j >> 4, q = j & 15; bf16_t* W = wl(P, l); ConvJob c; c.map = 0; c.nbegin = 0;
    switch (q) {
        case 0: c.src = P.inp(8) + (size_t)l * 1024 * 5632; c.ld = 5632; c.K = 1024; c.ncount = 5632; c.dst = W + OW_FA_IN; c.map = 1; break;
        case 1: c.src = P.inp(9) + (size_t)l * 2816 * 1024; c.ld = 1024; c.K = 2816; c.ncount = 1024; c.dst = W + OW_FA_OUT; break;
        case 2: c.src = P.inp(10) + (size_t)l * 1024 * 5632; c.ld = 5632; c.K = 1024; c.ncount = 5632; c.dst = W + OW_FB_IN; c.map = 1; break;
        case 3: c.src = P.inp(11) + (size_t)l * 2816 * 1024; c.ld = 1024; c.K = 2816; c.ncount = 1024; c.dst = W + OW_FB_OUT; break;
        case 4: c.src = P.inp(12) + (size_t)l * 1024 * 8576; c.ld = 8576; c.K = 1024; c.ncount = 3456; c.dst = W + OW_WIN; break;
        case 5: c.src = P.inp(12) + (size_t)l * 1024 * 8576; c.ld = 8576; c.K = 1024; c.nbegin = 3968; c.ncount = 4608; c.dst = W + OW_WIN + (size_t)3968 * 1024; break;
        case 6: case 7: case 8: case 9: { const int n = q - 6; c.src = P.inp(27) + (size_t)(l * 4 + n) * 512 * 1024; c.ld = 1024; c.K = 512; c.ncount = 1024; c.dst = W + OW_WBR + (size_t)n * 1024 * 512; } break;
        case 10: c.src = P.inp(28) + (size_t)l * 1024 * 1024; c.ld = 1024; c.K = 1024; c.ncount = 1024; c.dst = W + OW_WOUT; break;
        case 11: case 12: { const int d = q - 11; c.src = P.inp(15) + (size_t)(l * 2 + d) * 64 * 512; c.ld = 512; c.K = 64; c.ncount = 512; c.dst = W + OW_W2T + (size_t)d * 512 * 64; } break;
        case 13: case 14: { const int d = q - 13; c.src = P.inp(17) + (size_t)(l * 2 + d) * 64 * 512; c.ld = 512; c.K = 64; c.ncount = 512; c.dst = W + OW_A2T + (size_t)d * 512 * 64; } break;
        default: c.src = P.inp(18) + (size_t)l * 128 * 512; c.ld = 512; c.K = 128; c.ncount = 512; c.dst = W + OW_G2T; break;
    }
    return c;
}

__device__ __forceinline__ void prep_phase(const Ctx& C, const PV& P, unsigned char* smem) {
    const int tid = C.tid;
    {
        int total = 0;
        for (int j = 0; j < 32; ++j) { ConvJob c = conv_job(P, j); total += (c.K >> 6) * (c.ncount >> 6); }
        float* tile = (float*)smem;
        const int tx = tid & 63, ty = tid >> 6;
        for (int t = C.bid; t < total; t += C.nblk) {
            int tt = t, j = 0; ConvJob c = conv_job(P, 0);
            for (;;) { const int n = (c.K >> 6) * (c.ncount >> 6); if (tt < n) break; tt -= n; ++j; c = conv_job(P, j); }
            const int nkt = c.K >> 6, kt = tt % nkt, nt = tt / nkt, k0 = kt * 64, n0 = nt * 64;
            int col = c.nbegin + n0 + tx;
            if (c.map) { const int np = n0 + tx, blk = np >> 5, w = np & 31, f = blk * 16 + (w & 15); col = (w < 16) ? f : 2816 + f; }
            __syncthreads();
#pragma unroll 4
            for (int i = 0; i < 8; ++i) { const int kk = ty + 8 * i; tile[kk * 65 + tx] = c.src[(size_t)(k0 + kk) * c.ld + col]; }
            __syncthreads();
#pragma unroll 4
            for (int i = 0; i < 8; ++i) { const int nn = ty + 8 * i; c.dst[(size_t)(n0 + nn) * c.K + k0 + tx] = f2bf(tile[tx * 65 + nn]); }
        }
        __syncthreads();
    }
    {
        float* wt = (float*)smem;
        float* cosT = (float*)(smem + 64 * 129 * 4);
        for (int it = C.bid; it < 2 * 4 * 16; it += C.nblk) {
            const int l = it >> 6, g = (it >> 4) & 3, kc = it & 15, k0 = kc * 64;
            const float* src = P.inp(12) + (size_t)l * 1024 * 8576 + 3456 + g * 128;
            __syncthreads();
            for (int e = tid; e < 64 * 128; e += NT) { const int kk = e >> 7, c = e & 127; wt[kk * 129 + c] = src[(size_t)(k0 + kk) * 8576 + c]; }
            if (tid < 128) cosT[tid] = cospif((float)tid * (1.0f / 64.0f));
            __syncthreads();
            bf16_t* dst = wl(P, l) + OW_WIN + (size_t)(3456 + g * 128) * 1024;
            const int kk = tid & 63;
            for (int i = 0; i < 16; ++i) {
                const int j2 = (tid >> 6) + 8 * i, cc = j2 >> 1, part = j2 & 1;
                float s = 0.f;
                if (cc == 0) {
                    if (part == 0) { for (int c = 0; c < 128; ++c) s += wt[kk * 129 + c]; }
                    else { for (int c = 0; c < 128; ++c) s += (c & 1) ? -wt[kk * 129 + c] : wt[kk * 129 + c]; }
                } else if (part == 0) {
                    for (int c = 0; c < 128; ++c) s += wt[kk * 129 + c] * cosT[(cc * c) & 127];
                } else {
                    for (int c = 0; c < 128; ++c) s -= wt[kk * 129 + c] * cosT[(cc * c - 32) & 127];
                }
                dst[(size_t)j2 * 1024 + k0 + kk] = f2bf(s);
            }
        }
        __syncthreads();
    }
    if (C.bid == 0 && tid < 16) ((unsigned*)(P.ws + WS_CTR))[tid] = 0u;
    {
        float2* tw = (float2*)(P.ws + WS_TW);
        for (int m = C.bid * NT + tid; m < 4096; m += C.nblk * NT) { const float x = (float)m * (1.0f / 4096.0f); tw[m] = make_float2(cospif(x), -sinpif(x)); }
    }
    {
        float* sc = (float*)smem;
        float* red = (float*)(smem + 18 * 512 * 4);
        float* mod = (float*)(P.ws + WS_MOD);
        for (int it = C.bid; it < 2 * 144; it += C.nblk) {
            const int l = it / 144, n0 = (it % 144) * 64, nl = tid & 63, ks = tid >> 6;
            const float* aw = P.inp(4) + (size_t)l * 1024 * 9216;
            float acc[18];
#pragma unroll
            for (int b = 0; b < 18; ++b) acc[b] = 0.f;
            for (int half = 0; half < 2; ++half) {
                __syncthreads();
                for (int e = tid; e < 18 * 512; e += NT) {
                    const int b = e >> 9, kk = e & 511, k = half * 512 + kk;
                    const float cv = b < 2 ? P.inp(2)[b * 1024 + k] : P.inp(3)[(b - 2) * 1024 + k];
                    sc[e] = cv / (1.0f + __expf(-cv));
                }
                __syncthreads();
                for (int kk = ks * 64; kk < ks * 64 + 64; ++kk) {
                    const float w = aw[(size_t)(half * 512 + kk) * 9216 + n0 + nl];
#pragma unroll
                    for (int b = 0; b < 18; ++b) acc[b] += sc[b * 512 + kk] * w;
                }
            }
            __syncthreads();
#pragma unroll
            for (int b = 0; b < 18; ++b) red[(ks * 18 + b) * 64 + nl] = acc[b];
            __syncthreads();
            for (int e = tid; e < 18 * 64; e += NT) {
                const int b = e >> 6, n = e & 63;
                float s = 0.f;
#pragma unroll
                for (int k8 = 0; k8 < 8; ++k8) s += red[(k8 * 18 + b) * 64 + n];
                mod[((size_t)l * 18 + b) * 9216 + n0 + n] = s + P.inp(5)[(size_t)l * 9216 + n0 + n];
            }
        }
        __syncthreads();
    }
}

__device__ __forceinline__ void norm_phase(const Ctx& C, const PV& P, int pass, const float* lng, const float* lnb, int mod_layer, int j, bool from_input) {
    const int lane = C.tid & 63, wave = C.tid >> 6;
    bf16_t* hmod = (bf16_t*)(P.ws + WS_HMOD);
    const float* mod = (const float*)(P.ws + WS_MOD);
    for (int lt = C.bid * NWV + wave; lt < TP; lt += C.nblk * NWV) {
        const int gr = grow_of(pass, lt), b = brow_of(pass, lt);
        const float* src = from_input ? (gr < 16384 ? P.inp(0) + (size_t)gr * 1024 : P.inp(1) + (size_t)(gr - 16384) * 1024) : P.out + (size_t)gr * 1024;
        float4 v[4];
#pragma unroll
        for (int i = 0; i < 4; ++i) v[i] = *(const float4*)(src + i * 256 + lane * 4);
        if (lng) {
            float s = 0.f;
#pragma unroll
            for (int i = 0; i < 4; ++i) s += (v[i].x + v[i].y) + (v[i].z + v[i].w);
            const float mu = wsum(s) * (1.0f / 1024.0f);
            float q = 0.f;
#pragma unroll
            for (int i = 0; i < 4; ++i) { const float a = v[i].x - mu, bb = v[i].y - mu, c = v[i].z - mu, d = v[i].w - mu; q += a * a + bb * bb + c * c + d * d; }
            const float rs = rsqrtf(wsum(q) * (1.0f / 1024.0f) + 1e-5f);
#pragma unroll
            for (int i = 0; i < 4; ++i) {
                const float4 g = *(const float4*)(lng + i * 256 + lane * 4), bb = *(const float4*)(lnb + i * 256 + lane * 4);
                v[i].x = (v[i].x - mu) * rs * g.x + bb.x; v[i].y = (v[i].y - mu) * rs * g.y + bb.y; v[i].z = (v[i].z - mu) * rs * g.z + bb.z; v[i].w = (v[i].w - mu) * rs * g.w + bb.w;
            }
        }
        if (lng || from_input) {
#pragma unroll
            for (int i = 0; i < 4; ++i) *(float4*)(P.out + (size_t)gr * 1024 + i * 256 + lane * 4) = v[i];
        }
        if (j >= 0) {
            float s = 0.f;
#pragma unroll
            for (int i = 0; i < 4; ++i) s += (v[i].x + v[i].y) + (v[i].z + v[i].w);
            const float mu = wsum(s) * (1.0f / 1024.0f);
            float q = 0.f;
#pragma unroll
            for (int i = 0; i < 4; ++i) { const float a = v[i].x - mu, bb = v[i].y - mu, c = v[i].z - mu, d = v[i].w - mu; q += a * a + bb * bb + c * c + d * d; }
            const float rs = rsqrtf(wsum(q) * (1.0f / 1024.0f) + 1e-5f);
            const float* mb = mod + ((size_t)mod_layer * 18 + b) * 9216 + (size_t)(3 * j) * 1024;
#pragma unroll
            for (int i = 0; i < 4; ++i) {
                const float4 sh = *(const float4*)(mb + i * 256 + lane * 4), scl = *(const float4*)(mb + 1024 + i * 256 + lane * 4);
                const float h0 = (v[i].x - mu) * rs * (1.f + scl.x) + sh.x, h1 = (v[i].y - mu) * rs * (1.f + scl.y) + sh.y;
                const float h2 = (v[i].z - mu) * rs * (1.f + scl.z) + sh.z, h3 = (v[i].w - mu) * rs * (1.f + scl.w) + sh.w;
                uint2 o; o.x = pack2bf(h0, h1); o.y = pack2bf(h2, h3);
                *(uint2*)(hmod + (size_t)lt * 1024 + i * 256 + lane * 4) = o;
            }
        }
    }
}

__device__ __forceinline__ void ffn_up_phase(const Ctx& C, const PV& P, const bf16_t* Wt) {
    const bf16_t* hmod = (const bf16_t*)(P.ws + WS_HMOD);
    bf16_t* act = (bf16_t*)(P.ws + WS_R + R_ACT);
    int pm, pn;
    for (int it = 0; tile_order(it, C.nblk, C.bid, TP / 256, 22, pm, pn); ++it) {
        f32x4 acc[2][2][4][2];
        gemm256(C, acc, hmod, Wt, 1024, pm * 256, pn * 256);
        int z2 = 0; asm volatile("" : "+s"(z2));
        const int tid2 = tid_now(C.wave_s, z2), lane = tid2 & 63, wid = tid2 >> 6, wr = wid >> 2, wc = wid & 3, fr = lane & 15, fq = lane >> 4;
#pragma unroll
        for (int ai = 0; ai < 2; ++ai)
#pragma unroll
            for (int m = 0; m < 4; ++m) {
                const int row = pm * 256 + ai * 128 + wr * 64 + m * 16 + fr;
#pragma unroll
                for (int bj = 0; bj < 2; ++bj) {
                    const int colbase = pn * 256 + bj * 128 + wc * 32, f = (colbase >> 5) * 16 + fq * 4;
                    const f32x4 a = acc[ai][bj][m][0], bb = acc[ai][bj][m][1];
                    float o[4];
#pragma unroll
                    for (int r = 0; r < 4; ++r) o[r] = a[r] / (1.0f + __expf(-a[r])) * bb[r];
                    u32x2 w; w.x = pack2bf(o[0], o[1]); w.y = pack2bf(o[2], o[3]);
                    *(u32x2*)(act + (size_t)row * 2816 + f) = w;
                }
            }
    }
}

__device__ __forceinline__ void resid_gemm_phase(const Ctx& C, const PV& P, int pass, const bf16_t* A, int K, const bf16_t* Wt, int layer, int j, float scale) {
    const float* mod = (const float*)(P.ws + WS_MOD);
    int pm, pn;
    for (int it = 0; tile_order(it, C.nblk, C.bid, TP / 256, 4, pm, pn); ++it) {
        f32x4 acc[2][2][4][2];
        gemm256(C, acc, A, Wt, K, pm * 256, pn * 256);
        int z2 = 0; asm volatile("" : "+s"(z2));
        const int tid2 = tid_now(C.wave_s, z2), lane = tid2 & 63, wid = tid2 >> 6, wr = wid >> 2, wc = wid & 3, fr = lane & 15, fq = lane >> 4;
#pragma unroll
        for (int ai = 0; ai < 2; ++ai)
#pragma unroll
            for (int m = 0; m < 4; ++m) {
                const int lt = pm * 256 + ai * 128 + wr * 64 + m * 16 + fr;
                const int gr = grow_of(pass, lt), b = brow_of(pass, lt);
                const float* gate = mod + ((size_t)layer * 18 + b) * 9216 + (size_t)(3 * j + 2) * 1024;
#pragma unroll
                for (int bj = 0; bj < 2; ++bj)
#pragma unroll
                    for (int n = 0; n < 2; ++n) {
                        const int col = pn * 256 + bj * 128 + wc * 32 + n * 16 + fq * 4;
                        f32x4* xp = (f32x4*)(P.out + (size_t)gr * 1024 + col);
                        const f32x4 x = *xp, g = *(const f32x4*)(gate + col);
                        *xp = ALPHA * x + (1.0f + g) * scale * acc[ai][bj][m][n];
                    }
            }
    }
}

__device__ __forceinline__ void win_phase(const Ctx& C, const PV& P, int layer) {
    const bf16_t* hmod = (const bf16_t*)(P.ws + WS_HMOD);
    const bf16_t* Wt = wl(P, layer) + OW_WIN;
    unsigned char* R = P.ws + WS_R;
    f16* raw = (f16*)(R + R_RAW); bf16_t* Qb = (bf16_t*)(R + R_Q); bf16_t* Kb = (bf16_t*)(R + R_K); bf16_t* Vt = (bf16_t*)(R + R_VT);
    f16* Zc = (f16*)(R + R_ZC); f16* poolp = (f16*)(R + R_POOLP);
    typedef f16 f16x4 __attribute__((ext_vector_type(4)));
    typedef f16 f16x2 __attribute__((ext_vector_type(2)));
    int pm, pn;
    for (int it = 0; tile_order(it, C.nblk, C.bid, TP / 256, 18, pm, pn); ++it) {
        const int lt_t = pm * 256, sq = lt_t < 8192 ? 0 : 1 + ((lt_t - 8192) >> 12), lt0 = seqbase_of(sq), S = seqlen_of(sq);
        f32x4 acc[2][2][4][2];
        gemm256(C, acc, hmod, Wt, 1024, pm * 256, pn * 256);
        int z2 = 0; asm volatile("" : "+s"(z2));
        const int tid2 = tid_now(C.wave_s, z2), lane = tid2 & 63, wid = tid2 >> 6, wr = wid >> 2, wc = wid & 3, fr = lane & 15, fq = lane >> 4;
#pragma unroll
        for (int bj = 0; bj < 2; ++bj) {
            const int tn = pn * 2 + bj;
            if (tn >= 35) continue;
#pragma unroll
            for (int ai = 0; ai < 2; ++ai)
#pragma unroll
                for (int m = 0; m < 4; ++m) {
                    const int lt = pm * 256 + ai * 128 + wr * 64 + m * 16 + fr, pos = lt - lt0;
#pragma unroll
                    for (int n = 0; n < 2; ++n) {
                        const int col = tn * 128 + wc * 32 + n * 16 + fq * 4;
                        f32x4 v = acc[ai][bj][m][n];
                        if (tn < 15) {
                            f16x4 h; h[0] = (f16)v[0]; h[1] = (f16)v[1]; h[2] = (f16)v[2]; h[3] = (f16)v[3];
                            *(f16x4*)(raw + (size_t)lt * 1920 + col) = h;
                        } else if (tn < 23) {
                            const int nq = (col - 1920) & 511, hc = nq >> 6, d = nq & 63;
                            if (n == 0 && (wc & 1) == 0) {
#pragma unroll
                                for (int r = 0; r < 4; ++r) {
                                    const float invlo = r == 0 ? 1.0f : r == 1 ? 0.1939227432012558f : r == 2 ? 0.03760603070259094f : 0.007292664609849453f;
                                    const float invhi = r == 0 ? 0.0014142135623842478f : r == 1 ? 0.00027424818836152554f : r == 2 ? 5.3182957344688475e-05f : 1.0313385246263351e-05f;
                                    const float ang = (float)pos * ((fq & 1) ? invhi : invlo);
                                    const float hi = ang * 0.15915493667125702f;
                                    const float lo = __builtin_fmaf(ang, 0.15915493667125702f, -hi) + ang * 6.4206382432985265e-09f;
                                    const float rr = (hi - floorf(hi)) + lo;
                                    const float cs = __builtin_amdgcn_cosf(rr), sn = __builtin_amdgcn_sinf(rr);
                                    const float other = __shfl_xor(v[r], 32);
                                    v[r] = (fq < 2) ? (v[r] * cs - other * sn) : (other * sn + v[r] * cs);
                                }
                            }
                            bf16_t* dst = (tn < 19) ? Qb : Kb;
                            const float sc = (tn < 19) ? 0.125f * 1.44269504088896f : 1.0f;
                            u32x2 w; w.x = pack2bf(v[0] * sc, v[1] * sc); w.y = pack2bf(v[2] * sc, v[3] * sc);
                            *(u32x2*)(dst + (size_t)lt0 * 512 + ((size_t)hc * S + pos) * 64 + d) = w;
                        } else if (tn < 27) {
                            const int nv = col - 2944;
                            bf16_t* vb = Vt + (size_t)lt0 * 512 + (size_t)nv * S + pos;
                            vb[0] = f2bf(v[0]); vb[(size_t)S] = f2bf(v[1]); vb[(size_t)2 * S] = f2bf(v[2]); vb[(size_t)3 * S] = f2bf(v[3]);
                        } else if (tn < 31) {
                            const int nz = col - 3456, g = nz >> 7, cc = (nz & 127) >> 1;
                            f16x2 z0, z1; z0[0] = (f16)v[0]; z0[1] = (f16)v[1]; z1[0] = (f16)v[2]; z1[1] = (f16)v[3];
                            f16x2* zb = (f16x2*)Zc + (size_t)lt0 * 256;
                            zb[(size_t)(g * 64 + cc) * S + pos] = z0;
                            zb[(size_t)(g * 64 + cc + 1) * S + pos] = z1;
                        } else {
                            f16x4 h; h[0] = (f16)v[0]; h[1] = (f16)v[1]; h[2] = (f16)v[2]; h[3] = (f16)v[3];
                            *(f16x4*)(poolp + (size_t)lt * 512 + (col - 3968)) = h;
                        }
                    }
                    asm volatile("" ::: "memory");
                }
        }
    }
}

__device__ __forceinline__ float shiftv(const f16* __restrict__ raw, int lt, int t, int S, int col, float mu) {
    const float p = (float)raw[(size_t)lt * 1920 + col];
    const float pr = t > 0 ? (float)raw[(size_t)(lt - 1) * 1920 + col] : 0.f;
    const float nx = t < S - 1 ? (float)raw[(size_t)(lt + 1) * 1920 + col] : 0.f;
    return p + (0.5f * (pr + nx) - p) * mu;
}

__device__ __forceinline__ void lin_pool_phase(const Ctx& C, const PV& P, int layer) {
    unsigned char* R = P.ws + WS_R;
    const f16* raw = (const f16*)(R + R_RAW); bf16_t* lin = (bf16_t*)(R + R_LIN);
    const f16* poolp = (const f16*)(R + R_POOLP); bf16_t* ypool = (bf16_t*)(R + R_YB) + 3 * SZ512;
    const float* mu = P.inp(13) + (size_t)layer * 1920; const float* pscale = P.inp(26) + (size_t)layer * 512;
    const int gsz = C.nblk * NT, gid = C.bid * NT + C.tid;
    for (int e = gid; e < TP * 384; e += gsz) {
        const int lt = e / 384, c = e % 384, col = 1536 + c;
        const int pos = pos_of(lt), S = lt < 8192 ? 8192 : 4096;
        float v = shiftv(raw, lt, pos, S, col, mu[col]);
        if (c < 128) v = tanhf(v); else if (c >= 256) v = sigmoidf_(v);
        lin[(size_t)lt * 384 + c] = f2bf(v);
    }
    for (int e = gid; e < TP * 512; e += gsz) {
        const int lt = e >> 9, c = e & 511, g = c >> 7, half = 1 << g;
        const int pos = pos_of(lt), S = lt < 8192 ? 8192 : 4096;
        const int lo = max(pos - half, 0), hi = min(pos + half, S);
        const f16* base = poolp + (size_t)(lt - pos) * 512 + c;
        float s = 0.f;
#pragma unroll
        for (int o = -8; o < 8; ++o) {
            const int tt = pos + o;
            const bool in = (o >= -half) && (o < half) && tt >= 0 && tt < S;
            const float v = in ? (float)base[(size_t)(in ? tt : pos) * 512] : 0.f;
            s += v;
        }
        const float x = (float)base[(size_t)pos * 512];
        ypool[(size_t)lt * 512 + c] = f2bf((s / (float)(hi - lo) - x) * pscale[c]);
    }
    {
        float* invn = (float*)(P.ws + WS_INVN);
        const float* k_k = P.inp(19) + (size_t)layer * 512;
        const int lane = C.tid & 63, wave = C.tid >> 6;
        for (int lt = C.bid * NWV + wave; lt < TP; lt += C.nblk * NWV) {
            const int pos = pos_of(lt), S = lt < 8192 ? 8192 : 4096;
            float ss[8];
#pragma unroll
            for (int h = 0; h < 8; ++h) {
                const int c = h * 64 + lane;
                const float k = shiftv(raw, lt, pos, S, 512 + c, mu[512 + c]) * k_k[c];
                ss[h] = k * k;
            }
#pragma unroll
            for (int h = 0; h < 8; ++h) ss[h] = wsum(ss[h]);
            if (lane < 8) {
                float sel = ss[0];
#pragma unroll
                for (int h = 1; h < 8; ++h) sel = lane == h ? ss[h] : sel;
                invn[(size_t)lt * 8 + lane] = 1.0f / fmaxf(sqrtf(sel), 1e-12f);
            }
        }
    }
}

__device__ __forceinline__ void lora_phase(const Ctx& C, const PV& P, int layer, unsigned char* smem) {
    unsigned char* R = P.ws + WS_R;
    const bf16_t* lin = (const bf16_t*)(R + R_LIN); f16* wa = (f16*)(R + R_WA); f16* gbuf = (f16*)(R + R_G);
    const bf16_t* W = wl(P, layer);
    const int lane = C.tid & 63, wave = (C.tid >> 6) & 3, wm = wave >> 1, wn = wave & 1, fr = lane & 15, fq = lane >> 4;
    for (int t2 = C.bid; t2 < 5 * MT * 2; t2 += C.nblk) {
        const int t = t2 * 2 + (C.tid >> 8);
        const int which = t / (MT * 4), tt = t % (MT * 4), tm = tt >> 2, tn = tt & 3;
        const bf16_t* Bt; int K, acol; const float* bias = nullptr; f16* dst;
        if (which < 2) { Bt = W + OW_W2T + (size_t)which * 512 * 64; K = 64; acol = which * 64; bias = P.inp(14) + (size_t)(layer * 2 + which) * 512; dst = wa + (size_t)which * SZ512; }
        else if (which < 4) { const int d = which - 2; Bt = W + OW_A2T + (size_t)d * 512 * 64; K = 64; acol = 128 + d * 64; bias = P.inp(16) + (size_t)(layer * 2 + d) * 512; dst = wa + (size_t)which * SZ512; }
        else { Bt = W + OW_G2T; K = 128; acol = 256; dst = gbuf; }
        f32x4 acc[4][4];
        gemm_core<4, true>(C, acc, lin + (size_t)tm * 128 * 384 + acol, 384, Bt + (size_t)tn * 128 * K, K, K, smem);
#pragma unroll
        for (int i = 0; i < 4; ++i) {
            const int lt = tm * 128 + wm * 64 + i * 16 + fr;
#pragma unroll
            for (int jn = 0; jn < 4; ++jn) {
                const int n = tn * 128 + wn * 64 + jn * 16 + fq * 4;
                typedef f16 f16x4 __attribute__((ext_vector_type(4)));
                f16x4 h;
#pragma unroll
                for (int r = 0; r < 4; ++r) {
                    float v = acc[i][jn][r];
                    if (which < 2) {
                        const float z = bias[n + r] + v, nz = -z;
                        const float sp = fmaxf(nz, 0.f) + log1pf(expf(-fabsf(nz)));
                        v = expf(-expf(-sp - 0.5f));
                    } else if (which < 4) { v = 1.0f / (1.0f + expf(-(bias[n + r] + v))); }
                    h[r] = (f16)v;
                }
                *(f16x4*)(dst + (size_t)lt * 512 + n) = h;
            }
        }
    }
}

__device__ __forceinline__ void attn_items(const Ctx& C, const PV& P, int layer, int ctr_idx, unsigned char* smem) {
    unsigned char* R = P.ws + WS_R;
    const bf16_t* Qall = (const bf16_t*)(R + R_Q); const bf16_t* Kall = (const bf16_t*)(R + R_K); const bf16_t* Vall = (const bf16_t*)(R + R_VT);
    bf16_t* ydiff = (bf16_t*)(R + R_YB) + 1 * SZ512;
    const int tid = C.tid, lane = tid & 63, wave = tid >> 6, comp = wave & 1, rg = wave >> 1, fr = lane & 15, fq = lane >> 4;
    const float lam_init = layer == 0 ? 0.2f : (0.8f - 0.6f * 0.7408182206817179f);
    float lam_full;
    {
        const float* lm = P.inp(24) + (size_t)layer * 256;
        float s1 = 0.f, s2 = 0.f;
        for (int i = 0; i < 64; ++i) { s1 += lm[i] * lm[64 + i]; s2 += lm[128 + i] * lm[192 + i]; }
        lam_full = expf(s1) - expf(s2) + lam_init;
    }
    const float* normg = P.inp(25) + (size_t)layer * 128;
    unsigned* ctr = (unsigned*)(P.ws + WS_CTR) + ctr_idx;
    volatile unsigned* bc = (volatile unsigned*)(smem + 131056);
    for (;;) {
        __syncthreads();
        if (tid == 0) *bc = atomicAdd(ctr, 1u);
        __syncthreads();
        const int item = (int)*bc;
        if (item >= 1280) break;
        int sq, h, qb;
        if (item < 256) { sq = 0; h = item >> 6; qb = item & 63; } else { const int i2 = item - 256; sq = 1 + (i2 >> 7); h = (i2 >> 5) & 3; qb = i2 & 31; }
        const int lt0 = seqbase_of(sq), S = seqlen_of(sq);
        const bf16_t* Qb = Qall + (size_t)lt0 * 512; const bf16_t* Kb = Kall + (size_t)lt0 * 512; const bf16_t* Vb = Vall + (size_t)lt0 * 512 + (size_t)h * 128 * S;
        const int q0 = qb * 128 + rg * 32;
        bf16x8 bq[2][2];
#pragma unroll
        for (int qs = 0; qs < 2; ++qs)
#pragma unroll
            for (int ks = 0; ks < 2; ++ks) bq[qs][ks] = *(const bf16x8*)(Qb + ((size_t)(h * 2 + comp) * S + q0 + qs * 16 + fr) * 64 + ks * 32 + fq * 8);
        float m_run[2] = {-1e30f, -1e30f}, l_run[2] = {0.f, 0.f};
        f32x4 O[8][2];
#pragma unroll
        for (int a = 0; a < 8; ++a) { O[a][0] = (f32x4){0.f, 0.f, 0.f, 0.f}; O[a][1] = (f32x4){0.f, 0.f, 0.f, 0.f}; }
        u32x4 rk[2], rv[2];
        const int lrow = tid >> 3, lkc = (tid & 7) * 8;
#pragma unroll
        for (int i = 0; i < 2; ++i) {
            const int row = lrow + 64 * i, cm = row >> 6, key = row & 63;
            rk[i] = *(const u32x4*)(Kb + ((size_t)(h * 2 + cm) * S + key) * 64 + lkc);
            rv[i] = *(const u32x4*)(Vb + (size_t)row * S + lkc);
        }
        for (int kt0 = 0; kt0 < S; kt0 += 64) {
            __syncthreads();
#pragma unroll
            for (int i = 0; i < 2; ++i) {
                const int row = lrow + 64 * i;
                *(u32x4*)(smem + row * 144 + lkc * 2) = rk[i];
                *(u32x4*)(smem + 18432 + row * 144 + lkc * 2) = rv[i];
            }
            __syncthreads();
            if (kt0 + 64 < S) {
#pragma unroll
                for (int i = 0; i < 2; ++i) {
                    const int row = lrow + 64 * i, cm = row >> 6, key = row & 63;
                    rk[i] = *(const u32x4*)(Kb + ((size_t)(h * 2 + cm) * S + kt0 + 64 + key) * 64 + lkc);
                    rv[i] = *(const u32x4*)(Vb + (size_t)row * S + kt0 + 64 + lkc);
                }
            }
            f32x4 st[4][2];
#pragma unroll
            for (int t = 0; t < 4; ++t) {
                st[t][0] = (f32x4){0.f, 0.f, 0.f, 0.f}; st[t][1] = (f32x4){0.f, 0.f, 0.f, 0.f};
#pragma unroll
                for (int ks = 0; ks < 2; ++ks) {
                    const bf16x8 kf = *(const bf16x8*)(smem + (comp * 64 + t * 16 + fr) * 144 + (ks * 32 + fq * 8) * 2);
                    st[t][0] = __builtin_amdgcn_mfma_f32_16x16x32_bf16(kf, bq[0][ks], st[t][0], 0, 0, 0);
                    st[t][1] = __builtin_amdgcn_mfma_f32_16x16x32_bf16(kf, bq[1][ks], st[t][1], 0, 0, 0);
                }
            }
            bf16x8 pb[2][2];
#pragma unroll
            for (int qs = 0; qs < 2; ++qs) {
                float mx = -1e30f;
#pragma unroll
                for (int t = 0; t < 4; ++t)
#pragma unroll
                    for (int r = 0; r < 4; ++r) mx = fmaxf(mx, st[t][qs][r]);
                mx = fmaxf(mx, __shfl_xor(mx, 16)); mx = fmaxf(mx, __shfl_xor(mx, 32));
                const float mnew = fmaxf(m_run[qs], mx);
                const float alpha = __builtin_amdgcn_exp2f(m_run[qs] - mnew);
                m_run[qs] = mnew;
                float ls = 0.f;
                float pv[4][4];
#pragma unroll
                for (int t = 0; t < 4; ++t)
#pragma unroll
                    for (int r = 0; r < 4; ++r) { pv[t][r] = __builtin_amdgcn_exp2f(st[t][qs][r] - mnew); ls += pv[t][r]; }
                l_run[qs] = l_run[qs] * alpha + ls;
#pragma unroll
                for (int a = 0; a < 8; ++a) O[a][qs] = O[a][qs] * alpha;
#pragma unroll
                for (int u = 0; u < 2; ++u) {
                    union { bf16x8 v; unsigned w[4]; } pk;
                    pk.w[0] = pack2bf(pv[2 * u][0], pv[2 * u][1]); pk.w[1] = pack2bf(pv[2 * u][2], pv[2 * u][3]);
                    pk.w[2] = pack2bf(pv[2 * u + 1][0], pv[2 * u + 1][1]); pk.w[3] = pack2bf(pv[2 * u + 1][2], pv[2 * u + 1][3]);
                    pb[qs][u] = pk.v;
                }
            }
#pragma unroll
            for (int u = 0; u < 2; ++u)
#pragma unroll
                for (int a = 0; a < 8; ++a) {
                    union { bf16x8 v; uint2 h[2]; } vf;
                    vf.h[0] = *(const uint2*)(smem + 18432 + (a * 16 + fr) * 144 + (u * 32 + fq * 4) * 2);
                    vf.h[1] = *(const uint2*)(smem + 18432 + (a * 16 + fr) * 144 + (u * 32 + 16 + fq * 4) * 2);
                    O[a][0] = __builtin_amdgcn_mfma_f32_16x16x32_bf16(vf.v, pb[0][u], O[a][0], 0, 0, 0);
                    O[a][1] = __builtin_amdgcn_mfma_f32_16x16x32_bf16(vf.v, pb[1][u], O[a][1], 0, 0, 0);
                }
        }
#pragma unroll
        for (int qs = 0; qs < 2; ++qs) {
            float l = l_run[qs]; l += __shfl_xor(l, 16); l += __shfl_xor(l, 32);
            const float inv = 1.0f / l;
#pragma unroll
            for (int a = 0; a < 8; ++a) O[a][qs] = O[a][qs] * inv;
        }
        __syncthreads();
        float* Ox = (float*)smem;
        if (comp == 1) {
#pragma unroll
            for (int qs = 0; qs < 2; ++qs)
#pragma unroll
                for (int a = 0; a < 8; ++a)
#pragma unroll
                    for (int r = 0; r < 4; ++r) Ox[(rg * 128 + a * 16 + fq * 4 + r) * 32 + qs * 16 + fr] = O[a][qs][r];
        }
        __syncthreads();
        if (comp == 0) {
#pragma unroll
            for (int qs = 0; qs < 2; ++qs) {
                float ss = 0.f;
#pragma unroll
                for (int a = 0; a < 8; ++a)
#pragma unroll
                    for (int r = 0; r < 4; ++r) {
                        const float o = O[a][qs][r] - lam_full * Ox[(rg * 128 + a * 16 + fq * 4 + r) * 32 + qs * 16 + fr];
                        O[a][qs][r] = o; ss += o * o;
                    }
                ss += __shfl_xor(ss, 16); ss += __shfl_xor(ss, 32);
                const float sc = rsqrtf(ss * (1.0f / 128.0f) + 1e-5f) * (1.0f - lam_init);
                const int lt = lt0 + q0 + qs * 16 + fr;
#pragma unroll
                for (int a = 0; a < 8; ++a) {
                    const int dv = a * 16 + fq * 4;
                    const float4 g = *(const float4*)(normg + dv);
                    uint2 w; w.x = pack2bf(O[a][qs][0] * sc * g.x, O[a][qs][1] * sc * g.y); w.y = pack2bf(O[a][qs][2] * sc * g.z, O[a][qs][3] * sc * g.w);
                    *(uint2*)(ydiff + (size_t)lt * 512 + h * 128 + dv) = w;
                }
            }
        }
    }
    __syncthreads();
}

__device__ __forceinline__ void fft_items(const Ctx& C, const PV& P, unsigned char* smem) {
    unsigned char* R = P.ws + WS_R;
    typedef f16 f16x2 __attribute__((ext_vector_type(2)));
    const f16x2* Zall = (const f16x2*)(R + R_ZC);
    bf16_t* yf = (bf16_t*)(R + R_YB) + 2 * SZ512;
    const float2* tw = (const float2*)(P.ws + WS_TW);
    float2* sm = (float2*)smem;
    const int tid = C.tid;
    for (int item = C.bid; item < NSEQ * 256; item += C.nblk) {
        const int sq = item >> 8, col = item & 255, g = col >> 6, cc = col & 63;
        const int lt0 = seqbase_of(sq), S = seqlen_of(sq), lg = sq == 0 ? 13 : 12;
        const f16x2* z = Zall + (size_t)lt0 * 256 + (size_t)col * S;
        __syncthreads();
        for (int s = tid; s < S; s += NT) { const f16x2 v = z[s]; sm[__brev((unsigned)s) >> (32 - lg)] = make_float2((float)v[0], (float)v[1]); }
        __syncthreads();
        for (int st = 0; st < lg; ++st) {
            const int half = 1 << st, tshift = 12 - st;
            for (int b = tid; b < (S >> 1); b += NT) {
                const int j = b & (half - 1), i0 = ((b >> st) << (st + 1)) + j, i1 = i0 + half;
                const float2 w = tw[j << tshift], u = sm[i0], x = sm[i1];
                const float2 tv = make_float2(w.x * x.x - w.y * x.y, w.x * x.y + w.y * x.x);
                sm[i0] = make_float2(u.x + tv.x, u.y + tv.y); sm[i1] = make_float2(u.x - tv.x, u.y - tv.y);
            }
            __syncthreads();
        }
        const float nrm = rsqrtf((float)S * 128.0f);
        for (int k = tid; k < S; k += NT) {
            const float2 a = sm[k], b = sm[(S - k) & (S - 1)];
            bf16_t* row = yf + (size_t)(lt0 + k) * 512 + g * 128;
            if (cc == 0) { row[0] = f2bf(0.5f * (a.x + b.x) * nrm); row[64] = f2bf(0.5f * (a.y + b.y) * nrm); }
            else { row[cc] = f2bf(a.x * nrm); row[128 - cc] = f2bf(b.x * nrm); }
        }
    }
    __syncthreads();
}

typedef float f32x2 __attribute__((ext_vector_type(2)));
template <int KT>
__device__ __forceinline__ void scan_block(const Ctx& C, const PV& P, int layer, int sq, int h, int d, int row0, unsigned char* smem) {
    constexpr int TPR = 64 / KT, ROWS = NT / TPR, CH = 16, YP = TPR / 4, NV = ROWS / 32;
    unsigned char* R = P.ws + WS_R;
    const f16* raw = (const f16*)(R + R_RAW); const f16* wa = (const f16*)(R + R_WA); f16* yfb = (f16*)(R + R_YFB);
    const float* invn = (const float*)(P.ws + WS_INVN);
    const float* mu = P.inp(13) + (size_t)layer * 1920; const float* k_k = P.inp(19) + (size_t)layer * 512; const float* k_a = P.inp(20) + (size_t)layer * 512;
    const int tid = C.tid, row = tid / TPR, q = tid % TPR;
    const int lt0 = seqbase_of(sq), S = seqlen_of(sq);
    const int ch = tid & 63, c = h * 64 + ch;
    const float mu_r = mu[c], mu_k = mu[512 + c], kkw = k_k[c], kaw = k_a[c];
    const int vr = (ROWS == 32) ? (tid & 31) : (tid & 63);
    const int vcol = 1024 + h * 64 + row0 + vr; const float mu_v = mu[vcol];
    const f16* wdec = wa + (size_t)d * SZ512; const f16* aact = wa + (size_t)(2 + d) * SZ512;
    f16* ydst = yfb + (size_t)d * SZ512;
    f32x2 s[KT / 2];
#pragma unroll
    for (int j = 0; j < KT / 2; ++j) s[j] = (f32x2){0.f, 0.f};
    float pr_[2][3], pk_[2][3], pa_[2], pw_[2], pn_[2], pv_[NV][3];
    auto prefetch = [&](int c0) {
#pragma unroll
        for (int j = 0; j < 2; ++j) {
            const int i = (tid >> 6) + 8 * j, tstep = c0 + i, t = d == 0 ? tstep : S - 1 - tstep, lt = lt0 + t;
            const int tm = t > 0 ? lt - 1 : lt, tp = t < S - 1 ? lt + 1 : lt;
            pr_[j][0] = (float)raw[(size_t)tm * 1920 + c]; pr_[j][1] = (float)raw[(size_t)lt * 1920 + c]; pr_[j][2] = (float)raw[(size_t)tp * 1920 + c];
            pk_[j][0] = (float)raw[(size_t)tm * 1920 + 512 + c]; pk_[j][1] = (float)raw[(size_t)lt * 1920 + 512 + c]; pk_[j][2] = (float)raw[(size_t)tp * 1920 + 512 + c];
            pa_[j] = (float)aact[(size_t)lt * 512 + c]; pw_[j] = (float)wdec[(size_t)lt * 512 + c]; pn_[j] = invn[(size_t)lt * 8 + h];
        }
#pragma unroll
        for (int j = 0; j < NV; ++j) {
            const int i = (ROWS == 32) ? (tid >> 5) : ((tid >> 6) + 8 * j), tstep = c0 + i, t = d == 0 ? tstep : S - 1 - tstep, lt = lt0 + t;
            const int tm = t > 0 ? lt - 1 : lt, tp = t < S - 1 ? lt + 1 : lt;
            pv_[j][0] = (float)raw[(size_t)tm * 1920 + vcol]; pv_[j][1] = (float)raw[(size_t)lt * 1920 + vcol]; pv_[j][2] = (float)raw[(size_t)tp * 1920 + vcol];
        }
    };
    auto stage = [&](int c0, unsigned char* buf) {
        float* vec = (float*)buf; float* vbuf = (float*)(buf + 20480);
#pragma unroll
        for (int j = 0; j < 2; ++j) {
            const int i = (tid >> 6) + 8 * j, tstep = c0 + i, t = d == 0 ? tstep : S - 1 - tstep;
            const float rm = t > 0 ? pr_[j][0] : 0.f, rp = t < S - 1 ? pr_[j][2] : 0.f, km = t > 0 ? pk_[j][0] : 0.f, kp = t < S - 1 ? pk_[j][2] : 0.f;
            const float r = pr_[j][1] + (0.5f * (rm + rp) - pr_[j][1]) * mu_r;
            const float k = pk_[j][1] + (0.5f * (km + kp) - pk_[j][1]) * mu_k;
            const float kk = k * kkw * pn_[j], a = pa_[j];
            vec[(0 * CH + i) * 64 + ch] = kk;
            vec[(1 * CH + i) * 64 + ch] = pw_[j];
            vec[(2 * CH + i) * 64 + ch] = kk * a;
            vec[(3 * CH + i) * 64 + ch] = k * (1.0f + (a - 1.0f) * kaw);
            vec[(4 * CH + i) * 64 + ch] = r;
        }
#pragma unroll
        for (int j = 0; j < NV; ++j) {
            const int i = (ROWS == 32) ? (tid >> 5) : ((tid >> 6) + 8 * j), tstep = c0 + i, t = d == 0 ? tstep : S - 1 - tstep;
            const float vm = t > 0 ? pv_[j][0] : 0.f, vp = t < S - 1 ? pv_[j][2] : 0.f;
            vbuf[i * 64 + vr] = pv_[j][1] + (0.5f * (vm + vp) - pv_[j][1]) * mu_v;
        }
    };
    __syncthreads();
    prefetch(0);
    stage(0, smem);
    __syncthreads();
    const int nch = S / CH;
    for (int cix = 0; cix < nch; ++cix) {
        unsigned char* buf = smem + (cix & 1) * 32768;
        if (cix + 1 < nch) prefetch((cix + 1) * CH);
        {
            const float* vec = (const float*)buf; const float* vbuf = (const float*)(buf + 20480); float* ybuf = (float*)(buf + 24576);
#pragma unroll 4
            for (int i = 0; i < CH; ++i) {
                const f32x4* vp = (const f32x4*)(vec + i * 64 + q * KT);
                f32x2 kk2[KT / 2], w2[KT / 2], b2[KT / 2], kd2[KT / 2], r2[KT / 2];
#pragma unroll
                for (int u = 0; u < KT / 4; ++u) {
                    const f32x4 x0 = vp[u], x1 = vp[CH * 16 + u], x2 = vp[2 * CH * 16 + u], x3 = vp[3 * CH * 16 + u], x4 = vp[4 * CH * 16 + u];
                    kk2[2 * u] = (f32x2){x0[0], x0[1]}; kk2[2 * u + 1] = (f32x2){x0[2], x0[3]};
                    w2[2 * u] = (f32x2){x1[0], x1[1]}; w2[2 * u + 1] = (f32x2){x1[2], x1[3]};
                    b2[2 * u] = (f32x2){x2[0], x2[1]}; b2[2 * u + 1] = (f32x2){x2[2], x2[3]};
                    kd2[2 * u] = (f32x2){x3[0], x3[1]}; kd2[2 * u + 1] = (f32x2){x3[2], x3[3]};
                    r2[2 * u] = (f32x2){x4[0], x4[1]}; r2[2 * u + 1] = (f32x2){x4[2], x4[3]};
                }
                const float vv = vbuf[i * 64 + row];
                f32x2 acc2 = s[0] * kk2[0];
#pragma unroll
                for (int j = 1; j < KT / 2; ++j) acc2 = __builtin_elementwise_fma(s[j], kk2[j], acc2);
                float sa = acc2[0] + acc2[1];
                sa += dppf<0xB1>(sa); sa += dppf<0x4E>(sa); sa += dppf<0x141>(sa);
                if (TPR == 16) sa += dppf<0x140>(sa);
                sa = -sa;
                const f32x2 sa2 = (f32x2){sa, sa}, vv2 = (f32x2){vv, vv};
                f32x2 y2 = (f32x2){0.f, 0.f};
#pragma unroll
                for (int j = 0; j < KT / 2; ++j) {
                    s[j] = __builtin_elementwise_fma(s[j], w2[j], __builtin_elementwise_fma(sa2, b2[j], vv2 * kd2[j]));
                    y2 = __builtin_elementwise_fma(s[j], r2[j], y2);
                }
                float y = y2[0] + y2[1];
                y += dppf<0xB1>(y); y += dppf<0x4E>(y);
                if ((q & 3) == 0) ybuf[i * 128 + row * YP + (q >> 2)] = y;
            }
        }
        if (cix + 1 < nch) stage((cix + 1) * CH, smem + ((cix + 1) & 1) * 32768);
        __syncthreads();
        {
            const float* ybuf = (const float*)(buf + 24576);
#pragma unroll
            for (int j = 0; j < NV; ++j) {
                const int i = (ROWS == 32) ? (tid >> 5) : ((tid >> 6) + 8 * j), rr = vr, tstep = cix * CH + i, t = d == 0 ? tstep : S - 1 - tstep;
                float y = 0.f;
#pragma unroll
                for (int p = 0; p < YP; ++p) y += ybuf[i * 128 + rr * YP + p];
                ydst[(size_t)(lt0 + t) * 512 + h * 64 + row0 + rr] = (f16)y;
            }
        }
    }
    __syncthreads();
}

__device__ __forceinline__ void finish_phase(const Ctx& C, const PV& P, int layer) {
    unsigned char* R = P.ws + WS_R;
    const f16* raw = (const f16*)(R + R_RAW); const f16* wa = (const f16*)(R + R_WA); const f16* gbuf = (const f16*)(R + R_G); const f16* yfb = (const f16*)(R + R_YFB);
    bf16_t* yr = (bf16_t*)(R + R_YB);
    const float* mu = P.inp(13) + (size_t)layer * 1920; const float* k_a = P.inp(20) + (size_t)layer * 512; const float* r_k = P.inp(21) + (size_t)layer * 512;
    const float* lg = P.inp(22) + (size_t)layer * 512; const float* lb = P.inp(23) + (size_t)layer * 512;
    const int lane = C.tid & 63, wave = C.tid >> 6;
    for (int it = C.bid * NWV + wave; it < TP * 8; it += C.nblk * NWV) {
        const int lt = it >> 3, h = it & 7, c = h * 64 + lane;
        const int pos = pos_of(lt), S = lt < 8192 ? 8192 : 4096;
        const float r = shiftv(raw, lt, pos, S, c, mu[c]), k = shiftv(raw, lt, pos, S, 512 + c, mu[512 + c]), v = shiftv(raw, lt, pos, S, 1024 + c, mu[1024 + c]);
        const float af = (float)wa[2 * SZ512 + (size_t)lt * 512 + c], ab = (float)wa[3 * SZ512 + (size_t)lt * 512 + c];
        const float ka = k_a[c];
        const float ksum = k * (1.f + (af - 1.f) * ka) + k * (1.f + (ab - 1.f) * ka);
        const float y = (float)yfb[(size_t)lt * 512 + c] + (float)yfb[SZ512 + (size_t)lt * 512 + c];
        const float ym = wsum(y) * (1.0f / 64.0f);
        const float dy = y - ym;
        const float yv = wsum(dy * dy) * (1.0f / 64.0f);
        const float yn = dy * rsqrtf(yv + 64e-5f) * lg[c] + lb[c];
        const float bonus = wsum(r * (0.5f * ksum) * r_k[c]) * v;
        const float g = (float)gbuf[(size_t)lt * 512 + c];
        yr[(size_t)lt * 512 + c] = f2bf((yn + bonus) * g);
    }
}

__device__ __forceinline__ void merge_phase(const Ctx& C, const PV& P, int layer, unsigned char* smem) {
    unsigned char* R = P.ws + WS_R;
    const bf16_t* hmod = (const bf16_t*)(P.ws + WS_HMOD); const bf16_t* yb = (const bf16_t*)(R + R_YB); bf16_t* merged = (bf16_t*)(R + R_MERGED);
    const bf16_t* W = wl(P, layer);
    const int lane = C.tid & 63, wave = (C.tid >> 6) & 3, wm = wave >> 1, wn = wave & 1, fr = lane & 15, fq = lane >> 4;
    for (int t2 = C.bid; t2 < MT * 8; t2 += C.nblk) {
        const int t = t2 * 2 + (C.tid >> 8);
        const int tm = t >> 4, tn = t & 15;
        f32x4 m[4][2];
#pragma unroll
        for (int i = 0; i < 4; ++i) { m[i][0] = (f32x4){0.f, 0.f, 0.f, 0.f}; m[i][1] = (f32x4){0.f, 0.f, 0.f, 0.f}; }
        for (int n = 0; n < 4; ++n) {
            f32x4 ag[4][2], ap[4][2];
            gemm_core<2, true>(C, ag, hmod + (size_t)tm * 128 * 1024, 1024, W + OW_WIN + (size_t)(4480 + n * 1024 + tn * 64) * 1024, 1024, 1024, smem);
#pragma unroll
            for (int i = 0; i < 4; ++i)
#pragma unroll
                for (int j = 0; j < 2; ++j)
#pragma unroll
                    for (int r = 0; r < 4; ++r) ag[i][j][r] = sigmoidf_(ag[i][j][r]);
            gemm_core<2, true>(C, ap, yb + (size_t)n * SZ512 + (size_t)tm * 128 * 512, 512, W + OW_WBR + (size_t)n * 1024 * 512 + (size_t)(tn * 64) * 512, 512, 512, smem);
#pragma unroll
            for (int i = 0; i < 4; ++i)
#pragma unroll
                for (int j = 0; j < 2; ++j) m[i][j] += ag[i][j] * ap[i][j];
        }
#pragma unroll
        for (int i = 0; i < 4; ++i) {
            const int lt = tm * 128 + wm * 64 + i * 16 + fr;
#pragma unroll
            for (int j = 0; j < 2; ++j) {
                const int n = tn * 64 + wn * 32 + j * 16 + fq * 4;
                uint2 w; w.x = pack2bf(m[i][j][0], m[i][j][1]); w.y = pack2bf(m[i][j][2], m[i][j][3]);
                *(uint2*)(merged + (size_t)lt * 1024 + n) = w;
            }
        }
    }
}

constexpr int PH_PER_LAYER = 14, PH_PER_PASS = 2 * PH_PER_LAYER + 1, NPHASE = 1 + NPASS * PH_PER_PASS;

__global__ void __launch_bounds__(512, 2) mk_forward(Params P0, int ph_lo, int ph_hi) {
    unsigned char* smem = dyn_smem;
    const int wave_s = __builtin_amdgcn_readfirstlane((int)threadIdx.x >> 6);
    for (int it_ = 2 * ph_lo; it_ < 2 * ph_hi; ++it_) {
        const int ph = it_ >> 1;
        if (it_ & 1) {
            if (PROBE_MASK == 0 || ph == 0) continue;
            const int r_ = (ph - 1) % PH_PER_PASS;
            if (r_ == PH_PER_PASS - 1 || !((PROBE_MASK >> (r_ % PH_PER_LAYER)) & 1)) continue;
        }
        if (it_ > 2 * ph_lo) cg::this_grid().sync();
        int z = 0; asm volatile("" : "+s"(z));
        Ctx C; C.tid = tid_now(wave_s, z); C.bid = (int)blockIdx.x + z; C.nblk = (int)gridDim.x + z; C.wave_s = wave_s;
        ptrtab_t tab = (ptrtab_t)__builtin_amdgcn_kernarg_segment_ptr();
        asm volatile("" : "+s"(tab));
        const PV P{tab, (float*)tab[29], (unsigned char*)tab[30]};
        if (ph == 0) { prep_phase(C, P, smem); continue; }
        const int q = ph - 1, pass = q / PH_PER_PASS, r = q % PH_PER_PASS;
        if (r == PH_PER_PASS - 1) { norm_phase(C, P, pass, P.inp(6) + (size_t)(1 * 3 + 2) * 1024, P.inp(7) + (size_t)(1 * 3 + 2) * 1024, 0, -1, false); continue; }
        const int layer = r / PH_PER_LAYER, lp = r % PH_PER_LAYER;
        const bf16_t* W = wl(P, layer);
        const float* lng = P.inp(6) + (size_t)layer * 3 * 1024; const float* lnb = P.inp(7) + (size_t)layer * 3 * 1024;
        unsigned char* R = P.ws + WS_R;
        switch (lp) {
            case 0:
                if (layer == 0) norm_phase(C, P, pass, nullptr, nullptr, 0, 0, true);
                else norm_phase(C, P, pass, P.inp(6) + (size_t)((layer - 1) * 3 + 2) * 1024, P.inp(7) + (size_t)((layer - 1) * 3 + 2) * 1024, layer, 0, false);
                break;
            case 1: ffn_up_phase(C, P, W + OW_FA_IN); break;
            case 2: resid_gemm_phase(C, P, pass, (const bf16_t*)(R + R_ACT), 2816, W + OW_FA_OUT, layer, 0, 0.5f); break;
            case 3: norm_phase(C, P, pass, lng, lnb, layer, 1, false); break;
            case 4: win_phase(C, P, layer); break;
            case 5: lin_pool_phase(C, P, layer); break;
            case 6: lora_phase(C, P, layer, smem); break;
            case 7:
                if (C.bid < 32) scan_block<4>(C, P, layer, 0, C.bid >> 2, (C.bid >> 1) & 1, (C.bid & 1) * 32, smem);
                else if (C.bid < 160) { const int i2 = C.bid - 32; scan_block<8>(C, P, layer, 1 + (i2 >> 4), (i2 >> 1) & 7, i2 & 1, 0, smem); }
                attn_items(C, P, layer, pass * 2 + layer, smem); fft_items(C, P, smem); break;
            case 8: finish_phase(C, P, layer); break;
            case 9: merge_phase(C, P, layer, smem); break;
            case 10: resid_gemm_phase(C, P, pass, (const bf16_t*)(R + R_MERGED), 1024, W + OW_WOUT, layer, 1, 1.0f); break;
            case 11: norm_phase(C, P, pass, lng + 1024, lnb + 1024, layer, 2, false); break;
            case 12: ffn_up_phase(C, P, W + OW_FB_IN); break;
            default: resid_gemm_phase(C, P, pass, (const bf16_t*)(R + R_ACT), 2816, W + OW_FB_OUT, layer, 2, 0.5f); break;
        }
    }
}

extern "C" void kernel_launch(void* const* d_in, const int* in_sizes, int n_in, void* d_out, int out_size, void* d_ws, size_t ws_size, hipStream_t stream) {
    static int grid_blocks = 0;
    if (!grid_blocks) {
        int dev = 0, cus = 0, per_cu = 0;
        (void)hipGetDevice(&dev);
        (void)hipDeviceGetAttribute(&cus, hipDeviceAttributeMultiprocessorCount, dev);
        (void)hipFuncSetAttribute((const void*)mk_forward, hipFuncAttributeMaxDynamicSharedMemorySize, LDS_BYTES);
        (void)hipOccupancyMaxActiveBlocksPerMultiprocessor(&per_cu, mk_forward, NT, LDS_BYTES);
        if (per_cu < 1) per_cu = 1;
        if (per_cu > 1) per_cu = 1;
        grid_blocks = cus * per_cu;
    }
    Params p{};
    for (int i = 0; i < 29; ++i) p.in[i] = (const float*)d_in[i];
    p.out = (float*)d_out; p.ws = (unsigned char*)d_ws;
#if ONE_LAUNCH
    int lo = 0, hi = NPHASE;
    void* args[] = {&p, &lo, &hi};
    hipError_t e = hipLaunchCooperativeKernel((void*)mk_forward, dim3(grid_blocks), dim3(NT), args, LDS_BYTES, stream);
    if (e != hipSuccess) fprintf(stderr, "cooperative launch failed: %s (grid %d)\n", hipGetErrorString(e), grid_blocks);
#else
    for (int ph = 0; ph < NPHASE; ++ph) {
        int lo = ph, hi = ph + 1;
        void* args[] = {&p, &lo, &hi};
        (void)hipLaunchCooperativeKernel((void*)mk_forward, dim3(grid_blocks), dim3(NT), args, LDS_BYTES, stream);
    }
#endif
}
```

```cpp
#include <hip/hip_runtime.h>
#include <hip/hip_cooperative_groups.h>
#include <cstdio>
#include <cstdint>
namespace cg = cooperative_groups;

typedef unsigned short bf16_t;
typedef _Float16 f16;
typedef short bf16x8 __attribute__((ext_vector_type(8)));
typedef float f32x4 __attribute__((ext_vector_type(4)));
typedef unsigned u32x4 __attribute__((ext_vector_type(4)));
typedef unsigned u32x2 __attribute__((ext_vector_type(2)));

#ifndef ONE_LAUNCH
#define ONE_LAUNCH 1
#endif
#ifndef PROBE_MASK
#define PROBE_MASK 0
#endif

constexpr int TP = 40960;
constexpr int NPASS = 2;
constexpr int NSEQ = 9;
constexpr int MT = TP / 128;
constexpr int N_IN_FULL = 8576;
constexpr float ALPHA = 1.41421356237f;

constexpr size_t OW_FA_IN = 0, OW_FA_OUT = 5767168, OW_FB_IN = 8650752, OW_FB_OUT = 14417920, OW_WIN = 17301504,
                 OW_WBR = 26083328, OW_WOUT = 28180480, OW_W2T = 29229056, OW_A2T = 29294592, OW_G2T = 29360128, WL_TOTAL = 29425664;
constexpr size_t WS_W = 0, WS_TW = 117702656, WS_MOD = 117735424, WS_HMOD = 119062528, WS_R = 202948608, WS_INVN = 1062780928, WS_CTR = 1064091648;
constexpr size_t R_RAW = 0, R_LIN = 157286400, R_WA = 188743680, R_G = 356515840, R_Q = 398458880, R_K = 440401920, R_VT = 482344960,
                 R_YFB = 524288000, R_ZC = 608174080, R_POOLP = 650117120, R_YB = 692060160, R_ACT = 0, R_MERGED = 0;
constexpr size_t SZ512 = (size_t)TP * 512;

struct Params { const float* in[29]; float* out; unsigned char* ws; };
struct Ctx { int tid, bid, nblk, wave_s; };
__device__ __forceinline__ int tid_now(int wave_s, int z) { return wave_s * 64 + (int)__builtin_amdgcn_mbcnt_hi(~0u, __builtin_amdgcn_mbcnt_lo(~0u, (unsigned)z)); }
typedef const float* const __attribute__((address_space(4)))* ptrtab_t;
struct PV { ptrtab_t tab; float* out; unsigned char* ws;
    __device__ __forceinline__ const float* inp(int i) const { return tab[i]; } };
constexpr int NT = 512, NWV = 8;
extern __shared__ __attribute__((aligned(16))) unsigned char dyn_smem[];
constexpr int LDS_BYTES = 131072;

__device__ __forceinline__ bf16_t f2bf(float f) { unsigned u = __float_as_uint(f); u += 0x7fffu + ((u >> 16) & 1u); return (bf16_t)(u >> 16); }
__device__ __forceinline__ float bf2f(bf16_t b) { return __uint_as_float(((unsigned)b) << 16); }
__device__ __forceinline__ unsigned pack2bf(float a, float b) { return (unsigned)f2bf(a) | ((unsigned)f2bf(b) << 16); }
__device__ __forceinline__ float wsum(float v) {
#pragma unroll
    for (int o = 32; o > 0; o >>= 1) v += __shfl_xor(v, o);
    return v;
}
__device__ __forceinline__ float sigmoidf_(float x) { return 1.0f / (1.0f + __expf(-x)); }
template <int CTRL> __device__ __forceinline__ float dppf(float v) { return __int_as_float(__builtin_amdgcn_update_dpp(0, __float_as_int(v), CTRL, 0xF, 0xF, true)); }
__device__ __forceinline__ float red8(float v) { v += dppf<0xB1>(v); v += dppf<0x4E>(v); v += dppf<0x141>(v); return v; }

__device__ __forceinline__ int grow_of(int pass, int lt) { return lt < 8192 ? pass * 8192 + lt : 16384 + pass * 32768 + (lt - 8192); }
__device__ __forceinline__ int brow_of(int pass, int lt) { return lt < 8192 ? pass : 2 + pass * 8 + ((lt - 8192) >> 12); }
__device__ __forceinline__ int pos_of(int lt) { return lt < 8192 ? lt : ((lt - 8192) & 4095); }
__device__ __forceinline__ int seqbase_of(int sq) { return sq == 0 ? 0 : 8192 + (sq - 1) * 4096; }
__device__ __forceinline__ int seqlen_of(int sq) { return sq == 0 ? 8192 : 4096; }

__device__ __forceinline__ bf16_t* wl(const PV& P, int layer) { return (bf16_t*)(P.ws + WS_W) + (size_t)layer * WL_TOTAL; }

template <int NJ, bool SWAP>
__device__ __forceinline__ void gemm_core(const Ctx& C, f32x4 (&acc)[4][NJ], const bf16_t* __restrict__ A, int lda, const bf16_t* __restrict__ B, int ldb, int K, unsigned char* smem) {
    const int tid = C.tid & 255, lane = tid & 63, wave = tid >> 6, wm = wave >> 1, wn = wave & 1, fr = lane & 15, fq = lane >> 4;
    smem += (C.tid >> 8) * 36864;
    u32x4 ra[4], rb[NJ];
#pragma unroll
    for (int i = 0; i < 4; ++i)
#pragma unroll
        for (int j = 0; j < NJ; ++j) acc[i][j] = (f32x4){0.f, 0.f, 0.f, 0.f};
    const int lrow = tid >> 3, lkc = (tid & 7) * 8;
#pragma unroll
    for (int i = 0; i < 4; ++i) ra[i] = *(const u32x4*)(A + (size_t)(lrow + 32 * i) * lda + lkc);
#pragma unroll
    for (int i = 0; i < NJ; ++i) rb[i] = *(const u32x4*)(B + (size_t)(lrow + 32 * i) * ldb + lkc);
    for (int k0 = 0; k0 < K; k0 += 64) {
        __syncthreads();
#pragma unroll
        for (int i = 0; i < 4; ++i) *(u32x4*)(smem + (lrow + 32 * i) * 144 + lkc * 2) = ra[i];
#pragma unroll
        for (int i = 0; i < NJ; ++i) *(u32x4*)(smem + 18432 + (lrow + 32 * i) * 144 + lkc * 2) = rb[i];
        __syncthreads();
        if (k0 + 64 < K) {
#pragma unroll
            for (int i = 0; i < 4; ++i) ra[i] = *(const u32x4*)(A + (size_t)(lrow + 32 * i) * lda + k0 + 64 + lkc);
#pragma unroll
            for (int i = 0; i < NJ; ++i) rb[i] = *(const u32x4*)(B + (size_t)(lrow + 32 * i) * ldb + k0 + 64 + lkc);
        }
#pragma unroll
        for (int ks = 0; ks < 2; ++ks) {
            bf16x8 af[4], bfr[NJ];
#pragma unroll
            for (int i = 0; i < 4; ++i) af[i] = *(const bf16x8*)(smem + (wm * 64 + i * 16 + fr) * 144 + (ks * 32 + fq * 8) * 2);
#pragma unroll
            for (int j = 0; j < NJ; ++j) bfr[j] = *(const bf16x8*)(smem + 18432 + (wn * NJ * 16 + j * 16 + fr) * 144 + (ks * 32 + fq * 8) * 2);
#pragma unroll
            for (int i = 0; i < 4; ++i)
#pragma unroll
                for (int j = 0; j < NJ; ++j)
                    acc[i][j] = SWAP ? __builtin_amdgcn_mfma_f32_16x16x32_bf16(bfr[j], af[i], acc[i][j], 0, 0, 0)
                                     : __builtin_amdgcn_mfma_f32_16x16x32_bf16(af[i], bfr[j], acc[i][j], 0, 0, 0);
        }
    }
}


namespace g256 {
constexpr int BK = 64, HALF = 128, HT = HALF * BK;
__device__ __forceinline__ int lds_byte(int r, int c) { int st = (r >> 4) * 2 + (c >> 5), rr = r & 15, cc = c & 31, ob = rr * 64 + cc * 2; return st * 1024 + (ob ^ (((ob >> 9) & 1) << 5)); }
__device__ __forceinline__ void stage_rc(unsigned b, unsigned& R, unsigned& Cc) { const unsigned st = b >> 10, sb = b & 1023u, swz = sb ^ (((sb >> 9) & 1u) << 5); R = (st >> 1) * 16u + (swz >> 6); Cc = (st & 1u) * 32u + ((swz & 63u) >> 1); }
}
__device__ __forceinline__ void gemm256(const Ctx& C, f32x4 (&acc)[2][2][4][2], const bf16_t* __restrict__ A, const bf16_t* __restrict__ Bt, const int K, const int brow, const int bcol) {
    using namespace g256;
    bf16_t* shm = (bf16_t*)dyn_smem;
    const int tidx = C.tid;
    #define SA(b,h) (shm+((b)*2+(h))*HT)
    #define SB(b,h) (shm+(4+(b)*2+(h))*HT)
    #define STAGE(Pp,BASE,br,kt) do{const char* _ub=(const char*)((BASE)+(long)(br)*K+(long)(kt)*BK); asm volatile("" : "+s"(_ub)); \
        __builtin_amdgcn_global_load_lds((const unsigned*)(_ub+goff0), \
          (__attribute__((address_space(3))) unsigned*)((__attribute__((address_space(3))) char*)(Pp)+tidx*16),16,0,0); \
        __builtin_amdgcn_global_load_lds((const unsigned*)(_ub+goff1), \
          (__attribute__((address_space(3))) unsigned*)((__attribute__((address_space(3))) char*)(Pp)+tidx*16+8192),16,0,0);}while(0)
    #define LDA(dst,b,h) for(int m=0;m<4;++m)for(int k=0;k<2;++k) \
      dst[m][k]=*reinterpret_cast<const bf16x8*>(a_ptr+((b)*2+(h))*16384+m*2048+k*1024)
    #define LDB(dst,b,h) for(int n=0;n<2;++n)for(int k=0;k<2;++k) \
      dst[n][k]=*reinterpret_cast<const bf16x8*>(b_ptr+((b)*2+(h))*16384+n*2048+k*1024)
    #define MMA(ai,bj,Atx,Btx) do{__builtin_amdgcn_s_setprio(1); \
      for(int m=0;m<4;++m)for(int n=0;n<2;++n)for(int k=0;k<2;++k) \
        acc[ai][bj][m][n]=__builtin_amdgcn_mfma_f32_16x16x32_bf16(Btx[n][k],Atx[m][k],acc[ai][bj][m][n],0,0,0); \
      __builtin_amdgcn_s_setprio(0);}while(0)
    #define WAIT_V(n) asm volatile("s_waitcnt vmcnt(" #n ")":::"memory")
    #define WAIT_L(n) asm volatile("s_waitcnt lgkmcnt(" #n ")":::"memory")
    #define BAR __builtin_amdgcn_s_barrier()
    #define SCHED __builtin_amdgcn_sched_barrier(0)
    const int wid = tidx >> 6, lane = tidx & 63, wr = wid >> 2, wc = wid & 3, fr = lane & 15, fq = lane >> 4;
    const int swz = (fr * 64 + fq * 16) ^ ((fr >> 3) << 5);
    const char* a_ptr = (const char*)dyn_smem + wr * 8192 + swz;
    const char* b_ptr = (const char*)dyn_smem + 65536 + wc * 4096 + swz;
#pragma unroll
    for (int a = 0; a < 2; ++a)
#pragma unroll
        for (int b = 0; b < 2; ++b)
#pragma unroll
            for (int m = 0; m < 4; ++m) { acc[a][b][m][0] = (f32x4){0.f, 0.f, 0.f, 0.f}; acc[a][b][m][1] = (f32x4){0.f, 0.f, 0.f, 0.f}; }
    bf16x8 At[4][2], B0[2][2], B1[2][2];
    const int nt = K / BK;
    unsigned goff0, goff1;
    { unsigned r0, c0, r1, c1; stage_rc((unsigned)tidx * 16u, r0, c0); stage_rc((unsigned)tidx * 16u + 8192u, r1, c1); goff0 = (r0 * (unsigned)K + c0) * 2u; goff1 = (r1 * (unsigned)K + c1) * 2u; }
    WAIT_V(0); __syncthreads();
    STAGE(SB(0,0),Bt,bcol,0); STAGE(SA(0,0),A,brow,0);
    STAGE(SB(0,1),Bt,bcol+HALF,0); STAGE(SA(0,1),A,brow+HALF,0);
    if(wr==1)BAR;
    WAIT_V(4); BAR;
    STAGE(SB(1,0),Bt,bcol,1); STAGE(SA(1,0),A,brow,1); STAGE(SB(1,1),Bt,bcol+HALF,1);
    WAIT_V(6); BAR;
    for(int t=0;t<nt-2;t+=2){
      LDB(B0,0,0); SCHED; LDA(At,0,0); STAGE(SA(1,1),A,brow+HALF,t+1);
      WAIT_L(8); BAR; WAIT_L(0); MMA(0,0,At,B0); BAR; SCHED;
      LDB(B1,0,1); STAGE(SB(0,0),Bt,bcol,t+2);
      BAR; WAIT_L(0); MMA(0,1,At,B1); BAR;
      LDA(At,0,1); STAGE(SA(0,0),A,brow,t+2);
      BAR; WAIT_L(0); MMA(1,0,At,B0); BAR; SCHED;
      STAGE(SB(0,1),Bt,bcol+HALF,t+2);
      WAIT_V(6); BAR; MMA(1,1,At,B1); BAR;
      LDB(B0,1,0); SCHED; LDA(At,1,0); STAGE(SA(0,1),A,brow+HALF,t+2);
      WAIT_L(8); BAR; WAIT_L(0); MMA(0,0,At,B0); BAR; SCHED;
      LDB(B1,1,1); STAGE(SB(1,0),Bt,bcol,t+3);
      BAR; WAIT_L(0); MMA(0,1,At,B1); BAR;
      LDA(At,1,1); STAGE(SA(1,0),A,brow,t+3);
      BAR; WAIT_L(0); MMA(1,0,At,B0); BAR; SCHED;
      STAGE(SB(1,1),Bt,bcol+HALF,t+3);
      WAIT_V(6); BAR; MMA(1,1,At,B1); BAR;
    }
    { LDB(B0,0,0); LDA(At,0,0); STAGE(SA(1,1),A,brow+HALF,nt-1);
      BAR; WAIT_L(0); MMA(0,0,At,B0); BAR;
      LDB(B1,0,1); BAR; WAIT_L(0); MMA(0,1,At,B1); BAR;
      LDA(At,0,1); WAIT_V(4); BAR; WAIT_L(0); MMA(1,0,At,B0); MMA(1,1,At,B1); BAR; }
    { LDB(B0,1,0); LDA(At,1,0); WAIT_V(2); BAR; WAIT_L(0); MMA(0,0,At,B0); BAR;
      LDB(B1,1,1); WAIT_V(0); BAR; WAIT_L(0); MMA(0,1,At,B1); BAR;
      LDA(At,1,1); BAR; WAIT_L(0); MMA(1,0,At,B0); MMA(1,1,At,B1); BAR; }
    if(wr==0)BAR;
    #undef SA
    #undef SB
    #undef STAGE
    #undef LDA
    #undef LDB
    #undef MMA
    #undef WAIT_V
    #undef WAIT_L
    #undef BAR
    #undef SCHED
}
__device__ __forceinline__ bool tile_order(int i, int G, int c, int nM, int nN, int& pm, int& pn) {
    const int nwg = nM * nN; const long L = (long)i * G + c; if (L >= nwg) return false;
    int wgid = (int)L; { const int q = nwg / 8, r = nwg % 8, xcd = wgid % 8, off = wgid / 8; wgid = (xcd < r ? xcd * (q + 1) : r * (q + 1) + (xcd - r) * q) + off; }
    const int nig = 8 * nN, gid = wgid / nig, fm = gid * 8, gsz = (nM - fm) < 8 ? (nM - fm) : 8;
    pm = fm + ((wgid % nig) % gsz); pn = (wgid % nig) / gsz; return true;
}

struct ConvJob { const float* src; int ld, K, nbegin, ncount, map; bf16_t* dst; };
__device__ __forceinline__ ConvJob conv_job(const PV& P, int j) {
    const int l = j >> 4, q = j & 15; bf16_t* W = wl(P, l); ConvJob c; c.map = 0; c.nbegin = 0;
    switch (q) {
        case 0: c.src = P.inp(8) + (size_t)l * 1024 * 5632; c.ld = 5632; c.K = 1024; c.ncount = 5632; c.dst = W + OW_FA_IN; c.map = 1; break;
        case 1: c.src = P.inp(9) + (size_t)l * 2816 * 1024; c.ld = 1024; c.K = 2816; c.ncount = 1024; c.dst = W + OW_FA_OUT; break;
        case 2: c.src = P.inp(10) + (size_t)l * 1024 * 5632; c.ld = 5632; c.K = 1024; c.ncount = 5632; c.dst = W + OW_FB_IN; c.map = 1; break;
        case 3: c.src = P.inp(11) + (size_t)l * 2816 * 1024; c.ld = 1024; c.K = 2816; c.ncount = 1024; c.dst = W + OW_FB_OUT; break;
        case 4: c.src = P.inp(12) + (size_t)l * 1024 * 8576; c.ld = 8576; c.K = 1024; c.ncount = 3456; c.dst = W + OW_WIN; break;
        case 5: c.src = P.inp(12) + (size_t)l * 1024 * 8576; c.ld = 8576; c.K = 1024; c.nbegin = 3968; c.ncount = 4608; c.dst = W + OW_WIN + (size_t)3968 * 1024; break;
        case 6: case 7: case 8: case 9: { const int n = q - 6; c.src = P.inp(27) + (size_t)(l * 4 + n) * 512 * 1024; c.ld = 1024; c.K = 512; c.ncount = 1024; c.dst = W + OW_WBR + (size_t)n * 1024 * 512; } break;
        case 10: c.src = P.inp(28) + (size_t)l * 1024 * 1024; c.ld = 1024; c.K = 1024; c.ncount = 1024; c.dst = W + OW_WOUT; break;
        case 11: case 12: { const int d = q - 11; c.src = P.inp(15) + (size_t)(l * 2 + d) * 64 * 512; c.ld = 512; c.K = 64; c.ncount = 512; c.dst = W + OW_W2T + (size_t)d * 512 * 64; } break;
        case 13: case 14: { const int d = q - 13; c.src = P.inp(17) + (size_t)(l * 2 + d) * 64 * 512; c.ld = 512; c.K = 64; c.ncount = 512; c.dst = W + OW_A2T + (size_t)d * 512 * 64; } break;
        default: c.src = P.inp(18) + (size_t)l * 128 * 512; c.ld = 512; c.K = 128; c.ncount = 512; c.dst = W + OW_G2T; break;
    }
    return c;
}

__device__ __forceinline__ void prep_phase(const Ctx& C, const PV& P, unsigned char* smem) {
    const int tid = C.tid;
    {
        int total = 0;
        for (int j = 0; j < 32; ++j) { ConvJob c = conv_job(P, j); total += (c.K >> 6) * (c.ncount >> 6); }
        float* tile = (float*)smem;
        const int tx = tid & 63, ty = tid >> 6;
        for (int t = C.bid; t < total; t += C.nblk) {
            int tt = t, j = 0; ConvJob c = conv_job(P, 0);
            for (;;) { const int n = (c.K >> 6) * (c.ncount >> 6); if (tt < n) break; tt -= n; ++j; c = conv_job(P, j); }
            const int nkt = c.K >> 6, kt = tt % nkt, nt = tt / nkt, k0 = kt * 64, n0 = nt * 64;
            int col = c.nbegin + n0 + tx;
            if (c.map) { const int np = n0 + tx, blk = np >> 5, w = np & 31, f = blk * 16 + (w & 15); col = (w < 16) ? f : 2816 + f; }
            __syncthreads();
#pragma unroll 4
            for (int i = 0; i < 8; ++i) { const int kk = ty + 8 * i; tile[kk * 65 + tx] = c.src[(size_t)(k0 + kk) * c.ld + col]; }
            __syncthreads();
#pragma unroll 4
            for (int i = 0; i < 8; ++i) { const int nn = ty + 8 * i; c.dst[(size_t)(n0 + nn) * c.K + k0 + tx] = f2bf(tile[tx * 65 + nn]); }
        }
        __syncthreads();
    }
    {
        float* wt = (float*)smem;
        float* cosT = (float*)(smem + 64 * 129 * 4);
        for (int it = C.bid; it < 2 * 4 * 16; it += C.nblk) {
            const int l = it >> 6, g = (it >> 4) & 3, kc = it & 15, k0 = kc * 64;
            const float* src = P.inp(12) + (size_t)l * 1024 * 8576 + 3456 + g * 128;
            __syncthreads();
            for (int e = tid; e < 64 * 128; e += NT) { const int kk = e >> 7, c = e & 127; wt[kk * 129 + c] = src[(size_t)(k0 + kk) * 8576 + c]; }
            if (tid < 128) cosT[tid] = cospif((float)tid * (1.0f / 64.0f));
            __syncthreads();
            bf16_t* dst = wl(P, l) + OW_WIN + (size_t)(3456 + g * 128) * 1024;
            const int kk = tid & 63;
            for (int i = 0; i < 16; ++i) {
                const int j2 = (tid >> 6) + 8 * i, cc = j2 >> 1, part = j2 & 1;
                float s = 0.f;
                if (cc == 0) {
                    if (part == 0) { for (int c = 0; c < 128; ++c) s += wt[kk * 129 + c]; }
                    else { for (int c = 0; c < 128; ++c) s += (c & 1) ? -wt[kk * 129 + c] : wt[kk * 129 + c]; }
                } else if (part == 0) {
                    for (int c = 0; c < 128; ++c) s += wt[kk * 129 + c] * cosT[(cc * c) & 127];
                } else {
                    for (int c = 0; c < 128; ++c) s -= wt[kk * 129 + c] * cosT[(cc * c - 32) & 127];
                }
                dst[(size_t)j2 * 1024 + k0 + kk] = f2bf(s);
            }
        }
        __syncthreads();
    }
    if (C.bid == 0 && tid < 16) ((unsigned*)(P.ws + WS_CTR))[tid] = 0u;
    {
        float2* tw = (float2*)(P.ws + WS_TW);
        for (int m = C.bid * NT + tid; m < 4096; m += C.nblk * NT) { const float x = (float)m * (1.0f / 4096.0f); tw[m] = make_float2(cospif(x), -sinpif(x)); }
    }
    {
        float* sc = (float*)smem;
        float* red = (float*)(smem + 18 * 512 * 4);
        float* mod = (float*)(P.ws + WS_MOD);
        for (int it = C.bid; it < 2 * 144; it += C.nblk) {
            const int l = it / 144, n0 = (it % 144) * 64, nl = tid & 63, ks = tid >> 6;
            const float* aw = P.inp(4) + (size_t)l * 1024 * 9216;
            float acc[18];
#pragma unroll
            for (int b = 0; b < 18; ++b) acc[b] = 0.f;
            for (int half = 0; half < 2; ++half) {
                __syncthreads();
                for (int e = tid; e < 18 * 512; e += NT) {
                    const int b = e >> 9, kk = e & 511, k = half * 512 + kk;
                    const float cv = b < 2 ? P.inp(2)[b * 1024 + k] : P.inp(3)[(b - 2) * 1024 + k];
                    sc[e] = cv / (1.0f + __expf(-cv));
                }
                __syncthreads();
                for (int kk = ks * 64; kk < ks * 64 + 64; ++kk) {
                    const float w = aw[(size_t)(half * 512 + kk) * 9216 + n0 + nl];
#pragma unroll
                    for (int b = 0; b < 18; ++b) acc[b] += sc[b * 512 + kk] * w;
                }
            }
            __syncthreads();
#pragma unroll
            for (int b = 0; b < 18; ++b) red[(ks * 18 + b) * 64 + nl] = acc[b];
            __syncthreads();
            for (int e = tid; e < 18 * 64; e += NT) {
                const int b = e >> 6, n = e & 63;
                float s = 0.f;
#pragma unroll
                for (int k8 = 0; k8 < 8; ++k8) s += red[(k8 * 18 + b) * 64 + n];
                mod[((size_t)l * 18 + b) * 9216 + n0 + n] = s + P.inp(5)[(size_t)l * 9216 + n0 + n];
            }
        }
        __syncthreads();
    }
}

__device__ __forceinline__ void norm_phase(const Ctx& C, const PV& P, int pass, const float* lng, const float* lnb, int mod_layer, int j, bool from_input) {
    const int lane = C.tid & 63, wave = C.tid >> 6;
    bf16_t* hmod = (bf16_t*)(P.ws + WS_HMOD);
    const float* mod = (const float*)(P.ws + WS_MOD);
    const int nw = C.nblk * NWV;
    for (int lt0 = C.bid * NWV + wave; lt0 < TP; lt0 += 2 * nw) {
        f32x4 v[2][4]; int gr[2], bb[2]; bool ok[2];
#pragma unroll
        for (int u = 0; u < 2; ++u) {
            const int lt = lt0 + u * nw; ok[u] = lt < TP;
            const int ltc = ok[u] ? lt : lt0;
            gr[u] = grow_of(pass, ltc); bb[u] = brow_of(pass, ltc);
            const float* src = from_input ? (gr[u] < 16384 ? P.inp(0) + (size_t)gr[u] * 1024 : P.inp(1) + (size_t)(gr[u] - 16384) * 1024) : P.out + (size_t)gr[u] * 1024;
#pragma unroll
            for (int i = 0; i < 4; ++i) v[u][i] = *(const f32x4*)(src + i * 256 + lane * 4);
        }
        if (lng) {
            float s[2], q[2], mu[2], rs[2];
#pragma unroll
            for (int u = 0; u < 2; ++u) { s[u] = 0.f;
#pragma unroll
                for (int i = 0; i < 4; ++i) s[u] += (v[u][i][0] + v[u][i][1]) + (v[u][i][2] + v[u][i][3]); }
#pragma unroll
            for (int o = 32; o > 0; o >>= 1) { s[0] += __shfl_xor(s[0], o); s[1] += __shfl_xor(s[1], o); }
#pragma unroll
            for (int u = 0; u < 2; ++u) { mu[u] = s[u] * (1.0f / 1024.0f); q[u] = 0.f;
#pragma unroll
                for (int i = 0; i < 4; ++i) { const f32x4 dd = v[u][i] - mu[u]; q[u] += (dd[0] * dd[0] + dd[1] * dd[1]) + (dd[2] * dd[2] + dd[3] * dd[3]); } }
#pragma unroll
            for (int o = 32; o > 0; o >>= 1) { q[0] += __shfl_xor(q[0], o); q[1] += __shfl_xor(q[1], o); }
#pragma unroll
            for (int u = 0; u < 2; ++u) rs[u] = rsqrtf(q[u] * (1.0f / 1024.0f) + 1e-5f);
#pragma unroll
            for (int i = 0; i < 4; ++i) {
                const f32x4 g = *(const f32x4*)(lng + i * 256 + lane * 4), be = *(const f32x4*)(lnb + i * 256 + lane * 4);
                v[0][i] = (v[0][i] - mu[0]) * rs[0] * g + be; v[1][i] = (v[1][i] - mu[1]) * rs[1] * g + be;
            }
        }
        if (lng || from_input) {
#pragma unroll
            for (int u = 0; u < 2; ++u) if (ok[u]) {
#pragma unroll
                for (int i = 0; i < 4; ++i) *(f32x4*)(P.out + (size_t)gr[u] * 1024 + i * 256 + lane * 4) = v[u][i];
            }
        }
        if (j >= 0) {
            float s[2], q[2], mu[2], rs[2];
#pragma unroll
            for (int u = 0; u < 2; ++u) { s[u] = 0.f;
#pragma unroll
                for (int i = 0; i < 4; ++i) s[u] += (v[u][i][0] + v[u][i][1]) + (v[u][i][2] + v[u][i][3]); }
#pragma unroll
            for (int o = 32; o > 0; o >>= 1) { s[0] += __shfl_xor(s[0], o); s[1] += __shfl_xor(s[1], o); }
#pragma unroll
            for (int u = 0; u < 2; ++u) { mu[u] = s[u] * (1.0f / 1024.0f); q[u] = 0.f;
#pragma unroll
                for (int i = 0; i < 4; ++i) { const f32x4 dd = v[u][i] - mu[u]; q[u] += (dd[0] * dd[0] + dd[1] * dd[1]) + (dd[2] * dd[2] + dd[3] * dd[3]); } }
#pragma unroll
            for (int o = 32; o > 0; o >>= 1) { q[0] += __shfl_xor(q[0], o); q[1] += __shfl_xor(q[1], o); }
#pragma unroll
            for (int u = 0; u < 2; ++u) {
                rs[u] = rsqrtf(q[u] * (1.0f / 1024.0f) + 1e-5f);
                if (!ok[u]) continue;
                const float* mb = mod + ((size_t)mod_layer * 18 + bb[u]) * 9216 + (size_t)(3 * j) * 1024;
                const int lt = lt0 + u * nw;
#pragma unroll
                for (int i = 0; i < 4; ++i) {
                    const f32x4 sh = *(const f32x4*)(mb + i * 256 + lane * 4), scl = *(const f32x4*)(mb + 1024 + i * 256 + lane * 4);
                    const f32x4 hh = (v[u][i] - mu[u]) * rs[u] * (1.0f + scl) + sh;
                    u32x2 o; o.x = pack2bf(hh[0], hh[1]); o.y = pack2bf(hh[2], hh[3]);
                    *(u32x2*)(hmod + (size_t)lt * 1024 + i * 256 + lane * 4) = o;
                }
            }
        }
    }
}

__device__ __forceinline__ void ffn_up_phase(const Ctx& C, const PV& P, const bf16_t* Wt) {
    const bf16_t* hmod = (const bf16_t*)(P.ws + WS_HMOD);
    bf16_t* act = (bf16_t*)(P.ws + WS_R + R_ACT);
    int pm, pn;
    for (int it = 0; tile_order(it, C.nblk, C.bid, TP / 256, 22, pm, pn); ++it) {
        f32x4 acc[2][2][4][2];
        gemm256(C, acc, hmod, Wt, 1024, pm * 256, pn * 256);
        int z2 = 0; asm volatile("" : "+s"(z2));
        const int tid2 = tid_now(C.wave_s, z2), lane = tid2 & 63, wid = tid2 >> 6, wr = wid >> 2, wc = wid & 3, fr = lane & 15, fq = lane >> 4;
#pragma unroll
        for (int ai = 0; ai < 2; ++ai)
#pragma unroll
            for (int m = 0; m < 4; ++m) {
                const int row = pm * 256 + ai * 128 + wr * 64 + m * 16 + fr;
#pragma unroll
                for (int bj = 0; bj < 2; ++bj) {
                    const int colbase = pn * 256 + bj * 128 + wc * 32, f = (colbase >> 5) * 16 + fq * 4;
                    const f32x4 a = acc[ai][bj][m][0], bb = acc[ai][bj][m][1];
                    float o[4];
#pragma unroll
                    for (int r = 0; r < 4; ++r) o[r] = a[r] / (1.0f + __expf(-a[r])) * bb[r];
                    u32x2 w; w.x = pack2bf(o[0], o[1]); w.y = pack2bf(o[2], o[3]);
                    *(u32x2*)(act + (size_t)row * 2816 + f) = w;
                }
            }
    }
}

__device__ __forceinline__ void resid_gemm_phase(const Ctx& C, const PV& P, int pass, const bf16_t* A, int K, const bf16_t* Wt, int layer, int j, float scale) {
    const float* mod = (const float*)(P.ws + WS_MOD);
    int pm, pn;
    for (int it = 0; tile_order(it, C.nblk, C.bid, TP / 256, 4, pm, pn); ++it) {
        f32x4 acc[2][2][4][2];
        gemm256(C, acc, A, Wt, K, pm * 256, pn * 256);
        int z2 = 0; asm volatile("" : "+s"(z2));
        const int tid2 = tid_now(C.wave_s, z2), lane = tid2 & 63, wid = tid2 >> 6, wr = wid >> 2, wc = wid & 3, fr = lane & 15, fq = lane >> 4;
#pragma unroll
        for (int ai = 0; ai < 2; ++ai)
#pragma unroll
            for (int m = 0; m < 4; ++m) {
                const int lt = pm * 256 + ai * 128 + wr * 64 + m * 16 + fr;
                const int gr = grow_of(pass, lt), b = brow_of(pass, lt);
                const float* gate = mod + ((size_t)layer * 18 + b) * 9216 + (size_t)(3 * j + 2) * 1024;
#pragma unroll
                for (int bj = 0; bj < 2; ++bj)
#pragma unroll
                    for (int n = 0; n < 2; ++n) {
                        const int col = pn * 256 + bj * 128 + wc * 32 + n * 16 + fq * 4;
                        f32x4* xp = (f32x4*)(P.out + (size_t)gr * 1024 + col);
                        const f32x4 x = *xp, g = *(const f32x4*)(gate + col);
                        *xp = ALPHA * x + (1.0f + g) * scale * acc[ai][bj][m][n];
                    }
            }
    }
}

__device__ __forceinline__ void win_phase(const Ctx& C, const PV& P, int layer) {
    const bf16_t* hmod = (const bf16_t*)(P.ws + WS_HMOD);
    const bf16_t* Wt = wl(P, layer) + OW_WIN;
    unsigned char* R = P.ws + WS_R;
    f16* raw = (f16*)(R + R_RAW); bf16_t* Qb = (bf16_t*)(R + R_Q); bf16_t* Kb = (bf16_t*)(R + R_K); bf16_t* Vt = (bf16_t*)(R + R_VT);
    f16* Zc = (f16*)(R + R_ZC); f16* poolp = (f16*)(R + R_POOLP);
    typedef f16 f16x4 __attribute__((ext_vector_type(4)));
    typedef f16 f16x2 __attribute__((ext_vector_type(2)));
    int pm, pn;
    for (int it = 0; tile_order(it, C.nblk, C.bid, TP / 256, 18, pm, pn); ++it) {
        const int lt_t = pm * 256, sq = lt_t < 8192 ? 0 : 1 + ((lt_t - 8192) >> 12), lt0 = seqbase_of(sq), S = seqlen_of(sq);
        f32x4 acc[2][2][4][2];
        gemm256(C, acc, hmod, Wt, 1024, pm * 256, pn * 256);
        int z2 = 0; asm volatile("" : "+s"(z2));
        const int tid2 = tid_now(C.wave_s, z2), lane = tid2 & 63, wid = tid2 >> 6, wr = wid >> 2, wc = wid & 3, fr = lane & 15, fq = lane >> 4;
#pragma unroll
        for (int bj = 0; bj < 2; ++bj) {
            const int tn = pn * 2 + bj;
            if (tn >= 35) continue;
#pragma unroll
            for (int ai = 0; ai < 2; ++ai)
#pragma unroll
                for (int m = 0; m < 4; ++m) {
                    const int lt = pm * 256 + ai * 128 + wr * 64 + m * 16 + fr, pos = lt - lt0;
#pragma unroll
                    for (int n = 0; n < 2; ++n) {
                        const int col = tn * 128 + wc * 32 + n * 16 + fq * 4;
                        f32x4 v = acc[ai][bj][m][n];
                        if (tn < 15) {
                            f16x4 h; h[0] = (f16)v[0]; h[1] = (f16)v[1]; h[2] = (f16)v[2]; h[3] = (f16)v[3];
                            *(f16x4*)(raw + (size_t)lt * 1920 + col) = h;
                        } else if (tn < 23) {
                            const int nq = (col - 1920) & 511, hc = nq >> 6, d = nq & 63;
                            if (n == 0 && (wc & 1) == 0) {
#pragma unroll
                                for (int r = 0; r < 4; ++r) {
                                    const float invlo = r == 0 ? 1.0f : r == 1 ? 0.1939227432012558f : r == 2 ? 0.03760603070259094f : 0.007292664609849453f;
                                    const float invhi = r == 0 ? 0.0014142135623842478f : r == 1 ? 0.00027424818836152554f : r == 2 ? 5.3182957344688475e-05f : 1.0313385246263351e-05f;
                                    const float ang = (float)pos * ((fq & 1) ? invhi : invlo);
                                    const float hi = ang * 0.15915493667125702f;
                                    const float lo = __builtin_fmaf(ang, 0.15915493667125702f, -hi) + ang * 6.4206382432985265e-09f;
                                    const float rr = (hi - floorf(hi)) + lo;
                                    const float cs = __builtin_amdgcn_cosf(rr), sn = __builtin_amdgcn_sinf(rr);
                                    const float other = __shfl_xor(v[r], 32);
                                    v[r] = (fq < 2) ? (v[r] * cs - other * sn) : (other * sn + v[r] * cs);
                                }
                            }
                            bf16_t* dst = (tn < 19) ? Qb : Kb;
                            const float sc = (tn < 19) ? 0.125f * 1.44269504088896f : 1.0f;
                            u32x2 w; w.x = pack2bf(v[0] * sc, v[1] * sc); w.y = pack2bf(v[2] * sc, v[3] * sc);
                            *(u32x2*)(dst + (size_t)lt0 * 512 + ((size_t)hc * S + pos) * 64 + d) = w;
                        } else if (tn < 27) {
                            const int nv = col - 2944;
                            bf16_t* vb = Vt + (size_t)lt0 * 512 + (size_t)nv * S + pos;
                            vb[0] = f2bf(v[0]); vb[(size_t)S] = f2bf(v[1]); vb[(size_t)2 * S] = f2bf(v[2]); vb[(size_t)3 * S] = f2bf(v[3]);
                        } else if (tn < 31) {
                            const int nz = col - 3456, g = nz >> 7, cc = (nz & 127) >> 1;
                            f16x2 z0, z1; z0[0] = (f16)v[0]; z0[1] = (f16)v[1]; z1[0] = (f16)v[2]; z1[1] = (f16)v[3];
                            f16x2* zb = (f16x2*)Zc + (size_t)lt0 * 256;
                            zb[(size_t)(g * 64 + cc) * S + pos] = z0;
                            zb[(size_t)(g * 64 + cc + 1) * S + pos] = z1;
                        } else {
                            f16x4 h; h[0] = (f16)v[0]; h[1] = (f16)v[1]; h[2] = (f16)v[2]; h[3] = (f16)v[3];
                            *(f16x4*)(poolp + (size_t)lt * 512 + (col - 3968)) = h;
                        }
                    }
                    asm volatile("" ::: "memory");
                }
        }
    }
}

__device__ __forceinline__ float shiftv(const f16* __restrict__ raw, int lt, int t, int S, int col, float mu) {
    const float p = (float)raw[(size_t)lt * 1920 + col];
    const float pr = t > 0 ? (float)raw[(size_t)(lt - 1) * 1920 + col] : 0.f;
    const float nx = t < S - 1 ? (float)raw[(size_t)(lt + 1) * 1920 + col] : 0.f;
    return p + (0.5f * (pr + nx) - p) * mu;
}

typedef f16 f16x4_t __attribute__((ext_vector_type(4)));
typedef f16 f16x8_t __attribute__((ext_vector_type(8)));
__device__ __forceinline__ void lin_pool_phase(const Ctx& C, const PV& P, int layer) {
    unsigned char* R = P.ws + WS_R;
    const f16* raw = (const f16*)(R + R_RAW); bf16_t* lin = (bf16_t*)(R + R_LIN);
    const f16* poolp = (const f16*)(R + R_POOLP); bf16_t* ypool = (bf16_t*)(R + R_YB) + 3 * SZ512;
    const float* mu = P.inp(13) + (size_t)layer * 1920; const float* pscale = P.inp(26) + (size_t)layer * 512;
    const int gsz = C.nblk * NT, gid = C.bid * NT + C.tid;
    for (int e = gid; e < TP * 96; e += gsz) {
        const int lt = e / 96, c = (e % 96) * 4, col = 1536 + c;
        const int pos = pos_of(lt), S = lt < 8192 ? 8192 : 4096;
        const f16x4_t p0 = *(const f16x4_t*)(raw + (size_t)lt * 1920 + col);
        const f16x4_t pm = *(const f16x4_t*)(raw + (size_t)(pos > 0 ? lt - 1 : lt) * 1920 + col);
        const f16x4_t pp = *(const f16x4_t*)(raw + (size_t)(pos < S - 1 ? lt + 1 : lt) * 1920 + col);
        const f32x4 m4 = *(const f32x4*)(mu + col);
        const float wm = pos > 0 ? 0.5f : 0.f, wp = pos < S - 1 ? 0.5f : 0.f;
        float o[4];
#pragma unroll
        for (int r = 0; r < 4; ++r) {
            const float p = (float)p0[r];
            float v = p + (wm * (float)pm[r] + wp * (float)pp[r] - p) * m4[r];
            if (c < 128) v = 1.0f - 2.0f / (__expf(2.0f * v) + 1.0f);
            else if (c >= 256) v = sigmoidf_(v);
            o[r] = v;
        }
        u32x2 w; w.x = pack2bf(o[0], o[1]); w.y = pack2bf(o[2], o[3]);
        *(u32x2*)(lin + (size_t)lt * 384 + c) = w;
    }
    for (int e = gid; e < TP * 128; e += gsz) {
        const int lt = e >> 7, c = (e & 127) * 4, g = c >> 7, half = 1 << g;
        const int pos = pos_of(lt), S = lt < 8192 ? 8192 : 4096;
        const int lo = max(pos - half, 0), hi = min(pos + half, S);
        const f16* base = poolp + (size_t)(lt - pos) * 512 + c;
        float s0 = 0.f, s1 = 0.f, s2 = 0.f, s3 = 0.f;
#pragma unroll
        for (int o = -8; o < 8; ++o) {
            const int tt = pos + o;
            const bool in = (o >= -half) && (o < half) && tt >= 0 && tt < S;
            if (in) { const f16x4_t v = *(const f16x4_t*)(base + (size_t)tt * 512); s0 += (float)v[0]; s1 += (float)v[1]; s2 += (float)v[2]; s3 += (float)v[3]; }
        }
        const f16x4_t x = *(const f16x4_t*)(base + (size_t)pos * 512);
        const f32x4 ps = *(const f32x4*)(pscale + c);
        const float ic = 1.0f / (float)(hi - lo);
        u32x2 w; w.x = pack2bf((s0 * ic - (float)x[0]) * ps[0], (s1 * ic - (float)x[1]) * ps[1]); w.y = pack2bf((s2 * ic - (float)x[2]) * ps[2], (s3 * ic - (float)x[3]) * ps[3]);
        *(u32x2*)(ypool + (size_t)lt * 512 + c) = w;
    }
    {
        float* invn = (float*)(P.ws + WS_INVN);
        const float* k_k = P.inp(19) + (size_t)layer * 512;
        const int lane = C.tid & 63, wave = C.tid >> 6;
        for (int lt = C.bid * NWV + wave; lt < TP; lt += C.nblk * NWV) {
            const int pos = pos_of(lt), S = lt < 8192 ? 8192 : 4096;
            float ss[8];
#pragma unroll
            for (int h = 0; h < 8; ++h) {
                const int c = h * 64 + lane;
                const float k = shiftv(raw, lt, pos, S, 512 + c, mu[512 + c]) * k_k[c];
                ss[h] = k * k;
            }
#pragma unroll
            for (int h = 0; h < 8; ++h) ss[h] = wsum(ss[h]);
            if (lane < 8) {
                float sel = ss[0];
#pragma unroll
                for (int h = 1; h < 8; ++h) sel = lane == h ? ss[h] : sel;
                invn[(size_t)lt * 8 + lane] = 1.0f / fmaxf(sqrtf(sel), 1e-12f);
            }
        }
    }
}

__device__ __forceinline__ void lora_phase(const Ctx& C, const PV& P, int layer, unsigned char* smem) {
    unsigned char* R = P.ws + WS_R;
    const bf16_t* lin = (const bf16_t*)(R + R_LIN); f16* wa = (f16*)(R + R_WA); f16* gbuf = (f16*)(R + R_G);
    const bf16_t* W = wl(P, layer);
    const int lane = C.tid & 63, wave = (C.tid >> 6) & 3, wm = wave >> 1, wn = wave & 1, fr = lane & 15, fq = lane >> 4;
    for (int t2 = C.bid; t2 < 5 * MT * 2; t2 += C.nblk) {
        const int t = t2 * 2 + (C.tid >> 8);
        const int which = t / (MT * 4), tt = t % (MT * 4), tm = tt >> 2, tn = tt & 3;
        const bf16_t* Bt; int K, acol; const float* bias = nullptr; f16* dst;
        if (which < 2) { Bt = W + OW_W2T + (size_t)which * 512 * 64; K = 64; acol = which * 64; bias = P.inp(14) + (size_t)(layer * 2 + which) * 512; dst = wa + (size_t)which * SZ512; }
        else if (which < 4) { const int d = which - 2; Bt = W + OW_A2T + (size_t)d * 512 * 64; K = 64; acol = 128 + d * 64; bias = P.inp(16) + (size_t)(layer * 2 + d) * 512; dst = wa + (size_t)which * SZ512; }
        else { Bt = W + OW_G2T; K = 128; acol = 256; dst = gbuf; }
        f32x4 acc[4][4];
        gemm_core<4, true>(C, acc, lin + (size_t)tm * 128 * 384 + acol, 384, Bt + (size_t)tn * 128 * K, K, K, smem);
#pragma unroll
        for (int i = 0; i < 4; ++i) {
            const int lt = tm * 128 + wm * 64 + i * 16 + fr;
#pragma unroll
            for (int jn = 0; jn < 4; ++jn) {
                const int n = tn * 128 + wn * 64 + jn * 16 + fq * 4;
                typedef f16 f16x4 __attribute__((ext_vector_type(4)));
                f16x4 h;
#pragma unroll
                for (int r = 0; r < 4; ++r) {
                    float v = acc[i][jn][r];
                    if (which < 2) {
                        const float z = bias[n + r] + v, nz = -z;
                        const float sp = fmaxf(nz, 0.f) + log1pf(expf(-fabsf(nz)));
                        v = expf(-expf(-sp - 0.5f));
                    } else if (which < 4) { v = 1.0f / (1.0f + expf(-(bias[n + r] + v))); }
                    h[r] = (f16)v;
                }
                *(f16x4*)(dst + (size_t)lt * 512 + n) = h;
            }
        }
    }
}

__device__ __forceinline__ void attn_items(const Ctx& C, const PV& P, int layer, int ctr_idx, unsigned char* smem) {
    unsigned char* R = P.ws + WS_R;
    const bf16_t* Qall = (const bf16_t*)(R + R_Q); const bf16_t* Kall = (const bf16_t*)(R + R_K); const bf16_t* Vall = (const bf16_t*)(R + R_VT);
    bf16_t* ydiff = (bf16_t*)(R + R_YB) + 1 * SZ512;
    const int tid = C.tid, lane = tid & 63, wave = tid >> 6, comp = wave & 1, rg = wave >> 1, fr = lane & 15, fq = lane >> 4;
    const float lam_init = layer == 0 ? 0.2f : (0.8f - 0.6f * 0.7408182206817179f);
    float lam_full;
    {
        const float* lm = P.inp(24) + (size_t)layer * 256;
        float s1 = 0.f, s2 = 0.f;
        for (int i = 0; i < 64; ++i) { s1 += lm[i] * lm[64 + i]; s2 += lm[128 + i] * lm[192 + i]; }
        lam_full = expf(s1) - expf(s2) + lam_init;
    }
    const float* normg = P.inp(25) + (size_t)layer * 128;
    unsigned* ctr = (unsigned*)(P.ws + WS_CTR) + ctr_idx;
    volatile unsigned* bc = (volatile unsigned*)(smem + 131056);
    for (;;) {
        __syncthreads();
        if (tid == 0) *bc = atomicAdd(ctr, 1u);
        __syncthreads();
        const int item = (int)*bc;
        if (item >= 1280) break;
        int sq, h, qb;
        if (item < 256) { sq = 0; h = item >> 6; qb = item & 63; } else { const int i2 = item - 256; sq = 1 + (i2 >> 7); h = (i2 >> 5) & 3; qb = i2 & 31; }
        const int lt0 = seqbase_of(sq), S = seqlen_of(sq);
        const bf16_t* Qb = Qall + (size_t)lt0 * 512; const bf16_t* Kb = Kall + (size_t)lt0 * 512; const bf16_t* Vb = Vall + (size_t)lt0 * 512 + (size_t)h * 128 * S;
        const int q0 = qb * 128 + rg * 32;
        bf16x8 bq[2][2];
#pragma unroll
        for (int qs = 0; qs < 2; ++qs)
#pragma unroll
            for (int ks = 0; ks < 2; ++ks) bq[qs][ks] = *(const bf16x8*)(Qb + ((size_t)(h * 2 + comp) * S + q0 + qs * 16 + fr) * 64 + ks * 32 + fq * 8);
        float m_run[2] = {-1e30f, -1e30f}, l_run[2] = {0.f, 0.f};
        f32x4 O[8][2];
#pragma unroll
        for (int a = 0; a < 8; ++a) { O[a][0] = (f32x4){0.f, 0.f, 0.f, 0.f}; O[a][1] = (f32x4){0.f, 0.f, 0.f, 0.f}; }
        u32x4 rk[2], rv[2];
        const int lrow = tid >> 3, lkc = (tid & 7) * 8;
#pragma unroll
        for (int i = 0; i < 2; ++i) {
            const int row = lrow + 64 * i, cm = row >> 6, key = row & 63;
            rk[i] = *(const u32x4*)(Kb + ((size_t)(h * 2 + cm) * S + key) * 64 + lkc);
            rv[i] = *(const u32x4*)(Vb + (size_t)row * S + lkc);
        }
        for (int kt0 = 0; kt0 < S; kt0 += 64) {
            __syncthreads();
#pragma unroll
            for (int i = 0; i < 2; ++i) {
                const int row = lrow + 64 * i;
                *(u32x4*)(smem + row * 144 + lkc * 2) = rk[i];
                *(u32x4*)(smem + 18432 + row * 144 + lkc * 2) = rv[i];
            }
            __syncthreads();
            if (kt0 + 64 < S) {
#pragma unroll
                for (int i = 0; i < 2; ++i) {
                    const int row = lrow + 64 * i, cm = row >> 6, key = row & 63;
                    rk[i] = *(const u32x4*)(Kb + ((size_t)(h * 2 + cm) * S + kt0 + 64 + key) * 64 + lkc);
                    rv[i] = *(const u32x4*)(Vb + (size_t)row * S + kt0 + 64 + lkc);
                }
            }
            f32x4 st[4][2];
#pragma unroll
            for (int t = 0; t < 4; ++t) {
                st[t][0] = (f32x4){0.f, 0.f, 0.f, 0.f}; st[t][1] = (f32x4){0.f, 0.f, 0.f, 0.f};
#pragma unroll
                for (int ks = 0; ks < 2; ++ks) {
                    const bf16x8 kf = *(const bf16x8*)(smem + (comp * 64 + t * 16 + fr) * 144 + (ks * 32 + fq * 8) * 2);
                    st[t][0] = __builtin_amdgcn_mfma_f32_16x16x32_bf16(kf, bq[0][ks], st[t][0], 0, 0, 0);
                    st[t][1] = __builtin_amdgcn_mfma_f32_16x16x32_bf16(kf, bq[1][ks], st[t][1], 0, 0, 0);
                }
            }
            bf16x8 pb[2][2];
#pragma unroll
            for (int qs = 0; qs < 2; ++qs) {
                float mx = -1e30f;
#pragma unroll
                for (int t = 0; t < 4; ++t)
#pragma unroll
                    for (int r = 0; r < 4; ++r) mx = fmaxf(mx, st[t][qs][r]);
                mx = fmaxf(mx, __shfl_xor(mx, 16)); mx = fmaxf(mx, __shfl_xor(mx, 32));
                const float mnew = fmaxf(m_run[qs], mx);
                const float alpha = __builtin_amdgcn_exp2f(m_run[qs] - mnew);
                m_run[qs] = mnew;
                float ls = 0.f;
                float pv[4][4];
#pragma unroll
                for (int t = 0; t < 4; ++t)
#pragma unroll
                    for (int r = 0; r < 4; ++r) { pv[t][r] = __builtin_amdgcn_exp2f(st[t][qs][r] - mnew); ls += pv[t][r]; }
                l_run[qs] = l_run[qs] * alpha + ls;
#pragma unroll
                for (int a = 0; a < 8; ++a) O[a][qs] = O[a][qs] * alpha;
#pragma unroll
                for (int u = 0; u < 2; ++u) {
                    union { bf16x8 v; unsigned w[4]; } pk;
                    pk.w[0] = pack2bf(pv[2 * u][0], pv[2 * u][1]); pk.w[1] = pack2bf(pv[2 * u][2], pv[2 * u][3]);
                    pk.w[2] = pack2bf(pv[2 * u + 1][0], pv[2 * u + 1][1]); pk.w[3] = pack2bf(pv[2 * u + 1][2], pv[2 * u + 1][3]);
                    pb[qs][u] = pk.v;
                }
            }
#pragma unroll
            for (int u = 0; u < 2; ++u)
#pragma unroll
                for (int a = 0; a < 8; ++a) {
                    union { bf16x8 v; uint2 h[2]; } vf;
                    vf.h[0] = *(const uint2*)(smem + 18432 + (a * 16 + fr) * 144 + (u * 32 + fq * 4) * 2);
                    vf.h[1] = *(const uint2*)(smem + 18432 + (a * 16 + fr) * 144 + (u * 32 + 16 + fq * 4) * 2);
                    O[a][0] = __builtin_amdgcn_mfma_f32_16x16x32_bf16(vf.v, pb[0][u], O[a][0], 0, 0, 0);
                    O[a][1] = __builtin_amdgcn_mfma_f32_16x16x32_bf16(vf.v, pb[1][u], O[a][1], 0, 0, 0);
                }
        }
#pragma unroll
        for (int qs = 0; qs < 2; ++qs) {
            float l = l_run[qs]; l += __shfl_xor(l, 16); l += __shfl_xor(l, 32);
            const float inv = 1.0f / l;
#pragma unroll
            for (int a = 0; a < 8; ++a) O[a][qs] = O[a][qs] * inv;
        }
        __syncthreads();
        float* Ox = (float*)smem;
        if (comp == 1) {
#pragma unroll
            for (int qs = 0; qs < 2; ++qs)
#pragma unroll
                for (int a = 0; a < 8; ++a)
#pragma unroll
                    for (int r = 0; r < 4; ++r) Ox[(rg * 128 + a * 16 + fq * 4 + r) * 32 + qs * 16 + fr] = O[a][qs][r];
        }
        __syncthreads();
        if (comp == 0) {
#pragma unroll
            for (int qs = 0; qs < 2; ++qs) {
                float ss = 0.f;
#pragma unroll
                for (int a = 0; a < 8; ++a)
#pragma unroll
                    for (int r = 0; r < 4; ++r) {
                        const float o = O[a][qs][r] - lam_full * Ox[(rg * 128 + a * 16 + fq * 4 + r) * 32 + qs * 16 + fr];
                        O[a][qs][r] = o; ss += o * o;
                    }
                ss += __shfl_xor(ss, 16); ss += __shfl_xor(ss, 32);
                const float sc = rsqrtf(ss * (1.0f / 128.0f) + 1e-5f) * (1.0f - lam_init);
                const int lt = lt0 + q0 + qs * 16 + fr;
#pragma unroll
                for (int a = 0; a < 8; ++a) {
                    const int dv = a * 16 + fq * 4;
                    const float4 g = *(const float4*)(normg + dv);
                    uint2 w; w.x = pack2bf(O[a][qs][0] * sc * g.x, O[a][qs][1] * sc * g.y); w.y = pack2bf(O[a][qs][2] * sc * g.z, O[a][qs][3] * sc * g.w);
                    *(uint2*)(ydiff + (size_t)lt * 512 + h * 128 + dv) = w;
                }
            }
        }
    }
    __syncthreads();
}

__device__ __forceinline__ void fft_items(const Ctx& C, const PV& P, unsigned char* smem) {
    unsigned char* R = P.ws + WS_R;
    typedef f16 f16x2 __attribute__((ext_vector_type(2)));
    const f16x2* Zall = (const f16x2*)(R + R_ZC);
    bf16_t* yf = (bf16_t*)(R + R_YB) + 2 * SZ512;
    const float2* tw = (const float2*)(P.ws + WS_TW);
    float2* sm = (float2*)smem;
    const int tid = C.tid;
    for (int item = C.bid; item < NSEQ * 256; item += C.nblk) {
        const int sq = item >> 8, col = item & 255, g = col >> 6, cc = col & 63;
        const int lt0 = seqbase_of(sq), S = seqlen_of(sq), lg = sq == 0 ? 13 : 12;
        const f16x2* z = Zall + (size_t)lt0 * 256 + (size_t)col * S;
        __syncthreads();
        for (int s = tid; s < S; s += NT) { const f16x2 v = z[s]; sm[__brev((unsigned)s) >> (32 - lg)] = make_float2((float)v[0], (float)v[1]); }
        __syncthreads();
        for (int st = 0; st < lg; ++st) {
            const int half = 1 << st, tshift = 12 - st;
            for (int b = tid; b < (S >> 1); b += NT) {
                const int j = b & (half - 1), i0 = ((b >> st) << (st + 1)) + j, i1 = i0 + half;
                const float2 w = tw[j << tshift], u = sm[i0], x = sm[i1];
                const float2 tv = make_float2(w.x * x.x - w.y * x.y, w.x * x.y + w.y * x.x);
                sm[i0] = make_float2(u.x + tv.x, u.y + tv.y); sm[i1] = make_float2(u.x - tv.x, u.y - tv.y);
            }
            __syncthreads();
        }
        const float nrm = rsqrtf((float)S * 128.0f);
        for (int k = tid; k < S; k += NT) {
            const float2 a = sm[k], b = sm[(S - k) & (S - 1)];
            bf16_t* row = yf + (size_t)(lt0 + k) * 512 + g * 128;
            if (cc == 0) { row[0] = f2bf(0.5f * (a.x + b.x) * nrm); row[64] = f2bf(0.5f * (a.y + b.y) * nrm); }
            else { row[cc] = f2bf(a.x * nrm); row[128 - cc] = f2bf(b.x * nrm); }
        }
    }
    __syncthreads();
}

typedef float f32x2 __attribute__((ext_vector_type(2)));
template <int KT>
__device__ __forceinline__ void scan_block(const Ctx& C, const PV& P, int layer, int sq, int h, int d, int row0, unsigned char* smem) {
    constexpr int TPR = 64 / KT, ROWS = NT / TPR, CH = 16, YP = TPR / 4, NV = ROWS / 32;
    unsigned char* R = P.ws + WS_R;
    const f16* raw = (const f16*)(R + R_RAW); const f16* wa = (const f16*)(R + R_WA); f16* yfb = (f16*)(R + R_YFB);
    const float* invn = (const float*)(P.ws + WS_INVN);
    const float* mu = P.inp(13) + (size_t)layer * 1920; const float* k_k = P.inp(19) + (size_t)layer * 512; const float* k_a = P.inp(20) + (size_t)layer * 512;
    const int tid = C.tid, row = tid / TPR, q = tid % TPR;
    const int lt0 = seqbase_of(sq), S = seqlen_of(sq);
    const int ch = tid & 63, c = h * 64 + ch;
    const float mu_r = mu[c], mu_k = mu[512 + c], kkw = k_k[c], kaw = k_a[c];
    const int vr = (ROWS == 32) ? (tid & 31) : (tid & 63);
    const int vcol = 1024 + h * 64 + row0 + vr; const float mu_v = mu[vcol];
    const f16* wdec = wa + (size_t)d * SZ512; const f16* aact = wa + (size_t)(2 + d) * SZ512;
    f16* ydst = yfb + (size_t)d * SZ512;
    f32x2 s[KT / 2];
#pragma unroll
    for (int j = 0; j < KT / 2; ++j) s[j] = (f32x2){0.f, 0.f};
    float pr_[2][3], pk_[2][3], pa_[2], pw_[2], pn_[2], pv_[NV][3];
    auto prefetch = [&](int c0) {
#pragma unroll
        for (int j = 0; j < 2; ++j) {
            const int i = (tid >> 6) + 8 * j, tstep = c0 + i, t = d == 0 ? tstep : S - 1 - tstep, lt = lt0 + t;
            const int tm = t > 0 ? lt - 1 : lt, tp = t < S - 1 ? lt + 1 : lt;
            pr_[j][0] = (float)raw[(size_t)tm * 1920 + c]; pr_[j][1] = (float)raw[(size_t)lt * 1920 + c]; pr_[j][2] = (float)raw[(size_t)tp * 1920 + c];
            pk_[j][0] = (float)raw[(size_t)tm * 1920 + 512 + c]; pk_[j][1] = (float)raw[(size_t)lt * 1920 + 512 + c]; pk_[j][2] = (float)raw[(size_t)tp * 1920 + 512 + c];
            pa_[j] = (float)aact[(size_t)lt * 512 + c]; pw_[j] = (float)wdec[(size_t)lt * 512 + c]; pn_[j] = invn[(size_t)lt * 8 + h];
        }
#pragma unroll
        for (int j = 0; j < NV; ++j) {
            const int i = (ROWS == 32) ? (tid >> 5) : ((tid >> 6) + 8 * j), tstep = c0 + i, t = d == 0 ? tstep : S - 1 - tstep, lt = lt0 + t;
            const int tm = t > 0 ? lt - 1 : lt, tp = t < S - 1 ? lt + 1 : lt;
            pv_[j][0] = (float)raw[(size_t)tm * 1920 + vcol]; pv_[j][1] = (float)raw[(size_t)lt * 1920 + vcol]; pv_[j][2] = (float)raw[(size_t)tp * 1920 + vcol];
        }
    };
    auto stage = [&](int c0, unsigned char* buf) {
        float* vec = (float*)buf; float* vbuf = (float*)(buf + 20480);
#pragma unroll
        for (int j = 0; j < 2; ++j) {
            const int i = (tid >> 6) + 8 * j, tstep = c0 + i, t = d == 0 ? tstep : S - 1 - tstep;
            const float rm = t > 0 ? pr_[j][0] : 0.f, rp = t < S - 1 ? pr_[j][2] : 0.f, km = t > 0 ? pk_[j][0] : 0.f, kp = t < S - 1 ? pk_[j][2] : 0.f;
            const float r = pr_[j][1] + (0.5f * (rm + rp) - pr_[j][1]) * mu_r;
            const float k = pk_[j][1] + (0.5f * (km + kp) - pk_[j][1]) * mu_k;
            const float kk = k * kkw * pn_[j], a = pa_[j];
            vec[(0 * CH + i) * 64 + ch] = kk;
            vec[(1 * CH + i) * 64 + ch] = pw_[j];
            vec[(2 * CH + i) * 64 + ch] = kk * a;
            vec[(3 * CH + i) * 64 + ch] = k * (1.0f + (a - 1.0f) * kaw);
            vec[(4 * CH + i) * 64 + ch] = r;
        }
#pragma unroll
        for (int j = 0; j < NV; ++j) {
            const int i = (ROWS == 32) ? (tid >> 5) : ((tid >> 6) + 8 * j), tstep = c0 + i, t = d == 0 ? tstep : S - 1 - tstep;
            const float vm = t > 0 ? pv_[j][0] : 0.f, vp = t < S - 1 ? pv_[j][2] : 0.f;
            vbuf[i * 64 + vr] = pv_[j][1] + (0.5f * (vm + vp) - pv_[j][1]) * mu_v;
        }
    };
    __syncthreads();
    prefetch(0);
    stage(0, smem);
    __syncthreads();
    const int nch = S / CH;
    for (int cix = 0; cix < nch; ++cix) {
        unsigned char* buf = smem + (cix & 1) * 32768;
        if (cix + 1 < nch) prefetch((cix + 1) * CH);
        {
            const float* vec = (const float*)buf; const float* vbuf = (const float*)(buf + 20480); float* ybuf = (float*)(buf + 24576);
            const f32x4* vp0 = (const f32x4*)(vec + q * KT);
            f32x4 nx[5][KT / 4]; float nvv;
#pragma unroll
            for (int u = 0; u < KT / 4; ++u)
#pragma unroll
                for (int a5 = 0; a5 < 5; ++a5) nx[a5][u] = vp0[a5 * CH * 16 + u];
            nvv = vbuf[row];
            float yv[CH];
#pragma unroll
            for (int i = 0; i < CH; ++i) {
                f32x2 kk2[KT / 2], w2[KT / 2], b2[KT / 2], kd2[KT / 2], r2[KT / 2];
#pragma unroll
                for (int u = 0; u < KT / 4; ++u) {
                    kk2[2 * u] = (f32x2){nx[0][u][0], nx[0][u][1]}; kk2[2 * u + 1] = (f32x2){nx[0][u][2], nx[0][u][3]};
                    w2[2 * u] = (f32x2){nx[1][u][0], nx[1][u][1]}; w2[2 * u + 1] = (f32x2){nx[1][u][2], nx[1][u][3]};
                    b2[2 * u] = (f32x2){nx[2][u][0], nx[2][u][1]}; b2[2 * u + 1] = (f32x2){nx[2][u][2], nx[2][u][3]};
                    kd2[2 * u] = (f32x2){nx[3][u][0], nx[3][u][1]}; kd2[2 * u + 1] = (f32x2){nx[3][u][2], nx[3][u][3]};
                    r2[2 * u] = (f32x2){nx[4][u][0], nx[4][u][1]}; r2[2 * u + 1] = (f32x2){nx[4][u][2], nx[4][u][3]};
                }
                const float vv = nvv;
                if (i + 1 < CH) {
#pragma unroll
                    for (int u = 0; u < KT / 4; ++u)
#pragma unroll
                        for (int a5 = 0; a5 < 5; ++a5) nx[a5][u] = vp0[(i + 1) * 16 + a5 * CH * 16 + u];
                    nvv = vbuf[(i + 1) * 64 + row];
                }
                f32x2 acc2 = s[0] * kk2[0];
#pragma unroll
                for (int j = 1; j < KT / 2; ++j) acc2 = __builtin_elementwise_fma(s[j], kk2[j], acc2);
                float sa = acc2[0] + acc2[1];
                sa += dppf<0xB1>(sa); sa += dppf<0x4E>(sa); sa += dppf<0x141>(sa);
                if (TPR == 16) sa += dppf<0x140>(sa);
                sa = -sa;
                const f32x2 sa2 = (f32x2){sa, sa}, vv2 = (f32x2){vv, vv};
                f32x2 y2 = (f32x2){0.f, 0.f};
#pragma unroll
                for (int j = 0; j < KT / 2; ++j) {
                    s[j] = __builtin_elementwise_fma(s[j], w2[j], __builtin_elementwise_fma(sa2, b2[j], vv2 * kd2[j]));
                    y2 = __builtin_elementwise_fma(s[j], r2[j], y2);
                }
                float y = y2[0] + y2[1];
                y += dppf<0xB1>(y); y += dppf<0x4E>(y);
                yv[i] = y;
            }
            if ((q & 3) == 0) {
#pragma unroll
                for (int i = 0; i < CH; ++i) ybuf[i * 128 + row * YP + (q >> 2)] = yv[i];
            }
        }
        if (cix + 1 < nch) stage((cix + 1) * CH, smem + ((cix + 1) & 1) * 32768);
        __syncthreads();
        {
            const float* ybuf = (const float*)(buf + 24576);
#pragma unroll
            for (int j = 0; j < NV; ++j) {
                const int i = (ROWS == 32) ? (tid >> 5) : ((tid >> 6) + 8 * j), rr = vr, tstep = cix * CH + i, t = d == 0 ? tstep : S - 1 - tstep;
                float y = 0.f;
#pragma unroll
                for (int p = 0; p < YP; ++p) y += ybuf[i * 128 + rr * YP + p];
                ydst[(size_t)(lt0 + t) * 512 + h * 64 + row0 + rr] = (f16)y;
            }
        }
    }
    __syncthreads();
}

__device__ __forceinline__ void finish_phase(const Ctx& C, const PV& P, int layer) {
    unsigned char* R = P.ws + WS_R;
    const f16* raw = (const f16*)(R + R_RAW); const f16* wa = (const f16*)(R + R_WA); const f16* gbuf = (const f16*)(R + R_G); const f16* yfb = (const f16*)(R + R_YFB);
    bf16_t* yr = (bf16_t*)(R + R_YB);
    const float* mu = P.inp(13) + (size_t)layer * 1920; const float* k_a = P.inp(20) + (size_t)layer * 512; const float* r_k = P.inp(21) + (size_t)layer * 512;
    const float* lg = P.inp(22) + (size_t)layer * 512; const float* lb = P.inp(23) + (size_t)layer * 512;
    const int lane = C.tid & 63, wave = C.tid >> 6, c = lane * 8;
    for (int lt = C.bid * NWV + wave; lt < TP; lt += C.nblk * NWV) {
        const int pos = pos_of(lt), S = lt < 8192 ? 8192 : 4096;
        const size_t rm = (size_t)(pos > 0 ? lt - 1 : lt) * 1920, r0 = (size_t)lt * 1920, rp = (size_t)(pos < S - 1 ? lt + 1 : lt) * 1920;
        const float wm = pos > 0 ? 0.5f : 0.f, wp = pos < S - 1 ? 0.5f : 0.f;
        const f16x8_t rA = *(const f16x8_t*)(raw + rm + c), rB = *(const f16x8_t*)(raw + r0 + c), rC = *(const f16x8_t*)(raw + rp + c);
        const f16x8_t kA = *(const f16x8_t*)(raw + rm + 512 + c), kB = *(const f16x8_t*)(raw + r0 + 512 + c), kC = *(const f16x8_t*)(raw + rp + 512 + c);
        const f16x8_t vA = *(const f16x8_t*)(raw + rm + 1024 + c), vB = *(const f16x8_t*)(raw + r0 + 1024 + c), vC = *(const f16x8_t*)(raw + rp + 1024 + c);
        const f16x8_t af = *(const f16x8_t*)(wa + 2 * SZ512 + (size_t)lt * 512 + c), ab = *(const f16x8_t*)(wa + 3 * SZ512 + (size_t)lt * 512 + c);
        const f16x8_t gg = *(const f16x8_t*)(gbuf + (size_t)lt * 512 + c);
        const f16x8_t yF = *(const f16x8_t*)(yfb + (size_t)lt * 512 + c), yB = *(const f16x8_t*)(yfb + SZ512 + (size_t)lt * 512 + c);
        float y[8], vv[8], bsum = 0.f, ysum = 0.f;
#pragma unroll
        for (int j = 0; j < 8; ++j) {
            const float r_ = (float)rB[j], k_ = (float)kB[j], v_ = (float)vB[j];
            const float r = r_ + (wm * (float)rA[j] + wp * (float)rC[j] - r_) * mu[c + j];
            const float k = k_ + (wm * (float)kA[j] + wp * (float)kC[j] - k_) * mu[512 + c + j];
            vv[j] = v_ + (wm * (float)vA[j] + wp * (float)vC[j] - v_) * mu[1024 + c + j];
            const float ka = k_a[c + j];
            const float ksum = k * (1.f + ((float)af[j] - 1.f) * ka) + k * (1.f + ((float)ab[j] - 1.f) * ka);
            bsum += r * (0.5f * ksum) * r_k[c + j];
            y[j] = (float)yF[j] + (float)yB[j]; ysum += y[j];
        }
        const float ym = red8(ysum) * (1.0f / 64.0f);
        float q = 0.f;
#pragma unroll
        for (int j = 0; j < 8; ++j) { const float dy = y[j] - ym; q += dy * dy; }
        const float rs = rsqrtf(red8(q) * (1.0f / 64.0f) + 64e-5f);
        const float bonus = red8(bsum);
        float o[8];
#pragma unroll
        for (int j = 0; j < 8; ++j) o[j] = ((y[j] - ym) * rs * lg[c + j] + lb[c + j] + bonus * vv[j]) * (float)gg[j];
        u32x4 w; w.x = pack2bf(o[0], o[1]); w.y = pack2bf(o[2], o[3]); w.z = pack2bf(o[4], o[5]); w.w = pack2bf(o[6], o[7]);
        *(u32x4*)(yr + (size_t)lt * 512 + c) = w;
    }
}

__device__ __forceinline__ void merge_phase(const Ctx& C, const PV& P, int layer, unsigned char* smem) {
    unsigned char* R = P.ws + WS_R;
    const bf16_t* hmod = (const bf16_t*)(P.ws + WS_HMOD); const bf16_t* yb = (const bf16_t*)(R + R_YB); bf16_t* merged = (bf16_t*)(R + R_MERGED);
    const bf16_t* W = wl(P, layer);
    const int lane = C.tid & 63, wave = (C.tid >> 6) & 3, wm = wave >> 1, wn = wave & 1, fr = lane & 15, fq = lane >> 4;
    for (int t2 = C.bid; t2 < MT * 8; t2 += C.nblk) {
        const int t = t2 * 2 + (C.tid >> 8);
        const int tm = t >> 4, tn = t & 15;
        f32x4 m[4][2];
#pragma unroll
        for (int i = 0; i < 4; ++i) { m[i][0] = (f32x4){0.f, 0.f, 0.f, 0.f}; m[i][1] = (f32x4){0.f, 0.f, 0.f, 0.f}; }
        for (int n = 0; n < 4; ++n) {
            f32x4 ag[4][2], ap[4][2];
            gemm_core<2, true>(C, ag, hmod + (size_t)tm * 128 * 1024, 1024, W + OW_WIN + (size_t)(4480 + n * 1024 + tn * 64) * 1024, 1024, 1024, smem);
#pragma unroll
            for (int i = 0; i < 4; ++i)
#pragma unroll
                for (int j = 0; j < 2; ++j)
#pragma unroll
                    for (int r = 0; r < 4; ++r) ag[i][j][r] = sigmoidf_(ag[i][j][r]);
            gemm_core<2, true>(C, ap, yb + (size_t)n * SZ512 + (size_t)tm * 128 * 512, 512, W + OW_WBR + (size_t)n * 1024 * 512 + (size_t)(tn * 64) * 512, 512, 512, smem);
#pragma unroll
            for (int i = 0; i < 4; ++i)
#pragma unroll
                for (int j = 0; j < 2; ++j) m[i][j] += ag[i][j] * ap[i][j];
        }
#pragma unroll
        for (int i = 0; i < 4; ++i) {
            const int lt = tm * 128 + wm * 64 + i * 16 + fr;
#pragma unroll
            for (int j = 0; j < 2; ++j) {
                const int n = tn * 64 + wn * 32 + j * 16 + fq * 4;
                uint2 w; w.x = pack2bf(m[i][j][0], m[i][j][1]); w.y = pack2bf(m[i][j][2], m[i][j][3]);
                *(uint2*)(merged + (size_t)lt * 1024 + n) = w;
            }
        }
    }
}

constexpr int PH_PER_LAYER = 14, PH_PER_PASS = 2 * PH_PER_LAYER + 1, NPHASE = 1 + NPASS * PH_PER_PASS;

__global__ void __launch_bounds__(512, 2) mk_forward(Params P0, int ph_lo, int ph_hi) {
    unsigned char* smem = dyn_smem;
    const int wave_s = __builtin_amdgcn_readfirstlane((int)threadIdx.x >> 6);
    for (int it_ = 2 * ph_lo; it_ < 2 * ph_hi; ++it_) {
        const int ph = it_ >> 1;
        if (it_ & 1) {
            if (PROBE_MASK == 0 || ph == 0) continue;
            const int r_ = (ph - 1) % PH_PER_PASS;
            if (r_ == PH_PER_PASS - 1 || !((PROBE_MASK >> (r_ % PH_PER_LAYER)) & 1)) continue;
        }
        if (it_ > 2 * ph_lo) cg::this_grid().sync();
        int z = 0; asm volatile("" : "+s"(z));
        Ctx C; C.tid = tid_now(wave_s, z); C.bid = (int)blockIdx.x + z; C.nblk = (int)gridDim.x + z; C.wave_s = wave_s;
        ptrtab_t tab = (ptrtab_t)__builtin_amdgcn_kernarg_segment_ptr();
        asm volatile("" : "+s"(tab));
        const PV P{tab, (float*)tab[29], (unsigned char*)tab[30]};
        if (ph == 0) { prep_phase(C, P, smem); continue; }
        const int q = ph - 1, pass = q / PH_PER_PASS, r = q % PH_PER_PASS;
        if (r == PH_PER_PASS - 1) { norm_phase(C, P, pass, P.inp(6) + (size_t)(1 * 3 + 2) * 1024, P.inp(7) + (size_t)(1 * 3 + 2) * 1024, 0, -1, false); continue; }
        const int layer = r / PH_PER_LAYER, lp = r % PH_PER_LAYER;
        const bf16_t* W = wl(P, layer);
        const float* lng = P.inp(6) + (size_t)layer * 3 * 1024; const float* lnb = P.inp(7) + (size_t)layer * 3 * 1024;
        unsigned char* R = P.ws + WS_R;
        switch (lp) {
            case 0:
                if (layer == 0) norm_phase(C, P, pass, nullptr, nullptr, 0, 0, true);
                else norm_phase(C, P, pass, P.inp(6) + (size_t)((layer - 1) * 3 + 2) * 1024, P.inp(7) + (size_t)((layer - 1) * 3 + 2) * 1024, layer, 0, false);
                break;
            case 1: ffn_up_phase(C, P, W + OW_FA_IN); break;
            case 2: resid_gemm_phase(C, P, pass, (const bf16_t*)(R + R_ACT), 2816, W + OW_FA_OUT, layer, 0, 0.5f); break;
            case 3: norm_phase(C, P, pass, lng, lnb, layer, 1, false); break;
            case 4: win_phase(C, P, layer); break;
            case 5: lin_pool_phase(C, P, layer); break;
            case 6: lora_phase(C, P, layer, smem); break;
            case 7:
                if (C.bid < 32) scan_block<4>(C, P, layer, 0, C.bid >> 2, (C.bid >> 1) & 1, (C.bid & 1) * 32, smem);
                else if (C.bid < 160) { const int i2 = C.bid - 32; scan_block<8>(C, P, layer, 1 + (i2 >> 4), (i2 >> 1) & 7, i2 & 1, 0, smem); }
                attn_items(C, P, layer, pass * 2 + layer, smem); fft_items(C, P, smem); break;
            case 8: finish_phase(C, P, layer); break;
            case 9: merge_phase(C, P, layer, smem); break;
            case 10: resid_gemm_phase(C, P, pass, (const bf16_t*)(R + R_MERGED), 1024, W + OW_WOUT, layer, 1, 1.0f); break;
            case 11: norm_phase(C, P, pass, lng + 1024, lnb + 1024, layer, 2, false); break;
            case 12: ffn_up_phase(C, P, W + OW_FB_IN); break;
            default: resid_gemm_phase(C, P, pass, (const bf16_t*)(R + R_ACT), 2816, W + OW_FB_OUT, layer, 2, 0.5f); break;
        }
    }
}

extern "C" void kernel_launch(void* const* d_in, const int* in_sizes, int n_in, void* d_out, int out_size, void* d_ws, size_t ws_size, hipStream_t stream) {
    static int grid_blocks = 0;
    if (!grid_blocks) {
        int dev = 0, cus = 0, per_cu = 0;
        (void)hipGetDevice(&dev);
        (void)hipDeviceGetAttribute(&cus, hipDeviceAttributeMultiprocessorCount, dev);
        (void)hipFuncSetAttribute((const void*)mk_forward, hipFuncAttributeMaxDynamicSharedMemorySize, LDS_BYTES);
        (void)hipOccupancyMaxActiveBlocksPerMultiprocessor(&per_cu, mk_forward, NT, LDS_BYTES);
        if (per_cu < 1) per_cu = 1;
        if (per_cu > 1) per_cu = 1;
        grid_blocks = cus * per_cu;
    }
    Params p{};
    for (int i = 0; i < 29; ++i) p.in[i] = (const float*)d_in[i];
    p.out = (float*)d_out; p.ws = (unsigned char*)d_ws;
#if ONE_LAUNCH
    int lo = 0, hi = NPHASE;
    void* args[] = {&p, &lo, &hi};
    hipError_t e = hipLaunchCooperativeKernel((void*)mk_forward, dim3(grid_blocks), dim3(NT), args, LDS_BYTES, stream);
    if (e != hipSuccess) fprintf(stderr, "cooperative launch failed: %s (grid %d)\n", hipGetErrorString(e), grid_blocks);
#else
    for (int ph = 0; ph < NPHASE; ++ph) {
        int lo = ph, hi = ph + 1;
        void* args[] = {&p, &lo, &hi};
        (void)hipLaunchCooperativeKernel((void*)mk_forward, dim3(grid_blocks), dim3(NT), args, LDS_BYTES, stream);
    }
#endif
}
```

```cpp
#include <hip/hip_runtime.h>
#include <hip/hip_cooperative_groups.h>
#include <cstdio>
#include <cstdint>
namespace cg = cooperative_groups;

typedef unsigned short bf16_t;
typedef _Float16 f16;
typedef short bf16x8 __attribute__((ext_vector_type(8)));
typedef float f32x4 __attribute__((ext_vector_type(4)));
typedef unsigned u32x4 __attribute__((ext_vector_type(4)));
typedef unsigned u32x2 __attribute__((ext_vector_type(2)));

#ifndef ONE_LAUNCH
#define ONE_LAUNCH 1
#endif
#ifndef PROBE_MASK
#define PROBE_MASK 0
#endif

constexpr int TP = 40960;
constexpr int NPASS = 2;
constexpr int NSEQ = 9;
constexpr int MT = TP / 128;
constexpr int N_IN_FULL = 8576;
constexpr float ALPHA = 1.41421356237f;

constexpr size_t OW_FA_IN = 0, OW_FA_OUT = 5767168, OW_FB_IN = 8650752, OW_FB_OUT = 14417920, OW_WIN = 17301504,
                 OW_WBR = 26083328, OW_WOUT = 28180480, OW_W2T = 29229056, OW_A2T = 29294592, OW_G2T = 29360128, WL_TOTAL = 29425664;
constexpr size_t WS_W = 0, WS_TW = 117702656, WS_MOD = 117735424, WS_HMOD = 119062528, WS_R = 202948608, WS_INVN = 1062780928, WS_CTR = 1064091648;
constexpr size_t R_RAW = 0, R_LIN = 157286400, R_WA = 188743680, R_G = 356515840, R_Q = 398458880, R_K = 440401920, R_VT = 482344960,
                 R_YFB = 524288000, R_ZC = 608174080, R_POOLP = 650117120, R_YB = 692060160, R_ACT = 0, R_MERGED = 0;
constexpr size_t SZ512 = (size_t)TP * 512;

struct Params { const float* in[29]; float* out; unsigned char* ws; };
struct Ctx { int tid, bid, nblk, wave_s; };
__device__ __forceinline__ int tid_now(int wave_s, int z) { return wave_s * 64 + (int)__builtin_amdgcn_mbcnt_hi(~0u, __builtin_amdgcn_mbcnt_lo(~0u, (unsigned)z)); }
typedef const float* const __attribute__((address_space(4)))* ptrtab_t;
struct PV { ptrtab_t tab; float* out; unsigned char* ws;
    __device__ __forceinline__ const float* inp(int i) const { return tab[i]; } };
constexpr int NT = 512, NWV = 8;
extern __shared__ __attribute__((aligned(16))) unsigned char dyn_smem[];
constexpr int LDS_BYTES = 131072;

__device__ __forceinline__ bf16_t f2bf(float f) { unsigned u = __float_as_uint(f); u += 0x7fffu + ((u >> 16) & 1u); return (bf16_t)(u >> 16); }
__device__ __forceinline__ float bf2f(bf16_t b) { return __uint_as_float(((unsigned)b) << 16); }
__device__ __forceinline__ unsigned pack2bf(float a, float b) { return (unsigned)f2bf(a) | ((unsigned)f2bf(b) << 16); }
__device__ __forceinline__ float wsum(float v) {
#pragma unroll
    for (int o = 32; o > 0; o >>= 1) v += __shfl_xor(v, o);
    return v;
}
__device__ __forceinline__ float sigmoidf_(float x) { return 1.0f / (1.0f + __expf(-x)); }
template <int CTRL> __device__ __forceinline__ float dppf(float v) { return __int_as_float(__builtin_amdgcn_update_dpp(0, __float_as_int(v), CTRL, 0xF, 0xF, true)); }
__device__ __forceinline__ float red8(float v) { v += dppf<0xB1>(v); v += dppf<0x4E>(v); v += dppf<0x141>(v); return v; }

__device__ __forceinline__ int grow_of(int pass, int lt) { return lt < 8192 ? pass * 8192 + lt : 16384 + pass * 32768 + (lt - 8192); }
__device__ __forceinline__ int brow_of(int pass, int lt) { return lt < 8192 ? pass : 2 + pass * 8 + ((lt - 8192) >> 12); }
__device__ __forceinline__ int pos_of(int lt) { return lt < 8192 ? lt : ((lt - 8192) & 4095); }
__device__ __forceinline__ int seqbase_of(int sq) { return sq == 0 ? 0 : 8192 + (sq - 1) * 4096; }
__device__ __forceinline__ int seqlen_of(int sq) { return sq == 0 ? 8192 : 4096; }

__device__ __forceinline__ bf16_t* wl(const PV& P, int layer) { return (bf16_t*)(P.ws + WS_W) + (size_t)layer * WL_TOTAL; }

template <int NJ, bool SWAP>
__device__ __forceinline__ void gemm_core(const Ctx& C, f32x4 (&acc)[4][NJ], const bf16_t* __restrict__ A, int lda, const bf16_t* __restrict__ B, int ldb, int K, unsigned char* smem) {
    const int tid = C.tid & 255, lane = tid & 63, wave = tid >> 6, wm = wave >> 1, wn = wave & 1, fr = lane & 15, fq = lane >> 4;
    smem += (C.tid >> 8) * 36864;
    u32x4 ra[4], rb[NJ];
#pragma unroll
    for (int i = 0; i < 4; ++i)
#pragma unroll
        for (int j = 0; j < NJ; ++j) acc[i][j] = (f32x4){0.f, 0.f, 0.f, 0.f};
    const int lrow = tid >> 3, lkc = (tid & 7) * 8;
#pragma unroll
    for (int i = 0; i < 4; ++i) ra[i] = *(const u32x4*)(A + (size_t)(lrow + 32 * i) * lda + lkc);
#pragma unroll
    for (int i = 0; i < NJ; ++i) rb[i] = *(const u32x4*)(B + (size_t)(lrow + 32 * i) * ldb + lkc);
    for (int k0 = 0; k0 < K; k0 += 64) {
        __syncthreads();
#pragma unroll
        for (int i = 0; i < 4; ++i) *(u32x4*)(smem + (lrow + 32 * i) * 144 + lkc * 2) = ra[i];
#pragma unroll
        for (int i = 0; i < NJ; ++i) *(u32x4*)(smem + 18432 + (lrow + 32 * i) * 144 + lkc * 2) = rb[i];
        __syncthreads();
        if (k0 + 64 < K) {
#pragma unroll
            for (int i = 0; i < 4; ++i) ra[i] = *(const u32x4*)(A + (size_t)(lrow + 32 * i) * lda + k0 + 64 + lkc);
#pragma unroll
            for (int i = 0; i < NJ; ++i) rb[i] = *(const u32x4*)(B + (size_t)(lrow + 32 * i) * ldb + k0 + 64 + lkc);
        }
#pragma unroll
        for (int ks = 0; ks < 2; ++ks) {
            bf16x8 af[4], bfr[NJ];
#pragma unroll
            for (int i = 0; i < 4; ++i) af[i] = *(const bf16x8*)(smem + (wm * 64 + i * 16 + fr) * 144 + (ks * 32 + fq * 8) * 2);
#pragma unroll
            for (int j = 0; j < NJ; ++j) bfr[j] = *(const bf16x8*)(smem + 18432 + (wn * NJ * 16 + j * 16 + fr) * 144 + (ks * 32 + fq * 8) * 2);
#pragma unroll
            for (int i = 0; i < 4; ++i)
#pragma unroll
                for (int j = 0; j < NJ; ++j)
                    acc[i][j] = SWAP ? __builtin_amdgcn_mfma_f32_16x16x32_bf16(bfr[j], af[i], acc[i][j], 0, 0, 0)
                                     : __builtin_amdgcn_mfma_f32_16x16x32_bf16(af[i], bfr[j], acc[i][j], 0, 0, 0);
        }
    }
}


namespace g256 {
constexpr int BK = 64, HALF = 128, HT = HALF * BK;
__device__ __forceinline__ int lds_byte(int r, int c) { int st = (r >> 4) * 2 + (c >> 5), rr = r & 15, cc = c & 31, ob = rr * 64 + cc * 2; return st * 1024 + (ob ^ (((ob >> 9) & 1) << 5)); }
__device__ __forceinline__ void stage_rc(unsigned b, unsigned& R, unsigned& Cc) { const unsigned st = b >> 10, sb = b & 1023u, swz = sb ^ (((sb >> 9) & 1u) << 5); R = (st >> 1) * 16u + (swz >> 6); Cc = (st & 1u) * 32u + ((swz & 63u) >> 1); }
}
__device__ __forceinline__ void gemm256(const Ctx& C, f32x4 (&acc)[2][2][4][2], const bf16_t* __restrict__ A, const bf16_t* __restrict__ Bt, const int K, const int brow, const int bcol) {
    using namespace g256;
    bf16_t* shm = (bf16_t*)dyn_smem;
    const int tidx = C.tid;
    #define SA(b,h) (shm+((b)*2+(h))*HT)
    #define SB(b,h) (shm+(4+(b)*2+(h))*HT)
    #define STAGE(Pp,BASE,br,kt) do{const char* _ub=(const char*)((BASE)+(long)(br)*K+(long)(kt)*BK); asm volatile("" : "+s"(_ub)); \
        __builtin_amdgcn_global_load_lds((const unsigned*)(_ub+goff0), \
          (__attribute__((address_space(3))) unsigned*)((__attribute__((address_space(3))) char*)(Pp)+tidx*16),16,0,0); \
        __builtin_amdgcn_global_load_lds((const unsigned*)(_ub+goff1), \
          (__attribute__((address_space(3))) unsigned*)((__attribute__((address_space(3))) char*)(Pp)+tidx*16+8192),16,0,0);}while(0)
    #define LDA(dst,b,h) for(int m=0;m<4;++m)for(int k=0;k<2;++k) \
      dst[m][k]=*reinterpret_cast<const bf16x8*>(a_ptr+((b)*2+(h))*16384+m*2048+k*1024)
    #define LDB(dst,b,h) for(int n=0;n<2;++n)for(int k=0;k<2;++k) \
      dst[n][k]=*reinterpret_cast<const bf16x8*>(b_ptr+((b)*2+(h))*16384+n*2048+k*1024)
    #define MMA(ai,bj,Atx,Btx) do{__builtin_amdgcn_s_setprio(1); \
      for(int m=0;m<4;++m)for(int n=0;n<2;++n)for(int k=0;k<2;++k) \
        acc[ai][bj][m][n]=__builtin_amdgcn_mfma_f32_16x16x32_bf16(Btx[n][k],Atx[m][k],acc[ai][bj][m][n],0,0,0); \
      __builtin_amdgcn_s_setprio(0);}while(0)
    #define WAIT_V(n) asm volatile("s_waitcnt vmcnt(" #n ")":::"memory")
    #define WAIT_L(n) asm volatile("s_waitcnt lgkmcnt(" #n ")":::"memory")
    #define BAR __builtin_amdgcn_s_barrier()
    #define SCHED __builtin_amdgcn_sched_barrier(0)
    const int wid = tidx >> 6, lane = tidx & 63, wr = wid >> 2, wc = wid & 3, fr = lane & 15, fq = lane >> 4;
    const int swz = (fr * 64 + fq * 16) ^ ((fr >> 3) << 5);
    const char* a_ptr = (const char*)dyn_smem + wr * 8192 + swz;
    const char* b_ptr = (const char*)dyn_smem + 65536 + wc * 4096 + swz;
#pragma unroll
    for (int a = 0; a < 2; ++a)
#pragma unroll
        for (int b = 0; b < 2; ++b)
#pragma unroll
            for (int m = 0; m < 4; ++m) { acc[a][b][m][0] = (f32x4){0.f, 0.f, 0.f, 0.f}; acc[a][b][m][1] = (f32x4){0.f, 0.f, 0.f, 0.f}; }
    bf16x8 At[4][2], B0[2][2], B1[2][2];
    const int nt = K / BK;
    unsigned goff0, goff1;
    { unsigned r0, c0, r1, c1; stage_rc((unsigned)tidx * 16u, r0, c0); stage_rc((unsigned)tidx * 16u + 8192u, r1, c1); goff0 = (r0 * (unsigned)K + c0) * 2u; goff1 = (r1 * (unsigned)K + c1) * 2u; }
    WAIT_V(0); __syncthreads();
    STAGE(SB(0,0),Bt,bcol,0); STAGE(SA(0,0),A,brow,0);
    STAGE(SB(0,1),Bt,bcol+HALF,0); STAGE(SA(0,1),A,brow+HALF,0);
    if(wr==1)BAR;
    WAIT_V(4); BAR;
    STAGE(SB(1,0),Bt,bcol,1); STAGE(SA(1,0),A,brow,1); STAGE(SB(1,1),Bt,bcol+HALF,1);
    WAIT_V(6); BAR;
    for(int t=0;t<nt-2;t+=2){
      LDB(B0,0,0); SCHED; LDA(At,0,0); STAGE(SA(1,1),A,brow+HALF,t+1);
      WAIT_L(8); BAR; WAIT_L(0); MMA(0,0,At,B0); BAR; SCHED;
      LDB(B1,0,1); STAGE(SB(0,0),Bt,bcol,t+2);
      BAR; WAIT_L(0); MMA(0,1,At,B1); BAR;
      LDA(At,0,1); STAGE(SA(0,0),A,brow,t+2);
      BAR; WAIT_L(0); MMA(1,0,At,B0); BAR; SCHED;
      STAGE(SB(0,1),Bt,bcol+HALF,t+2);
      WAIT_V(6); BAR; MMA(1,1,At,B1); BAR;
      LDB(B0,1,0); SCHED; LDA(At,1,0); STAGE(SA(0,1),A,brow+HALF,t+2);
      WAIT_L(8); BAR; WAIT_L(0); MMA(0,0,At,B0); BAR; SCHED;
      LDB(B1,1,1); STAGE(SB(1,0),Bt,bcol,t+3);
      BAR; WAIT_L(0); MMA(0,1,At,B1); BAR;
      LDA(At,1,1); STAGE(SA(1,0),A,brow,t+3);
      BAR; WAIT_L(0); MMA(1,0,At,B0); BAR; SCHED;
      STAGE(SB(1,1),Bt,bcol+HALF,t+3);
      WAIT_V(6); BAR; MMA(1,1,At,B1); BAR;
    }
    { LDB(B0,0,0); LDA(At,0,0); STAGE(SA(1,1),A,brow+HALF,nt-1);
      BAR; WAIT_L(0); MMA(0,0,At,B0); BAR;
      LDB(B1,0,1); BAR; WAIT_L(0); MMA(0,1,At,B1); BAR;
      LDA(At,0,1); WAIT_V(4); BAR; WAIT_L(0); MMA(1,0,At,B0); MMA(1,1,At,B1); BAR; }
    { LDB(B0,1,0); LDA(At,1,0); WAIT_V(2); BAR; WAIT_L(0); MMA(0,0,At,B0); BAR;
      LDB(B1,1,1); WAIT_V(0); BAR; WAIT_L(0); MMA(0,1,At,B1); BAR;
      LDA(At,1,1); BAR; WAIT_L(0); MMA(1,0,At,B0); MMA(1,1,At,B1); BAR; }
    if(wr==0)BAR;
    #undef SA
    #undef SB
    #undef STAGE
    #undef LDA
    #undef LDB
    #undef MMA
    #undef WAIT_V
    #undef WAIT_L
    #undef BAR
    #undef SCHED
}
__device__ __forceinline__ bool tile_order(int i, int G, int c, int nM, int nN, int& pm, int& pn) {
    const int nwg = nM * nN; const long L = (long)i * G + c; if (L >= nwg) return false;
    int wgid = (int)L; { const int q = nwg / 8, r = nwg % 8, xcd = wgid % 8, off = wgid / 8; wgid = (xcd < r ? xcd * (q + 1) : r * (q + 1) + (xcd - r) * q) + off; }
    const int nig = 8 * nN, gid = wgid / nig, fm = gid * 8, gsz = (nM - fm) < 8 ? (nM - fm) : 8;
    pm = fm + ((wgid % nig) % gsz); pn = (wgid % nig) / gsz; return true;
}

struct ConvJob { const float* src; int ld, K, nbegin, ncount, map; bf16_t* dst; };
__device__ __forceinline__ ConvJob conv_job(const PV& P, int j) {
    const int l = j >> 4, q = j & 15; bf16_t* W = wl(P, l); ConvJob c; c.map = 0; c.nbegin = 0;
    switch (q) {
        case 0: c.src = P.inp(8) + (size_t)l * 1024 * 5632; c.ld = 5632; c.K = 1024; c.ncount = 5632; c.dst = W + OW_FA_IN; c.map = 1; break;
        case 1: c.src = P.inp(9) + (size_t)l * 2816 * 1024; c.ld = 1024; c.K = 2816; c.ncount = 1024; c.dst = W + OW_FA_OUT; break;
        case 2: c.src = P.inp(10) + (size_t)l * 1024 * 5632; c.ld = 5632; c.K = 1024; c.ncount = 5632; c.dst = W + OW_FB_IN; c.map = 1; break;
        case 3: c.src = P.inp(11) + (size_t)l * 2816 * 1024; c.ld = 1024; c.K = 2816; c.ncount = 1024; c.dst = W + OW_FB_OUT; break;
        case 4: c.src = P.inp(12) + (size_t)l * 1024 * 8576; c.ld = 8576; c.K = 1024; c.ncount = 3456; c.dst = W + OW_WIN; break;
        case 5: c.src = P.inp(12) + (size_t)l * 1024 * 8576; c.ld = 8576; c.K = 1024; c.nbegin = 3968; c.ncount = 4608; c.dst = W + OW_WIN + (size_t)3968 * 1024; break;
        case 6: case 7: case 8: case 9: { const int n = q - 6; c.src = P.inp(27) + (size_t)(l * 4 + n) * 512 * 1024; c.ld = 1024; c.K = 512; c.ncount = 1024; c.dst = W + OW_WBR + (size_t)n * 1024 * 512; } break;
        case 10: c.src = P.inp(28) + (size_t)l * 1024 * 1024; c.ld = 1024; c.K = 1024; c.ncount = 1024; c.dst = W + OW_WOUT; break;
        case 11: case 12: { const int d = q - 11; c.src = P.inp(15) + (size_t)(l * 2 + d) * 64 * 512; c.ld = 512; c.K = 64; c.ncount = 512; c.dst = W + OW_W2T + (size_t)d * 512 * 64; } break;
        case 13: case 14: { const int d = q - 13; c.src = P.inp(17) + (size_t)(l * 2 + d) * 64 * 512; c.ld = 512; c.K = 64; c.ncount = 512; c.dst = W + OW_A2T + (size_t)d * 512 * 64; } break;
        default: c.src = P.inp(18) + (size_t)l * 128 * 512; c.ld = 512; c.K = 128; c.ncount = 512; c.dst = W + OW_G2T; break;
    }
    return c;
}

__device__ __forceinline__ void prep_phase(const Ctx& C, const PV& P, unsigned char* smem) {
    const int tid = C.tid;
    {
        int total = 0;
        for (int j = 0; j < 32; ++j) { ConvJob c = conv_job(P, j); total += (c.K >> 6) * (c.ncount >> 6); }
        float* tile = (float*)smem;
        const int tx = tid & 63, ty = tid >> 6;
        for (int t = C.bid; t < total; t += C.nblk) {
            int tt = t, j = 0; ConvJob c = conv_job(P, 0);
            for (;;) { const int n = (c.K >> 6) * (c.ncount >> 6); if (tt < n) break; tt -= n; ++j; c = conv_job(P, j); }
            const int nkt = c.K >> 6, kt = tt % nkt, nt = tt / nkt, k0 = kt * 64, n0 = nt * 64;
            int col = c.nbegin + n0 + tx;
            if (c.map) { const int np = n0 + tx, blk = np >> 5, w = np & 31, f = blk * 16 + (w & 15); col = (w < 16) ? f : 2816 + f; }
            __syncthreads();
#pragma unroll 4
            for (int i = 0; i < 8; ++i) { const int kk = ty + 8 * i; tile[kk * 65 + tx] = c.src[(size_t)(k0 + kk) * c.ld + col]; }
            __syncthreads();
#pragma unroll 4
            for (int i = 0; i < 8; ++i) { const int nn = ty + 8 * i; c.dst[(size_t)(n0 + nn) * c.K + k0 + tx] = f2bf(tile[tx * 65 + nn]); }
        }
        __syncthreads();
    }
    {
        float* wt = (float*)smem;
        float* cosT = (float*)(smem + 64 * 129 * 4);
        for (int it = C.bid; it < 2 * 4 * 16; it += C.nblk) {
            const int l = it >> 6, g = (it >> 4) & 3, kc = it & 15, k0 = kc * 64;
            const float* src = P.inp(12) + (size_t)l * 1024 * 8576 + 3456 + g * 128;
            __syncthreads();
            for (int e = tid; e < 64 * 128; e += NT) { const int kk = e >> 7, c = e & 127; wt[kk * 129 + c] = src[(size_t)(k0 + kk) * 8576 + c]; }
            if (tid < 128) cosT[tid] = cospif((float)tid * (1.0f / 64.0f));
            __syncthreads();
            bf16_t* dst = wl(P, l) + OW_WIN + (size_t)(3456 + g * 128) * 1024;
            const int kk = tid & 63;
            for (int i = 0; i < 16; ++i) {
                const int j2 = (tid >> 6) + 8 * i, cc = j2 >> 1, part = j2 & 1;
                float s = 0.f;
                if (cc == 0) {
                    if (part == 0) { for (int c = 0; c < 128; ++c) s += wt[kk * 129 + c]; }
                    else { for (int c = 0; c < 128; ++c) s += (c & 1) ? -wt[kk * 129 + c] : wt[kk * 129 + c]; }
                } else if (part == 0) {
                    for (int c = 0; c < 128; ++c) s += wt[kk * 129 + c] * cosT[(cc * c) & 127];
                } else {
                    for (int c = 0; c < 128; ++c) s -= wt[kk * 129 + c] * cosT[(cc * c - 32) & 127];
                }
                dst[(size_t)j2 * 1024 + k0 + kk] = f2bf(s);
            }
        }
        __syncthreads();
    }
    if (C.bid == 0 && tid < 16) ((unsigned*)(P.ws + WS_CTR))[tid] = 0u;
    {
        float2* tw = (float2*)(P.ws + WS_TW);
        for (int m = C.bid * NT + tid; m < 4096; m += C.nblk * NT) { const float x = (float)m * (1.0f / 4096.0f); tw[m] = make_float2(cospif(x), -sinpif(x)); }
    }
    {
        float* sc = (float*)smem;
        float* red = (float*)(smem + 18 * 512 * 4);
        float* mod = (float*)(P.ws + WS_MOD);
        for (int it = C.bid; it < 2 * 144; it += C.nblk) {
            const int l = it / 144, n0 = (it % 144) * 64, nl = tid & 63, ks = tid >> 6;
            const float* aw = P.inp(4) + (size_t)l * 1024 * 9216;
            float acc[18];
#pragma unroll
            for (int b = 0; b < 18; ++b) acc[b] = 0.f;
            for (int half = 0; half < 2; ++half) {
                __syncthreads();
                for (int e = tid; e < 18 * 512; e += NT) {
                    const int b = e >> 9, kk = e & 511, k = half * 512 + kk;
                    const float cv = b < 2 ? P.inp(2)[b * 1024 + k] : P.inp(3)[(b - 2) * 1024 + k];
                    sc[e] = cv / (1.0f + __expf(-cv));
                }
                __syncthreads();
                for (int kk = ks * 64; kk < ks * 64 + 64; ++kk) {
                    const float w = aw[(size_t)(half * 512 + kk) * 9216 + n0 + nl];
#pragma unroll
                    for (int b = 0; b < 18; ++b) acc[b] += sc[b * 512 + kk] * w;
                }
            }
            __syncthreads();
#pragma unroll
            for (int b = 0; b < 18; ++b) red[(ks * 18 + b) * 64 + nl] = acc[b];
            __syncthreads();
            for (int e = tid; e < 18 * 64; e += NT) {
                const int b = e >> 6, n = e & 63;
                float s = 0.f;
#pragma unroll
                for (int k8 = 0; k8 < 8; ++k8) s += red[(k8 * 18 + b) * 64 + n];
                mod[((size_t)l * 18 + b) * 9216 + n0 + n] = s + P.inp(5)[(size_t)l * 9216 + n0 + n];
            }
        }
        __syncthreads();
    }
}

__device__ __forceinline__ void norm_phase(const Ctx& C, const PV& P, int pass, const float* lng, const float* lnb, int mod_layer, int j, bool from_input) {
    const int lane = C.tid & 63, wave = C.tid >> 6;
    bf16_t* hmod = (bf16_t*)(P.ws + WS_HMOD);
    const float* mod = (const float*)(P.ws + WS_MOD);
    const int nw = C.nblk * NWV;
    for (int lt0 = C.bid * NWV + wave; lt0 < TP; lt0 += 2 * nw) {
        f32x4 v[2][4]; int gr[2], bb[2]; bool ok[2];
#pragma unroll
        for (int u = 0; u < 2; ++u) {
            const int lt = lt0 + u * nw; ok[u] = lt < TP;
            const int ltc = ok[u] ? lt : lt0;
            gr[u] = grow_of(pass, ltc); bb[u] = brow_of(pass, ltc);
            const float* src = from_input ? (gr[u] < 16384 ? P.inp(0) + (size_t)gr[u] * 1024 : P.inp(1) + (size_t)(gr[u] - 16384) * 1024) : P.out + (size_t)gr[u] * 1024;
#pragma unroll
            for (int i = 0; i < 4; ++i) v[u][i] = *(const f32x4*)(src + i * 256 + lane * 4);
        }
        if (lng) {
            float s[2], q[2], mu[2], rs[2];
#pragma unroll
            for (int u = 0; u < 2; ++u) { s[u] = 0.f;
#pragma unroll
                for (int i = 0; i < 4; ++i) s[u] += (v[u][i][0] + v[u][i][1]) + (v[u][i][2] + v[u][i][3]); }
#pragma unroll
            for (int o = 32; o > 0; o >>= 1) { s[0] += __shfl_xor(s[0], o); s[1] += __shfl_xor(s[1], o); }
#pragma unroll
            for (int u = 0; u < 2; ++u) { mu[u] = s[u] * (1.0f / 1024.0f); q[u] = 0.f;
#pragma unroll
                for (int i = 0; i < 4; ++i) { const f32x4 dd = v[u][i] - mu[u]; q[u] += (dd[0] * dd[0] + dd[1] * dd[1]) + (dd[2] * dd[2] + dd[3] * dd[3]); } }
#pragma unroll
            for (int o = 32; o > 0; o >>= 1) { q[0] += __shfl_xor(q[0], o); q[1] += __shfl_xor(q[1], o); }
#pragma unroll
            for (int u = 0; u < 2; ++u) rs[u] = rsqrtf(q[u] * (1.0f / 1024.0f) + 1e-5f);
#pragma unroll
            for (int i = 0; i < 4; ++i) {
                const f32x4 g = *(const f32x4*)(lng + i * 256 + lane * 4), be = *(const f32x4*)(lnb + i * 256 + lane * 4);
                v[0][i] = (v[0][i] - mu[0]) * rs[0] * g + be; v[1][i] = (v[1][i] - mu[1]) * rs[1] * g + be;
            }
        }
        if (lng || from_input) {
#pragma unroll
            for (int u = 0; u < 2; ++u) if (ok[u]) {
#pragma unroll
                for (int i = 0; i < 4; ++i) *(f32x4*)(P.out + (size_t)gr[u] * 1024 + i * 256 + lane * 4) = v[u][i];
            }
        }
        if (j >= 0) {
            float s[2], q[2], mu[2], rs[2];
#pragma unroll
            for (int u = 0; u < 2; ++u) { s[u] = 0.f;
#pragma unroll
                for (int i = 0; i < 4; ++i) s[u] += (v[u][i][0] + v[u][i][1]) + (v[u][i][2] + v[u][i][3]); }
#pragma unroll
            for (int o = 32; o > 0; o >>= 1) { s[0] += __shfl_xor(s[0], o); s[1] += __shfl_xor(s[1], o); }
#pragma unroll
            for (int u = 0; u < 2; ++u) { mu[u] = s[u] * (1.0f / 1024.0f); q[u] = 0.f;
#pragma unroll
                for (int i = 0; i < 4; ++i) { const f32x4 dd = v[u][i] - mu[u]; q[u] += (dd[0] * dd[0] + dd[1] * dd[1]) + (dd[2] * dd[2] + dd[3] * dd[3]); } }
#pragma unroll
            for (int o = 32; o > 0; o >>= 1) { q[0] += __shfl_xor(q[0], o); q[1] += __shfl_xor(q[1], o); }
#pragma unroll
            for (int u = 0; u < 2; ++u) {
                rs[u] = rsqrtf(q[u] * (1.0f / 1024.0f) + 1e-5f);
                if (!ok[u]) continue;
                const float* mb = mod + ((size_t)mod_layer * 18 + bb[u]) * 9216 + (size_t)(3 * j) * 1024;
                const int lt = lt0 + u * nw;
#pragma unroll
                for (int i = 0; i < 4; ++i) {
                    const f32x4 sh = *(const f32x4*)(mb + i * 256 + lane * 4), scl = *(const f32x4*)(mb + 1024 + i * 256 + lane * 4);
                    const f32x4 hh = (v[u][i] - mu[u]) * rs[u] * (1.0f + scl) + sh;
                    u32x2 o; o.x = pack2bf(hh[0], hh[1]); o.y = pack2bf(hh[2], hh[3]);
                    *(u32x2*)(hmod + (size_t)lt * 1024 + i * 256 + lane * 4) = o;
                }
            }
        }
    }
}

__device__ __forceinline__ void ffn_up_phase(const Ctx& C, const PV& P, const bf16_t* Wt) {
    const bf16_t* hmod = (const bf16_t*)(P.ws + WS_HMOD);
    bf16_t* act = (bf16_t*)(P.ws + WS_R + R_ACT);
    int pm, pn;
    for (int it = 0; tile_order(it, C.nblk, C.bid, TP / 256, 22, pm, pn); ++it) {
        f32x4 acc[2][2][4][2];
        gemm256(C, acc, hmod, Wt, 1024, pm * 256, pn * 256);
        int z2 = 0; asm volatile("" : "+s"(z2));
        const int tid2 = tid_now(C.wave_s, z2), lane = tid2 & 63, wid = tid2 >> 6, wr = wid >> 2, wc = wid & 3, fr = lane & 15, fq = lane >> 4;
#pragma unroll
        for (int ai = 0; ai < 2; ++ai)
#pragma unroll
            for (int m = 0; m < 4; ++m) {
                const int row = pm * 256 + ai * 128 + wr * 64 + m * 16 + fr;
#pragma unroll
                for (int bj = 0; bj < 2; ++bj) {
                    const int colbase = pn * 256 + bj * 128 + wc * 32, f = (colbase >> 5) * 16 + fq * 4;
                    const f32x4 a = acc[ai][bj][m][0], bb = acc[ai][bj][m][1];
                    float o[4];
#pragma unroll
                    for (int r = 0; r < 4; ++r) o[r] = a[r] / (1.0f + __expf(-a[r])) * bb[r];
                    u32x2 w; w.x = pack2bf(o[0], o[1]); w.y = pack2bf(o[2], o[3]);
                    *(u32x2*)(act + (size_t)row * 2816 + f) = w;
                }
            }
    }
}

__device__ __forceinline__ void resid_gemm_phase(const Ctx& C, const PV& P, int pass, const bf16_t* A, int K, const bf16_t* Wt, int layer, int j, float scale) {
    const float* mod = (const float*)(P.ws + WS_MOD);
    int pm, pn;
    for (int it = 0; tile_order(it, C.nblk, C.bid, TP / 256, 4, pm, pn); ++it) {
        f32x4 acc[2][2][4][2];
        gemm256(C, acc, A, Wt, K, pm * 256, pn * 256);
        int z2 = 0; asm volatile("" : "+s"(z2));
        const int tid2 = tid_now(C.wave_s, z2), lane = tid2 & 63, wid = tid2 >> 6, wr = wid >> 2, wc = wid & 3, fr = lane & 15, fq = lane >> 4;
#pragma unroll
        for (int ai = 0; ai < 2; ++ai)
#pragma unroll
            for (int m = 0; m < 4; ++m) {
                const int lt = pm * 256 + ai * 128 + wr * 64 + m * 16 + fr;
                const int gr = grow_of(pass, lt), b = brow_of(pass, lt);
                const float* gate = mod + ((size_t)layer * 18 + b) * 9216 + (size_t)(3 * j + 2) * 1024;
#pragma unroll
                for (int bj = 0; bj < 2; ++bj)
#pragma unroll
                    for (int n = 0; n < 2; ++n) {
                        const int col = pn * 256 + bj * 128 + wc * 32 + n * 16 + fq * 4;
                        f32x4* xp = (f32x4*)(P.out + (size_t)gr * 1024 + col);
                        const f32x4 x = *xp, g = *(const f32x4*)(gate + col);
                        *xp = ALPHA * x + (1.0f + g) * scale * acc[ai][bj][m][n];
                    }
            }
    }
}

__device__ __forceinline__ void win_phase(const Ctx& C, const PV& P, int layer) {
    const bf16_t* hmod = (const bf16_t*)(P.ws + WS_HMOD);
    const bf16_t* Wt = wl(P, layer) + OW_WIN;
    unsigned char* R = P.ws + WS_R;
    f16* raw = (f16*)(R + R_RAW); bf16_t* Qb = (bf16_t*)(R + R_Q); bf16_t* Kb = (bf16_t*)(R + R_K); bf16_t* Vt = (bf16_t*)(R + R_VT);
    f16* Zc = (f16*)(R + R_ZC); f16* poolp = (f16*)(R + R_POOLP);
    typedef f16 f16x4 __attribute__((ext_vector_type(4)));
    typedef f16 f16x2 __attribute__((ext_vector_type(2)));
    int pm, pn;
    for (int it = 0; tile_order(it, C.nblk, C.bid, TP / 256, 18, pm, pn); ++it) {
        const int lt_t = pm * 256, sq = lt_t < 8192 ? 0 : 1 + ((lt_t - 8192) >> 12), lt0 = seqbase_of(sq), S = seqlen_of(sq);
        f32x4 acc[2][2][4][2];
        gemm256(C, acc, hmod, Wt, 1024, pm * 256, pn * 256);
        int z2 = 0; asm volatile("" : "+s"(z2));
        const int tid2 = tid_now(C.wave_s, z2), lane = tid2 & 63, wid = tid2 >> 6, wr = wid >> 2, wc = wid & 3, fr = lane & 15, fq = lane >> 4;
#pragma unroll
        for (int bj = 0; bj < 2; ++bj) {
            const int tn = pn * 2 + bj;
            if (tn >= 35) continue;
#pragma unroll
            for (int ai = 0; ai < 2; ++ai)
#pragma unroll
                for (int m = 0; m < 4; ++m) {
                    const int lt = pm * 256 + ai * 128 + wr * 64 + m * 16 + fr, pos = lt - lt0;
#pragma unroll
                    for (int n = 0; n < 2; ++n) {
                        const int col = tn * 128 + wc * 32 + n * 16 + fq * 4;
                        f32x4 v = acc[ai][bj][m][n];
                        if (tn < 15) {
                            f16x4 h; h[0] = (f16)v[0]; h[1] = (f16)v[1]; h[2] = (f16)v[2]; h[3] = (f16)v[3];
                            *(f16x4*)(raw + (size_t)lt * 1920 + col) = h;
                        } else if (tn < 23) {
                            const int nq = (col - 1920) & 511, hc = nq >> 6, d = nq & 63;
                            if (n == 0 && (wc & 1) == 0) {
#pragma unroll
                                for (int r = 0; r < 4; ++r) {
                                    const float invlo = r == 0 ? 1.0f : r == 1 ? 0.1939227432012558f : r == 2 ? 0.03760603070259094f : 0.007292664609849453f;
                                    const float invhi = r == 0 ? 0.0014142135623842478f : r == 1 ? 0.00027424818836152554f : r == 2 ? 5.3182957344688475e-05f : 1.0313385246263351e-05f;
                                    const float ang = (float)pos * ((fq & 1) ? invhi : invlo);
                                    const float hi = ang * 0.15915493667125702f;
                                    const float lo = __builtin_fmaf(ang, 0.15915493667125702f, -hi) + ang * 6.4206382432985265e-09f;
                                    const float rr = (hi - floorf(hi)) + lo;
                                    const float cs = __builtin_amdgcn_cosf(rr), sn = __builtin_amdgcn_sinf(rr);
                                    const float other = __shfl_xor(v[r], 32);
                                    v[r] = (fq < 2) ? (v[r] * cs - other * sn) : (other * sn + v[r] * cs);
                                }
                            }
                            bf16_t* dst = (tn < 19) ? Qb : Kb;
                            const float sc = (tn < 19) ? 0.125f * 1.44269504088896f : 1.0f;
                            u32x2 w; w.x = pack2bf(v[0] * sc, v[1] * sc); w.y = pack2bf(v[2] * sc, v[3] * sc);
                            *(u32x2*)(dst + (size_t)lt0 * 512 + ((size_t)hc * S + pos) * 64 + d) = w;
                        } else if (tn < 27) {
                            const int nv = col - 2944;
                            bf16_t* vb = Vt + (size_t)lt0 * 512 + (size_t)nv * S + pos;
                            vb[0] = f2bf(v[0]); vb[(size_t)S] = f2bf(v[1]); vb[(size_t)2 * S] = f2bf(v[2]); vb[(size_t)3 * S] = f2bf(v[3]);
                        } else if (tn < 31) {
                            const int nz = col - 3456, g = nz >> 7, cc = (nz & 127) >> 1;
                            f16x2 z0, z1; z0[0] = (f16)v[0]; z0[1] = (f16)v[1]; z1[0] = (f16)v[2]; z1[1] = (f16)v[3];
                            f16x2* zb = (f16x2*)Zc + (size_t)lt0 * 256;
                            zb[(size_t)(g * 64 + cc) * S + pos] = z0;
                            zb[(size_t)(g * 64 + cc + 1) * S + pos] = z1;
                        } else {
                            f16x4 h; h[0] = (f16)v[0]; h[1] = (f16)v[1]; h[2] = (f16)v[2]; h[3] = (f16)v[3];
                            *(f16x4*)(poolp + (size_t)lt * 512 + (col - 3968)) = h;
                        }
                    }
                    asm volatile("" ::: "memory");
                }
        }
    }
}

__device__ __forceinline__ float shiftv(const f16* __restrict__ raw, int lt, int t, int S, int col, float mu) {
    const float p = (float)raw[(size_t)lt * 1920 + col];
    const float pr = t > 0 ? (float)raw[(size_t)(lt - 1) * 1920 + col] : 0.f;
    const float nx = t < S - 1 ? (float)raw[(size_t)(lt + 1) * 1920 + col] : 0.f;
    return p + (0.5f * (pr + nx) - p) * mu;
}

typedef f16 f16x4_t __attribute__((ext_vector_type(4)));
typedef f16 f16x8_t __attribute__((ext_vector_type(8)));
__device__ __forceinline__ void lin_pool_phase(const Ctx& C, const PV& P, int layer) {
    unsigned char* R = P.ws + WS_R;
    const f16* raw = (const f16*)(R + R_RAW); bf16_t* lin = (bf16_t*)(R + R_LIN);
    const f16* poolp = (const f16*)(R + R_POOLP); bf16_t* ypool = (bf16_t*)(R + R_YB) + 3 * SZ512;
    const float* mu = P.inp(13) + (size_t)layer * 1920; const float* pscale = P.inp(26) + (size_t)layer * 512;
    const int gsz = C.nblk * NT, gid = C.bid * NT + C.tid;
    for (int e = gid; e < TP * 96; e += gsz) {
        const int lt = e / 96, c = (e % 96) * 4, col = 1536 + c;
        const int pos = pos_of(lt), S = lt < 8192 ? 8192 : 4096;
        const f16x4_t p0 = *(const f16x4_t*)(raw + (size_t)lt * 1920 + col);
        const f16x4_t pm = *(const f16x4_t*)(raw + (size_t)(pos > 0 ? lt - 1 : lt) * 1920 + col);
        const f16x4_t pp = *(const f16x4_t*)(raw + (size_t)(pos < S - 1 ? lt + 1 : lt) * 1920 + col);
        const f32x4 m4 = *(const f32x4*)(mu + col);
        const float wm = pos > 0 ? 0.5f : 0.f, wp = pos < S - 1 ? 0.5f : 0.f;
        float o[4];
#pragma unroll
        for (int r = 0; r < 4; ++r) {
            const float p = (float)p0[r];
            float v = p + (wm * (float)pm[r] + wp * (float)pp[r] - p) * m4[r];
            if (c < 128) v = 1.0f - 2.0f / (__expf(2.0f * v) + 1.0f);
            else if (c >= 256) v = sigmoidf_(v);
            o[r] = v;
        }
        u32x2 w; w.x = pack2bf(o[0], o[1]); w.y = pack2bf(o[2], o[3]);
        *(u32x2*)(lin + (size_t)lt * 384 + c) = w;
    }
    for (int e = gid; e < TP * 128; e += gsz) {
        const int lt = e >> 7, c = (e & 127) * 4, g = c >> 7, half = 1 << g;
        const int pos = pos_of(lt), S = lt < 8192 ? 8192 : 4096;
        const int lo = max(pos - half, 0), hi = min(pos + half, S);
        const f16* base = poolp + (size_t)(lt - pos) * 512 + c;
        float s0 = 0.f, s1 = 0.f, s2 = 0.f, s3 = 0.f;
#pragma unroll
        for (int o = -8; o < 8; ++o) {
            const int tt = pos + o;
            const bool in = (o >= -half) && (o < half) && tt >= 0 && tt < S;
            if (in) { const f16x4_t v = *(const f16x4_t*)(base + (size_t)tt * 512); s0 += (float)v[0]; s1 += (float)v[1]; s2 += (float)v[2]; s3 += (float)v[3]; }
        }
        const f16x4_t x = *(const f16x4_t*)(base + (size_t)pos * 512);
        const f32x4 ps = *(const f32x4*)(pscale + c);
        const float ic = 1.0f / (float)(hi - lo);
        u32x2 w; w.x = pack2bf((s0 * ic - (float)x[0]) * ps[0], (s1 * ic - (float)x[1]) * ps[1]); w.y = pack2bf((s2 * ic - (float)x[2]) * ps[2], (s3 * ic - (float)x[3]) * ps[3]);
        *(u32x2*)(ypool + (size_t)lt * 512 + c) = w;
    }
    {
        float* invn = (float*)(P.ws + WS_INVN);
        const float* k_k = P.inp(19) + (size_t)layer * 512;
        const int lane = C.tid & 63, wave = C.tid >> 6;
        for (int lt = C.bid * NWV + wave; lt < TP; lt += C.nblk * NWV) {
            const int pos = pos_of(lt), S = lt < 8192 ? 8192 : 4096;
            float ss[8];
#pragma unroll
            for (int h = 0; h < 8; ++h) {
                const int c = h * 64 + lane;
                const float k = shiftv(raw, lt, pos, S, 512 + c, mu[512 + c]) * k_k[c];
                ss[h] = k * k;
            }
#pragma unroll
            for (int h = 0; h < 8; ++h) ss[h] = wsum(ss[h]);
            if (lane < 8) {
                float sel = ss[0];
#pragma unroll
                for (int h = 1; h < 8; ++h) sel = lane == h ? ss[h] : sel;
                invn[(size_t)lt * 8 + lane] = 1.0f / fmaxf(sqrtf(sel), 1e-12f);
            }
        }
    }
}

__device__ __forceinline__ void lora_phase(const Ctx& C, const PV& P, int layer, unsigned char* smem) {
    unsigned char* R = P.ws + WS_R;
    const bf16_t* lin = (const bf16_t*)(R + R_LIN); f16* wa = (f16*)(R + R_WA); f16* gbuf = (f16*)(R + R_G);
    const bf16_t* W = wl(P, layer);
    const int lane = C.tid & 63, wave = (C.tid >> 6) & 3, wm = wave >> 1, wn = wave & 1, fr = lane & 15, fq = lane >> 4;
    for (int t2 = C.bid; t2 < 5 * MT * 2; t2 += C.nblk) {
        const int t = t2 * 2 + (C.tid >> 8);
        const int which = t / (MT * 4), tt = t % (MT * 4), tm = tt >> 2, tn = tt & 3;
        const bf16_t* Bt; int K, acol; const float* bias = nullptr; f16* dst;
        if (which < 2) { Bt = W + OW_W2T + (size_t)which * 512 * 64; K = 64; acol = which * 64; bias = P.inp(14) + (size_t)(layer * 2 + which) * 512; dst = wa + (size_t)which * SZ512; }
        else if (which < 4) { const int d = which - 2; Bt = W + OW_A2T + (size_t)d * 512 * 64; K = 64; acol = 128 + d * 64; bias = P.inp(16) + (size_t)(layer * 2 + d) * 512; dst = wa + (size_t)which * SZ512; }
        else { Bt = W + OW_G2T; K = 128; acol = 256; dst = gbuf; }
        f32x4 acc[4][4];
        gemm_core<4, true>(C, acc, lin + (size_t)tm * 128 * 384 + acol, 384, Bt + (size_t)tn * 128 * K, K, K, smem);
#pragma unroll
        for (int i = 0; i < 4; ++i) {
            const int lt = tm * 128 + wm * 64 + i * 16 + fr;
#pragma unroll
            for (int jn = 0; jn < 4; ++jn) {
                const int n = tn * 128 + wn * 64 + jn * 16 + fq * 4;
                typedef f16 f16x4 __attribute__((ext_vector_type(4)));
                f16x4 h;
#pragma unroll
                for (int r = 0; r < 4; ++r) {
                    float v = acc[i][jn][r];
                    if (which < 2) {
                        const float z = bias[n + r] + v, nz = -z;
                        const float sp = fmaxf(nz, 0.f) + log1pf(expf(-fabsf(nz)));
                        v = expf(-expf(-sp - 0.5f));
                    } else if (which < 4) { v = 1.0f / (1.0f + expf(-(bias[n + r] + v))); }
                    h[r] = (f16)v;
                }
                *(f16x4*)(dst + (size_t)lt * 512 + n) = h;
            }
        }
    }
}

__device__ __forceinline__ void attn_items(const Ctx& C, const PV& P, int layer, int ctr_idx, unsigned char* smem) {
    unsigned char* R = P.ws + WS_R;
    const bf16_t* Qall = (const bf16_t*)(R + R_Q); const bf16_t* Kall = (const bf16_t*)(R + R_K); const bf16_t* Vall = (const bf16_t*)(R + R_VT);
    bf16_t* ydiff = (bf16_t*)(R + R_YB) + 1 * SZ512;
    const int tid = C.tid, lane = tid & 63, wave = tid >> 6, comp = wave & 1, rg = wave >> 1, fr = lane & 15, fq = lane >> 4;
    const float lam_init = layer == 0 ? 0.2f : (0.8f - 0.6f * 0.7408182206817179f);
    float lam_full;
    {
        const float* lm = P.inp(24) + (size_t)layer * 256;
        float s1 = 0.f, s2 = 0.f;
        for (int i = 0; i < 64; ++i) { s1 += lm[i] * lm[64 + i]; s2 += lm[128 + i] * lm[192 + i]; }
        lam_full = expf(s1) - expf(s2) + lam_init;
    }
    const float* normg = P.inp(25) + (size_t)layer * 128;
    unsigned* ctr = (unsigned*)(P.ws + WS_CTR) + ctr_idx;
    volatile unsigned* bc = (volatile unsigned*)(smem + 131056);
    for (;;) {
        __syncthreads();
        if (tid == 0) *bc = atomicAdd(ctr, 1u);
        __syncthreads();
        const int item = (int)*bc;
        if (item >= 1280) break;
        int sq, h, qb;
        if (item < 256) { sq = 0; h = item >> 6; qb = item & 63; } else { const int i2 = item - 256; sq = 1 + (i2 >> 7); h = (i2 >> 5) & 3; qb = i2 & 31; }
        const int lt0 = seqbase_of(sq), S = seqlen_of(sq);
        const bf16_t* Qb = Qall + (size_t)lt0 * 512; const bf16_t* Kb = Kall + (size_t)lt0 * 512; const bf16_t* Vb = Vall + (size_t)lt0 * 512 + (size_t)h * 128 * S;
        const int q0 = qb * 128 + rg * 32;
        bf16x8 bq[2][2];
#pragma unroll
        for (int qs = 0; qs < 2; ++qs)
#pragma unroll
            for (int ks = 0; ks < 2; ++ks) bq[qs][ks] = *(const bf16x8*)(Qb + ((size_t)(h * 2 + comp) * S + q0 + qs * 16 + fr) * 64 + ks * 32 + fq * 8);
        float m_run[2] = {-1e30f, -1e30f}, l_run[2] = {0.f, 0.f};
        f32x4 O[8][2];
#pragma unroll
        for (int a = 0; a < 8; ++a) { O[a][0] = (f32x4){0.f, 0.f, 0.f, 0.f}; O[a][1] = (f32x4){0.f, 0.f, 0.f, 0.f}; }
        u32x4 rk[2], rv[2];
        const int lrow = tid >> 3, lkc = (tid & 7) * 8;
#pragma unroll
        for (int i = 0; i < 2; ++i) {
            const int row = lrow + 64 * i, cm = row >> 6, key = row & 63;
            rk[i] = *(const u32x4*)(Kb + ((size_t)(h * 2 + cm) * S + key) * 64 + lkc);
            rv[i] = *(const u32x4*)(Vb + (size_t)row * S + lkc);
        }
        for (int kt0 = 0; kt0 < S; kt0 += 64) {
            __syncthreads();
#pragma unroll
            for (int i = 0; i < 2; ++i) {
                const int row = lrow + 64 * i;
                *(u32x4*)(smem + row * 144 + lkc * 2) = rk[i];
                *(u32x4*)(smem + 18432 + row * 144 + lkc * 2) = rv[i];
            }
            __syncthreads();
            if (kt0 + 64 < S) {
#pragma unroll
                for (int i = 0; i < 2; ++i) {
                    const int row = lrow + 64 * i, cm = row >> 6, key = row & 63;
                    rk[i] = *(const u32x4*)(Kb + ((size_t)(h * 2 + cm) * S + kt0 + 64 + key) * 64 + lkc);
                    rv[i] = *(const u32x4*)(Vb + (size_t)row * S + kt0 + 64 + lkc);
                }
            }
            f32x4 st[4][2];
#pragma unroll
            for (int t = 0; t < 4; ++t) {
                st[t][0] = (f32x4){0.f, 0.f, 0.f, 0.f}; st[t][1] = (f32x4){0.f, 0.f, 0.f, 0.f};
#pragma unroll
                for (int ks = 0; ks < 2; ++ks) {
                    const bf16x8 kf = *(const bf16x8*)(smem + (comp * 64 + t * 16 + fr) * 144 + (ks * 32 + fq * 8) * 2);
                    st[t][0] = __builtin_amdgcn_mfma_f32_16x16x32_bf16(kf, bq[0][ks], st[t][0], 0, 0, 0);
                    st[t][1] = __builtin_amdgcn_mfma_f32_16x16x32_bf16(kf, bq[1][ks], st[t][1], 0, 0, 0);
                }
            }
            bf16x8 pb[2][2];
#pragma unroll
            for (int qs = 0; qs < 2; ++qs) {
                float mx = -1e30f;
#pragma unroll
                for (int t = 0; t < 4; ++t)
#pragma unroll
                    for (int r = 0; r < 4; ++r) mx = fmaxf(mx, st[t][qs][r]);
                mx = fmaxf(mx, __shfl_xor(mx, 16)); mx = fmaxf(mx, __shfl_xor(mx, 32));
                const float mnew = fmaxf(m_run[qs], mx);
                const float alpha = __builtin_amdgcn_exp2f(m_run[qs] - mnew);
                m_run[qs] = mnew;
                float ls = 0.f;
                float pv[4][4];
#pragma unroll
                for (int t = 0; t < 4; ++t)
#pragma unroll
                    for (int r = 0; r < 4; ++r) { pv[t][r] = __builtin_amdgcn_exp2f(st[t][qs][r] - mnew); ls += pv[t][r]; }
                l_run[qs] = l_run[qs] * alpha + ls;
#pragma unroll
                for (int a = 0; a < 8; ++a) O[a][qs] = O[a][qs] * alpha;
#pragma unroll
                for (int u = 0; u < 2; ++u) {
                    union { bf16x8 v; unsigned w[4]; } pk;
                    pk.w[0] = pack2bf(pv[2 * u][0], pv[2 * u][1]); pk.w[1] = pack2bf(pv[2 * u][2], pv[2 * u][3]);
                    pk.w[2] = pack2bf(pv[2 * u + 1][0], pv[2 * u + 1][1]); pk.w[3] = pack2bf(pv[2 * u + 1][2], pv[2 * u + 1][3]);
                    pb[qs][u] = pk.v;
                }
            }
#pragma unroll
            for (int u = 0; u < 2; ++u)
#pragma unroll
                for (int a = 0; a < 8; ++a) {
                    union { bf16x8 v; uint2 h[2]; } vf;
                    vf.h[0] = *(const uint2*)(smem + 18432 + (a * 16 + fr) * 144 + (u * 32 + fq * 4) * 2);
                    vf.h[1] = *(const uint2*)(smem + 18432 + (a * 16 + fr) * 144 + (u * 32 + 16 + fq * 4) * 2);
                    O[a][0] = __builtin_amdgcn_mfma_f32_16x16x32_bf16(vf.v, pb[0][u], O[a][0], 0, 0, 0);
                    O[a][1] = __builtin_amdgcn_mfma_f32_16x16x32_bf16(vf.v, pb[1][u], O[a][1], 0, 0, 0);
                }
        }
#pragma unroll
        for (int qs = 0; qs < 2; ++qs) {
            float l = l_run[qs]; l += __shfl_xor(l, 16); l += __shfl_xor(l, 32);
            const float inv = 1.0f / l;
#pragma unroll
            for (int a = 0; a < 8; ++a) O[a][qs] = O[a][qs] * inv;
        }
        __syncthreads();
        float* Ox = (float*)smem;
        if (comp == 1) {
#pragma unroll
            for (int qs = 0; qs < 2; ++qs)
#pragma unroll
                for (int a = 0; a < 8; ++a)
#pragma unroll
                    for (int r = 0; r < 4; ++r) Ox[(rg * 128 + a * 16 + fq * 4 + r) * 32 + qs * 16 + fr] = O[a][qs][r];
        }
        __syncthreads();
        if (comp == 0) {
#pragma unroll
            for (int qs = 0; qs < 2; ++qs) {
                float ss = 0.f;
#pragma unroll
                for (int a = 0; a < 8; ++a)
#pragma unroll
                    for (int r = 0; r < 4; ++r) {
                        const float o = O[a][qs][r] - lam_full * Ox[(rg * 128 + a * 16 + fq * 4 + r) * 32 + qs * 16 + fr];
                        O[a][qs][r] = o; ss += o * o;
                    }
                ss += __shfl_xor(ss, 16); ss += __shfl_xor(ss, 32);
                const float sc = rsqrtf(ss * (1.0f / 128.0f) + 1e-5f) * (1.0f - lam_init);
                const int lt = lt0 + q0 + qs * 16 + fr;
#pragma unroll
                for (int a = 0; a < 8; ++a) {
                    const int dv = a * 16 + fq * 4;
                    const float4 g = *(const float4*)(normg + dv);
                    uint2 w; w.x = pack2bf(O[a][qs][0] * sc * g.x, O[a][qs][1] * sc * g.y); w.y = pack2bf(O[a][qs][2] * sc * g.z, O[a][qs][3] * sc * g.w);
                    *(uint2*)(ydiff + (size_t)lt * 512 + h * 128 + dv) = w;
                }
            }
        }
    }
    __syncthreads();
}

__device__ __forceinline__ void fft_items(const Ctx& C, const PV& P, unsigned char* smem) {
    unsigned char* R = P.ws + WS_R;
    typedef f16 f16x2 __attribute__((ext_vector_type(2)));
    const f16x2* Zall = (const f16x2*)(R + R_ZC);
    bf16_t* yf = (bf16_t*)(R + R_YB) + 2 * SZ512;
    const float2* tw = (const float2*)(P.ws + WS_TW);
    float2* sm = (float2*)smem;
    const int tid = C.tid;
    for (int item = C.bid; item < NSEQ * 256; item += C.nblk) {
        const int sq = item >> 8, col = item & 255, g = col >> 6, cc = col & 63;
        const int lt0 = seqbase_of(sq), S = seqlen_of(sq), lg = sq == 0 ? 13 : 12;
        const f16x2* z = Zall + (size_t)lt0 * 256 + (size_t)col * S;
        __syncthreads();
        for (int s = tid; s < S; s += NT) { const f16x2 v = z[s]; sm[__brev((unsigned)s) >> (32 - lg)] = make_float2((float)v[0], (float)v[1]); }
        __syncthreads();
        for (int st = 0; st < lg; ++st) {
            const int half = 1 << st, tshift = 12 - st;
            for (int b = tid; b < (S >> 1); b += NT) {
                const int j = b & (half - 1), i0 = ((b >> st) << (st + 1)) + j, i1 = i0 + half;
                const float2 w = tw[j << tshift], u = sm[i0], x = sm[i1];
                const float2 tv = make_float2(w.x * x.x - w.y * x.y, w.x * x.y + w.y * x.x);
                sm[i0] = make_float2(u.x + tv.x, u.y + tv.y); sm[i1] = make_float2(u.x - tv.x, u.y - tv.y);
            }
            __syncthreads();
        }
        const float nrm = rsqrtf((float)S * 128.0f);
        for (int k = tid; k < S; k += NT) {
            const float2 a = sm[k], b = sm[(S - k) & (S - 1)];
            bf16_t* row = yf + (size_t)(lt0 + k) * 512 + g * 128;
            if (cc == 0) { row[0] = f2bf(0.5f * (a.x + b.x) * nrm); row[64] = f2bf(0.5f * (a.y + b.y) * nrm); }
            else { row[cc] = f2bf(a.x * nrm); row[128 - cc] = f2bf(b.x * nrm); }
        }
    }
    __syncthreads();
}

typedef float f32x2 __attribute__((ext_vector_type(2)));
template <int KT>
__device__ __forceinline__ void scan_block(const Ctx& C, const PV& P, int layer, int sq, int h, int d, int row0, unsigned char* smem) {
    constexpr int TPR = 64 / KT, ROWS = NT / TPR, CH = 16, YP = TPR / 4, NV = ROWS / 32;
    unsigned char* R = P.ws + WS_R;
    const f16* raw = (const f16*)(R + R_RAW); const f16* wa = (const f16*)(R + R_WA); f16* yfb = (f16*)(R + R_YFB);
    const float* invn = (const float*)(P.ws + WS_INVN);
    const float* mu = P.inp(13) + (size_t)layer * 1920; const float* k_k = P.inp(19) + (size_t)layer * 512; const float* k_a = P.inp(20) + (size_t)layer * 512;
    const int tid = C.tid, row = tid / TPR, q = tid % TPR;
    const int lt0 = seqbase_of(sq), S = seqlen_of(sq);
    const int ch = tid & 63, c = h * 64 + ch;
    const float mu_r = mu[c], mu_k = mu[512 + c], kkw = k_k[c], kaw = k_a[c];
    const int vr = (ROWS == 32) ? (tid & 31) : (tid & 63);
    const int vcol = 1024 + h * 64 + row0 + vr; const float mu_v = mu[vcol];
    const f16* wdec = wa + (size_t)d * SZ512; const f16* aact = wa + (size_t)(2 + d) * SZ512;
    f16* ydst = yfb + (size_t)d * SZ512;
    f32x2 s[KT / 2];
#pragma unroll
    for (int j = 0; j < KT / 2; ++j) s[j] = (f32x2){0.f, 0.f};
    f16 pr_[2][3], pk_[2][3], pa_[2], pw_[2], pv_[NV][3]; float pn_[2];
    auto prefetch = [&](int c0) {
#pragma unroll
        for (int j = 0; j < 2; ++j) {
            const int i = (tid >> 6) + 8 * j, tstep = c0 + i, t = d == 0 ? tstep : S - 1 - tstep, lt = lt0 + t;
            const int tm = t > 0 ? lt - 1 : lt, tp = t < S - 1 ? lt + 1 : lt;
            pr_[j][0] = raw[(size_t)tm * 1920 + c]; pr_[j][1] = raw[(size_t)lt * 1920 + c]; pr_[j][2] = raw[(size_t)tp * 1920 + c];
            pk_[j][0] = raw[(size_t)tm * 1920 + 512 + c]; pk_[j][1] = raw[(size_t)lt * 1920 + 512 + c]; pk_[j][2] = raw[(size_t)tp * 1920 + 512 + c];
            pa_[j] = aact[(size_t)lt * 512 + c]; pw_[j] = wdec[(size_t)lt * 512 + c]; pn_[j] = invn[(size_t)lt * 8 + h];
        }
#pragma unroll
        for (int j = 0; j < NV; ++j) {
            const int i = (ROWS == 32) ? (tid >> 5) : ((tid >> 6) + 8 * j), tstep = c0 + i, t = d == 0 ? tstep : S - 1 - tstep, lt = lt0 + t;
            const int tm = t > 0 ? lt - 1 : lt, tp = t < S - 1 ? lt + 1 : lt;
            pv_[j][0] = raw[(size_t)tm * 1920 + vcol]; pv_[j][1] = raw[(size_t)lt * 1920 + vcol]; pv_[j][2] = raw[(size_t)tp * 1920 + vcol];
        }
    };
    auto stage = [&](int c0, unsigned char* buf) {
        float* vec = (float*)buf; float* vbuf = (float*)(buf + 20480);
#pragma unroll
        for (int j = 0; j < 2; ++j) {
            const int i = (tid >> 6) + 8 * j, tstep = c0 + i, t = d == 0 ? tstep : S - 1 - tstep;
            const float rm = t > 0 ? (float)pr_[j][0] : 0.f, rp = t < S - 1 ? (float)pr_[j][2] : 0.f, km = t > 0 ? (float)pk_[j][0] : 0.f, kp = t < S - 1 ? (float)pk_[j][2] : 0.f;
            const float r1 = (float)pr_[j][1], k1 = (float)pk_[j][1];
            const float r = r1 + (0.5f * (rm + rp) - r1) * mu_r;
            const float k = k1 + (0.5f * (km + kp) - k1) * mu_k;
            const float kk = k * kkw * pn_[j], a = (float)pa_[j];
            vec[(0 * CH + i) * 64 + ch] = kk;
            vec[(1 * CH + i) * 64 + ch] = (float)pw_[j];
            vec[(2 * CH + i) * 64 + ch] = kk * a;
            vec[(3 * CH + i) * 64 + ch] = k * (1.0f + (a - 1.0f) * kaw);
            vec[(4 * CH + i) * 64 + ch] = r;
        }
#pragma unroll
        for (int j = 0; j < NV; ++j) {
            const int i = (ROWS == 32) ? (tid >> 5) : ((tid >> 6) + 8 * j), tstep = c0 + i, t = d == 0 ? tstep : S - 1 - tstep;
            const float vm = t > 0 ? (float)pv_[j][0] : 0.f, vp = t < S - 1 ? (float)pv_[j][2] : 0.f, v1 = (float)pv_[j][1];
            vbuf[i * 64 + vr] = v1 + (0.5f * (vm + vp) - v1) * mu_v;
        }
    };
    __syncthreads();
    prefetch(0);
    stage(0, smem);
    __syncthreads();
    const int nch = S / CH;
    for (int cix = 0; cix < nch; ++cix) {
        unsigned char* buf = smem + (cix & 1) * 32768;
        if (cix + 1 < nch) prefetch((cix + 1) * CH);
        {
            const float* vec = (const float*)buf; const float* vbuf = (const float*)(buf + 20480); float* ybuf = (float*)(buf + 24576);
            const f32x4* vp0 = (const f32x4*)(vec + q * KT);
            f32x4 nx[5][KT / 4]; float nvv;
#pragma unroll
            for (int u = 0; u < KT / 4; ++u)
#pragma unroll
                for (int a5 = 0; a5 < 5; ++a5) nx[a5][u] = vp0[a5 * CH * 16 + u];
            nvv = vbuf[row];
            float yv[CH];
#pragma unroll
            for (int i = 0; i < CH; ++i) {
                f32x2 kk2[KT / 2], w2[KT / 2], b2[KT / 2], kd2[KT / 2], r2[KT / 2];
#pragma unroll
                for (int u = 0; u < KT / 4; ++u) {
                    kk2[2 * u] = (f32x2){nx[0][u][0], nx[0][u][1]}; kk2[2 * u + 1] = (f32x2){nx[0][u][2], nx[0][u][3]};
                    w2[2 * u] = (f32x2){nx[1][u][0], nx[1][u][1]}; w2[2 * u + 1] = (f32x2){nx[1][u][2], nx[1][u][3]};
                    b2[2 * u] = (f32x2){nx[2][u][0], nx[2][u][1]}; b2[2 * u + 1] = (f32x2){nx[2][u][2], nx[2][u][3]};
                    kd2[2 * u] = (f32x2){nx[3][u][0], nx[3][u][1]}; kd2[2 * u + 1] = (f32x2){nx[3][u][2], nx[3][u][3]};
                    r2[2 * u] = (f32x2){nx[4][u][0], nx[4][u][1]}; r2[2 * u + 1] = (f32x2){nx[4][u][2], nx[4][u][3]};
                }
                const float vv = nvv;
                if (i + 1 < CH) {
#pragma unroll
                    for (int u = 0; u < KT / 4; ++u)
#pragma unroll
                        for (int a5 = 0; a5 < 5; ++a5) nx[a5][u] = vp0[(i + 1) * 16 + a5 * CH * 16 + u];
                    nvv = vbuf[(i + 1) * 64 + row];
                }
                f32x2 acc2 = s[0] * kk2[0];
#pragma unroll
                for (int j = 1; j < KT / 2; ++j) acc2 = __builtin_elementwise_fma(s[j], kk2[j], acc2);
                float sa = acc2[0] + acc2[1];
                sa += dppf<0xB1>(sa); sa += dppf<0x4E>(sa); sa += dppf<0x141>(sa);
                if (TPR == 16) sa += dppf<0x140>(sa);
                sa = -sa;
                const f32x2 sa2 = (f32x2){sa, sa}, vv2 = (f32x2){vv, vv};
                f32x2 y2 = (f32x2){0.f, 0.f};
#pragma unroll
                for (int j = 0; j < KT / 2; ++j) {
                    s[j] = __builtin_elementwise_fma(s[j], w2[j], __builtin_elementwise_fma(sa2, b2[j], vv2 * kd2[j]));
                    y2 = __builtin_elementwise_fma(s[j], r2[j], y2);
                }
                float y = y2[0] + y2[1];
                y += dppf<0xB1>(y); y += dppf<0x4E>(y);
                yv[i] = y;
            }
            if ((q & 3) == 0) {
#pragma unroll
                for (int i = 0; i < CH; ++i) ybuf[i * 128 + row * YP + (q >> 2)] = yv[i];
            }
        }
        if (cix + 1 < nch) stage((cix + 1) * CH, smem + ((cix + 1) & 1) * 32768);
        __syncthreads();
        {
            const float* ybuf = (const float*)(buf + 24576);
#pragma unroll
            for (int j = 0; j < NV; ++j) {
                const int i = (ROWS == 32) ? (tid >> 5) : ((tid >> 6) + 8 * j), rr = vr, tstep = cix * CH + i, t = d == 0 ? tstep : S - 1 - tstep;
                float y = 0.f;
#pragma unroll
                for (int p = 0; p < YP; ++p) y += ybuf[i * 128 + rr * YP + p];
                ydst[(size_t)(lt0 + t) * 512 + h * 64 + row0 + rr] = (f16)y;
            }
        }
    }
    __syncthreads();
}

__device__ __forceinline__ void finish_phase(const Ctx& C, const PV& P, int layer) {
    unsigned char* R = P.ws + WS_R;
    const f16* raw = (const f16*)(R + R_RAW); const f16* wa = (const f16*)(R + R_WA); const f16* gbuf = (const f16*)(R + R_G); const f16* yfb = (const f16*)(R + R_YFB);
    bf16_t* yr = (bf16_t*)(R + R_YB);
    const float* mu = P.inp(13) + (size_t)layer * 1920; const float* k_a = P.inp(20) + (size_t)layer * 512; const float* r_k = P.inp(21) + (size_t)layer * 512;
    const float* lg = P.inp(22) + (size_t)layer * 512; const float* lb = P.inp(23) + (size_t)layer * 512;
    const int lane = C.tid & 63, wave = C.tid >> 6, c = lane * 8;
    for (int lt = C.bid * NWV + wave; lt < TP; lt += C.nblk * NWV) {
        const int pos = pos_of(lt), S = lt < 8192 ? 8192 : 4096;
        const size_t rm = (size_t)(pos > 0 ? lt - 1 : lt) * 1920, r0 = (size_t)lt * 1920, rp = (size_t)(pos < S - 1 ? lt + 1 : lt) * 1920;
        const float wm = pos > 0 ? 0.5f : 0.f, wp = pos < S - 1 ? 0.5f : 0.f;
        const f16x8_t rA = *(const f16x8_t*)(raw + rm + c), rB = *(const f16x8_t*)(raw + r0 + c), rC = *(const f16x8_t*)(raw + rp + c);
        const f16x8_t kA = *(const f16x8_t*)(raw + rm + 512 + c), kB = *(const f16x8_t*)(raw + r0 + 512 + c), kC = *(const f16x8_t*)(raw + rp + 512 + c);
        const f16x8_t vA = *(const f16x8_t*)(raw + rm + 1024 + c), vB = *(const f16x8_t*)(raw + r0 + 1024 + c), vC = *(const f16x8_t*)(raw + rp + 1024 + c);
        const f16x8_t af = *(const f16x8_t*)(wa + 2 * SZ512 + (size_t)lt * 512 + c), ab = *(const f16x8_t*)(wa + 3 * SZ512 + (size_t)lt * 512 + c);
        const f16x8_t gg = *(const f16x8_t*)(gbuf + (size_t)lt * 512 + c);
        const f16x8_t yF = *(const f16x8_t*)(yfb + (size_t)lt * 512 + c), yB = *(const f16x8_t*)(yfb + SZ512 + (size_t)lt * 512 + c);
        float y[8], vv[8], bsum = 0.f, ysum = 0.f;
#pragma unroll
        for (int j = 0; j < 8; ++j) {
            const float r_ = (float)rB[j], k_ = (float)kB[j], v_ = (float)vB[j];
            const float r = r_ + (wm * (float)rA[j] + wp * (float)rC[j] - r_) * mu[c + j];
            const float k = k_ + (wm * (float)kA[j] + wp * (float)kC[j] - k_) * mu[512 + c + j];
            vv[j] = v_ + (wm * (float)vA[j] + wp * (float)vC[j] - v_) * mu[1024 + c + j];
            const float ka = k_a[c + j];
            const float ksum = k * (1.f + ((float)af[j] - 1.f) * ka) + k * (1.f + ((float)ab[j] - 1.f) * ka);
            bsum += r * (0.5f * ksum) * r_k[c + j];
            y[j] = (float)yF[j] + (float)yB[j]; ysum += y[j];
        }
        const float ym = red8(ysum) * (1.0f / 64.0f);
        float q = 0.f;
#pragma unroll
        for (int j = 0; j < 8; ++j) { const float dy = y[j] - ym; q += dy * dy; }
        const float rs = rsqrtf(red8(q) * (1.0f / 64.0f) + 64e-5f);
        const float bonus = red8(bsum);
        float o[8];
#pragma unroll
        for (int j = 0; j < 8; ++j) o[j] = ((y[j] - ym) * rs * lg[c + j] + lb[c + j] + bonus * vv[j]) * (float)gg[j];
        u32x4 w; w.x = pack2bf(o[0], o[1]); w.y = pack2bf(o[2], o[3]); w.z = pack2bf(o[4], o[5]); w.w = pack2bf(o[6], o[7]);
        *(u32x4*)(yr + (size_t)lt * 512 + c) = w;
    }
}

__device__ __forceinline__ void merge_phase(const Ctx& C, const PV& P, int layer, unsigned char* smem) {
    unsigned char* R = P.ws + WS_R;
    const bf16_t* hmod = (const bf16_t*)(P.ws + WS_HMOD); const bf16_t* yb = (const bf16_t*)(R + R_YB); bf16_t* merged = (bf16_t*)(R + R_MERGED);
    const bf16_t* W = wl(P, layer);
    const int lane = C.tid & 63, wave = (C.tid >> 6) & 3, wm = wave >> 1, wn = wave & 1, fr = lane & 15, fq = lane >> 4;
    for (int t2 = C.bid; t2 < MT * 8; t2 += C.nblk) {
        const int t = t2 * 2 + (C.tid >> 8);
        const int tm = t >> 4, tn = t & 15;
        f32x4 m[4][2];
#pragma unroll
        for (int i = 0; i < 4; ++i) { m[i][0] = (f32x4){0.f, 0.f, 0.f, 0.f}; m[i][1] = (f32x4){0.f, 0.f, 0.f, 0.f}; }
        for (int n = 0; n < 4; ++n) {
            f32x4 ag[4][2], ap[4][2];
            gemm_core<2, true>(C, ag, hmod + (size_t)tm * 128 * 1024, 1024, W + OW_WIN + (size_t)(4480 + n * 1024 + tn * 64) * 1024, 1024, 1024, smem);
#pragma unroll
            for (int i = 0; i < 4; ++i)
#pragma unroll
                for (int j = 0; j < 2; ++j)
#pragma unroll
                    for (int r = 0; r < 4; ++r) ag[i][j][r] = sigmoidf_(ag[i][j][r]);
            gemm_core<2, true>(C, ap, yb + (size_t)n * SZ512 + (size_t)tm * 128 * 512, 512, W + OW_WBR + (size_t)n * 1024 * 512 + (size_t)(tn * 64) * 512, 512, 512, smem);
#pragma unroll
            for (int i = 0; i < 4; ++i)
#pragma unroll
                for (int j = 0; j < 2; ++j) m[i][j] += ag[i][j] * ap[i][j];
        }
#pragma unroll
        for (int i = 0; i < 4; ++i) {
            const int lt = tm * 128 + wm * 64 + i * 16 + fr;
#pragma unroll
            for (int j = 0; j < 2; ++j) {
                const int n = tn * 64 + wn * 32 + j * 16 + fq * 4;
                uint2 w; w.x = pack2bf(m[i][j][0], m[i][j][1]); w.y = pack2bf(m[i][j][2], m[i][j][3]);
                *(uint2*)(merged + (size_t)lt * 1024 + n) = w;
            }
        }
    }
}

constexpr int PH_PER_LAYER = 14, PH_PER_PASS = 2 * PH_PER_LAYER + 1, NPHASE = 1 + NPASS * PH_PER_PASS;

__global__ void __launch_bounds__(512, 2) mk_forward(Params P0, int ph_lo, int ph_hi) {
    unsigned char* smem = dyn_smem;
    const int wave_s = __builtin_amdgcn_readfirstlane((int)threadIdx.x >> 6);
    for (int it_ = 2 * ph_lo; it_ < 2 * ph_hi; ++it_) {
        const int ph = it_ >> 1;
        if (it_ & 1) {
            if (PROBE_MASK == 0 || ph == 0) continue;
            const int r_ = (ph - 1) % PH_PER_PASS;
            if (r_ == PH_PER_PASS - 1 || !((PROBE_MASK >> (r_ % PH_PER_LAYER)) & 1)) continue;
        }
        if (it_ > 2 * ph_lo) cg::this_grid().sync();
        int z = 0; asm volatile("" : "+s"(z));
        Ctx C; C.tid = tid_now(wave_s, z); C.bid = (int)blockIdx.x + z; C.nblk = (int)gridDim.x + z; C.wave_s = wave_s;
        ptrtab_t tab = (ptrtab_t)__builtin_amdgcn_kernarg_segment_ptr();
        asm volatile("" : "+s"(tab));
        const PV P{tab, (float*)tab[29], (unsigned char*)tab[30]};
        if (ph == 0) { prep_phase(C, P, smem); continue; }
        const int q = ph - 1, pass = q / PH_PER_PASS, r = q % PH_PER_PASS;
        if (r == PH_PER_PASS - 1) { norm_phase(C, P, pass, P.inp(6) + (size_t)(1 * 3 + 2) * 1024, P.inp(7) + (size_t)(1 * 3 + 2) * 1024, 0, -1, false); continue; }
        const int layer = r / PH_PER_LAYER, lp = r % PH_PER_LAYER;
        const bf16_t* W = wl(P, layer);
        const float* lng = P.inp(6) + (size_t)layer * 3 * 1024; const float* lnb = P.inp(7) + (size_t)layer * 3 * 1024;
        unsigned char* R = P.ws + WS_R;
        switch (lp) {
            case 0:
                if (layer == 0) norm_phase(C, P, pass, nullptr, nullptr, 0, 0, true);
                else norm_phase(C, P, pass, P.inp(6) + (size_t)((layer - 1) * 3 + 2) * 1024, P.inp(7) + (size_t)((layer - 1) * 3 + 2) * 1024, layer, 0, false);
                break;
            case 1: ffn_up_phase(C, P, W + OW_FA_IN); break;
            case 2: resid_gemm_phase(C, P, pass, (const bf16_t*)(R + R_ACT), 2816, W + OW_FA_OUT, layer, 0, 0.5f); break;
            case 3: norm_phase(C, P, pass, lng, lnb, layer, 1, false); break;
            case 4: win_phase(C, P, layer); break;
            case 5: lin_pool_phase(C, P, layer); break;
            case 6: lora_phase(C, P, layer, smem); break;
            case 7:
                if (C.bid < 32) scan_block<4>(C, P, layer, 0, C.bid >> 2, (C.bid >> 1) & 1, (C.bid & 1) * 32, smem);
                else if (C.bid < 160) { const int i2 = C.bid - 32; scan_block<8>(C, P, layer, 1 + (i2 >> 4), (i2 >> 1) & 7, i2 & 1, 0, smem); }
                attn_items(C, P, layer, pass * 2 + layer, smem); fft_items(C, P, smem); break;
            case 8: finish_phase(C, P, layer); break;
            case 9: merge_phase(C, P, layer, smem); break;
            case 10: resid_gemm_phase(C, P, pass, (const bf16_t*)(R + R_MERGED), 1024, W + OW_WOUT, layer, 1, 1.0f); break;
            case 11: norm_phase(C, P, pass, lng + 1024, lnb + 1024, layer, 2, false); break;
            case 12: ffn_up_phase(C, P, W + OW_FB_IN); break;
            default: resid_gemm_phase(C, P, pass, (const bf16_t*)(R + R_ACT), 2816, W + OW_FB_OUT, layer, 2, 0.5f); break;
        }
    }
}

extern "C" void kernel_launch(void* const* d_in, const int* in_sizes, int n_in, void* d_out, int out_size, void* d_ws, size_t ws_size, hipStream_t stream) {
    static int grid_blocks = 0;
    if (!grid_blocks) {
        int dev = 0, cus = 0, per_cu = 0;
        (void)hipGetDevice(&dev);
        (void)hipDeviceGetAttribute(&cus, hipDeviceAttributeMultiprocessorCount, dev);
        (void)hipFuncSetAttribute((const void*)mk_forward, hipFuncAttributeMaxDynamicSharedMemorySize, LDS_BYTES);
        (void)hipOccupancyMaxActiveBlocksPerMultiprocessor(&per_cu, mk_forward, NT, LDS_BYTES);
        if (per_cu < 1) per_cu = 1;
        if (per_cu > 1) per_cu = 1;
        grid_blocks = cus * per_cu;
    }
    Params p{};
    for (int i = 0; i < 29; ++i) p.in[i] = (const float*)d_in[i];
    p.out = (float*)d_out; p.ws = (unsigned char*)d_ws;
#if ONE_LAUNCH
    int lo = 0, hi = NPHASE;
    void* args[] = {&p, &lo, &hi};
    hipError_t e = hipLaunchCooperativeKernel((void*)mk_forward, dim3(grid_blocks), dim3(NT), args, LDS_BYTES, stream);
    if (e != hipSuccess) fprintf(stderr, "cooperative launch failed: %s (grid %d)\n", hipGetErrorString(e), grid_blocks);
#else
    for (int ph = 0; ph < NPHASE; ++ph) {
        int lo = ph, hi = ph + 1;
        void* args[] = {&p, &lo, &hi};
        (void)hipLaunchCooperativeKernel((void*)mk_forward, dim3(grid_blocks), dim3(NT), args, LDS_BYTES, stream);
    }
#endif
}
```

```cpp
#include <hip/hip_runtime.h>
#include <hip/hip_cooperative_groups.h>
#include <cstdio>
#include <cstdint>
namespace cg = cooperative_groups;

typedef unsigned short bf16_t;
typedef _Float16 f16;
typedef short bf16x8 __attribute__((ext_vector_type(8)));
typedef float f32x4 __attribute__((ext_vector_type(4)));
typedef unsigned u32x4 __attribute__((ext_vector_type(4)));
typedef unsigned u32x2 __attribute__((ext_vector_type(2)));

#ifndef ONE_LAUNCH
#define ONE_LAUNCH 1
#endif
#ifndef PROBE_MASK
#define PROBE_MASK 0
#endif

constexpr int TP = 40960;
constexpr int NPASS = 2;
constexpr int NSEQ = 9;
constexpr int MT = TP / 128;
constexpr int N_IN_FULL = 8576;
constexpr float ALPHA = 1.41421356237f;

constexpr size_t OW_FA_IN = 0, OW_FA_OUT = 5767168, OW_FB_IN = 8650752, OW_FB_OUT = 14417920, OW_WIN = 17301504,
                 OW_WBR = 26083328, OW_WOUT = 28180480, OW_W2T = 29229056, OW_A2T = 29294592, OW_G2T = 29360128, WL_TOTAL = 29425664;
constexpr size_t WS_W = 0, WS_TW = 117702656, WS_MOD = 117735424, WS_HMOD = 119062528, WS_R = 202948608, WS_INVN = 1062780928, WS_CTR = 1064091648;
constexpr size_t R_RAW = 0, R_LIN = 157286400, R_WA = 188743680, R_G = 356515840, R_Q = 398458880, R_K = 440401920, R_VT = 482344960,
                 R_YFB = 524288000, R_ZC = 608174080, R_POOLP = 650117120, R_YB = 692060160, R_ACT = 0,
                 R_GATES = 0  , R_M32 = 398458880  , R_MERGED = 566231040  ;
constexpr size_t SZ512 = (size_t)TP * 512;

struct Params { const float* in[29]; float* out; unsigned char* ws; };
struct Ctx { int tid, bid, nblk, wave_s; };
__device__ __forceinline__ int tid_now(int wave_s, int z) { return wave_s * 64 + (int)__builtin_amdgcn_mbcnt_hi(~0u, __builtin_amdgcn_mbcnt_lo(~0u, (unsigned)z)); }
typedef const float* const __attribute__((address_space(4)))* ptrtab_t;
struct PV { ptrtab_t tab; float* out; unsigned char* ws;
    __device__ __forceinline__ const float* inp(int i) const { return tab[i]; } };
constexpr int NT = 512, NWV = 8;
extern __shared__ __attribute__((aligned(16))) unsigned char dyn_smem[];
constexpr int LDS_BYTES = 131072;

__device__ __forceinline__ bf16_t f2bf(float f) { unsigned u = __float_as_uint(f); u += 0x7fffu + ((u >> 16) & 1u); return (bf16_t)(u >> 16); }
__device__ __forceinline__ float bf2f(bf16_t b) { return __uint_as_float(((unsigned)b) << 16); }
__device__ __forceinline__ unsigned pack2bf(float a, float b) { return (unsigned)f2bf(a) | ((unsigned)f2bf(b) << 16); }
__device__ __forceinline__ float wsum(float v) {
#pragma unroll
    for (int o = 32; o > 0; o >>= 1) v += __shfl_xor(v, o);
    return v;
}
__device__ __forceinline__ float sigmoidf_(float x) { return 1.0f / (1.0f + __expf(-x)); }
template <int CTRL> __device__ __forceinline__ float dppf(float v) { return __int_as_float(__builtin_amdgcn_update_dpp(0, __float_as_int(v), CTRL, 0xF, 0xF, true)); }
__device__ __forceinline__ float red8(float v) { v += dppf<0xB1>(v); v += dppf<0x4E>(v); v += dppf<0x141>(v); return v; }

__device__ __forceinline__ int grow_of(int pass, int lt) { return lt < 8192 ? pass * 8192 + lt : 16384 + pass * 32768 + (lt - 8192); }
__device__ __forceinline__ int brow_of(int pass, int lt) { return lt < 8192 ? pass : 2 + pass * 8 + ((lt - 8192) >> 12); }
__device__ __forceinline__ int pos_of(int lt) { return lt < 8192 ? lt : ((lt - 8192) & 4095); }
__device__ __forceinline__ int seqbase_of(int sq) { return sq == 0 ? 0 : 8192 + (sq - 1) * 4096; }
__device__ __forceinline__ int seqlen_of(int sq) { return sq == 0 ? 8192 : 4096; }

__device__ __forceinline__ bf16_t* wl(const PV& P, int layer) { return (bf16_t*)(P.ws + WS_W) + (size_t)layer * WL_TOTAL; }

template <int NJ, bool SWAP>
__device__ __forceinline__ void gemm_core(const Ctx& C, f32x4 (&acc)[4][NJ], const bf16_t* __restrict__ A, int lda, const bf16_t* __restrict__ B, int ldb, int K, unsigned char* smem) {
    const int tid = C.tid & 255, lane = tid & 63, wave = tid >> 6, wm = wave >> 1, wn = wave & 1, fr = lane & 15, fq = lane >> 4;
    smem += (C.tid >> 8) * 36864;
    u32x4 ra[4], rb[NJ];
#pragma unroll
    for (int i = 0; i < 4; ++i)
#pragma unroll
        for (int j = 0; j < NJ; ++j) acc[i][j] = (f32x4){0.f, 0.f, 0.f, 0.f};
    const int lrow = tid >> 3, lkc = (tid & 7) * 8;
#pragma unroll
    for (int i = 0; i < 4; ++i) ra[i] = *(const u32x4*)(A + (size_t)(lrow + 32 * i) * lda + lkc);
#pragma unroll
    for (int i = 0; i < NJ; ++i) rb[i] = *(const u32x4*)(B + (size_t)(lrow + 32 * i) * ldb + lkc);
    for (int k0 = 0; k0 < K; k0 += 64) {
        __syncthreads();
#pragma unroll
        for (int i = 0; i < 4; ++i) *(u32x4*)(smem + (lrow + 32 * i) * 144 + lkc * 2) = ra[i];
#pragma unroll
        for (int i = 0; i < NJ; ++i) *(u32x4*)(smem + 18432 + (lrow + 32 * i) * 144 + lkc * 2) = rb[i];
        __syncthreads();
        if (k0 + 64 < K) {
#pragma unroll
            for (int i = 0; i < 4; ++i) ra[i] = *(const u32x4*)(A + (size_t)(lrow + 32 * i) * lda + k0 + 64 + lkc);
#pragma unroll
            for (int i = 0; i < NJ; ++i) rb[i] = *(const u32x4*)(B + (size_t)(lrow + 32 * i) * ldb + k0 + 64 + lkc);
        }
#pragma unroll
        for (int ks = 0; ks < 2; ++ks) {
            bf16x8 af[4], bfr[NJ];
#pragma unroll
            for (int i = 0; i < 4; ++i) af[i] = *(const bf16x8*)(smem + (wm * 64 + i * 16 + fr) * 144 + (ks * 32 + fq * 8) * 2);
#pragma unroll
            for (int j = 0; j < NJ; ++j) bfr[j] = *(const bf16x8*)(smem + 18432 + (wn * NJ * 16 + j * 16 + fr) * 144 + (ks * 32 + fq * 8) * 2);
#pragma unroll
            for (int i = 0; i < 4; ++i)
#pragma unroll
                for (int j = 0; j < NJ; ++j)
                    acc[i][j] = SWAP ? __builtin_amdgcn_mfma_f32_16x16x32_bf16(bfr[j], af[i], acc[i][j], 0, 0, 0)
                                     : __builtin_amdgcn_mfma_f32_16x16x32_bf16(af[i], bfr[j], acc[i][j], 0, 0, 0);
        }
    }
}


namespace g256 {
constexpr int BK = 64, HALF = 128, HT = HALF * BK;
__device__ __forceinline__ int lds_byte(int r, int c) { int st = (r >> 4) * 2 + (c >> 5), rr = r & 15, cc = c & 31, ob = rr * 64 + cc * 2; return st * 1024 + (ob ^ (((ob >> 9) & 1) << 5)); }
__device__ __forceinline__ void stage_rc(unsigned b, unsigned& R, unsigned& Cc) { const unsigned st = b >> 10, sb = b & 1023u, swz = sb ^ (((sb >> 9) & 1u) << 5); R = (st >> 1) * 16u + (swz >> 6); Cc = (st & 1u) * 32u + ((swz & 63u) >> 1); }
}
__device__ __forceinline__ void gemm256(const Ctx& C, f32x4 (&acc)[2][2][4][2], const bf16_t* __restrict__ A, const bf16_t* __restrict__ Bt, const int K, const int brow, const int bcol) {
    using namespace g256;
    bf16_t* shm = (bf16_t*)dyn_smem;
    const int tidx = C.tid;
    #define SA(b,h) (shm+((b)*2+(h))*HT)
    #define SB(b,h) (shm+(4+(b)*2+(h))*HT)
    #define STAGE(Pp,BASE,br,kt) do{const char* _ub=(const char*)((BASE)+(long)(br)*K+(long)(kt)*BK); asm volatile("" : "+s"(_ub)); \
        __builtin_amdgcn_global_load_lds((const unsigned*)(_ub+goff0), \
          (__attribute__((address_space(3))) unsigned*)((__attribute__((address_space(3))) char*)(Pp)+tidx*16),16,0,0); \
        __builtin_amdgcn_global_load_lds((const unsigned*)(_ub+goff1), \
          (__attribute__((address_space(3))) unsigned*)((__attribute__((address_space(3))) char*)(Pp)+tidx*16+8192),16,0,0);}while(0)
    #define LDA(dst,b,h) for(int m=0;m<4;++m)for(int k=0;k<2;++k) \
      dst[m][k]=*reinterpret_cast<const bf16x8*>(a_ptr+((b)*2+(h))*16384+m*2048+k*1024)
    #define LDB(dst,b,h) for(int n=0;n<2;++n)for(int k=0;k<2;++k) \
      dst[n][k]=*reinterpret_cast<const bf16x8*>(b_ptr+((b)*2+(h))*16384+n*2048+k*1024)
    #define MMA(ai,bj,Atx,Btx) do{__builtin_amdgcn_s_setprio(1); \
      for(int m=0;m<4;++m)for(int n=0;n<2;++n)for(int k=0;k<2;++k) \
        acc[ai][bj][m][n]=__builtin_amdgcn_mfma_f32_16x16x32_bf16(Btx[n][k],Atx[m][k],acc[ai][bj][m][n],0,0,0); \
      __builtin_amdgcn_s_setprio(0);}while(0)
    #define WAIT_V(n) asm volatile("s_waitcnt vmcnt(" #n ")":::"memory")
    #define WAIT_L(n) asm volatile("s_waitcnt lgkmcnt(" #n ")":::"memory")
    #define BAR __builtin_amdgcn_s_barrier()
    #define SCHED __builtin_amdgcn_sched_barrier(0)
    const int wid = tidx >> 6, lane = tidx & 63, wr = wid >> 2, wc = wid & 3, fr = lane & 15, fq = lane >> 4;
    const int swz = (fr * 64 + fq * 16) ^ ((fr >> 3) << 5);
    const char* a_ptr = (const char*)dyn_smem + wr * 8192 + swz;
    const char* b_ptr = (const char*)dyn_smem + 65536 + wc * 4096 + swz;
#pragma unroll
    for (int a = 0; a < 2; ++a)
#pragma unroll
        for (int b = 0; b < 2; ++b)
#pragma unroll
            for (int m = 0; m < 4; ++m) { acc[a][b][m][0] = (f32x4){0.f, 0.f, 0.f, 0.f}; acc[a][b][m][1] = (f32x4){0.f, 0.f, 0.f, 0.f}; }
    bf16x8 At[4][2], B0[2][2], B1[2][2];
    const int nt = K / BK;
    unsigned goff0, goff1;
    { unsigned r0, c0, r1, c1; stage_rc((unsigned)tidx * 16u, r0, c0); stage_rc((unsigned)tidx * 16u + 8192u, r1, c1); goff0 = (r0 * (unsigned)K + c0) * 2u; goff1 = (r1 * (unsigned)K + c1) * 2u; }
    WAIT_V(0); __syncthreads();
    STAGE(SB(0,0),Bt,bcol,0); STAGE(SA(0,0),A,brow,0);
    STAGE(SB(0,1),Bt,bcol+HALF,0); STAGE(SA(0,1),A,brow+HALF,0);
    if(wr==1)BAR;
    WAIT_V(4); BAR;
    STAGE(SB(1,0),Bt,bcol,1); STAGE(SA(1,0),A,brow,1); STAGE(SB(1,1),Bt,bcol+HALF,1);
    WAIT_V(6); BAR;
    for(int t=0;t<nt-2;t+=2){
      LDB(B0,0,0); SCHED; LDA(At,0,0); STAGE(SA(1,1),A,brow+HALF,t+1);
      WAIT_L(8); BAR; WAIT_L(0); MMA(0,0,At,B0); BAR; SCHED;
      LDB(B1,0,1); STAGE(SB(0,0),Bt,bcol,t+2);
      BAR; WAIT_L(0); MMA(0,1,At,B1); BAR;
      LDA(At,0,1); STAGE(SA(0,0),A,brow,t+2);
      BAR; WAIT_L(0); MMA(1,0,At,B0); BAR; SCHED;
      STAGE(SB(0,1),Bt,bcol+HALF,t+2);
      WAIT_V(6); BAR; MMA(1,1,At,B1); BAR;
      LDB(B0,1,0); SCHED; LDA(At,1,0); STAGE(SA(0,1),A,brow+HALF,t+2);
      WAIT_L(8); BAR; WAIT_L(0); MMA(0,0,At,B0); BAR; SCHED;
      LDB(B1,1,1); STAGE(SB(1,0),Bt,bcol,t+3);
      BAR; WAIT_L(0); MMA(0,1,At,B1); BAR;
      LDA(At,1,1); STAGE(SA(1,0),A,brow,t+3);
      BAR; WAIT_L(0); MMA(1,0,At,B0); BAR; SCHED;
      STAGE(SB(1,1),Bt,bcol+HALF,t+3);
      WAIT_V(6); BAR; MMA(1,1,At,B1); BAR;
    }
    { LDB(B0,0,0); LDA(At,0,0); STAGE(SA(1,1),A,brow+HALF,nt-1);
      BAR; WAIT_L(0); MMA(0,0,At,B0); BAR;
      LDB(B1,0,1); BAR; WAIT_L(0); MMA(0,1,At,B1); BAR;
      LDA(At,0,1); WAIT_V(4); BAR; WAIT_L(0); MMA(1,0,At,B0); MMA(1,1,At,B1); BAR; }
    { LDB(B0,1,0); LDA(At,1,0); WAIT_V(2); BAR; WAIT_L(0); MMA(0,0,At,B0); BAR;
      LDB(B1,1,1); WAIT_V(0); BAR; WAIT_L(0); MMA(0,1,At,B1); BAR;
      LDA(At,1,1); BAR; WAIT_L(0); MMA(1,0,At,B0); MMA(1,1,At,B1); BAR; }
    if(wr==0)BAR;
    #undef SA
    #undef SB
    #undef STAGE
    #undef LDA
    #undef LDB
    #undef MMA
    #undef WAIT_V
    #undef WAIT_L
    #undef BAR
    #undef SCHED
}
__device__ __forceinline__ bool tile_order(int i, int G, int c, int nM, int nN, int& pm, int& pn) {
    const int nwg = nM * nN; const long L = (long)i * G + c; if (L >= nwg) return false;
    int wgid = (int)L; { const int q = nwg / 8, r = nwg % 8, xcd = wgid % 8, off = wgid / 8; wgid = (xcd < r ? xcd * (q + 1) : r * (q + 1) + (xcd - r) * q) + off; }
    const int nig = 8 * nN, gid = wgid / nig, fm = gid * 8, gsz = (nM - fm) < 8 ? (nM - fm) : 8;
    pm = fm + ((wgid % nig) % gsz); pn = (wgid % nig) / gsz; return true;
}

struct ConvJob { const float* src; int ld, K, nbegin, ncount, map; bf16_t* dst; };
__device__ __forceinline__ ConvJob conv_job(const PV& P, int j) {
    const int l = j >> 4, q = j & 15; bf16_t* W = wl(P, l); ConvJob c; c.map = 0; c.nbegin = 0;
    switch (q) {
        case 0: c.src = P.inp(8) + (size_t)l * 1024 * 5632; c.ld = 5632; c.K = 1024; c.ncount = 5632; c.dst = W + OW_FA_IN; c.map = 1; break;
        case 1: c.src = P.inp(9) + (size_t)l * 2816 * 1024; c.ld = 1024; c.K = 2816; c.ncount = 1024; c.dst = W + OW_FA_OUT; break;
        case 2: c.src = P.inp(10) + (size_t)l * 1024 * 5632; c.ld = 5632; c.K = 1024; c.ncount = 5632; c.dst = W + OW_FB_IN; c.map = 1; break;
        case 3: c.src = P.inp(11) + (size_t)l * 2816 * 1024; c.ld = 1024; c.K = 2816; c.ncount = 1024; c.dst = W + OW_FB_OUT; break;
        case 4: c.src = P.inp(12) + (size_t)l * 1024 * 8576; c.ld = 8576; c.K = 1024; c.ncount = 3456; c.dst = W + OW_WIN; break;
        case 5: c.src = P.inp(12) + (size_t)l * 1024 * 8576; c.ld = 8576; c.K = 1024; c.nbegin = 3968; c.ncount = 4608; c.dst = W + OW_WIN + (size_t)3968 * 1024; break;
        case 6: case 7: case 8: case 9: { const int n = q - 6; c.src = P.inp(27) + (size_t)(l * 4 + n) * 512 * 1024; c.ld = 1024; c.K = 512; c.ncount = 1024; c.dst = W + OW_WBR + (size_t)n * 1024 * 512; } break;
        case 10: c.src = P.inp(28) + (size_t)l * 1024 * 1024; c.ld = 1024; c.K = 1024; c.ncount = 1024; c.dst = W + OW_WOUT; break;
        case 11: case 12: { const int d = q - 11; c.src = P.inp(15) + (size_t)(l * 2 + d) * 64 * 512; c.ld = 512; c.K = 64; c.ncount = 512; c.dst = W + OW_W2T + (size_t)d * 512 * 64; } break;
        case 13: case 14: { const int d = q - 13; c.src = P.inp(17) + (size_t)(l * 2 + d) * 64 * 512; c.ld = 512; c.K = 64; c.ncount = 512; c.dst = W + OW_A2T + (size_t)d * 512 * 64; } break;
        default: c.src = P.inp(18) + (size_t)l * 128 * 512; c.ld = 512; c.K = 128; c.ncount = 512; c.dst = W + OW_G2T; break;
    }
    return c;
}

__device__ __forceinline__ void prep_phase(const Ctx& C, const PV& P, unsigned char* smem) {
    const int tid = C.tid;
    {
        int total = 0;
        for (int j = 0; j < 32; ++j) { ConvJob c = conv_job(P, j); total += (c.K >> 6) * (c.ncount >> 6); }
        float* tile = (float*)smem;
        const int tx = tid & 63, ty = tid >> 6;
        for (int t = C.bid; t < total; t += C.nblk) {
            int tt = t, j = 0; ConvJob c = conv_job(P, 0);
            for (;;) { const int n = (c.K >> 6) * (c.ncount >> 6); if (tt < n) break; tt -= n; ++j; c = conv_job(P, j); }
            const int nkt = c.K >> 6, kt = tt % nkt, nt = tt / nkt, k0 = kt * 64, n0 = nt * 64;
            int col = c.nbegin + n0 + tx;
            if (c.map) { const int np = n0 + tx, blk = np >> 5, w = np & 31, f = blk * 16 + (w & 15); col = (w < 16) ? f : 2816 + f; }
            __syncthreads();
#pragma unroll 4
            for (int i = 0; i < 8; ++i) { const int kk = ty + 8 * i; tile[kk * 65 + tx] = c.src[(size_t)(k0 + kk) * c.ld + col]; }
            __syncthreads();
#pragma unroll 4
            for (int i = 0; i < 8; ++i) { const int nn = ty + 8 * i; c.dst[(size_t)(n0 + nn) * c.K + k0 + tx] = f2bf(tile[tx * 65 + nn]); }
        }
        __syncthreads();
    }
    {
        float* wt = (float*)smem;
        float* cosT = (float*)(smem + 64 * 129 * 4);
        for (int it = C.bid; it < 2 * 4 * 16; it += C.nblk) {
            const int l = it >> 6, g = (it >> 4) & 3, kc = it & 15, k0 = kc * 64;
            const float* src = P.inp(12) + (size_t)l * 1024 * 8576 + 3456 + g * 128;
            __syncthreads();
            for (int e = tid; e < 64 * 128; e += NT) { const int kk = e >> 7, c = e & 127; wt[kk * 129 + c] = src[(size_t)(k0 + kk) * 8576 + c]; }
            if (tid < 128) cosT[tid] = cospif((float)tid * (1.0f / 64.0f));
            __syncthreads();
            bf16_t* dst = wl(P, l) + OW_WIN + (size_t)(3456 + g * 128) * 1024;
            const int kk = tid & 63;
            for (int i = 0; i < 16; ++i) {
                const int j2 = (tid >> 6) + 8 * i, cc = j2 >> 1, part = j2 & 1;
                float s = 0.f;
                if (cc == 0) {
                    if (part == 0) { for (int c = 0; c < 128; ++c) s += wt[kk * 129 + c]; }
                    else { for (int c = 0; c < 128; ++c) s += (c & 1) ? -wt[kk * 129 + c] : wt[kk * 129 + c]; }
                } else if (part == 0) {
                    for (int c = 0; c < 128; ++c) s += wt[kk * 129 + c] * cosT[(cc * c) & 127];
                } else {
                    for (int c = 0; c < 128; ++c) s -= wt[kk * 129 + c] * cosT[(cc * c - 32) & 127];
                }
                dst[(size_t)j2 * 1024 + k0 + kk] = f2bf(s);
            }
        }
        __syncthreads();
    }
    if (C.bid == 0 && tid < 16) ((unsigned*)(P.ws + WS_CTR))[tid] = 0u;
    {
        float2* tw = (float2*)(P.ws + WS_TW);
        for (int m = C.bid * NT + tid; m < 4096; m += C.nblk * NT) { const float x = (float)m * (1.0f / 4096.0f); tw[m] = make_float2(cospif(x), -sinpif(x)); }
    }
    {
        float* sc = (float*)smem;
        float* red = (float*)(smem + 18 * 512 * 4);
        float* mod = (float*)(P.ws + WS_MOD);
        for (int it = C.bid; it < 2 * 144; it += C.nblk) {
            const int l = it / 144, n0 = (it % 144) * 64, nl = tid & 63, ks = tid >> 6;
            const float* aw = P.inp(4) + (size_t)l * 1024 * 9216;
            float acc[18];
#pragma unroll
            for (int b = 0; b < 18; ++b) acc[b] = 0.f;
            for (int half = 0; half < 2; ++half) {
                __syncthreads();
                for (int e = tid; e < 18 * 512; e += NT) {
                    const int b = e >> 9, kk = e & 511, k = half * 512 + kk;
                    const float cv = b < 2 ? P.inp(2)[b * 1024 + k] : P.inp(3)[(b - 2) * 1024 + k];
                    sc[e] = cv / (1.0f + __expf(-cv));
                }
                __syncthreads();
                for (int kk = ks * 64; kk < ks * 64 + 64; ++kk) {
                    const float w = aw[(size_t)(half * 512 + kk) * 9216 + n0 + nl];
#pragma unroll
                    for (int b = 0; b < 18; ++b) acc[b] += sc[b * 512 + kk] * w;
                }
            }
            __syncthreads();
#pragma unroll
            for (int b = 0; b < 18; ++b) red[(ks * 18 + b) * 64 + nl] = acc[b];
            __syncthreads();
            for (int e = tid; e < 18 * 64; e += NT) {
                const int b = e >> 6, n = e & 63;
                float s = 0.f;
#pragma unroll
                for (int k8 = 0; k8 < 8; ++k8) s += red[(k8 * 18 + b) * 64 + n];
                mod[((size_t)l * 18 + b) * 9216 + n0 + n] = s + P.inp(5)[(size_t)l * 9216 + n0 + n];
            }
        }
        __syncthreads();
    }
}

__device__ __forceinline__ void norm_phase(const Ctx& C, const PV& P, int pass, const float* lng, const float* lnb, int mod_layer, int j, bool from_input) {
    const int lane = C.tid & 63, wave = C.tid >> 6;
    bf16_t* hmod = (bf16_t*)(P.ws + WS_HMOD);
    const float* mod = (const float*)(P.ws + WS_MOD);
    const int nw = C.nblk * NWV;
    for (int lt0 = C.bid * NWV + wave; lt0 < TP; lt0 += 2 * nw) {
        f32x4 v[2][4]; int gr[2], bb[2]; bool ok[2];
#pragma unroll
        for (int u = 0; u < 2; ++u) {
            const int lt = lt0 + u * nw; ok[u] = lt < TP;
            const int ltc = ok[u] ? lt : lt0;
            gr[u] = grow_of(pass, ltc); bb[u] = brow_of(pass, ltc);
            const float* src = from_input ? (gr[u] < 16384 ? P.inp(0) + (size_t)gr[u] * 1024 : P.inp(1) + (size_t)(gr[u] - 16384) * 1024) : P.out + (size_t)gr[u] * 1024;
#pragma unroll
            for (int i = 0; i < 4; ++i) v[u][i] = *(const f32x4*)(src + i * 256 + lane * 4);
        }
        if (lng) {
            float s[2], q[2], mu[2], rs[2];
#pragma unroll
            for (int u = 0; u < 2; ++u) { s[u] = 0.f;
#pragma unroll
                for (int i = 0; i < 4; ++i) s[u] += (v[u][i][0] + v[u][i][1]) + (v[u][i][2] + v[u][i][3]); }
#pragma unroll
            for (int o = 32; o > 0; o >>= 1) { s[0] += __shfl_xor(s[0], o); s[1] += __shfl_xor(s[1], o); }
#pragma unroll
            for (int u = 0; u < 2; ++u) { mu[u] = s[u] * (1.0f / 1024.0f); q[u] = 0.f;
#pragma unroll
                for (int i = 0; i < 4; ++i) { const f32x4 dd = v[u][i] - mu[u]; q[u] += (dd[0] * dd[0] + dd[1] * dd[1]) + (dd[2] * dd[2] + dd[3] * dd[3]); } }
#pragma unroll
            for (int o = 32; o > 0; o >>= 1) { q[0] += __shfl_xor(q[0], o); q[1] += __shfl_xor(q[1], o); }
#pragma unroll
            for (int u = 0; u < 2; ++u) rs[u] = rsqrtf(q[u] * (1.0f / 1024.0f) + 1e-5f);
#pragma unroll
            for (int i = 0; i < 4; ++i) {
                const f32x4 g = *(const f32x4*)(lng + i * 256 + lane * 4), be = *(const f32x4*)(lnb + i * 256 + lane * 4);
                v[0][i] = (v[0][i] - mu[0]) * rs[0] * g + be; v[1][i] = (v[1][i] - mu[1]) * rs[1] * g + be;
            }
        }
        if (lng || from_input) {
#pragma unroll
            for (int u = 0; u < 2; ++u) if (ok[u]) {
#pragma unroll
                for (int i = 0; i < 4; ++i) *(f32x4*)(P.out + (size_t)gr[u] * 1024 + i * 256 + lane * 4) = v[u][i];
            }
        }
        if (j >= 0) {
            float s[2], q[2], mu[2], rs[2];
#pragma unroll
            for (int u = 0; u < 2; ++u) { s[u] = 0.f;
#pragma unroll
                for (int i = 0; i < 4; ++i) s[u] += (v[u][i][0] + v[u][i][1]) + (v[u][i][2] + v[u][i][3]); }
#pragma unroll
            for (int o = 32; o > 0; o >>= 1) { s[0] += __shfl_xor(s[0], o); s[1] += __shfl_xor(s[1], o); }
#pragma unroll
            for (int u = 0; u < 2; ++u) { mu[u] = s[u] * (1.0f / 1024.0f); q[u] = 0.f;
#pragma unroll
                for (int i = 0; i < 4; ++i) { const f32x4 dd = v[u][i] - mu[u]; q[u] += (dd[0] * dd[0] + dd[1] * dd[1]) + (dd[2] * dd[2] + dd[3] * dd[3]); } }
#pragma unroll
            for (int o = 32; o > 0; o >>= 1) { q[0] += __shfl_xor(q[0], o); q[1] += __shfl_xor(q[1], o); }
#pragma unroll
            for (int u = 0; u < 2; ++u) {
                rs[u] = rsqrtf(q[u] * (1.0f / 1024.0f) + 1e-5f);
                if (!ok[u]) continue;
                const float* mb = mod + ((size_t)mod_layer * 18 + bb[u]) * 9216 + (size_t)(3 * j) * 1024;
                const int lt = lt0 + u * nw;
#pragma unroll
                for (int i = 0; i < 4; ++i) {
                    const f32x4 sh = *(const f32x4*)(mb + i * 256 + lane * 4), scl = *(const f32x4*)(mb + 1024 + i * 256 + lane * 4);
                    const f32x4 hh = (v[u][i] - mu[u]) * rs[u] * (1.0f + scl) + sh;
                    u32x2 o; o.x = pack2bf(hh[0], hh[1]); o.y = pack2bf(hh[2], hh[3]);
                    *(u32x2*)(hmod + (size_t)lt * 1024 + i * 256 + lane * 4) = o;
                }
            }
        }
    }
}

__device__ __forceinline__ void ffn_up_phase(const Ctx& C, const PV& P, const bf16_t* Wt) {
    const bf16_t* hmod = (const bf16_t*)(P.ws + WS_HMOD);
    bf16_t* act = (bf16_t*)(P.ws + WS_R + R_ACT);
    int pm, pn;
    for (int it = 0; tile_order(it, C.nblk, C.bid, TP / 256, 22, pm, pn); ++it) {
        f32x4 acc[2][2][4][2];
        gemm256(C, acc, hmod, Wt, 1024, pm * 256, pn * 256);
        int z2 = 0; asm volatile("" : "+s"(z2));
        const int tid2 = tid_now(C.wave_s, z2), lane = tid2 & 63, wid = tid2 >> 6, wr = wid >> 2, wc = wid & 3, fr = lane & 15, fq = lane >> 4;
#pragma unroll
        for (int ai = 0; ai < 2; ++ai)
#pragma unroll
            for (int m = 0; m < 4; ++m) {
                const int row = pm * 256 + ai * 128 + wr * 64 + m * 16 + fr;
#pragma unroll
                for (int bj = 0; bj < 2; ++bj) {
                    const int colbase = pn * 256 + bj * 128 + wc * 32, f = (colbase >> 5) * 16 + fq * 4;
                    const f32x4 a = acc[ai][bj][m][0], bb = acc[ai][bj][m][1];
                    float o[4];
#pragma unroll
                    for (int r = 0; r < 4; ++r) o[r] = a[r] / (1.0f + __expf(-a[r])) * bb[r];
                    u32x2 w; w.x = pack2bf(o[0], o[1]); w.y = pack2bf(o[2], o[3]);
                    *(u32x2*)(act + (size_t)row * 2816 + f) = w;
                }
            }
    }
}

__device__ __forceinline__ void resid_gemm_phase(const Ctx& C, const PV& P, int pass, const bf16_t* A, int K, const bf16_t* Wt, int layer, int j, float scale) {
    const float* mod = (const float*)(P.ws + WS_MOD);
    int pm, pn;
    for (int it = 0; tile_order(it, C.nblk, C.bid, TP / 256, 4, pm, pn); ++it) {
        f32x4 acc[2][2][4][2];
        gemm256(C, acc, A, Wt, K, pm * 256, pn * 256);
        int z2 = 0; asm volatile("" : "+s"(z2));
        const int tid2 = tid_now(C.wave_s, z2), lane = tid2 & 63, wid = tid2 >> 6, wr = wid >> 2, wc = wid & 3, fr = lane & 15, fq = lane >> 4;
#pragma unroll
        for (int ai = 0; ai < 2; ++ai)
#pragma unroll
            for (int m = 0; m < 4; ++m) {
                const int lt = pm * 256 + ai * 128 + wr * 64 + m * 16 + fr;
                const int gr = grow_of(pass, lt), b = brow_of(pass, lt);
                const float* gate = mod + ((size_t)layer * 18 + b) * 9216 + (size_t)(3 * j + 2) * 1024;
#pragma unroll
                for (int bj = 0; bj < 2; ++bj)
#pragma unroll
                    for (int n = 0; n < 2; ++n) {
                        const int col = pn * 256 + bj * 128 + wc * 32 + n * 16 + fq * 4;
                        f32x4* xp = (f32x4*)(P.out + (size_t)gr * 1024 + col);
                        const f32x4 x = *xp, g = *(const f32x4*)(gate + col);
                        *xp = ALPHA * x + (1.0f + g) * scale * acc[ai][bj][m][n];
                    }
            }
    }
}

__device__ __forceinline__ void win_phase(const Ctx& C, const PV& P, int layer) {
    const bf16_t* hmod = (const bf16_t*)(P.ws + WS_HMOD);
    const bf16_t* Wt = wl(P, layer) + OW_WIN;
    unsigned char* R = P.ws + WS_R;
    f16* raw = (f16*)(R + R_RAW); bf16_t* Qb = (bf16_t*)(R + R_Q); bf16_t* Kb = (bf16_t*)(R + R_K); bf16_t* Vt = (bf16_t*)(R + R_VT);
    f16* Zc = (f16*)(R + R_ZC); f16* poolp = (f16*)(R + R_POOLP);
    typedef f16 f16x4 __attribute__((ext_vector_type(4)));
    typedef f16 f16x2 __attribute__((ext_vector_type(2)));
    int pm, pn;
    for (int it = 0; tile_order(it, C.nblk, C.bid, TP / 256, 18, pm, pn); ++it) {
        const int lt_t = pm * 256, sq = lt_t < 8192 ? 0 : 1 + ((lt_t - 8192) >> 12), lt0 = seqbase_of(sq), S = seqlen_of(sq);
        f32x4 acc[2][2][4][2];
        gemm256(C, acc, hmod, Wt, 1024, pm * 256, pn * 256);
        int z2 = 0; asm volatile("" : "+s"(z2));
        const int tid2 = tid_now(C.wave_s, z2), lane = tid2 & 63, wid = tid2 >> 6, wr = wid >> 2, wc = wid & 3, fr = lane & 15, fq = lane >> 4;
#pragma unroll
        for (int bj = 0; bj < 2; ++bj) {
            const int tn = pn * 2 + bj;
            if (tn >= 35) continue;
#pragma unroll
            for (int ai = 0; ai < 2; ++ai)
#pragma unroll
                for (int m = 0; m < 4; ++m) {
                    const int lt = pm * 256 + ai * 128 + wr * 64 + m * 16 + fr, pos = lt - lt0;
#pragma unroll
                    for (int n = 0; n < 2; ++n) {
                        const int col = tn * 128 + wc * 32 + n * 16 + fq * 4;
                        f32x4 v = acc[ai][bj][m][n];
                        if (tn < 15) {
                            f16x4 h; h[0] = (f16)v[0]; h[1] = (f16)v[1]; h[2] = (f16)v[2]; h[3] = (f16)v[3];
                            *(f16x4*)(raw + (size_t)lt * 1920 + col) = h;
                        } else if (tn < 23) {
                            const int nq = (col - 1920) & 511, hc = nq >> 6, d = nq & 63;
                            if (n == 0 && (wc & 1) == 0) {
#pragma unroll
                                for (int r = 0; r < 4; ++r) {
                                    const float invlo = r == 0 ? 1.0f : r == 1 ? 0.1939227432012558f : r == 2 ? 0.03760603070259094f : 0.007292664609849453f;
                                    const float invhi = r == 0 ? 0.0014142135623842478f : r == 1 ? 0.00027424818836152554f : r == 2 ? 5.3182957344688475e-05f : 1.0313385246263351e-05f;
                                    const float ang = (float)pos * ((fq & 1) ? invhi : invlo);
                                    const float hi = ang * 0.15915493667125702f;
                                    const float lo = __builtin_fmaf(ang, 0.15915493667125702f, -hi) + ang * 6.4206382432985265e-09f;
                                    const float rr = (hi - floorf(hi)) + lo;
                                    const float cs = __builtin_amdgcn_cosf(rr), sn = __builtin_amdgcn_sinf(rr);
                                    const float other = __shfl_xor(v[r], 32);
                                    v[r] = (fq < 2) ? (v[r] * cs - other * sn) : (other * sn + v[r] * cs);
                                }
                            }
                            bf16_t* dst = (tn < 19) ? Qb : Kb;
                            const float sc = (tn < 19) ? 0.125f * 1.44269504088896f : 1.0f;
                            u32x2 w; w.x = pack2bf(v[0] * sc, v[1] * sc); w.y = pack2bf(v[2] * sc, v[3] * sc);
                            *(u32x2*)(dst + (size_t)lt0 * 512 + ((size_t)hc * S + pos) * 64 + d) = w;
                        } else if (tn < 27) {
                            const int nv = col - 2944;
                            bf16_t* vb = Vt + (size_t)lt0 * 512 + (size_t)nv * S + pos;
                            vb[0] = f2bf(v[0]); vb[(size_t)S] = f2bf(v[1]); vb[(size_t)2 * S] = f2bf(v[2]); vb[(size_t)3 * S] = f2bf(v[3]);
                        } else if (tn < 31) {
                            const int nz = col - 3456, g = nz >> 7, cc = (nz & 127) >> 1;
                            f16x2 z0, z1; z0[0] = (f16)v[0]; z0[1] = (f16)v[1]; z1[0] = (f16)v[2]; z1[1] = (f16)v[3];
                            f16x2* zb = (f16x2*)Zc + (size_t)lt0 * 256;
                            zb[(size_t)(g * 64 + cc) * S + pos] = z0;
                            zb[(size_t)(g * 64 + cc + 1) * S + pos] = z1;
                        } else {
                            f16x4 h; h[0] = (f16)v[0]; h[1] = (f16)v[1]; h[2] = (f16)v[2]; h[3] = (f16)v[3];
                            *(f16x4*)(poolp + (size_t)lt * 512 + (col - 3968)) = h;
                        }
                    }
                    asm volatile("" ::: "memory");
                }
        }
    }
}

__device__ __forceinline__ float shiftv(const f16* __restrict__ raw, int lt, int t, int S, int col, float mu) {
    const float p = (float)raw[(size_t)lt * 1920 + col];
    const float pr = t > 0 ? (float)raw[(size_t)(lt - 1) * 1920 + col] : 0.f;
    const float nx = t < S - 1 ? (float)raw[(size_t)(lt + 1) * 1920 + col] : 0.f;
    return p + (0.5f * (pr + nx) - p) * mu;
}

typedef f16 f16x4_t __attribute__((ext_vector_type(4)));
typedef f16 f16x8_t __attribute__((ext_vector_type(8)));
__device__ __forceinline__ void lin_pool_phase(const Ctx& C, const PV& P, int layer) {
    unsigned char* R = P.ws + WS_R;
    const f16* raw = (const f16*)(R + R_RAW); bf16_t* lin = (bf16_t*)(R + R_LIN);
    const f16* poolp = (const f16*)(R + R_POOLP); bf16_t* ypool = (bf16_t*)(R + R_YB) + 3 * SZ512;
    const float* mu = P.inp(13) + (size_t)layer * 1920; const float* pscale = P.inp(26) + (size_t)layer * 512;
    const int gsz = C.nblk * NT, gid = C.bid * NT + C.tid;
    for (int e = gid; e < TP * 96; e += gsz) {
        const int lt = e / 96, c = (e % 96) * 4, col = 1536 + c;
        const int pos = pos_of(lt), S = lt < 8192 ? 8192 : 4096;
        const f16x4_t p0 = *(const f16x4_t*)(raw + (size_t)lt * 1920 + col);
        const f16x4_t pm = *(const f16x4_t*)(raw + (size_t)(pos > 0 ? lt - 1 : lt) * 1920 + col);
        const f16x4_t pp = *(const f16x4_t*)(raw + (size_t)(pos < S - 1 ? lt + 1 : lt) * 1920 + col);
        const f32x4 m4 = *(const f32x4*)(mu + col);
        const float wm = pos > 0 ? 0.5f : 0.f, wp = pos < S - 1 ? 0.5f : 0.f;
        float o[4];
#pragma unroll
        for (int r = 0; r < 4; ++r) {
            const float p = (float)p0[r];
            float v = p + (wm * (float)pm[r] + wp * (float)pp[r] - p) * m4[r];
            if (c < 128) v = 1.0f - 2.0f / (__expf(2.0f * v) + 1.0f);
            else if (c >= 256) v = sigmoidf_(v);
            o[r] = v;
        }
        u32x2 w; w.x = pack2bf(o[0], o[1]); w.y = pack2bf(o[2], o[3]);
        *(u32x2*)(lin + (size_t)lt * 384 + c) = w;
    }
    for (int e = gid; e < TP * 128; e += gsz) {
        const int lt = e >> 7, c = (e & 127) * 4, g = c >> 7, half = 1 << g;
        const int pos = pos_of(lt), S = lt < 8192 ? 8192 : 4096;
        const int lo = max(pos - half, 0), hi = min(pos + half, S);
        const f16* base = poolp + (size_t)(lt - pos) * 512 + c;
        float s0 = 0.f, s1 = 0.f, s2 = 0.f, s3 = 0.f;
#pragma unroll
        for (int o = -8; o < 8; ++o) {
            const int tt = pos + o;
            const bool in = (o >= -half) && (o < half) && tt >= 0 && tt < S;
            if (in) { const f16x4_t v = *(const f16x4_t*)(base + (size_t)tt * 512); s0 += (float)v[0]; s1 += (float)v[1]; s2 += (float)v[2]; s3 += (float)v[3]; }
        }
        const f16x4_t x = *(const f16x4_t*)(base + (size_t)pos * 512);
        const f32x4 ps = *(const f32x4*)(pscale + c);
        const float ic = 1.0f / (float)(hi - lo);
        u32x2 w; w.x = pack2bf((s0 * ic - (float)x[0]) * ps[0], (s1 * ic - (float)x[1]) * ps[1]); w.y = pack2bf((s2 * ic - (float)x[2]) * ps[2], (s3 * ic - (float)x[3]) * ps[3]);
        *(u32x2*)(ypool + (size_t)lt * 512 + c) = w;
    }
    {
        float* invn = (float*)(P.ws + WS_INVN);
        const float* k_k = P.inp(19) + (size_t)layer * 512;
        const int lane = C.tid & 63, wave = C.tid >> 6;
        for (int lt = C.bid * NWV + wave; lt < TP; lt += C.nblk * NWV) {
            const int pos = pos_of(lt), S = lt < 8192 ? 8192 : 4096;
            float ss[8];
#pragma unroll
            for (int h = 0; h < 8; ++h) {
                const int c = h * 64 + lane;
                const float k = shiftv(raw, lt, pos, S, 512 + c, mu[512 + c]) * k_k[c];
                ss[h] = k * k;
            }
#pragma unroll
            for (int h = 0; h < 8; ++h) ss[h] = wsum(ss[h]);
            if (lane < 8) {
                float sel = ss[0];
#pragma unroll
                for (int h = 1; h < 8; ++h) sel = lane == h ? ss[h] : sel;
                invn[(size_t)lt * 8 + lane] = 1.0f / fmaxf(sqrtf(sel), 1e-12f);
            }
        }
    }
}

__device__ __forceinline__ void lora_phase(const Ctx& C, const PV& P, int layer, unsigned char* smem) {
    unsigned char* R = P.ws + WS_R;
    const bf16_t* lin = (const bf16_t*)(R + R_LIN); f16* wa = (f16*)(R + R_WA); f16* gbuf = (f16*)(R + R_G);
    const bf16_t* W = wl(P, layer);
    const int lane = C.tid & 63, wave = (C.tid >> 6) & 3, wm = wave >> 1, wn = wave & 1, fr = lane & 15, fq = lane >> 4;
    for (int t2 = C.bid; t2 < 5 * MT * 2; t2 += C.nblk) {
        const int t = t2 * 2 + (C.tid >> 8);
        const int which = t / (MT * 4), tt = t % (MT * 4), tm = tt >> 2, tn = tt & 3;
        const bf16_t* Bt; int K, acol; const float* bias = nullptr; f16* dst;
        if (which < 2) { Bt = W + OW_W2T + (size_t)which * 512 * 64; K = 64; acol = which * 64; bias = P.inp(14) + (size_t)(layer * 2 + which) * 512; dst = wa + (size_t)which * SZ512; }
        else if (which < 4) { const int d = which - 2; Bt = W + OW_A2T + (size_t)d * 512 * 64; K = 64; acol = 128 + d * 64; bias = P.inp(16) + (size_t)(layer * 2 + d) * 512; dst = wa + (size_t)which * SZ512; }
        else { Bt = W + OW_G2T; K = 128; acol = 256; dst = gbuf; }
        f32x4 acc[4][4];
        gemm_core<4, true>(C, acc, lin + (size_t)tm * 128 * 384 + acol, 384, Bt + (size_t)tn * 128 * K, K, K, smem);
#pragma unroll
        for (int i = 0; i < 4; ++i) {
            const int lt = tm * 128 + wm * 64 + i * 16 + fr;
#pragma unroll
            for (int jn = 0; jn < 4; ++jn) {
                const int n = tn * 128 + wn * 64 + jn * 16 + fq * 4;
                typedef f16 f16x4 __attribute__((ext_vector_type(4)));
                f16x4 h;
#pragma unroll
                for (int r = 0; r < 4; ++r) {
                    float v = acc[i][jn][r];
                    if (which < 2) {
                        const float z = bias[n + r] + v;
                        v = __expf(-0.6065306597126334f * sigmoidf_(z));
                    } else if (which < 4) { v = sigmoidf_(bias[n + r] + v); }
                    h[r] = (f16)v;
                }
                *(f16x4*)(dst + (size_t)lt * 512 + n) = h;
            }
        }
    }
}

__device__ __forceinline__ void attn_items(const Ctx& C, const PV& P, int layer, int ctr_idx, unsigned char* smem) {
    unsigned char* R = P.ws + WS_R;
    const bf16_t* Qall = (const bf16_t*)(R + R_Q); const bf16_t* Kall = (const bf16_t*)(R + R_K); const bf16_t* Vall = (const bf16_t*)(R + R_VT);
    bf16_t* ydiff = (bf16_t*)(R + R_YB) + 1 * SZ512;
    const int tid = C.tid, lane = tid & 63, wave = tid >> 6, comp = wave & 1, rg = wave >> 1, fr = lane & 15, fq = lane >> 4;
    const float lam_init = layer == 0 ? 0.2f : (0.8f - 0.6f * 0.7408182206817179f);
    float lam_full;
    {
        const float* lm = P.inp(24) + (size_t)layer * 256;
        float s1 = 0.f, s2 = 0.f;
        for (int i = 0; i < 64; ++i) { s1 += lm[i] * lm[64 + i]; s2 += lm[128 + i] * lm[192 + i]; }
        lam_full = expf(s1) - expf(s2) + lam_init;
    }
    const float* normg = P.inp(25) + (size_t)layer * 128;
    unsigned* ctr = (unsigned*)(P.ws + WS_CTR) + ctr_idx;
    volatile unsigned* bc = (volatile unsigned*)(smem + 131056);
    for (;;) {
        __syncthreads();
        if (tid == 0) *bc = atomicAdd(ctr, 1u);
        __syncthreads();
        const int item = (int)*bc;
        if (item >= 1280) break;
        int sq, h, qb;
        if (item < 256) { sq = 0; h = item >> 6; qb = item & 63; } else { const int i2 = item - 256; sq = 1 + (i2 >> 7); h = (i2 >> 5) & 3; qb = i2 & 31; }
        const int lt0 = seqbase_of(sq), S = seqlen_of(sq);
        const bf16_t* Qb = Qall + (size_t)lt0 * 512; const bf16_t* Kb = Kall + (size_t)lt0 * 512; const bf16_t* Vb = Vall + (size_t)lt0 * 512 + (size_t)h * 128 * S;
        const int q0 = qb * 128 + rg * 32;
        bf16x8 bq[2][2];
#pragma unroll
        for (int qs = 0; qs < 2; ++qs)
#pragma unroll
            for (int ks = 0; ks < 2; ++ks) bq[qs][ks] = *(const bf16x8*)(Qb + ((size_t)(h * 2 + comp) * S + q0 + qs * 16 + fr) * 64 + ks * 32 + fq * 8);
        float m_run[2] = {-1e30f, -1e30f}, l_run[2] = {0.f, 0.f};
        f32x4 O[8][2];
#pragma unroll
        for (int a = 0; a < 8; ++a) { O[a][0] = (f32x4){0.f, 0.f, 0.f, 0.f}; O[a][1] = (f32x4){0.f, 0.f, 0.f, 0.f}; }
        u32x4 rk[2], rv[2];
        const int lrow = tid >> 3, lkc = (tid & 7) * 8;
#pragma unroll
        for (int i = 0; i < 2; ++i) {
            const int row = lrow + 64 * i, cm = row >> 6, key = row & 63;
            rk[i] = *(const u32x4*)(Kb + ((size_t)(h * 2 + cm) * S + key) * 64 + lkc);
            rv[i] = *(const u32x4*)(Vb + (size_t)row * S + lkc);
        }
        for (int kt0 = 0; kt0 < S; kt0 += 64) {
            __syncthreads();
#pragma unroll
            for (int i = 0; i < 2; ++i) {
                const int row = lrow + 64 * i;
                *(u32x4*)(smem + row * 144 + lkc * 2) = rk[i];
                *(u32x4*)(smem + 18432 + row * 144 + lkc * 2) = rv[i];
            }
            __syncthreads();
            if (kt0 + 64 < S) {
#pragma unroll
                for (int i = 0; i < 2; ++i) {
                    const int row = lrow + 64 * i, cm = row >> 6, key = row & 63;
                    rk[i] = *(const u32x4*)(Kb + ((size_t)(h * 2 + cm) * S + kt0 + 64 + key) * 64 + lkc);
                    rv[i] = *(const u32x4*)(Vb + (size_t)row * S + kt0 + 64 + lkc);
                }
            }
            f32x4 st[4][2];
#pragma unroll
            for (int t = 0; t < 4; ++t) {
                st[t][0] = (f32x4){0.f, 0.f, 0.f, 0.f}; st[t][1] = (f32x4){0.f, 0.f, 0.f, 0.f};
#pragma unroll
                for (int ks = 0; ks < 2; ++ks) {
                    const bf16x8 kf = *(const bf16x8*)(smem + (comp * 64 + t * 16 + fr) * 144 + (ks * 32 + fq * 8) * 2);
                    st[t][0] = __builtin_amdgcn_mfma_f32_16x16x32_bf16(kf, bq[0][ks], st[t][0], 0, 0, 0);
                    st[t][1] = __builtin_amdgcn_mfma_f32_16x16x32_bf16(kf, bq[1][ks], st[t][1], 0, 0, 0);
                }
            }
            bf16x8 pb[2][2];
#pragma unroll
            for (int qs = 0; qs < 2; ++qs) {
                float mx = -1e30f;
#pragma unroll
                for (int t = 0; t < 4; ++t)
#pragma unroll
                    for (int r = 0; r < 4; ++r) mx = fmaxf(mx, st[t][qs][r]);
                mx = fmaxf(mx, __shfl_xor(mx, 16)); mx = fmaxf(mx, __shfl_xor(mx, 32));
                const float mnew = fmaxf(m_run[qs], mx);
                const float alpha = __builtin_amdgcn_exp2f(m_run[qs] - mnew);
                m_run[qs] = mnew;
                float ls = 0.f;
                float pv[4][4];
#pragma unroll
                for (int t = 0; t < 4; ++t)
#pragma unroll
                    for (int r = 0; r < 4; ++r) { pv[t][r] = __builtin_amdgcn_exp2f(st[t][qs][r] - mnew); ls += pv[t][r]; }
                l_run[qs] = l_run[qs] * alpha + ls;
#pragma unroll
                for (int a = 0; a < 8; ++a) O[a][qs] = O[a][qs] * alpha;
#pragma unroll
                for (int u = 0; u < 2; ++u) {
                    union { bf16x8 v; unsigned w[4]; } pk;
                    pk.w[0] = pack2bf(pv[2 * u][0], pv[2 * u][1]); pk.w[1] = pack2bf(pv[2 * u][2], pv[2 * u][3]);
                    pk.w[2] = pack2bf(pv[2 * u + 1][0], pv[2 * u + 1][1]); pk.w[3] = pack2bf(pv[2 * u + 1][2], pv[2 * u + 1][3]);
                    pb[qs][u] = pk.v;
                }
            }
#pragma unroll
            for (int u = 0; u < 2; ++u)
#pragma unroll
                for (int a = 0; a < 8; ++a) {
                    union { bf16x8 v; uint2 h[2]; } vf;
                    vf.h[0] = *(const uint2*)(smem + 18432 + (a * 16 + fr) * 144 + (u * 32 + fq * 4) * 2);
                    vf.h[1] = *(const uint2*)(smem + 18432 + (a * 16 + fr) * 144 + (u * 32 + 16 + fq * 4) * 2);
                    O[a][0] = __builtin_amdgcn_mfma_f32_16x16x32_bf16(vf.v, pb[0][u], O[a][0], 0, 0, 0);
                    O[a][1] = __builtin_amdgcn_mfma_f32_16x16x32_bf16(vf.v, pb[1][u], O[a][1], 0, 0, 0);
                }
        }
#pragma unroll
        for (int qs = 0; qs < 2; ++qs) {
            float l = l_run[qs]; l += __shfl_xor(l, 16); l += __shfl_xor(l, 32);
            const float inv = 1.0f / l;
#pragma unroll
            for (int a = 0; a < 8; ++a) O[a][qs] = O[a][qs] * inv;
        }
        __syncthreads();
        float* Ox = (float*)smem;
        if (comp == 1) {
#pragma unroll
            for (int qs = 0; qs < 2; ++qs)
#pragma unroll
                for (int a = 0; a < 8; ++a)
#pragma unroll
                    for (int r = 0; r < 4; ++r) Ox[(rg * 128 + a * 16 + fq * 4 + r) * 32 + qs * 16 + fr] = O[a][qs][r];
        }
        __syncthreads();
        if (comp == 0) {
#pragma unroll
            for (int qs = 0; qs < 2; ++qs) {
                float ss = 0.f;
#pragma unroll
                for (int a = 0; a < 8; ++a)
#pragma unroll
                    for (int r = 0; r < 4; ++r) {
                        const float o = O[a][qs][r] - lam_full * Ox[(rg * 128 + a * 16 + fq * 4 + r) * 32 + qs * 16 + fr];
                        O[a][qs][r] = o; ss += o * o;
                    }
                ss += __shfl_xor(ss, 16); ss += __shfl_xor(ss, 32);
                const float sc = rsqrtf(ss * (1.0f / 128.0f) + 1e-5f) * (1.0f - lam_init);
                const int lt = lt0 + q0 + qs * 16 + fr;
#pragma unroll
                for (int a = 0; a < 8; ++a) {
                    const int dv = a * 16 + fq * 4;
                    const float4 g = *(const float4*)(normg + dv);
                    uint2 w; w.x = pack2bf(O[a][qs][0] * sc * g.x, O[a][qs][1] * sc * g.y); w.y = pack2bf(O[a][qs][2] * sc * g.z, O[a][qs][3] * sc * g.w);
                    *(uint2*)(ydiff + (size_t)lt * 512 + h * 128 + dv) = w;
                }
            }
        }
    }
    __syncthreads();
}

__device__ __forceinline__ void fft_items(const Ctx& C, const PV& P, unsigned char* smem) {
    unsigned char* R = P.ws + WS_R;
    typedef f16 f16x2 __attribute__((ext_vector_type(2)));
    const f16x2* Zall = (const f16x2*)(R + R_ZC);
    bf16_t* yf = (bf16_t*)(R + R_YB) + 2 * SZ512;
    const float2* tw = (const float2*)(P.ws + WS_TW);
    float2* sm = (float2*)smem;
    const int tid = C.tid;
    for (int item = C.bid; item < NSEQ * 256; item += C.nblk) {
        const int sq = item >> 8, col = item & 255, g = col >> 6, cc = col & 63;
        const int lt0 = seqbase_of(sq), S = seqlen_of(sq), lg = sq == 0 ? 13 : 12;
        const f16x2* z = Zall + (size_t)lt0 * 256 + (size_t)col * S;
        __syncthreads();
        for (int s = tid; s < S; s += NT) { const f16x2 v = z[s]; sm[__brev((unsigned)s) >> (32 - lg)] = make_float2((float)v[0], (float)v[1]); }
        __syncthreads();
        for (int st = 0; st < lg; ++st) {
            const int half = 1 << st, tshift = 12 - st;
            for (int b = tid; b < (S >> 1); b += NT) {
                const int j = b & (half - 1), i0 = ((b >> st) << (st + 1)) + j, i1 = i0 + half;
                const float2 w = tw[j << tshift], u = sm[i0], x = sm[i1];
                const float2 tv = make_float2(w.x * x.x - w.y * x.y, w.x * x.y + w.y * x.x);
                sm[i0] = make_float2(u.x + tv.x, u.y + tv.y); sm[i1] = make_float2(u.x - tv.x, u.y - tv.y);
            }
            __syncthreads();
        }
        const float nrm = rsqrtf((float)S * 128.0f);
        for (int k = tid; k < S; k += NT) {
            const float2 a = sm[k], b = sm[(S - k) & (S - 1)];
            bf16_t* row = yf + (size_t)(lt0 + k) * 512 + g * 128;
            if (cc == 0) { row[0] = f2bf(0.5f * (a.x + b.x) * nrm); row[64] = f2bf(0.5f * (a.y + b.y) * nrm); }
            else { row[cc] = f2bf(a.x * nrm); row[128 - cc] = f2bf(b.x * nrm); }
        }
    }
    __syncthreads();
}

typedef float f32x2 __attribute__((ext_vector_type(2)));
template <int KT>
__device__ __forceinline__ void scan_block(const Ctx& C, const PV& P, int layer, int sq, int h, int d, int row0, unsigned char* smem) {
    constexpr int TPR = 64 / KT, ROWS = NT / TPR, CH = 16, YP = TPR / 4, NV = ROWS / 32;
    unsigned char* R = P.ws + WS_R;
    const f16* raw = (const f16*)(R + R_RAW); const f16* wa = (const f16*)(R + R_WA); f16* yfb = (f16*)(R + R_YFB);
    const float* invn = (const float*)(P.ws + WS_INVN);
    const float* mu = P.inp(13) + (size_t)layer * 1920; const float* k_k = P.inp(19) + (size_t)layer * 512; const float* k_a = P.inp(20) + (size_t)layer * 512;
    const int tid = C.tid, row = tid / TPR, q = tid % TPR;
    const int lt0 = seqbase_of(sq), S = seqlen_of(sq);
    const int ch = tid & 63, c = h * 64 + ch;
    const float mu_r = mu[c], mu_k = mu[512 + c], kkw = k_k[c], kaw = k_a[c];
    const int vr = (ROWS == 32) ? (tid & 31) : (tid & 63);
    const int vcol = 1024 + h * 64 + row0 + vr; const float mu_v = mu[vcol];
    const f16* wdec = wa + (size_t)d * SZ512; const f16* aact = wa + (size_t)(2 + d) * SZ512;
    f16* ydst = yfb + (size_t)d * SZ512;
    f32x2 s[KT / 2];
#pragma unroll
    for (int j = 0; j < KT / 2; ++j) s[j] = (f32x2){0.f, 0.f};
    f16 pr_[2][3], pk_[2][3], pa_[2], pw_[2], pv_[NV][3]; float pn_[2];
    auto prefetch = [&](int c0) {
#pragma unroll
        for (int j = 0; j < 2; ++j) {
            const int i = (tid >> 6) + 8 * j, tstep = c0 + i, t = d == 0 ? tstep : S - 1 - tstep, lt = lt0 + t;
            const int tm = t > 0 ? lt - 1 : lt, tp = t < S - 1 ? lt + 1 : lt;
            pr_[j][0] = raw[(size_t)tm * 1920 + c]; pr_[j][1] = raw[(size_t)lt * 1920 + c]; pr_[j][2] = raw[(size_t)tp * 1920 + c];
            pk_[j][0] = raw[(size_t)tm * 1920 + 512 + c]; pk_[j][1] = raw[(size_t)lt * 1920 + 512 + c]; pk_[j][2] = raw[(size_t)tp * 1920 + 512 + c];
            pa_[j] = aact[(size_t)lt * 512 + c]; pw_[j] = wdec[(size_t)lt * 512 + c]; pn_[j] = invn[(size_t)lt * 8 + h];
        }
#pragma unroll
        for (int j = 0; j < NV; ++j) {
            const int i = (ROWS == 32) ? (tid >> 5) : ((tid >> 6) + 8 * j), tstep = c0 + i, t = d == 0 ? tstep : S - 1 - tstep, lt = lt0 + t;
            const int tm = t > 0 ? lt - 1 : lt, tp = t < S - 1 ? lt + 1 : lt;
            pv_[j][0] = raw[(size_t)tm * 1920 + vcol]; pv_[j][1] = raw[(size_t)lt * 1920 + vcol]; pv_[j][2] = raw[(size_t)tp * 1920 + vcol];
        }
    };
    auto stage = [&](int c0, unsigned char* buf) {
        float* vec = (float*)buf; float* vbuf = (float*)(buf + 20480);
#pragma unroll
        for (int j = 0; j < 2; ++j) {
            const int i = (tid >> 6) + 8 * j, tstep = c0 + i, t = d == 0 ? tstep : S - 1 - tstep;
            const float rm = t > 0 ? (float)pr_[j][0] : 0.f, rp = t < S - 1 ? (float)pr_[j][2] : 0.f, km = t > 0 ? (float)pk_[j][0] : 0.f, kp = t < S - 1 ? (float)pk_[j][2] : 0.f;
            const float r1 = (float)pr_[j][1], k1 = (float)pk_[j][1];
            const float r = r1 + (0.5f * (rm + rp) - r1) * mu_r;
            const float k = k1 + (0.5f * (km + kp) - k1) * mu_k;
            const float kk = k * kkw * pn_[j], a = (float)pa_[j];
            vec[(0 * CH + i) * 64 + ch] = kk;
            vec[(1 * CH + i) * 64 + ch] = (float)pw_[j];
            vec[(2 * CH + i) * 64 + ch] = kk * a;
            vec[(3 * CH + i) * 64 + ch] = k * (1.0f + (a - 1.0f) * kaw);
            vec[(4 * CH + i) * 64 + ch] = r;
        }
#pragma unroll
        for (int j = 0; j < NV; ++j) {
            const int i = (ROWS == 32) ? (tid >> 5) : ((tid >> 6) + 8 * j), tstep = c0 + i, t = d == 0 ? tstep : S - 1 - tstep;
            const float vm = t > 0 ? (float)pv_[j][0] : 0.f, vp = t < S - 1 ? (float)pv_[j][2] : 0.f, v1 = (float)pv_[j][1];
            vbuf[i * 64 + vr] = v1 + (0.5f * (vm + vp) - v1) * mu_v;
        }
    };
    __syncthreads();
    prefetch(0);
    stage(0, smem);
    __syncthreads();
    const int nch = S / CH;
    for (int cix = 0; cix < nch; ++cix) {
        unsigned char* buf = smem + (cix & 1) * 32768;
        if (cix + 1 < nch) prefetch((cix + 1) * CH);
        {
            const float* vec = (const float*)buf; const float* vbuf = (const float*)(buf + 20480); float* ybuf = (float*)(buf + 24576);
            const f32x4* vp0 = (const f32x4*)(vec + q * KT);
            f32x4 nx[5][KT / 4]; float nvv;
#pragma unroll
            for (int u = 0; u < KT / 4; ++u)
#pragma unroll
                for (int a5 = 0; a5 < 5; ++a5) nx[a5][u] = vp0[a5 * CH * 16 + u];
            nvv = vbuf[row];
            float yv[CH];
#pragma unroll
            for (int i = 0; i < CH; ++i) {
                f32x2 kk2[KT / 2], w2[KT / 2], b2[KT / 2], kd2[KT / 2], r2[KT / 2];
#pragma unroll
                for (int u = 0; u < KT / 4; ++u) {
                    kk2[2 * u] = (f32x2){nx[0][u][0], nx[0][u][1]}; kk2[2 * u + 1] = (f32x2){nx[0][u][2], nx[0][u][3]};
                    w2[2 * u] = (f32x2){nx[1][u][0], nx[1][u][1]}; w2[2 * u + 1] = (f32x2){nx[1][u][2], nx[1][u][3]};
                    b2[2 * u] = (f32x2){nx[2][u][0], nx[2][u][1]}; b2[2 * u + 1] = (f32x2){nx[2][u][2], nx[2][u][3]};
                    kd2[2 * u] = (f32x2){nx[3][u][0], nx[3][u][1]}; kd2[2 * u + 1] = (f32x2){nx[3][u][2], nx[3][u][3]};
                    r2[2 * u] = (f32x2){nx[4][u][0], nx[4][u][1]}; r2[2 * u + 1] = (f32x2){nx[4][u][2], nx[4][u][3]};
                }
                const float vv = nvv;
                if (i + 1 < CH) {
#pragma unroll
                    for (int u = 0; u < KT / 4; ++u)
#pragma unroll
                        for (int a5 = 0; a5 < 5; ++a5) nx[a5][u] = vp0[(i + 1) * 16 + a5 * CH * 16 + u];
                    nvv = vbuf[(i + 1) * 64 + row];
                }
                f32x2 acc2 = s[0] * kk2[0];
#pragma unroll
                for (int j = 1; j < KT / 2; ++j) acc2 = __builtin_elementwise_fma(s[j], kk2[j], acc2);
                float sa = acc2[0] + acc2[1];
                sa += dppf<0xB1>(sa); sa += dppf<0x4E>(sa); sa += dppf<0x141>(sa);
                if (TPR == 16) sa += dppf<0x140>(sa);
                sa = -sa;
                const f32x2 sa2 = (f32x2){sa, sa}, vv2 = (f32x2){vv, vv};
                f32x2 y2 = (f32x2){0.f, 0.f};
#pragma unroll
                for (int j = 0; j < KT / 2; ++j) {
                    s[j] = __builtin_elementwise_fma(s[j], w2[j], __builtin_elementwise_fma(sa2, b2[j], vv2 * kd2[j]));
                    y2 = __builtin_elementwise_fma(s[j], r2[j], y2);
                }
                float y = y2[0] + y2[1];
                y += dppf<0xB1>(y); y += dppf<0x4E>(y);
                yv[i] = y;
            }
            if ((q & 3) == 0) {
#pragma unroll
                for (int i = 0; i < CH; ++i) ybuf[i * 128 + row * YP + (q >> 2)] = yv[i];
            }
        }
        if (cix + 1 < nch) stage((cix + 1) * CH, smem + ((cix + 1) & 1) * 32768);
        __syncthreads();
        {
            const float* ybuf = (const float*)(buf + 24576);
#pragma unroll
            for (int j = 0; j < NV; ++j) {
                const int i = (ROWS == 32) ? (tid >> 5) : ((tid >> 6) + 8 * j), rr = vr, tstep = cix * CH + i, t = d == 0 ? tstep : S - 1 - tstep;
                float y = 0.f;
#pragma unroll
                for (int p = 0; p < YP; ++p) y += ybuf[i * 128 + rr * YP + p];
                ydst[(size_t)(lt0 + t) * 512 + h * 64 + row0 + rr] = (f16)y;
            }
        }
    }
    __syncthreads();
}

__device__ __forceinline__ void finish_phase(const Ctx& C, const PV& P, int layer) {
    unsigned char* R = P.ws + WS_R;
    const f16* raw = (const f16*)(R + R_RAW); const f16* wa = (const f16*)(R + R_WA); const f16* gbuf = (const f16*)(R + R_G); const f16* yfb = (const f16*)(R + R_YFB);
    bf16_t* yr = (bf16_t*)(R + R_YB);
    const float* mu = P.inp(13) + (size_t)layer * 1920; const float* k_a = P.inp(20) + (size_t)layer * 512; const float* r_k = P.inp(21) + (size_t)layer * 512;
    const float* lg = P.inp(22) + (size_t)layer * 512; const float* lb = P.inp(23) + (size_t)layer * 512;
    const int lane = C.tid & 63, wave = C.tid >> 6, c = lane * 8;
    for (int lt = C.bid * NWV + wave; lt < TP; lt += C.nblk * NWV) {
        const int pos = pos_of(lt), S = lt < 8192 ? 8192 : 4096;
        const size_t rm = (size_t)(pos > 0 ? lt - 1 : lt) * 1920, r0 = (size_t)lt * 1920, rp = (size_t)(pos < S - 1 ? lt + 1 : lt) * 1920;
        const float wm = pos > 0 ? 0.5f : 0.f, wp = pos < S - 1 ? 0.5f : 0.f;
        const f16x8_t rA = *(const f16x8_t*)(raw + rm + c), rB = *(const f16x8_t*)(raw + r0 + c), rC = *(const f16x8_t*)(raw + rp + c);
        const f16x8_t kA = *(const f16x8_t*)(raw + rm + 512 + c), kB = *(const f16x8_t*)(raw + r0 + 512 + c), kC = *(const f16x8_t*)(raw + rp + 512 + c);
        const f16x8_t vA = *(const f16x8_t*)(raw + rm + 1024 + c), vB = *(const f16x8_t*)(raw + r0 + 1024 + c), vC = *(const f16x8_t*)(raw + rp + 1024 + c);
        const f16x8_t af = *(const f16x8_t*)(wa + 2 * SZ512 + (size_t)lt * 512 + c), ab = *(const f16x8_t*)(wa + 3 * SZ512 + (size_t)lt * 512 + c);
        const f16x8_t gg = *(const f16x8_t*)(gbuf + (size_t)lt * 512 + c);
        const f16x8_t yF = *(const f16x8_t*)(yfb + (size_t)lt * 512 + c), yB = *(const f16x8_t*)(yfb + SZ512 + (size_t)lt * 512 + c);
        float y[8], vv[8], bsum = 0.f, ysum = 0.f;
#pragma unroll
        for (int j = 0; j < 8; ++j) {
            const float r_ = (float)rB[j], k_ = (float)kB[j], v_ = (float)vB[j];
            const float r = r_ + (wm * (float)rA[j] + wp * (float)rC[j] - r_) * mu[c + j];
            const float k = k_ + (wm * (float)kA[j] + wp * (float)kC[j] - k_) * mu[512 + c + j];
            vv[j] = v_ + (wm * (float)vA[j] + wp * (float)vC[j] - v_) * mu[1024 + c + j];
            const float ka = k_a[c + j];
            const float ksum = k * (1.f + ((float)af[j] - 1.f) * ka) + k * (1.f + ((float)ab[j] - 1.f) * ka);
            bsum += r * (0.5f * ksum) * r_k[c + j];
            y[j] = (float)yF[j] + (float)yB[j]; ysum += y[j];
        }
        const float ym = red8(ysum) * (1.0f / 64.0f);
        float q = 0.f;
#pragma unroll
        for (int j = 0; j < 8; ++j) { const float dy = y[j] - ym; q += dy * dy; }
        const float rs = rsqrtf(red8(q) * (1.0f / 64.0f) + 64e-5f);
        const float bonus = red8(bsum);
        float o[8];
#pragma unroll
        for (int j = 0; j < 8; ++j) o[j] = ((y[j] - ym) * rs * lg[c + j] + lb[c + j] + bonus * vv[j]) * (float)gg[j];
        u32x4 w; w.x = pack2bf(o[0], o[1]); w.y = pack2bf(o[2], o[3]); w.z = pack2bf(o[4], o[5]); w.w = pack2bf(o[6], o[7]);
        *(u32x4*)(yr + (size_t)lt * 512 + c) = w;
    }
}

__device__ __forceinline__ void gates_phase(const Ctx& C, const PV& P, int layer) {
    const bf16_t* hmod = (const bf16_t*)(P.ws + WS_HMOD);
    const bf16_t* Wt = wl(P, layer) + OW_WIN + (size_t)4480 * 1024;
    bf16_t* gates = (bf16_t*)(P.ws + WS_R + R_GATES);
    int pm, pn;
    for (int it = 0; tile_order(it, C.nblk, C.bid, TP / 256, 16, pm, pn); ++it) {
        f32x4 acc[2][2][4][2];
        gemm256(C, acc, hmod, Wt, 1024, pm * 256, pn * 256);
        int z2 = 0; asm volatile("" : "+s"(z2));
        const int tid2 = tid_now(C.wave_s, z2), lane = tid2 & 63, wid = tid2 >> 6, wr = wid >> 2, wc = wid & 3, fr = lane & 15, fq = lane >> 4;
#pragma unroll
        for (int ai = 0; ai < 2; ++ai)
#pragma unroll
            for (int m = 0; m < 4; ++m) {
                const int lt = pm * 256 + ai * 128 + wr * 64 + m * 16 + fr;
#pragma unroll
                for (int bj = 0; bj < 2; ++bj)
#pragma unroll
                    for (int n = 0; n < 2; ++n) {
                        const int col = pn * 256 + bj * 128 + wc * 32 + n * 16 + fq * 4;
                        const f32x4 v = acc[ai][bj][m][n];
                        u32x2 w; w.x = pack2bf(sigmoidf_(v[0]), sigmoidf_(v[1])); w.y = pack2bf(sigmoidf_(v[2]), sigmoidf_(v[3]));
                        *(u32x2*)(gates + (size_t)lt * 4096 + col) = w;
                    }
            }
    }
}
__device__ __forceinline__ void branch_phase(const Ctx& C, const PV& P, int layer) {
    unsigned char* R = P.ws + WS_R;
    const bf16_t* yb = (const bf16_t*)(R + R_YB); const bf16_t* gates = (const bf16_t*)(R + R_GATES);
    float* m32 = (float*)(R + R_M32); bf16_t* merged = (bf16_t*)(R + R_MERGED);
    const bf16_t* W = wl(P, layer) + OW_WBR;
    int pm, pn;
    for (int it = 0; tile_order(it, C.nblk, C.bid, TP / 256, 4, pm, pn); ++it) {
        for (int nb = 0; nb < 4; ++nb) {
            f32x4 acc[2][2][4][2];
            gemm256(C, acc, yb + (size_t)nb * SZ512, W + (size_t)nb * 1024 * 512, 512, pm * 256, pn * 256);
            int z2 = 0; asm volatile("" : "+s"(z2));
            const int tid2 = tid_now(C.wave_s, z2), lane = tid2 & 63, wid = tid2 >> 6, wr = wid >> 2, wc = wid & 3, fr = lane & 15, fq = lane >> 4;
#pragma unroll
            for (int ai = 0; ai < 2; ++ai)
#pragma unroll
                for (int m = 0; m < 4; ++m) {
                    const int lt = pm * 256 + ai * 128 + wr * 64 + m * 16 + fr;
#pragma unroll
                    for (int bj = 0; bj < 2; ++bj)
#pragma unroll
                        for (int n = 0; n < 2; ++n) {
                            const int col = pn * 256 + bj * 128 + wc * 32 + n * 16 + fq * 4;
                            const u32x2 gw = *(const u32x2*)(gates + (size_t)lt * 4096 + nb * 1024 + col);
                            f32x4 g; g[0] = __uint_as_float(gw.x << 16); g[1] = __uint_as_float(gw.x & 0xffff0000u); g[2] = __uint_as_float(gw.y << 16); g[3] = __uint_as_float(gw.y & 0xffff0000u);
                            f32x4 mv = g * acc[ai][bj][m][n];
                            f32x4* mp = (f32x4*)(m32 + (size_t)lt * 1024 + col);
                            if (nb > 0) mv += *mp;
                            if (nb < 3) *mp = mv;
                            else { u32x2 w; w.x = pack2bf(mv[0], mv[1]); w.y = pack2bf(mv[2], mv[3]); *(u32x2*)(merged + (size_t)lt * 1024 + col) = w; }
                        }
                    asm volatile("" ::: "memory");
                }
        }
    }
}

constexpr int PH_PER_LAYER = 15, PH_PER_PASS = 2 * PH_PER_LAYER + 1, NPHASE = 1 + NPASS * PH_PER_PASS;

__global__ void __launch_bounds__(512, 2) mk_forward(Params P0, int ph_lo, int ph_hi) {
    unsigned char* smem = dyn_smem;
    const int wave_s = __builtin_amdgcn_readfirstlane((int)threadIdx.x >> 6);
    for (int it_ = 2 * ph_lo; it_ < 2 * ph_hi; ++it_) {
        const int ph = it_ >> 1;
        if (it_ & 1) {
            if (PROBE_MASK == 0 || ph == 0) continue;
            const int r_ = (ph - 1) % PH_PER_PASS;
            if (r_ == PH_PER_PASS - 1 || !((PROBE_MASK >> (r_ % PH_PER_LAYER)) & 1)) continue;
        }
        if (it_ > 2 * ph_lo) cg::this_grid().sync();
        int z = 0; asm volatile("" : "+s"(z));
        Ctx C; C.tid = tid_now(wave_s, z); C.bid = (int)blockIdx.x + z; C.nblk = (int)gridDim.x + z; C.wave_s = wave_s;
        ptrtab_t tab = (ptrtab_t)__builtin_amdgcn_kernarg_segment_ptr();
        asm volatile("" : "+s"(tab));
        const PV P{tab, (float*)tab[29], (unsigned char*)tab[30]};
        if (ph == 0) { prep_phase(C, P, smem); continue; }
        const int q = ph - 1, pass = q / PH_PER_PASS, r = q % PH_PER_PASS;
        if (r == PH_PER_PASS - 1) { norm_phase(C, P, pass, P.inp(6) + (size_t)(1 * 3 + 2) * 1024, P.inp(7) + (size_t)(1 * 3 + 2) * 1024, 0, -1, false); continue; }
        const int layer = r / PH_PER_LAYER, lp = r % PH_PER_LAYER;
        const bf16_t* W = wl(P, layer);
        const float* lng = P.inp(6) + (size_t)layer * 3 * 1024; const float* lnb = P.inp(7) + (size_t)layer * 3 * 1024;
        unsigned char* R = P.ws + WS_R;
        switch (lp) {
            case 0:
                if (layer == 0) norm_phase(C, P, pass, nullptr, nullptr, 0, 0, true);
                else norm_phase(C, P, pass, P.inp(6) + (size_t)((layer - 1) * 3 + 2) * 1024, P.inp(7) + (size_t)((layer - 1) * 3 + 2) * 1024, layer, 0, false);
                break;
            case 1: ffn_up_phase(C, P, W + OW_FA_IN); break;
            case 2: resid_gemm_phase(C, P, pass, (const bf16_t*)(R + R_ACT), 2816, W + OW_FA_OUT, layer, 0, 0.5f); break;
            case 3: norm_phase(C, P, pass, lng, lnb, layer, 1, false); break;
            case 4: win_phase(C, P, layer); break;
            case 5: lin_pool_phase(C, P, layer); break;
            case 6: lora_phase(C, P, layer, smem); break;
            case 7:
                if (C.bid < 32) scan_block<4>(C, P, layer, 0, C.bid >> 2, (C.bid >> 1) & 1, (C.bid & 1) * 32, smem);
                else if (C.bid < 160) { const int i2 = C.bid - 32; scan_block<8>(C, P, layer, 1 + (i2 >> 4), (i2 >> 1) & 7, i2 & 1, 0, smem); }
                attn_items(C, P, layer, pass * 2 + layer, smem); fft_items(C, P, smem); break;
            case 8: finish_phase(C, P, layer); break;
            case 9: gates_phase(C, P, layer); break;
            case 10: branch_phase(C, P, layer); break;
            case 11: resid_gemm_phase(C, P, pass, (const bf16_t*)(R + R_MERGED), 1024, W + OW_WOUT, layer, 1, 1.0f); break;
            case 12: norm_phase(C, P, pass, lng + 1024, lnb + 1024, layer, 2, false); break;
            case 13: ffn_up_phase(C, P, W + OW_FB_IN); break;
            default: resid_gemm_phase(C, P, pass, (const bf16_t*)(R + R_ACT), 2816, W + OW_FB_OUT, layer, 2, 0.5f); break;
        }
    }
}

extern "C" void kernel_launch(void* const* d_in, const int* in_sizes, int n_in, void* d_out, int out_size, void* d_ws, size_t ws_size, hipStream_t stream) {
    static int grid_blocks = 0;
    if (!grid_blocks) {
        int dev = 0, cus = 0, per_cu = 0;
        (void)hipGetDevice(&dev);
        (void)hipDeviceGetAttribute(&cus, hipDeviceAttributeMultiprocessorCount, dev);
        (void)hipFuncSetAttribute((const void*)mk_forward, hipFuncAttributeMaxDynamicSharedMemorySize, LDS_BYTES);
        (void)hipOccupancyMaxActiveBlocksPerMultiprocessor(&per_cu, mk_forward, NT, LDS_BYTES);
        if (per_cu < 1) per_cu = 1;
        if (per_cu > 1) per_cu = 1;
        grid_blocks = cus * per_cu;
    }
    Params p{};
    for (int i = 0; i < 29; ++i) p.in[i] = (const float*)d_in[i];
    p.out = (float*)d_out; p.ws = (unsigned char*)d_ws;
#if ONE_LAUNCH
    int lo = 0, hi = NPHASE;
    void* args[] = {&p, &lo, &hi};
    hipError_t e = hipLaunchCooperativeKernel((void*)mk_forward, dim3(grid_blocks), dim3(NT), args, LDS_BYTES, stream);
    if (e != hipSuccess) fprintf(stderr, "cooperative launch failed: %s (grid %d)\n", hipGetErrorString(e), grid_blocks);
#else
    for (int ph = 0; ph < NPHASE; ++ph) {
        int lo = ph, hi = ph + 1;
        void* args[] = {&p, &lo, &hi};
        (void)hipLaunchCooperativeKernel((void*)mk_forward, dim3(grid_blocks), dim3(NT), args, LDS_BYTES, stream);
    }
#endif
}
```

```cpp
#include <hip/hip_runtime.h>
#include <hip/hip_cooperative_groups.h>
#include <cstdio>
#include <cstdint>
namespace cg = cooperative_groups;

typedef unsigned short bf16_t;
typedef _Float16 f16;
typedef short bf16x8 __attribute__((ext_vector_type(8)));
typedef float f32x4 __attribute__((ext_vector_type(4)));
typedef unsigned u32x4 __attribute__((ext_vector_type(4)));
typedef unsigned u32x2 __attribute__((ext_vector_type(2)));

#ifndef ONE_LAUNCH
#define ONE_LAUNCH 1
#endif
#ifndef PROBE_MASK
#define PROBE_MASK 0
#endif

constexpr int TP = 40960;
constexpr int NPASS = 2;
constexpr int NSEQ = 9;
constexpr int MT = TP / 128;
constexpr int N_IN_FULL = 8576;
constexpr float ALPHA = 1.41421356237f;

constexpr size_t OW_FA_IN = 0, OW_FA_OUT = 5767168, OW_FB_IN = 8650752, OW_FB_OUT = 14417920, OW_WIN = 17301504,
                 OW_WBR = 26083328, OW_WOUT = 28180480, OW_W2T = 29229056, OW_A2T = 29294592, OW_G2T = 29360128, WL_TOTAL = 29425664;
constexpr size_t WS_W = 0, WS_TW = 117702656, WS_MOD = 117735424, WS_HMOD = 119062528, WS_R = 202948608, WS_INVN = 1062780928, WS_CTR = 1064091648;
constexpr size_t R_RAW = 0, R_LIN = 157286400, R_WA = 188743680, R_G = 356515840, R_Q = 398458880, R_K = 440401920, R_VT = 482344960,
                 R_YFB = 524288000, R_ZC = 608174080, R_POOLP = 650117120, R_YB = 692060160, R_ACT = 0,
                 R_GATES = 0  , R_M32 = 398458880  , R_MERGED = 566231040  ;
constexpr size_t SZ512 = (size_t)TP * 512;

struct Params { const float* in[29]; float* out; unsigned char* ws; };
struct Ctx { int tid, bid, nblk, wave_s; };
__device__ __forceinline__ int tid_now(int wave_s, int z) { return wave_s * 64 + (int)__builtin_amdgcn_mbcnt_hi(~0u, __builtin_amdgcn_mbcnt_lo(~0u, (unsigned)z)); }
typedef const float* const __attribute__((address_space(4)))* ptrtab_t;
struct PV { ptrtab_t tab; float* out; unsigned char* ws;
    __device__ __forceinline__ const float* inp(int i) const { return tab[i]; } };
constexpr int NT = 512, NWV = 8;
extern __shared__ __attribute__((aligned(16))) unsigned char dyn_smem[];
constexpr int LDS_BYTES = 131072;

__device__ __forceinline__ bf16_t f2bf(float f) { unsigned u = __float_as_uint(f); u += 0x7fffu + ((u >> 16) & 1u); return (bf16_t)(u >> 16); }
__device__ __forceinline__ float bf2f(bf16_t b) { return __uint_as_float(((unsigned)b) << 16); }
__device__ __forceinline__ unsigned pack2bf(float a, float b) { unsigned r; asm("v_cvt_pk_bf16_f32 %0, %1, %2" : "=v"(r) : "v"(a), "v"(b)); return r; }
__device__ __forceinline__ float wsum(float v) {
#pragma unroll
    for (int o = 32; o > 0; o >>= 1) v += __shfl_xor(v, o);
    return v;
}
__device__ __forceinline__ float sigmoidf_(float x) { return 1.0f / (1.0f + __expf(-x)); }
template <int CTRL> __device__ __forceinline__ float dppf(float v) { return __int_as_float(__builtin_amdgcn_update_dpp(0, __float_as_int(v), CTRL, 0xF, 0xF, true)); }
__device__ __forceinline__ float red8(float v) { v += dppf<0xB1>(v); v += dppf<0x4E>(v); v += dppf<0x141>(v); return v; }

__device__ __forceinline__ int grow_of(int pass, int lt) { return lt < 8192 ? pass * 8192 + lt : 16384 + pass * 32768 + (lt - 8192); }
__device__ __forceinline__ int brow_of(int pass, int lt) { return lt < 8192 ? pass : 2 + pass * 8 + ((lt - 8192) >> 12); }
__device__ __forceinline__ int pos_of(int lt) { return lt < 8192 ? lt : ((lt - 8192) & 4095); }
__device__ __forceinline__ int seqbase_of(int sq) { return sq == 0 ? 0 : 8192 + (sq - 1) * 4096; }
__device__ __forceinline__ int seqlen_of(int sq) { return sq == 0 ? 8192 : 4096; }

__device__ __forceinline__ bf16_t* wl(const PV& P, int layer) { return (bf16_t*)(P.ws + WS_W) + (size_t)layer * WL_TOTAL; }

template <int NJ, bool SWAP>
__device__ __forceinline__ void gemm_core(const Ctx& C, f32x4 (&acc)[4][NJ], const bf16_t* __restrict__ A, int lda, const bf16_t* __restrict__ B, int ldb, int K, unsigned char* smem) {
    const int tid = C.tid & 255, lane = tid & 63, wave = tid >> 6, wm = wave >> 1, wn = wave & 1, fr = lane & 15, fq = lane >> 4;
    smem += (C.tid >> 8) * 36864;
    u32x4 ra[4], rb[NJ];
#pragma unroll
    for (int i = 0; i < 4; ++i)
#pragma unroll
        for (int j = 0; j < NJ; ++j) acc[i][j] = (f32x4){0.f, 0.f, 0.f, 0.f};
    const int lrow = tid >> 3, lkc = (tid & 7) * 8;
#pragma unroll
    for (int i = 0; i < 4; ++i) ra[i] = *(const u32x4*)(A + (size_t)(lrow + 32 * i) * lda + lkc);
#pragma unroll
    for (int i = 0; i < NJ; ++i) rb[i] = *(const u32x4*)(B + (size_t)(lrow + 32 * i) * ldb + lkc);
    for (int k0 = 0; k0 < K; k0 += 64) {
        __syncthreads();
#pragma unroll
        for (int i = 0; i < 4; ++i) *(u32x4*)(smem + (lrow + 32 * i) * 144 + lkc * 2) = ra[i];
#pragma unroll
        for (int i = 0; i < NJ; ++i) *(u32x4*)(smem + 18432 + (lrow + 32 * i) * 144 + lkc * 2) = rb[i];
        __syncthreads();
        if (k0 + 64 < K) {
#pragma unroll
            for (int i = 0; i < 4; ++i) ra[i] = *(const u32x4*)(A + (size_t)(lrow + 32 * i) * lda + k0 + 64 + lkc);
#pragma unroll
            for (int i = 0; i < NJ; ++i) rb[i] = *(const u32x4*)(B + (size_t)(lrow + 32 * i) * ldb + k0 + 64 + lkc);
        }
#pragma unroll
        for (int ks = 0; ks < 2; ++ks) {
            bf16x8 af[4], bfr[NJ];
#pragma unroll
            for (int i = 0; i < 4; ++i) af[i] = *(const bf16x8*)(smem + (wm * 64 + i * 16 + fr) * 144 + (ks * 32 + fq * 8) * 2);
#pragma unroll
            for (int j = 0; j < NJ; ++j) bfr[j] = *(const bf16x8*)(smem + 18432 + (wn * NJ * 16 + j * 16 + fr) * 144 + (ks * 32 + fq * 8) * 2);
#pragma unroll
            for (int i = 0; i < 4; ++i)
#pragma unroll
                for (int j = 0; j < NJ; ++j)
                    acc[i][j] = SWAP ? __builtin_amdgcn_mfma_f32_16x16x32_bf16(bfr[j], af[i], acc[i][j], 0, 0, 0)
                                     : __builtin_amdgcn_mfma_f32_16x16x32_bf16(af[i], bfr[j], acc[i][j], 0, 0, 0);
        }
    }
}


namespace g256 {
constexpr int BK = 64, HALF = 128, HT = HALF * BK;
__device__ __forceinline__ int lds_byte(int r, int c) { int st = (r >> 4) * 2 + (c >> 5), rr = r & 15, cc = c & 31, ob = rr * 64 + cc * 2; return st * 1024 + (ob ^ (((ob >> 9) & 1) << 5)); }
__device__ __forceinline__ void stage_rc(unsigned b, unsigned& R, unsigned& Cc) { const unsigned st = b >> 10, sb = b & 1023u, swz = sb ^ (((sb >> 9) & 1u) << 5); R = (st >> 1) * 16u + (swz >> 6); Cc = (st & 1u) * 32u + ((swz & 63u) >> 1); }
}
__device__ __forceinline__ void gemm256(const Ctx& C, f32x4 (&acc)[2][2][4][2], const bf16_t* __restrict__ A, const bf16_t* __restrict__ Bt, const int K, const int brow, const int bcol) {
    using namespace g256;
    bf16_t* shm = (bf16_t*)dyn_smem;
    const int tidx = C.tid;
    #define SA(b,h) (shm+((b)*2+(h))*HT)
    #define SB(b,h) (shm+(4+(b)*2+(h))*HT)
    #define STAGE(Pp,BASE,br,kt) do{const char* _ub=(const char*)((BASE)+(long)(br)*K+(long)(kt)*BK); asm volatile("" : "+s"(_ub)); \
        __builtin_amdgcn_global_load_lds((const unsigned*)(_ub+goff0), \
          (__attribute__((address_space(3))) unsigned*)((__attribute__((address_space(3))) char*)(Pp)+tidx*16),16,0,0); \
        __builtin_amdgcn_global_load_lds((const unsigned*)(_ub+goff1), \
          (__attribute__((address_space(3))) unsigned*)((__attribute__((address_space(3))) char*)(Pp)+tidx*16+8192),16,0,0);}while(0)
    #define LDA(dst,b,h) for(int m=0;m<4;++m)for(int k=0;k<2;++k) \
      dst[m][k]=*reinterpret_cast<const bf16x8*>(a_ptr+((b)*2+(h))*16384+m*2048+k*1024)
    #define LDB(dst,b,h) for(int n=0;n<2;++n)for(int k=0;k<2;++k) \
      dst[n][k]=*reinterpret_cast<const bf16x8*>(b_ptr+((b)*2+(h))*16384+n*2048+k*1024)
    #define MMA(ai,bj,Atx,Btx) do{__builtin_amdgcn_s_setprio(1); \
      for(int m=0;m<4;++m)for(int n=0;n<2;++n)for(int k=0;k<2;++k) \
        acc[ai][bj][m][n]=__builtin_amdgcn_mfma_f32_16x16x32_bf16(Btx[n][k],Atx[m][k],acc[ai][bj][m][n],0,0,0); \
      __builtin_amdgcn_s_setprio(0);}while(0)
    #define WAIT_V(n) asm volatile("s_waitcnt vmcnt(" #n ")":::"memory")
    #define WAIT_L(n) asm volatile("s_waitcnt lgkmcnt(" #n ")":::"memory")
    #define BAR __builtin_amdgcn_s_barrier()
    #define SCHED __builtin_amdgcn_sched_barrier(0)
    const int wid = tidx >> 6, lane = tidx & 63, wr = wid >> 2, wc = wid & 3, fr = lane & 15, fq = lane >> 4;
    const int swz = (fr * 64 + fq * 16) ^ ((fr >> 3) << 5);
    const char* a_ptr = (const char*)dyn_smem + wr * 8192 + swz;
    const char* b_ptr = (const char*)dyn_smem + 65536 + wc * 4096 + swz;
#pragma unroll
    for (int a = 0; a < 2; ++a)
#pragma unroll
        for (int b = 0; b < 2; ++b)
#pragma unroll
            for (int m = 0; m < 4; ++m) { acc[a][b][m][0] = (f32x4){0.f, 0.f, 0.f, 0.f}; acc[a][b][m][1] = (f32x4){0.f, 0.f, 0.f, 0.f}; }
    bf16x8 At[4][2], B0[2][2], B1[2][2];
    const int nt = K / BK;
    unsigned goff0, goff1;
    { unsigned r0, c0, r1, c1; stage_rc((unsigned)tidx * 16u, r0, c0); stage_rc((unsigned)tidx * 16u + 8192u, r1, c1); goff0 = (r0 * (unsigned)K + c0) * 2u; goff1 = (r1 * (unsigned)K + c1) * 2u; }
    WAIT_V(0); __syncthreads();
    STAGE(SB(0,0),Bt,bcol,0); STAGE(SA(0,0),A,brow,0);
    STAGE(SB(0,1),Bt,bcol+HALF,0); STAGE(SA(0,1),A,brow+HALF,0);
    if(wr==1)BAR;
    WAIT_V(4); BAR;
    STAGE(SB(1,0),Bt,bcol,1); STAGE(SA(1,0),A,brow,1); STAGE(SB(1,1),Bt,bcol+HALF,1);
    WAIT_V(6); BAR;
    for(int t=0;t<nt-2;t+=2){
      LDB(B0,0,0); SCHED; LDA(At,0,0); STAGE(SA(1,1),A,brow+HALF,t+1);
      WAIT_L(8); BAR; WAIT_L(0); MMA(0,0,At,B0); BAR; SCHED;
      LDB(B1,0,1); STAGE(SB(0,0),Bt,bcol,t+2);
      BAR; WAIT_L(0); MMA(0,1,At,B1); BAR;
      LDA(At,0,1); STAGE(SA(0,0),A,brow,t+2);
      BAR; WAIT_L(0); MMA(1,0,At,B0); BAR; SCHED;
      STAGE(SB(0,1),Bt,bcol+HALF,t+2);
      WAIT_V(6); BAR; MMA(1,1,At,B1); BAR;
      LDB(B0,1,0); SCHED; LDA(At,1,0); STAGE(SA(0,1),A,brow+HALF,t+2);
      WAIT_L(8); BAR; WAIT_L(0); MMA(0,0,At,B0); BAR; SCHED;
      LDB(B1,1,1); STAGE(SB(1,0),Bt,bcol,t+3);
      BAR; WAIT_L(0); MMA(0,1,At,B1); BAR;
      LDA(At,1,1); STAGE(SA(1,0),A,brow,t+3);
      BAR; WAIT_L(0); MMA(1,0,At,B0); BAR; SCHED;
      STAGE(SB(1,1),Bt,bcol+HALF,t+3);
      WAIT_V(6); BAR; MMA(1,1,At,B1); BAR;
    }
    { LDB(B0,0,0); LDA(At,0,0); STAGE(SA(1,1),A,brow+HALF,nt-1);
      BAR; WAIT_L(0); MMA(0,0,At,B0); BAR;
      LDB(B1,0,1); BAR; WAIT_L(0); MMA(0,1,At,B1); BAR;
      LDA(At,0,1); WAIT_V(4); BAR; WAIT_L(0); MMA(1,0,At,B0); MMA(1,1,At,B1); BAR; }
    { LDB(B0,1,0); LDA(At,1,0); WAIT_V(2); BAR; WAIT_L(0); MMA(0,0,At,B0); BAR;
      LDB(B1,1,1); WAIT_V(0); BAR; WAIT_L(0); MMA(0,1,At,B1); BAR;
      LDA(At,1,1); BAR; WAIT_L(0); MMA(1,0,At,B0); MMA(1,1,At,B1); BAR; }
    if(wr==0)BAR;
    #undef SA
    #undef SB
    #undef STAGE
    #undef LDA
    #undef LDB
    #undef MMA
    #undef WAIT_V
    #undef WAIT_L
    #undef BAR
    #undef SCHED
}
__device__ __forceinline__ bool tile_order(int i, int G, int c, int nM, int nN, int& pm, int& pn) {
    const int nwg = nM * nN; const long L = (long)i * G + c; if (L >= nwg) return false;
    int wgid = (int)L; { const int q = nwg / 8, r = nwg % 8, xcd = wgid % 8, off = wgid / 8; wgid = (xcd < r ? xcd * (q + 1) : r * (q + 1) + (xcd - r) * q) + off; }
    const int nig = 8 * nN, gid = wgid / nig, fm = gid * 8, gsz = (nM - fm) < 8 ? (nM - fm) : 8;
    pm = fm + ((wgid % nig) % gsz); pn = (wgid % nig) / gsz; return true;
}

struct ConvJob { const float* src; int ld, K, nbegin, ncount, map; bf16_t* dst; };
__device__ __forceinline__ ConvJob conv_job(const PV& P, int j) {
    const int l = j >> 4, q = j & 15; bf16_t* W = wl(P, l); ConvJob c; c.map = 0; c.nbegin = 0;
    switch (q) {
        case 0: c.src = P.inp(8) + (size_t)l * 1024 * 5632; c.ld = 5632; c.K = 1024; c.ncount = 5632; c.dst = W + OW_FA_IN; c.map = 1; break;
        case 1: c.src = P.inp(9) + (size_t)l * 2816 * 1024; c.ld = 1024; c.K = 2816; c.ncount = 1024; c.dst = W + OW_FA_OUT; break;
        case 2: c.src = P.inp(10) + (size_t)l * 1024 * 5632; c.ld = 5632; c.K = 1024; c.ncount = 5632; c.dst = W + OW_FB_IN; c.map = 1; break;
        case 3: c.src = P.inp(11) + (size_t)l * 2816 * 1024; c.ld = 1024; c.K = 2816; c.ncount = 1024; c.dst = W + OW_FB_OUT; break;
        case 4: c.src = P.inp(12) + (size_t)l * 1024 * 8576; c.ld = 8576; c.K = 1024; c.ncount = 3456; c.dst = W + OW_WIN; break;
        case 5: c.src = P.inp(12) + (size_t)l * 1024 * 8576; c.ld = 8576; c.K = 1024; c.nbegin = 3968; c.ncount = 4608; c.dst = W + OW_WIN + (size_t)3968 * 1024; break;
        case 6: case 7: case 8: case 9: { const int n = q - 6; c.src = P.inp(27) + (size_t)(l * 4 + n) * 512 * 1024; c.ld = 1024; c.K = 512; c.ncount = 1024; c.dst = W + OW_WBR + (size_t)n * 1024 * 512; } break;
        case 10: c.src = P.inp(28) + (size_t)l * 1024 * 1024; c.ld = 1024; c.K = 1024; c.ncount = 1024; c.dst = W + OW_WOUT; break;
        case 11: case 12: { const int d = q - 11; c.src = P.inp(15) + (size_t)(l * 2 + d) * 64 * 512; c.ld = 512; c.K = 64; c.ncount = 512; c.dst = W + OW_W2T + (size_t)d * 512 * 64; } break;
        case 13: case 14: { const int d = q - 13; c.src = P.inp(17) + (size_t)(l * 2 + d) * 64 * 512; c.ld = 512; c.K = 64; c.ncount = 512; c.dst = W + OW_A2T + (size_t)d * 512 * 64; } break;
        default: c.src = P.inp(18) + (size_t)l * 128 * 512; c.ld = 512; c.K = 128; c.ncount = 512; c.dst = W + OW_G2T; break;
    }
    return c;
}

__device__ __forceinline__ void prep_phase(const Ctx& C, const PV& P, unsigned char* smem) {
    const int tid = C.tid;
    {
        int total = 0;
        for (int j = 0; j < 32; ++j) { ConvJob c = conv_job(P, j); total += (c.K >> 6) * (c.ncount >> 6); }
        float* tile = (float*)smem;
        const int tx = tid & 63, ty = tid >> 6;
        for (int t = C.bid; t < total; t += C.nblk) {
            int tt = t, j = 0; ConvJob c = conv_job(P, 0);
            for (;;) { const int n = (c.K >> 6) * (c.ncount >> 6); if (tt < n) break; tt -= n; ++j; c = conv_job(P, j); }
            const int nkt = c.K >> 6, kt = tt % nkt, nt = tt / nkt, k0 = kt * 64, n0 = nt * 64;
            int col = c.nbegin + n0 + tx;
            if (c.map) { const int np = n0 + tx, blk = np >> 5, w = np & 31, f = blk * 16 + (w & 15); col = (w < 16) ? f : 2816 + f; }
            __syncthreads();
#pragma unroll 4
            for (int i = 0; i < 8; ++i) { const int kk = ty + 8 * i; tile[kk * 65 + tx] = c.src[(size_t)(k0 + kk) * c.ld + col]; }
            __syncthreads();
#pragma unroll 4
            for (int i = 0; i < 8; ++i) { const int nn = ty + 8 * i; c.dst[(size_t)(n0 + nn) * c.K + k0 + tx] = f2bf(tile[tx * 65 + nn]); }
        }
        __syncthreads();
    }
    {
        float* wt = (float*)smem;
        float* cosT = (float*)(smem + 64 * 129 * 4);
        for (int it = C.bid; it < 2 * 4 * 16; it += C.nblk) {
            const int l = it >> 6, g = (it >> 4) & 3, kc = it & 15, k0 = kc * 64;
            const float* src = P.inp(12) + (size_t)l * 1024 * 8576 + 3456 + g * 128;
            __syncthreads();
            for (int e = tid; e < 64 * 128; e += NT) { const int kk = e >> 7, c = e & 127; wt[kk * 129 + c] = src[(size_t)(k0 + kk) * 8576 + c]; }
            if (tid < 128) cosT[tid] = cospif((float)tid * (1.0f / 64.0f));
            __syncthreads();
            bf16_t* dst = wl(P, l) + OW_WIN + (size_t)(3456 + g * 128) * 1024;
            const int kk = tid & 63;
            for (int i = 0; i < 16; ++i) {
                const int j2 = (tid >> 6) + 8 * i, cc = j2 >> 1, part = j2 & 1;
                float s = 0.f;
                if (cc == 0) {
                    if (part == 0) { for (int c = 0; c < 128; ++c) s += wt[kk * 129 + c]; }
                    else { for (int c = 0; c < 128; ++c) s += (c & 1) ? -wt[kk * 129 + c] : wt[kk * 129 + c]; }
                } else if (part == 0) {
                    for (int c = 0; c < 128; ++c) s += wt[kk * 129 + c] * cosT[(cc * c) & 127];
                } else {
                    for (int c = 0; c < 128; ++c) s -= wt[kk * 129 + c] * cosT[(cc * c - 32) & 127];
                }
                dst[(size_t)j2 * 1024 + k0 + kk] = f2bf(s);
            }
        }
        __syncthreads();
    }
    if (C.bid == 0 && tid < 16) ((unsigned*)(P.ws + WS_CTR))[tid] = 0u;
    {
        float2* tw = (float2*)(P.ws + WS_TW);
        for (int m = C.bid * NT + tid; m < 4096; m += C.nblk * NT) { const float x = (float)m * (1.0f / 4096.0f); tw[m] = make_float2(cospif(x), -sinpif(x)); }
    }
    {
        float* sc = (float*)smem;
        float* red = (float*)(smem + 18 * 512 * 4);
        float* mod = (float*)(P.ws + WS_MOD);
        for (int it = C.bid; it < 2 * 144; it += C.nblk) {
            const int l = it / 144, n0 = (it % 144) * 64, nl = tid & 63, ks = tid >> 6;
            const float* aw = P.inp(4) + (size_t)l * 1024 * 9216;
            float acc[18];
#pragma unroll
            for (int b = 0; b < 18; ++b) acc[b] = 0.f;
            for (int half = 0; half < 2; ++half) {
                __syncthreads();
                for (int e = tid; e < 18 * 512; e += NT) {
                    const int b = e >> 9, kk = e & 511, k = half * 512 + kk;
                    const float cv = b < 2 ? P.inp(2)[b * 1024 + k] : P.inp(3)[(b - 2) * 1024 + k];
                    sc[e] = cv / (1.0f + __expf(-cv));
                }
                __syncthreads();
                for (int kk = ks * 64; kk < ks * 64 + 64; ++kk) {
                    const float w = aw[(size_t)(half * 512 + kk) * 9216 + n0 + nl];
#pragma unroll
                    for (int b = 0; b < 18; ++b) acc[b] += sc[b * 512 + kk] * w;
                }
            }
            __syncthreads();
#pragma unroll
            for (int b = 0; b < 18; ++b) red[(ks * 18 + b) * 64 + nl] = acc[b];
            __syncthreads();
            for (int e = tid; e < 18 * 64; e += NT) {
                const int b = e >> 6, n = e & 63;
                float s = 0.f;
#pragma unroll
                for (int k8 = 0; k8 < 8; ++k8) s += red[(k8 * 18 + b) * 64 + n];
                mod[((size_t)l * 18 + b) * 9216 + n0 + n] = s + P.inp(5)[(size_t)l * 9216 + n0 + n];
            }
        }
        __syncthreads();
    }
}

__device__ __forceinline__ void norm_phase(const Ctx& C, const PV& P, int pass, const float* lng, const float* lnb, int mod_layer, int j, bool from_input) {
    const int lane = C.tid & 63, wave = C.tid >> 6;
    bf16_t* hmod = (bf16_t*)(P.ws + WS_HMOD);
    const float* mod = (const float*)(P.ws + WS_MOD);
    const int nw = C.nblk * NWV;
    for (int lt0 = C.bid * NWV + wave; lt0 < TP; lt0 += 2 * nw) {
        f32x4 v[2][4]; int gr[2], bb[2]; bool ok[2];
#pragma unroll
        for (int u = 0; u < 2; ++u) {
            const int lt = lt0 + u * nw; ok[u] = lt < TP;
            const int ltc = ok[u] ? lt : lt0;
            gr[u] = grow_of(pass, ltc); bb[u] = brow_of(pass, ltc);
            const float* src = from_input ? (gr[u] < 16384 ? P.inp(0) + (size_t)gr[u] * 1024 : P.inp(1) + (size_t)(gr[u] - 16384) * 1024) : P.out + (size_t)gr[u] * 1024;
#pragma unroll
            for (int i = 0; i < 4; ++i) v[u][i] = *(const f32x4*)(src + i * 256 + lane * 4);
        }
        if (lng) {
            float s[2], q[2], mu[2], rs[2];
#pragma unroll
            for (int u = 0; u < 2; ++u) { s[u] = 0.f;
#pragma unroll
                for (int i = 0; i < 4; ++i) s[u] += (v[u][i][0] + v[u][i][1]) + (v[u][i][2] + v[u][i][3]); }
#pragma unroll
            for (int o = 32; o > 0; o >>= 1) { s[0] += __shfl_xor(s[0], o); s[1] += __shfl_xor(s[1], o); }
#pragma unroll
            for (int u = 0; u < 2; ++u) { mu[u] = s[u] * (1.0f / 1024.0f); q[u] = 0.f;
#pragma unroll
                for (int i = 0; i < 4; ++i) { const f32x4 dd = v[u][i] - mu[u]; q[u] += (dd[0] * dd[0] + dd[1] * dd[1]) + (dd[2] * dd[2] + dd[3] * dd[3]); } }
#pragma unroll
            for (int o = 32; o > 0; o >>= 1) { q[0] += __shfl_xor(q[0], o); q[1] += __shfl_xor(q[1], o); }
#pragma unroll
            for (int u = 0; u < 2; ++u) rs[u] = rsqrtf(q[u] * (1.0f / 1024.0f) + 1e-5f);
#pragma unroll
            for (int i = 0; i < 4; ++i) {
                const f32x4 g = *(const f32x4*)(lng + i * 256 + lane * 4), be = *(const f32x4*)(lnb + i * 256 + lane * 4);
                v[0][i] = (v[0][i] - mu[0]) * rs[0] * g + be; v[1][i] = (v[1][i] - mu[1]) * rs[1] * g + be;
            }
        }
        if (lng || from_input) {
#pragma unroll
            for (int u = 0; u < 2; ++u) if (ok[u]) {
#pragma unroll
                for (int i = 0; i < 4; ++i) *(f32x4*)(P.out + (size_t)gr[u] * 1024 + i * 256 + lane * 4) = v[u][i];
            }
        }
        if (j >= 0) {
            float s[2], q[2], mu[2], rs[2];
#pragma unroll
            for (int u = 0; u < 2; ++u) { s[u] = 0.f;
#pragma unroll
                for (int i = 0; i < 4; ++i) s[u] += (v[u][i][0] + v[u][i][1]) + (v[u][i][2] + v[u][i][3]); }
#pragma unroll
            for (int o = 32; o > 0; o >>= 1) { s[0] += __shfl_xor(s[0], o); s[1] += __shfl_xor(s[1], o); }
#pragma unroll
            for (int u = 0; u < 2; ++u) { mu[u] = s[u] * (1.0f / 1024.0f); q[u] = 0.f;
#pragma unroll
                for (int i = 0; i < 4; ++i) { const f32x4 dd = v[u][i] - mu[u]; q[u] += (dd[0] * dd[0] + dd[1] * dd[1]) + (dd[2] * dd[2] + dd[3] * dd[3]); } }
#pragma unroll
            for (int o = 32; o > 0; o >>= 1) { q[0] += __shfl_xor(q[0], o); q[1] += __shfl_xor(q[1], o); }
#pragma unroll
            for (int u = 0; u < 2; ++u) {
                rs[u] = rsqrtf(q[u] * (1.0f / 1024.0f) + 1e-5f);
                if (!ok[u]) continue;
                const float* mb = mod + ((size_t)mod_layer * 18 + bb[u]) * 9216 + (size_t)(3 * j) * 1024;
                const int lt = lt0 + u * nw;
#pragma unroll
                for (int i = 0; i < 4; ++i) {
                    const f32x4 sh = *(const f32x4*)(mb + i * 256 + lane * 4), scl = *(const f32x4*)(mb + 1024 + i * 256 + lane * 4);
                    const f32x4 hh = (v[u][i] - mu[u]) * rs[u] * (1.0f + scl) + sh;
                    u32x2 o; o.x = pack2bf(hh[0], hh[1]); o.y = pack2bf(hh[2], hh[3]);
                    *(u32x2*)(hmod + (size_t)lt * 1024 + i * 256 + lane * 4) = o;
                }
            }
        }
    }
}

__device__ __forceinline__ void ffn_up_phase(const Ctx& C, const PV& P, const bf16_t* Wt) {
    const bf16_t* hmod = (const bf16_t*)(P.ws + WS_HMOD);
    bf16_t* act = (bf16_t*)(P.ws + WS_R + R_ACT);
    int pm, pn;
    for (int it = 0; tile_order(it, C.nblk, C.bid, TP / 256, 22, pm, pn); ++it) {
        f32x4 acc[2][2][4][2];
        gemm256(C, acc, hmod, Wt, 1024, pm * 256, pn * 256);
        int z2 = 0; asm volatile("" : "+s"(z2));
        const int tid2 = tid_now(C.wave_s, z2), lane = tid2 & 63, wid = tid2 >> 6, wr = wid >> 2, wc = wid & 3, fr = lane & 15, fq = lane >> 4;
#pragma unroll
        for (int ai = 0; ai < 2; ++ai)
#pragma unroll
            for (int m = 0; m < 4; ++m) {
                const int row = pm * 256 + ai * 128 + wr * 64 + m * 16 + fr;
#pragma unroll
                for (int bj = 0; bj < 2; ++bj) {
                    const int colbase = pn * 256 + bj * 128 + wc * 32, f = (colbase >> 5) * 16 + fq * 4;
                    const f32x4 a = acc[ai][bj][m][0], bb = acc[ai][bj][m][1];
                    float o[4];
#pragma unroll
                    for (int r = 0; r < 4; ++r) o[r] = a[r] / (1.0f + __expf(-a[r])) * bb[r];
                    u32x2 w; w.x = pack2bf(o[0], o[1]); w.y = pack2bf(o[2], o[3]);
                    *(u32x2*)(act + (size_t)row * 2816 + f) = w;
                }
            }
    }
}

__device__ __forceinline__ void resid_gemm_phase(const Ctx& C, const PV& P, int pass, const bf16_t* A, int K, const bf16_t* Wt, int layer, int j, float scale) {
    const float* mod = (const float*)(P.ws + WS_MOD);
    int pm, pn;
    for (int it = 0; tile_order(it, C.nblk, C.bid, TP / 256, 4, pm, pn); ++it) {
        f32x4 acc[2][2][4][2];
        gemm256(C, acc, A, Wt, K, pm * 256, pn * 256);
        int z2 = 0; asm volatile("" : "+s"(z2));
        const int tid2 = tid_now(C.wave_s, z2), lane = tid2 & 63, wid = tid2 >> 6, wr = wid >> 2, wc = wid & 3, fr = lane & 15, fq = lane >> 4;
#pragma unroll
        for (int ai = 0; ai < 2; ++ai)
#pragma unroll
            for (int m = 0; m < 4; ++m) {
                const int lt = pm * 256 + ai * 128 + wr * 64 + m * 16 + fr;
                const int gr = grow_of(pass, lt), b = brow_of(pass, lt);
                const float* gate = mod + ((size_t)layer * 18 + b) * 9216 + (size_t)(3 * j + 2) * 1024;
#pragma unroll
                for (int bj = 0; bj < 2; ++bj)
#pragma unroll
                    for (int n = 0; n < 2; ++n) {
                        const int col = pn * 256 + bj * 128 + wc * 32 + n * 16 + fq * 4;
                        f32x4* xp = (f32x4*)(P.out + (size_t)gr * 1024 + col);
                        const f32x4 x = *xp, g = *(const f32x4*)(gate + col);
                        *xp = ALPHA * x + (1.0f + g) * scale * acc[ai][bj][m][n];
                    }
            }
    }
}

__device__ __forceinline__ void win_phase(const Ctx& C, const PV& P, int layer) {
    const bf16_t* hmod = (const bf16_t*)(P.ws + WS_HMOD);
    const bf16_t* Wt = wl(P, layer) + OW_WIN;
    unsigned char* R = P.ws + WS_R;
    f16* raw = (f16*)(R + R_RAW); bf16_t* Qb = (bf16_t*)(R + R_Q); bf16_t* Kb = (bf16_t*)(R + R_K); bf16_t* Vt = (bf16_t*)(R + R_VT);
    f16* Zc = (f16*)(R + R_ZC); f16* poolp = (f16*)(R + R_POOLP);
    typedef f16 f16x4 __attribute__((ext_vector_type(4)));
    typedef f16 f16x2 __attribute__((ext_vector_type(2)));
    int pm, pn;
    for (int it = 0; tile_order(it, C.nblk, C.bid, TP / 256, 18, pm, pn); ++it) {
        const int lt_t = pm * 256, sq = lt_t < 8192 ? 0 : 1 + ((lt_t - 8192) >> 12), lt0 = seqbase_of(sq), S = seqlen_of(sq);
        f32x4 acc[2][2][4][2];
        gemm256(C, acc, hmod, Wt, 1024, pm * 256, pn * 256);
        int z2 = 0; asm volatile("" : "+s"(z2));
        const int tid2 = tid_now(C.wave_s, z2), lane = tid2 & 63, wid = tid2 >> 6, wr = wid >> 2, wc = wid & 3, fr = lane & 15, fq = lane >> 4;
#pragma unroll
        for (int bj = 0; bj < 2; ++bj) {
            const int tn = pn * 2 + bj;
            if (tn >= 35) continue;
#pragma unroll
            for (int ai = 0; ai < 2; ++ai)
#pragma unroll
                for (int m = 0; m < 4; ++m) {
                    const int lt = pm * 256 + ai * 128 + wr * 64 + m * 16 + fr, pos = lt - lt0;
#pragma unroll
                    for (int n = 0; n < 2; ++n) {
                        const int col = tn * 128 + wc * 32 + n * 16 + fq * 4;
                        f32x4 v = acc[ai][bj][m][n];
                        if (tn < 15) {
                            f16x4 h; h[0] = (f16)v[0]; h[1] = (f16)v[1]; h[2] = (f16)v[2]; h[3] = (f16)v[3];
                            *(f16x4*)(raw + (size_t)lt * 1920 + col) = h;
                        } else if (tn < 23) {
                            const int nq = (col - 1920) & 511, hc = nq >> 6, d = nq & 63;
                            if (n == 0 && (wc & 1) == 0) {
#pragma unroll
                                for (int r = 0; r < 4; ++r) {
                                    const float invlo = r == 0 ? 1.0f : r == 1 ? 0.1939227432012558f : r == 2 ? 0.03760603070259094f : 0.007292664609849453f;
                                    const float invhi = r == 0 ? 0.0014142135623842478f : r == 1 ? 0.00027424818836152554f : r == 2 ? 5.3182957344688475e-05f : 1.0313385246263351e-05f;
                                    const float ang = (float)pos * ((fq & 1) ? invhi : invlo);
                                    const float hi = ang * 0.15915493667125702f;
                                    const float lo = __builtin_fmaf(ang, 0.15915493667125702f, -hi) + ang * 6.4206382432985265e-09f;
                                    const float rr = (hi - floorf(hi)) + lo;
                                    const float cs = __builtin_amdgcn_cosf(rr), sn = __builtin_amdgcn_sinf(rr);
                                    const float other = __shfl_xor(v[r], 32);
                                    v[r] = (fq < 2) ? (v[r] * cs - other * sn) : (other * sn + v[r] * cs);
                                }
                            }
                            bf16_t* dst = (tn < 19) ? Qb : Kb;
                            const float sc = (tn < 19) ? 0.125f * 1.44269504088896f : 1.0f;
                            u32x2 w; w.x = pack2bf(v[0] * sc, v[1] * sc); w.y = pack2bf(v[2] * sc, v[3] * sc);
                            *(u32x2*)(dst + (size_t)lt0 * 512 + ((size_t)hc * S + pos) * 64 + d) = w;
                        } else if (tn < 27) {
                            const int nv = col - 2944;
                            bf16_t* vb = Vt + (size_t)lt0 * 512 + (size_t)nv * S + pos;
                            vb[0] = f2bf(v[0]); vb[(size_t)S] = f2bf(v[1]); vb[(size_t)2 * S] = f2bf(v[2]); vb[(size_t)3 * S] = f2bf(v[3]);
                        } else if (tn < 31) {
                            const int nz = col - 3456, g = nz >> 7, cc = (nz & 127) >> 1;
                            f16x2 z0, z1; z0[0] = (f16)v[0]; z0[1] = (f16)v[1]; z1[0] = (f16)v[2]; z1[1] = (f16)v[3];
                            f16x2* zb = (f16x2*)Zc + (size_t)lt0 * 256;
                            zb[(size_t)(g * 64 + cc) * S + pos] = z0;
                            zb[(size_t)(g * 64 + cc + 1) * S + pos] = z1;
                        } else {
                            f16x4 h; h[0] = (f16)v[0]; h[1] = (f16)v[1]; h[2] = (f16)v[2]; h[3] = (f16)v[3];
                            *(f16x4*)(poolp + (size_t)lt * 512 + (col - 3968)) = h;
                        }
                    }
                    asm volatile("" ::: "memory");
                }
        }
    }
}

__device__ __forceinline__ float shiftv(const f16* __restrict__ raw, int lt, int t, int S, int col, float mu) {
    const float p = (float)raw[(size_t)lt * 1920 + col];
    const float pr = t > 0 ? (float)raw[(size_t)(lt - 1) * 1920 + col] : 0.f;
    const float nx = t < S - 1 ? (float)raw[(size_t)(lt + 1) * 1920 + col] : 0.f;
    return p + (0.5f * (pr + nx) - p) * mu;
}

typedef f16 f16x4_t __attribute__((ext_vector_type(4)));
typedef f16 f16x8_t __attribute__((ext_vector_type(8)));
__device__ __forceinline__ void lin_pool_phase(const Ctx& C, const PV& P, int layer) {
    unsigned char* R = P.ws + WS_R;
    const f16* raw = (const f16*)(R + R_RAW); bf16_t* lin = (bf16_t*)(R + R_LIN);
    const f16* poolp = (const f16*)(R + R_POOLP); bf16_t* ypool = (bf16_t*)(R + R_YB) + 3 * SZ512;
    const float* mu = P.inp(13) + (size_t)layer * 1920; const float* pscale = P.inp(26) + (size_t)layer * 512;
    const int gsz = C.nblk * NT, gid = C.bid * NT + C.tid;
    for (int e = gid; e < TP * 96; e += gsz) {
        const int lt = e / 96, c = (e % 96) * 4, col = 1536 + c;
        const int pos = pos_of(lt), S = lt < 8192 ? 8192 : 4096;
        const f16x4_t p0 = *(const f16x4_t*)(raw + (size_t)lt * 1920 + col);
        const f16x4_t pm = *(const f16x4_t*)(raw + (size_t)(pos > 0 ? lt - 1 : lt) * 1920 + col);
        const f16x4_t pp = *(const f16x4_t*)(raw + (size_t)(pos < S - 1 ? lt + 1 : lt) * 1920 + col);
        const f32x4 m4 = *(const f32x4*)(mu + col);
        const float wm = pos > 0 ? 0.5f : 0.f, wp = pos < S - 1 ? 0.5f : 0.f;
        float o[4];
#pragma unroll
        for (int r = 0; r < 4; ++r) {
            const float p = (float)p0[r];
            float v = p + (wm * (float)pm[r] + wp * (float)pp[r] - p) * m4[r];
            if (c < 128) v = 1.0f - 2.0f / (__expf(2.0f * v) + 1.0f);
            else if (c >= 256) v = sigmoidf_(v);
            o[r] = v;
        }
        u32x2 w; w.x = pack2bf(o[0], o[1]); w.y = pack2bf(o[2], o[3]);
        *(u32x2*)(lin + (size_t)lt * 384 + c) = w;
    }
    for (int e = gid; e < TP * 128; e += gsz) {
        const int lt = e >> 7, c = (e & 127) * 4, g = c >> 7, half = 1 << g;
        const int pos = pos_of(lt), S = lt < 8192 ? 8192 : 4096;
        const int lo = max(pos - half, 0), hi = min(pos + half, S);
        const f16* base = poolp + (size_t)(lt - pos) * 512 + c;
        float s0 = 0.f, s1 = 0.f, s2 = 0.f, s3 = 0.f;
#pragma unroll
        for (int o = -8; o < 8; ++o) {
            const int tt = pos + o;
            const bool in = (o >= -half) && (o < half) && tt >= 0 && tt < S;
            if (in) { const f16x4_t v = *(const f16x4_t*)(base + (size_t)tt * 512); s0 += (float)v[0]; s1 += (float)v[1]; s2 += (float)v[2]; s3 += (float)v[3]; }
        }
        const f16x4_t x = *(const f16x4_t*)(base + (size_t)pos * 512);
        const f32x4 ps = *(const f32x4*)(pscale + c);
        const float ic = 1.0f / (float)(hi - lo);
        u32x2 w; w.x = pack2bf((s0 * ic - (float)x[0]) * ps[0], (s1 * ic - (float)x[1]) * ps[1]); w.y = pack2bf((s2 * ic - (float)x[2]) * ps[2], (s3 * ic - (float)x[3]) * ps[3]);
        *(u32x2*)(ypool + (size_t)lt * 512 + c) = w;
    }
    {
        float* invn = (float*)(P.ws + WS_INVN);
        const float* k_k = P.inp(19) + (size_t)layer * 512;
        const int lane = C.tid & 63, wave = C.tid >> 6;
        for (int lt = C.bid * NWV + wave; lt < TP; lt += C.nblk * NWV) {
            const int pos = pos_of(lt), S = lt < 8192 ? 8192 : 4096;
            float ss[8];
#pragma unroll
            for (int h = 0; h < 8; ++h) {
                const int c = h * 64 + lane;
                const float k = shiftv(raw, lt, pos, S, 512 + c, mu[512 + c]) * k_k[c];
                ss[h] = k * k;
            }
#pragma unroll
            for (int h = 0; h < 8; ++h) ss[h] = wsum(ss[h]);
            if (lane < 8) {
                float sel = ss[0];
#pragma unroll
                for (int h = 1; h < 8; ++h) sel = lane == h ? ss[h] : sel;
                invn[(size_t)lt * 8 + lane] = 1.0f / fmaxf(sqrtf(sel), 1e-12f);
            }
        }
    }
}

__device__ __forceinline__ void lora_phase(const Ctx& C, const PV& P, int layer, unsigned char* smem) {
    unsigned char* R = P.ws + WS_R;
    const bf16_t* lin = (const bf16_t*)(R + R_LIN); f16* wa = (f16*)(R + R_WA); f16* gbuf = (f16*)(R + R_G);
    const bf16_t* W = wl(P, layer);
    const int lane = C.tid & 63, wave = (C.tid >> 6) & 3, wm = wave >> 1, wn = wave & 1, fr = lane & 15, fq = lane >> 4;
    for (int t2 = C.bid; t2 < 5 * MT * 2; t2 += C.nblk) {
        const int t = t2 * 2 + (C.tid >> 8);
        const int which = t / (MT * 4), tt = t % (MT * 4), tm = tt >> 2, tn = tt & 3;
        const bf16_t* Bt; int K, acol; const float* bias = nullptr; f16* dst;
        if (which < 2) { Bt = W + OW_W2T + (size_t)which * 512 * 64; K = 64; acol = which * 64; bias = P.inp(14) + (size_t)(layer * 2 + which) * 512; dst = wa + (size_t)which * SZ512; }
        else if (which < 4) { const int d = which - 2; Bt = W + OW_A2T + (size_t)d * 512 * 64; K = 64; acol = 128 + d * 64; bias = P.inp(16) + (size_t)(layer * 2 + d) * 512; dst = wa + (size_t)which * SZ512; }
        else { Bt = W + OW_G2T; K = 128; acol = 256; dst = gbuf; }
        f32x4 acc[4][4];
        gemm_core<4, true>(C, acc, lin + (size_t)tm * 128 * 384 + acol, 384, Bt + (size_t)tn * 128 * K, K, K, smem);
#pragma unroll
        for (int i = 0; i < 4; ++i) {
            const int lt = tm * 128 + wm * 64 + i * 16 + fr;
#pragma unroll
            for (int jn = 0; jn < 4; ++jn) {
                const int n = tn * 128 + wn * 64 + jn * 16 + fq * 4;
                typedef f16 f16x4 __attribute__((ext_vector_type(4)));
                f16x4 h;
#pragma unroll
                for (int r = 0; r < 4; ++r) {
                    float v = acc[i][jn][r];
                    if (which < 2) {
                        const float z = bias[n + r] + v;
                        v = __expf(-0.6065306597126334f * sigmoidf_(z));
                    } else if (which < 4) { v = sigmoidf_(bias[n + r] + v); }
                    h[r] = (f16)v;
                }
                *(f16x4*)(dst + (size_t)lt * 512 + n) = h;
            }
        }
    }
}

__device__ __forceinline__ void attn_items(const Ctx& C, const PV& P, int layer, int ctr_idx, unsigned char* smem) {
    unsigned char* R = P.ws + WS_R;
    const bf16_t* Qall = (const bf16_t*)(R + R_Q); const bf16_t* Kall = (const bf16_t*)(R + R_K); const bf16_t* Vall = (const bf16_t*)(R + R_VT);
    bf16_t* ydiff = (bf16_t*)(R + R_YB) + 1 * SZ512;
    const int tid = C.tid, lane = tid & 63, wave = tid >> 6, comp = wave & 1, rg = wave >> 1, fr = lane & 15, fq = lane >> 4;
    const float lam_init = layer == 0 ? 0.2f : (0.8f - 0.6f * 0.7408182206817179f);
    float lam_full;
    {
        const float* lm = P.inp(24) + (size_t)layer * 256;
        float s1 = 0.f, s2 = 0.f;
        for (int i = 0; i < 64; ++i) { s1 += lm[i] * lm[64 + i]; s2 += lm[128 + i] * lm[192 + i]; }
        lam_full = expf(s1) - expf(s2) + lam_init;
    }
    const float* normg = P.inp(25) + (size_t)layer * 128;
    unsigned* ctr = (unsigned*)(P.ws + WS_CTR) + ctr_idx;
    volatile unsigned* bc = (volatile unsigned*)(smem + 131056);
    for (;;) {
        __syncthreads();
        if (tid == 0) *bc = atomicAdd(ctr, 1u);
        __syncthreads();
        const int item = (int)*bc;
        if (item >= 1280) break;
        int sq, h, qb;
        if (item < 256) { sq = 0; h = item >> 6; qb = item & 63; } else { const int i2 = item - 256; sq = 1 + (i2 >> 7); h = (i2 >> 5) & 3; qb = i2 & 31; }
        const int lt0 = seqbase_of(sq), S = seqlen_of(sq);
        const bf16_t* Qb = Qall + (size_t)lt0 * 512; const bf16_t* Kb = Kall + (size_t)lt0 * 512; const bf16_t* Vb = Vall + (size_t)lt0 * 512 + (size_t)h * 128 * S;
        const int q0 = qb * 128 + rg * 32;
        bf16x8 bq[2][2];
#pragma unroll
        for (int qs = 0; qs < 2; ++qs)
#pragma unroll
            for (int ks = 0; ks < 2; ++ks) bq[qs][ks] = *(const bf16x8*)(Qb + ((size_t)(h * 2 + comp) * S + q0 + qs * 16 + fr) * 64 + ks * 32 + fq * 8);
        float m_run[2] = {-1e30f, -1e30f}, l_run[2] = {0.f, 0.f};
        f32x4 O[8][2];
#pragma unroll
        for (int a = 0; a < 8; ++a) { O[a][0] = (f32x4){0.f, 0.f, 0.f, 0.f}; O[a][1] = (f32x4){0.f, 0.f, 0.f, 0.f}; }
        u32x4 rk[2], rv[2];
        const int lrow = tid >> 3, lkc = (tid & 7) * 8;
#pragma unroll
        for (int i = 0; i < 2; ++i) {
            const int row = lrow + 64 * i, cm = row >> 6, key = row & 63;
            rk[i] = *(const u32x4*)(Kb + ((size_t)(h * 2 + cm) * S + key) * 64 + lkc);
            rv[i] = *(const u32x4*)(Vb + (size_t)row * S + lkc);
        }
        for (int kt0 = 0; kt0 < S; kt0 += 64) {
            __syncthreads();
#pragma unroll
            for (int i = 0; i < 2; ++i) {
                const int row = lrow + 64 * i;
                *(u32x4*)(smem + row * 144 + lkc * 2) = rk[i];
                *(u32x4*)(smem + 18432 + row * 144 + lkc * 2) = rv[i];
            }
            __syncthreads();
            if (kt0 + 64 < S) {
#pragma unroll
                for (int i = 0; i < 2; ++i) {
                    const int row = lrow + 64 * i, cm = row >> 6, key = row & 63;
                    rk[i] = *(const u32x4*)(Kb + ((size_t)(h * 2 + cm) * S + kt0 + 64 + key) * 64 + lkc);
                    rv[i] = *(const u32x4*)(Vb + (size_t)row * S + kt0 + 64 + lkc);
                }
            }
            f32x4 st[4][2];
#pragma unroll
            for (int t = 0; t < 4; ++t) {
                st[t][0] = (f32x4){0.f, 0.f, 0.f, 0.f}; st[t][1] = (f32x4){0.f, 0.f, 0.f, 0.f};
#pragma unroll
                for (int ks = 0; ks < 2; ++ks) {
                    const bf16x8 kf = *(const bf16x8*)(smem + (comp * 64 + t * 16 + fr) * 144 + (ks * 32 + fq * 8) * 2);
                    st[t][0] = __builtin_amdgcn_mfma_f32_16x16x32_bf16(kf, bq[0][ks], st[t][0], 0, 0, 0);
                    st[t][1] = __builtin_amdgcn_mfma_f32_16x16x32_bf16(kf, bq[1][ks], st[t][1], 0, 0, 0);
                }
            }
            bf16x8 pb[2][2];
#pragma unroll
            for (int qs = 0; qs < 2; ++qs) {
                float mx = -1e30f;
#pragma unroll
                for (int t = 0; t < 4; ++t)
#pragma unroll
                    for (int r = 0; r < 4; ++r) mx = fmaxf(mx, st[t][qs][r]);
                mx = fmaxf(mx, __shfl_xor(mx, 16)); mx = fmaxf(mx, __shfl_xor(mx, 32));
                const float mnew = fmaxf(m_run[qs], mx);
                const float alpha = __builtin_amdgcn_exp2f(m_run[qs] - mnew);
                m_run[qs] = mnew;
                float ls = 0.f;
                float pv[4][4];
#pragma unroll
                for (int t = 0; t < 4; ++t)
#pragma unroll
                    for (int r = 0; r < 4; ++r) { pv[t][r] = __builtin_amdgcn_exp2f(st[t][qs][r] - mnew); ls += pv[t][r]; }
                l_run[qs] = l_run[qs] * alpha + ls;
                if (__builtin_amdgcn_ballot_w64(alpha != 1.0f) != 0ull) {
#pragma unroll
                    for (int a = 0; a < 8; ++a) O[a][qs] = O[a][qs] * alpha;
                }
#pragma unroll
                for (int u = 0; u < 2; ++u) {
                    union { bf16x8 v; unsigned w[4]; } pk;
                    pk.w[0] = pack2bf(pv[2 * u][0], pv[2 * u][1]); pk.w[1] = pack2bf(pv[2 * u][2], pv[2 * u][3]);
                    pk.w[2] = pack2bf(pv[2 * u + 1][0], pv[2 * u + 1][1]); pk.w[3] = pack2bf(pv[2 * u + 1][2], pv[2 * u + 1][3]);
                    pb[qs][u] = pk.v;
                }
            }
#pragma unroll
            for (int u = 0; u < 2; ++u)
#pragma unroll
                for (int a = 0; a < 8; ++a) {
                    union { bf16x8 v; uint2 h[2]; } vf;
                    vf.h[0] = *(const uint2*)(smem + 18432 + (a * 16 + fr) * 144 + (u * 32 + fq * 4) * 2);
                    vf.h[1] = *(const uint2*)(smem + 18432 + (a * 16 + fr) * 144 + (u * 32 + 16 + fq * 4) * 2);
                    O[a][0] = __builtin_amdgcn_mfma_f32_16x16x32_bf16(vf.v, pb[0][u], O[a][0], 0, 0, 0);
                    O[a][1] = __builtin_amdgcn_mfma_f32_16x16x32_bf16(vf.v, pb[1][u], O[a][1], 0, 0, 0);
                }
        }
#pragma unroll
        for (int qs = 0; qs < 2; ++qs) {
            float l = l_run[qs]; l += __shfl_xor(l, 16); l += __shfl_xor(l, 32);
            const float inv = 1.0f / l;
#pragma unroll
            for (int a = 0; a < 8; ++a) O[a][qs] = O[a][qs] * inv;
        }
        __syncthreads();
        float* Ox = (float*)smem;
        if (comp == 1) {
#pragma unroll
            for (int qs = 0; qs < 2; ++qs)
#pragma unroll
                for (int a = 0; a < 8; ++a)
#pragma unroll
                    for (int r = 0; r < 4; ++r) Ox[(rg * 128 + a * 16 + fq * 4 + r) * 32 + qs * 16 + fr] = O[a][qs][r];
        }
        __syncthreads();
        if (comp == 0) {
#pragma unroll
            for (int qs = 0; qs < 2; ++qs) {
                float ss = 0.f;
#pragma unroll
                for (int a = 0; a < 8; ++a)
#pragma unroll
                    for (int r = 0; r < 4; ++r) {
                        const float o = O[a][qs][r] - lam_full * Ox[(rg * 128 + a * 16 + fq * 4 + r) * 32 + qs * 16 + fr];
                        O[a][qs][r] = o; ss += o * o;
                    }
                ss += __shfl_xor(ss, 16); ss += __shfl_xor(ss, 32);
                const float sc = rsqrtf(ss * (1.0f / 128.0f) + 1e-5f) * (1.0f - lam_init);
                const int lt = lt0 + q0 + qs * 16 + fr;
#pragma unroll
                for (int a = 0; a < 8; ++a) {
                    const int dv = a * 16 + fq * 4;
                    const float4 g = *(const float4*)(normg + dv);
                    uint2 w; w.x = pack2bf(O[a][qs][0] * sc * g.x, O[a][qs][1] * sc * g.y); w.y = pack2bf(O[a][qs][2] * sc * g.z, O[a][qs][3] * sc * g.w);
                    *(uint2*)(ydiff + (size_t)lt * 512 + h * 128 + dv) = w;
                }
            }
        }
    }
    __syncthreads();
}

__device__ __forceinline__ void fft_items(const Ctx& C, const PV& P, unsigned char* smem) {
    unsigned char* R = P.ws + WS_R;
    typedef f16 f16x2 __attribute__((ext_vector_type(2)));
    const f16x2* Zall = (const f16x2*)(R + R_ZC);
    bf16_t* yf = (bf16_t*)(R + R_YB) + 2 * SZ512;
    const float2* tw = (const float2*)(P.ws + WS_TW);
    float2* sm = (float2*)smem;
    const int tid = C.tid;
    for (int item = C.bid; item < NSEQ * 256; item += C.nblk) {
        const int sq = item >> 8, col = item & 255, g = col >> 6, cc = col & 63;
        const int lt0 = seqbase_of(sq), S = seqlen_of(sq), lg = sq == 0 ? 13 : 12;
        const f16x2* z = Zall + (size_t)lt0 * 256 + (size_t)col * S;
        __syncthreads();
        for (int s = tid; s < S; s += NT) { const f16x2 v = z[s]; sm[__brev((unsigned)s) >> (32 - lg)] = make_float2((float)v[0], (float)v[1]); }
        __syncthreads();
        for (int st = 0; st < lg; ++st) {
            const int half = 1 << st, tshift = 12 - st;
            for (int b = tid; b < (S >> 1); b += NT) {
                const int j = b & (half - 1), i0 = ((b >> st) << (st + 1)) + j, i1 = i0 + half;
                const float2 w = tw[j << tshift], u = sm[i0], x = sm[i1];
                const float2 tv = make_float2(w.x * x.x - w.y * x.y, w.x * x.y + w.y * x.x);
                sm[i0] = make_float2(u.x + tv.x, u.y + tv.y); sm[i1] = make_float2(u.x - tv.x, u.y - tv.y);
            }
            __syncthreads();
        }
        const float nrm = rsqrtf((float)S * 128.0f);
        for (int k = tid; k < S; k += NT) {
            const float2 a = sm[k], b = sm[(S - k) & (S - 1)];
            bf16_t* row = yf + (size_t)(lt0 + k) * 512 + g * 128;
            if (cc == 0) { row[0] = f2bf(0.5f * (a.x + b.x) * nrm); row[64] = f2bf(0.5f * (a.y + b.y) * nrm); }
            else { row[cc] = f2bf(a.x * nrm); row[128 - cc] = f2bf(b.x * nrm); }
        }
    }
    __syncthreads();
}

typedef float f32x2 __attribute__((ext_vector_type(2)));
template <int KT>
__device__ __forceinline__ void scan_block(const Ctx& C, const PV& P, int layer, int sq, int h, int d, int row0, unsigned char* smem) {
    constexpr int TPR = 64 / KT, ROWS = NT / TPR, CH = 16, YP = TPR / 4, NV = ROWS / 32;
    unsigned char* R = P.ws + WS_R;
    const f16* raw = (const f16*)(R + R_RAW); const f16* wa = (const f16*)(R + R_WA); f16* yfb = (f16*)(R + R_YFB);
    const float* invn = (const float*)(P.ws + WS_INVN);
    const float* mu = P.inp(13) + (size_t)layer * 1920; const float* k_k = P.inp(19) + (size_t)layer * 512; const float* k_a = P.inp(20) + (size_t)layer * 512;
    const int tid = C.tid, row = tid / TPR, q = tid % TPR;
    const int lt0 = seqbase_of(sq), S = seqlen_of(sq);
    const int ch = tid & 63, c = h * 64 + ch;
    const float mu_r = mu[c], mu_k = mu[512 + c], kkw = k_k[c], kaw = k_a[c];
    const int vr = (ROWS == 32) ? (tid & 31) : (tid & 63);
    const int vcol = 1024 + h * 64 + row0 + vr; const float mu_v = mu[vcol];
    const f16* wdec = wa + (size_t)d * SZ512; const f16* aact = wa + (size_t)(2 + d) * SZ512;
    f16* ydst = yfb + (size_t)d * SZ512;
    f32x2 s[KT / 2];
#pragma unroll
    for (int j = 0; j < KT / 2; ++j) s[j] = (f32x2){0.f, 0.f};
    f16 pr_[2][3], pk_[2][3], pa_[2], pw_[2], pv_[NV][3]; float pn_[2];
    auto prefetch = [&](int c0) {
#pragma unroll
        for (int j = 0; j < 2; ++j) {
            const int i = (tid >> 6) + 8 * j, tstep = c0 + i, t = d == 0 ? tstep : S - 1 - tstep, lt = lt0 + t;
            const int tm = t > 0 ? lt - 1 : lt, tp = t < S - 1 ? lt + 1 : lt;
            pr_[j][0] = raw[(size_t)tm * 1920 + c]; pr_[j][1] = raw[(size_t)lt * 1920 + c]; pr_[j][2] = raw[(size_t)tp * 1920 + c];
            pk_[j][0] = raw[(size_t)tm * 1920 + 512 + c]; pk_[j][1] = raw[(size_t)lt * 1920 + 512 + c]; pk_[j][2] = raw[(size_t)tp * 1920 + 512 + c];
            pa_[j] = aact[(size_t)lt * 512 + c]; pw_[j] = wdec[(size_t)lt * 512 + c]; pn_[j] = invn[(size_t)lt * 8 + h];
        }
#pragma unroll
        for (int j = 0; j < NV; ++j) {
            const int i = (ROWS == 32) ? (tid >> 5) : ((tid >> 6) + 8 * j), tstep = c0 + i, t = d == 0 ? tstep : S - 1 - tstep, lt = lt0 + t;
            const int tm = t > 0 ? lt - 1 : lt, tp = t < S - 1 ? lt + 1 : lt;
            pv_[j][0] = raw[(size_t)tm * 1920 + vcol]; pv_[j][1] = raw[(size_t)lt * 1920 + vcol]; pv_[j][2] = raw[(size_t)tp * 1920 + vcol];
        }
    };
    auto stage = [&](int c0, unsigned char* buf) {
        float* vec = (float*)buf; float* vbuf = (float*)(buf + 20480);
#pragma unroll
        for (int j = 0; j < 2; ++j) {
            const int i = (tid >> 6) + 8 * j, tstep = c0 + i, t = d == 0 ? tstep : S - 1 - tstep;
            const float rm = t > 0 ? (float)pr_[j][0] : 0.f, rp = t < S - 1 ? (float)pr_[j][2] : 0.f, km = t > 0 ? (float)pk_[j][0] : 0.f, kp = t < S - 1 ? (float)pk_[j][2] : 0.f;
            const float r1 = (float)pr_[j][1], k1 = (float)pk_[j][1];
            const float r = r1 + (0.5f * (rm + rp) - r1) * mu_r;
            const float k = k1 + (0.5f * (km + kp) - k1) * mu_k;
            const float kk = k * kkw * pn_[j], a = (float)pa_[j];
            vec[(0 * CH + i) * 64 + ch] = kk;
            vec[(1 * CH + i) * 64 + ch] = (float)pw_[j];
            vec[(2 * CH + i) * 64 + ch] = kk * a;
            vec[(3 * CH + i) * 64 + ch] = k * (1.0f + (a - 1.0f) * kaw);
            vec[(4 * CH + i) * 64 + ch] = r;
        }
#pragma unroll
        for (int j = 0; j < NV; ++j) {
            const int i = (ROWS == 32) ? (tid >> 5) : ((tid >> 6) + 8 * j), tstep = c0 + i, t = d == 0 ? tstep : S - 1 - tstep;
            const float vm = t > 0 ? (float)pv_[j][0] : 0.f, vp = t < S - 1 ? (float)pv_[j][2] : 0.f, v1 = (float)pv_[j][1];
            vbuf[i * 64 + vr] = v1 + (0.5f * (vm + vp) - v1) * mu_v;
        }
    };
    __syncthreads();
    prefetch(0);
    stage(0, smem);
    __syncthreads();
    const int nch = S / CH;
    for (int cix = 0; cix < nch; ++cix) {
        unsigned char* buf = smem + (cix & 1) * 32768;
        if (cix + 1 < nch) prefetch((cix + 1) * CH);
        {
            const float* vec = (const float*)buf; const float* vbuf = (const float*)(buf + 20480); float* ybuf = (float*)(buf + 24576);
            const f32x4* vp0 = (const f32x4*)(vec + q * KT);
            f32x4 nx[5][KT / 4]; float nvv;
#pragma unroll
            for (int u = 0; u < KT / 4; ++u)
#pragma unroll
                for (int a5 = 0; a5 < 5; ++a5) nx[a5][u] = vp0[a5 * CH * 16 + u];
            nvv = vbuf[row];
            float yv[CH];
#pragma unroll
            for (int i = 0; i < CH; ++i) {
                f32x2 kk2[KT / 2], w2[KT / 2], b2[KT / 2], kd2[KT / 2], r2[KT / 2];
#pragma unroll
                for (int u = 0; u < KT / 4; ++u) {
                    kk2[2 * u] = (f32x2){nx[0][u][0], nx[0][u][1]}; kk2[2 * u + 1] = (f32x2){nx[0][u][2], nx[0][u][3]};
                    w2[2 * u] = (f32x2){nx[1][u][0], nx[1][u][1]}; w2[2 * u + 1] = (f32x2){nx[1][u][2], nx[1][u][3]};
                    b2[2 * u] = (f32x2){nx[2][u][0], nx[2][u][1]}; b2[2 * u + 1] = (f32x2){nx[2][u][2], nx[2][u][3]};
                    kd2[2 * u] = (f32x2){nx[3][u][0], nx[3][u][1]}; kd2[2 * u + 1] = (f32x2){nx[3][u][2], nx[3][u][3]};
                    r2[2 * u] = (f32x2){nx[4][u][0], nx[4][u][1]}; r2[2 * u + 1] = (f32x2){nx[4][u][2], nx[4][u][3]};
                }
                const float vv = nvv;
                if (i + 1 < CH) {
#pragma unroll
                    for (int u = 0; u < KT / 4; ++u)
#pragma unroll
                        for (int a5 = 0; a5 < 5; ++a5) nx[a5][u] = vp0[(i + 1) * 16 + a5 * CH * 16 + u];
                    nvv = vbuf[(i + 1) * 64 + row];
                }
                f32x2 acc2 = s[0] * kk2[0];
#pragma unroll
                for (int j = 1; j < KT / 2; ++j) acc2 = __builtin_elementwise_fma(s[j], kk2[j], acc2);
                float sa = acc2[0] + acc2[1];
                sa += dppf<0xB1>(sa); sa += dppf<0x4E>(sa); sa += dppf<0x141>(sa);
                if (TPR == 16) sa += dppf<0x140>(sa);
                sa = -sa;
                const f32x2 sa2 = (f32x2){sa, sa}, vv2 = (f32x2){vv, vv};
                f32x2 y2 = (f32x2){0.f, 0.f};
#pragma unroll
                for (int j = 0; j < KT / 2; ++j) {
                    s[j] = __builtin_elementwise_fma(s[j], w2[j], __builtin_elementwise_fma(sa2, b2[j], vv2 * kd2[j]));
                    y2 = __builtin_elementwise_fma(s[j], r2[j], y2);
                }
                float y = y2[0] + y2[1];
                y += dppf<0xB1>(y); y += dppf<0x4E>(y);
                yv[i] = y;
            }
            if ((q & 3) == 0) {
#pragma unroll
                for (int i = 0; i < CH; ++i) ybuf[i * 128 + row * YP + (q >> 2)] = yv[i];
            }
        }
        if (cix + 1 < nch) stage((cix + 1) * CH, smem + ((cix + 1) & 1) * 32768);
        __syncthreads();
        {
            const float* ybuf = (const float*)(buf + 24576);
#pragma unroll
            for (int j = 0; j < NV; ++j) {
                const int i = (ROWS == 32) ? (tid >> 5) : ((tid >> 6) + 8 * j), rr = vr, tstep = cix * CH + i, t = d == 0 ? tstep : S - 1 - tstep;
                float y = 0.f;
#pragma unroll
                for (int p = 0; p < YP; ++p) y += ybuf[i * 128 + rr * YP + p];
                ydst[(size_t)(lt0 + t) * 512 + h * 64 + row0 + rr] = (f16)y;
            }
        }
    }
    __syncthreads();
}

__device__ __forceinline__ void finish_phase(const Ctx& C, const PV& P, int layer) {
    unsigned char* R = P.ws + WS_R;
    const f16* raw = (const f16*)(R + R_RAW); const f16* wa = (const f16*)(R + R_WA); const f16* gbuf = (const f16*)(R + R_G); const f16* yfb = (const f16*)(R + R_YFB);
    bf16_t* yr = (bf16_t*)(R + R_YB);
    const float* mu = P.inp(13) + (size_t)layer * 1920; const float* k_a = P.inp(20) + (size_t)layer * 512; const float* r_k = P.inp(21) + (size_t)layer * 512;
    const float* lg = P.inp(22) + (size_t)layer * 512; const float* lb = P.inp(23) + (size_t)layer * 512;
    const int lane = C.tid & 63, wave = C.tid >> 6, c = lane * 8;
    for (int lt = C.bid * NWV + wave; lt < TP; lt += C.nblk * NWV) {
        const int pos = pos_of(lt), S = lt < 8192 ? 8192 : 4096;
        const size_t rm = (size_t)(pos > 0 ? lt - 1 : lt) * 1920, r0 = (size_t)lt * 1920, rp = (size_t)(pos < S - 1 ? lt + 1 : lt) * 1920;
        const float wm = pos > 0 ? 0.5f : 0.f, wp = pos < S - 1 ? 0.5f : 0.f;
        const f16x8_t rA = *(const f16x8_t*)(raw + rm + c), rB = *(const f16x8_t*)(raw + r0 + c), rC = *(const f16x8_t*)(raw + rp + c);
        const f16x8_t kA = *(const f16x8_t*)(raw + rm + 512 + c), kB = *(const f16x8_t*)(raw + r0 + 512 + c), kC = *(const f16x8_t*)(raw + rp + 512 + c);
        const f16x8_t vA = *(const f16x8_t*)(raw + rm + 1024 + c), vB = *(const f16x8_t*)(raw + r0 + 1024 + c), vC = *(const f16x8_t*)(raw + rp + 1024 + c);
        const f16x8_t af = *(const f16x8_t*)(wa + 2 * SZ512 + (size_t)lt * 512 + c), ab = *(const f16x8_t*)(wa + 3 * SZ512 + (size_t)lt * 512 + c);
        const f16x8_t gg = *(const f16x8_t*)(gbuf + (size_t)lt * 512 + c);
        const f16x8_t yF = *(const f16x8_t*)(yfb + (size_t)lt * 512 + c), yB = *(const f16x8_t*)(yfb + SZ512 + (size_t)lt * 512 + c);
        float y[8], vv[8], bsum = 0.f, ysum = 0.f;
#pragma unroll
        for (int j = 0; j < 8; ++j) {
            const float r_ = (float)rB[j], k_ = (float)kB[j], v_ = (float)vB[j];
            const float r = r_ + (wm * (float)rA[j] + wp * (float)rC[j] - r_) * mu[c + j];
            const float k = k_ + (wm * (float)kA[j] + wp * (float)kC[j] - k_) * mu[512 + c + j];
            vv[j] = v_ + (wm * (float)vA[j] + wp * (float)vC[j] - v_) * mu[1024 + c + j];
            const float ka = k_a[c + j];
            const float ksum = k * (1.f + ((float)af[j] - 1.f) * ka) + k * (1.f + ((float)ab[j] - 1.f) * ka);
            bsum += r * (0.5f * ksum) * r_k[c + j];
            y[j] = (float)yF[j] + (float)yB[j]; ysum += y[j];
        }
        const float ym = red8(ysum) * (1.0f / 64.0f);
        float q = 0.f;
#pragma unroll
        for (int j = 0; j < 8; ++j) { const float dy = y[j] - ym; q += dy * dy; }
        const float rs = rsqrtf(red8(q) * (1.0f / 64.0f) + 64e-5f);
        const float bonus = red8(bsum);
        float o[8];
#pragma unroll
        for (int j = 0; j < 8; ++j) o[j] = ((y[j] - ym) * rs * lg[c + j] + lb[c + j] + bonus * vv[j]) * (float)gg[j];
        u32x4 w; w.x = pack2bf(o[0], o[1]); w.y = pack2bf(o[2], o[3]); w.z = pack2bf(o[4], o[5]); w.w = pack2bf(o[6], o[7]);
        *(u32x4*)(yr + (size_t)lt * 512 + c) = w;
    }
}

__device__ __forceinline__ void gates_phase(const Ctx& C, const PV& P, int layer) {
    const bf16_t* hmod = (const bf16_t*)(P.ws + WS_HMOD);
    const bf16_t* Wt = wl(P, layer) + OW_WIN + (size_t)4480 * 1024;
    bf16_t* gates = (bf16_t*)(P.ws + WS_R + R_GATES);
    int pm, pn;
    for (int it = 0; tile_order(it, C.nblk, C.bid, TP / 256, 16, pm, pn); ++it) {
        f32x4 acc[2][2][4][2];
        gemm256(C, acc, hmod, Wt, 1024, pm * 256, pn * 256);
        int z2 = 0; asm volatile("" : "+s"(z2));
        const int tid2 = tid_now(C.wave_s, z2), lane = tid2 & 63, wid = tid2 >> 6, wr = wid >> 2, wc = wid & 3, fr = lane & 15, fq = lane >> 4;
#pragma unroll
        for (int ai = 0; ai < 2; ++ai)
#pragma unroll
            for (int m = 0; m < 4; ++m) {
                const int lt = pm * 256 + ai * 128 + wr * 64 + m * 16 + fr;
#pragma unroll
                for (int bj = 0; bj < 2; ++bj)
#pragma unroll
                    for (int n = 0; n < 2; ++n) {
                        const int col = pn * 256 + bj * 128 + wc * 32 + n * 16 + fq * 4;
                        const f32x4 v = acc[ai][bj][m][n];
                        u32x2 w; w.x = pack2bf(sigmoidf_(v[0]), sigmoidf_(v[1])); w.y = pack2bf(sigmoidf_(v[2]), sigmoidf_(v[3]));
                        *(u32x2*)(gates + (size_t)lt * 4096 + col) = w;
                    }
            }
    }
}
__device__ __forceinline__ void branch_phase(const Ctx& C, const PV& P, int layer) {
    unsigned char* R = P.ws + WS_R;
    const bf16_t* yb = (const bf16_t*)(R + R_YB); const bf16_t* gates = (const bf16_t*)(R + R_GATES);
    float* m32 = (float*)(R + R_M32); bf16_t* merged = (bf16_t*)(R + R_MERGED);
    const bf16_t* W = wl(P, layer) + OW_WBR;
    int pm, pn;
    for (int it = 0; tile_order(it, C.nblk, C.bid, TP / 256, 4, pm, pn); ++it) {
        for (int nb = 0; nb < 4; ++nb) {
            f32x4 acc[2][2][4][2];
            gemm256(C, acc, yb + (size_t)nb * SZ512, W + (size_t)nb * 1024 * 512, 512, pm * 256, pn * 256);
            int z2 = 0; asm volatile("" : "+s"(z2));
            const int tid2 = tid_now(C.wave_s, z2), lane = tid2 & 63, wid = tid2 >> 6, wr = wid >> 2, wc = wid & 3, fr = lane & 15, fq = lane >> 4;
#pragma unroll
            for (int ai = 0; ai < 2; ++ai)
#pragma unroll
                for (int m = 0; m < 4; ++m) {
                    const int lt = pm * 256 + ai * 128 + wr * 64 + m * 16 + fr;
#pragma unroll
                    for (int bj = 0; bj < 2; ++bj)
#pragma unroll
                        for (int n = 0; n < 2; ++n) {
                            const int col = pn * 256 + bj * 128 + wc * 32 + n * 16 + fq * 4;
                            const u32x2 gw = *(const u32x2*)(gates + (size_t)lt * 4096 + nb * 1024 + col);
                            f32x4 g; g[0] = __uint_as_float(gw.x << 16); g[1] = __uint_as_float(gw.x & 0xffff0000u); g[2] = __uint_as_float(gw.y << 16); g[3] = __uint_as_float(gw.y & 0xffff0000u);
                            f32x4 mv = g * acc[ai][bj][m][n];
                            f32x4* mp = (f32x4*)(m32 + (size_t)lt * 1024 + col);
                            if (nb > 0) mv += *mp;
                            if (nb < 3) *mp = mv;
                            else { u32x2 w; w.x = pack2bf(mv[0], mv[1]); w.y = pack2bf(mv[2], mv[3]); *(u32x2*)(merged + (size_t)lt * 1024 + col) = w; }
                        }
                    asm volatile("" ::: "memory");
                }
        }
    }
}

constexpr int PH_PER_LAYER = 15, PH_PER_PASS = 2 * PH_PER_LAYER + 1, NPHASE = 1 + NPASS * PH_PER_PASS;

__global__ void __launch_bounds__(512, 2) mk_forward(Params P0, int ph_lo, int ph_hi) {
    unsigned char* smem = dyn_smem;
    const int wave_s = __builtin_amdgcn_readfirstlane((int)threadIdx.x >> 6);
    for (int it_ = 2 * ph_lo; it_ < 2 * ph_hi; ++it_) {
        const int ph = it_ >> 1;
        if (it_ & 1) {
            if (PROBE_MASK == 0 || ph == 0) continue;
            const int r_ = (ph - 1) % PH_PER_PASS;
            if (r_ == PH_PER_PASS - 1 || !((PROBE_MASK >> (r_ % PH_PER_LAYER)) & 1)) continue;
        }
        if (it_ > 2 * ph_lo) cg::this_grid().sync();
        int z = 0; asm volatile("" : "+s"(z));
        Ctx C; C.tid = tid_now(wave_s, z); C.bid = (int)blockIdx.x + z; C.nblk = (int)gridDim.x + z; C.wave_s = wave_s;
        ptrtab_t tab = (ptrtab_t)__builtin_amdgcn_kernarg_segment_ptr();
        asm volatile("" : "+s"(tab));
        const PV P{tab, (float*)tab[29], (unsigned char*)tab[30]};
        if (ph == 0) { prep_phase(C, P, smem); continue; }
        const int q = ph - 1, pass = q / PH_PER_PASS, r = q % PH_PER_PASS;
        if (r == PH_PER_PASS - 1) { norm_phase(C, P, pass, P.inp(6) + (size_t)(1 * 3 + 2) * 1024, P.inp(7) + (size_t)(1 * 3 + 2) * 1024, 0, -1, false); continue; }
        const int layer = r / PH_PER_LAYER, lp = r % PH_PER_LAYER;
        const bf16_t* W = wl(P, layer);
        const float* lng = P.inp(6) + (size_t)layer * 3 * 1024; const float* lnb = P.inp(7) + (size_t)layer * 3 * 1024;
        unsigned char* R = P.ws + WS_R;
        switch (lp) {
            case 0:
                if (layer == 0) norm_phase(C, P, pass, nullptr, nullptr, 0, 0, true);
                else norm_phase(C, P, pass, P.inp(6) + (size_t)((layer - 1) * 3 + 2) * 1024, P.inp(7) + (size_t)((layer - 1) * 3 + 2) * 1024, layer, 0, false);
                break;
            case 1: ffn_up_phase(C, P, W + OW_FA_IN); break;
            case 2: resid_gemm_phase(C, P, pass, (const bf16_t*)(R + R_ACT), 2816, W + OW_FA_OUT, layer, 0, 0.5f); break;
            case 3: norm_phase(C, P, pass, lng, lnb, layer, 1, false); break;
            case 4: win_phase(C, P, layer); break;
            case 5: lin_pool_phase(C, P, layer); break;
            case 6: lora_phase(C, P, layer, smem); break;
            case 7:
                if (C.bid < 32) scan_block<4>(C, P, layer, 0, C.bid >> 2, (C.bid >> 1) & 1, (C.bid & 1) * 32, smem);
                else if (C.bid < 160) { const int i2 = C.bid - 32; scan_block<8>(C, P, layer, 1 + (i2 >> 4), (i2 >> 1) & 7, i2 & 1, 0, smem); }
                attn_items(C, P, layer, pass * 2 + layer, smem); fft_items(C, P, smem); break;
            case 8: finish_phase(C, P, layer); break;
            case 9: gates_phase(C, P, layer); break;
            case 10: branch_phase(C, P, layer); break;
            case 11: resid_gemm_phase(C, P, pass, (const bf16_t*)(R + R_MERGED), 1024, W + OW_WOUT, layer, 1, 1.0f); break;
            case 12: norm_phase(C, P, pass, lng + 1024, lnb + 1024, layer, 2, false); break;
            case 13: ffn_up_phase(C, P, W + OW_FB_IN); break;
            default: resid_gemm_phase(C, P, pass, (const bf16_t*)(R + R_ACT), 2816, W + OW_FB_OUT, layer, 2, 0.5f); break;
        }
    }
}

extern "C" void kernel_launch(void* const* d_in, const int* in_sizes, int n_in, void* d_out, int out_size, void* d_ws, size_t ws_size, hipStream_t stream) {
    static int grid_blocks = 0;
    if (!grid_blocks) {
        int dev = 0, cus = 0, per_cu = 0;
        (void)hipGetDevice(&dev);
        (void)hipDeviceGetAttribute(&cus, hipDeviceAttributeMultiprocessorCount, dev);
        (void)hipFuncSetAttribute((const void*)mk_forward, hipFuncAttributeMaxDynamicSharedMemorySize, LDS_BYTES);
        (void)hipOccupancyMaxActiveBlocksPerMultiprocessor(&per_cu, mk_forward, NT, LDS_BYTES);
        if (per_cu < 1) per_cu = 1;
        if (per_cu > 1) per_cu = 1;
        grid_blocks = cus * per_cu;
    }
    Params p{};
    for (int i = 0; i < 29; ++i) p.in[i] = (const float*)d_in[i];
    p.out = (float*)d_out; p.ws = (unsigned char*)d_ws;
#if ONE_LAUNCH
    int lo = 0, hi = NPHASE;
    void* args[] = {&p, &lo, &hi};
    hipError_t e = hipLaunchCooperativeKernel((void*)mk_forward, dim3(grid_blocks), dim3(NT), args, LDS_BYTES, stream);
    if (e != hipSuccess) fprintf(stderr, "cooperative launch failed: %s (grid %d)\n", hipGetErrorString(e), grid_blocks);
#else
    for (int ph = 0; ph < NPHASE; ++ph) {
        int lo = ph, hi = ph + 1;
        void* args[] = {&p, &lo, &hi};
        (void)hipLaunchCooperativeKernel((void*)mk_forward, dim3(grid_blocks), dim3(NT), args, LDS_BYTES, stream);
    }
#endif
}
```

```cpp
#include <hip/hip_runtime.h>
#include <hip/hip_cooperative_groups.h>
#include <cstdio>
#include <cstdint>
namespace cg = cooperative_groups;

typedef unsigned short bf16_t;
typedef _Float16 f16;
typedef short bf16x8 __attribute__((ext_vector_type(8)));
typedef float f32x4 __attribute__((ext_vector_type(4)));
typedef unsigned u32x4 __attribute__((ext_vector_type(4)));
typedef unsigned u32x2 __attribute__((ext_vector_type(2)));
typedef float f32x2 __attribute__((ext_vector_type(2)));

#ifndef ONE_LAUNCH
#define ONE_LAUNCH 1
#endif
#ifndef PROBE_MASK
#define PROBE_MASK 0
#endif

constexpr int TP = 40960;
constexpr int NPASS = 2;
constexpr int NSEQ = 9;
constexpr int MT = TP / 128;
constexpr int N_IN_FULL = 8576;
constexpr float ALPHA = 1.41421356237f;

constexpr size_t OW_FA_IN = 0, OW_FA_OUT = 5767168, OW_FB_IN = 8650752, OW_FB_OUT = 14417920, OW_WIN = 17301504,
                 OW_WBR = 26083328, OW_WOUT = 28180480, OW_W2T = 29229056, OW_A2T = 29294592, OW_G2T = 29360128, WL_TOTAL = 29425664;
constexpr size_t WS_W = 0, WS_TW = 117702656, WS_MOD = 117735424, WS_HMOD = 119062528, WS_R = 202948608, WS_INVN = 1062780928, WS_CTR = 1064091648, WS_STATS = 1064091904, WS_BAR = 1064419584;
constexpr size_t R_RAW = 0, R_LIN = 157286400, R_WA = 188743680, R_G = 356515840, R_Q = 398458880, R_K = 440401920, R_VT = 482344960,
                 R_YFB = 524288000, R_ZC = 608174080, R_POOLP = 650117120, R_YB = 692060160, R_ACT = 0,
                 R_GATES = 0  , R_M32 = 398458880  , R_MERGED = 566231040  ;
constexpr size_t SZ512 = (size_t)TP * 512;

struct Params { const float* in[29]; float* out; unsigned char* ws; };
struct Ctx { int tid, bid, nblk, wave_s; };
__device__ __forceinline__ int tid_now(int wave_s, int z) { return wave_s * 64 + (int)__builtin_amdgcn_mbcnt_hi(~0u, __builtin_amdgcn_mbcnt_lo(~0u, (unsigned)z)); }
typedef const float* const __attribute__((address_space(4)))* ptrtab_t;
struct PV { ptrtab_t tab; float* out; unsigned char* ws;
    __device__ __forceinline__ const float* inp(int i) const { return tab[i]; } };
constexpr int NT = 512, NWV = 8;
extern __shared__ __attribute__((aligned(16))) unsigned char dyn_smem[];
constexpr int LDS_BYTES = 131072 + 64;

__device__ __forceinline__ bf16_t f2bf(float f) { unsigned u = __float_as_uint(f); u += 0x7fffu + ((u >> 16) & 1u); return (bf16_t)(u >> 16); }
__device__ __forceinline__ float bf2f(bf16_t b) { return __uint_as_float(((unsigned)b) << 16); }
__device__ __forceinline__ unsigned pack2bf(float a, float b) { unsigned r; asm("v_cvt_pk_bf16_f32 %0, %1, %2" : "=v"(r) : "v"(a), "v"(b)); return r; }
__device__ __forceinline__ float wsum(float v) {
#pragma unroll
    for (int o = 32; o > 0; o >>= 1) v += __shfl_xor(v, o);
    return v;
}
__device__ __forceinline__ float sigmoidf_(float x) { return 1.0f / (1.0f + __expf(-x)); }
template <int CTRL> __device__ __forceinline__ float dppf(float v) { return __int_as_float(__builtin_amdgcn_update_dpp(0, __float_as_int(v), CTRL, 0xF, 0xF, true)); }
__device__ __forceinline__ float red8(float v) { v += dppf<0xB1>(v); v += dppf<0x4E>(v); v += dppf<0x141>(v); return v; }

__device__ __forceinline__ int grow_of(int pass, int lt) { return lt < 8192 ? pass * 8192 + lt : 16384 + pass * 32768 + (lt - 8192); }
__device__ __forceinline__ int brow_of(int pass, int lt) { return lt < 8192 ? pass : 2 + pass * 8 + ((lt - 8192) >> 12); }
__device__ __forceinline__ int pos_of(int lt) { return lt < 8192 ? lt : ((lt - 8192) & 4095); }
__device__ __forceinline__ int seqbase_of(int sq) { return sq == 0 ? 0 : 8192 + (sq - 1) * 4096; }
__device__ __forceinline__ int seqlen_of(int sq) { return sq == 0 ? 8192 : 4096; }

__device__ __forceinline__ bf16_t* wl(const PV& P, int layer) { return (bf16_t*)(P.ws + WS_W) + (size_t)layer * WL_TOTAL; }

template <int NJ, bool SWAP>
__device__ __forceinline__ void gemm_core(const Ctx& C, f32x4 (&acc)[4][NJ], const bf16_t* __restrict__ A, int lda, const bf16_t* __restrict__ B, int ldb, int K, unsigned char* smem) {
    const int tid = C.tid & 255, lane = tid & 63, wave = tid >> 6, wm = wave >> 1, wn = wave & 1, fr = lane & 15, fq = lane >> 4;
    smem += (C.tid >> 8) * 36864;
    u32x4 ra[4], rb[NJ];
#pragma unroll
    for (int i = 0; i < 4; ++i)
#pragma unroll
        for (int j = 0; j < NJ; ++j) acc[i][j] = (f32x4){0.f, 0.f, 0.f, 0.f};
    const int lrow = tid >> 3, lkc = (tid & 7) * 8;
#pragma unroll
    for (int i = 0; i < 4; ++i) ra[i] = *(const u32x4*)(A + (size_t)(lrow + 32 * i) * lda + lkc);
#pragma unroll
    for (int i = 0; i < NJ; ++i) rb[i] = *(const u32x4*)(B + (size_t)(lrow + 32 * i) * ldb + lkc);
    for (int k0 = 0; k0 < K; k0 += 64) {
        __syncthreads();
#pragma unroll
        for (int i = 0; i < 4; ++i) *(u32x4*)(smem + (lrow + 32 * i) * 144 + lkc * 2) = ra[i];
#pragma unroll
        for (int i = 0; i < NJ; ++i) *(u32x4*)(smem + 18432 + (lrow + 32 * i) * 144 + lkc * 2) = rb[i];
        __syncthreads();
        if (k0 + 64 < K) {
#pragma unroll
            for (int i = 0; i < 4; ++i) ra[i] = *(const u32x4*)(A + (size_t)(lrow + 32 * i) * lda + k0 + 64 + lkc);
#pragma unroll
            for (int i = 0; i < NJ; ++i) rb[i] = *(const u32x4*)(B + (size_t)(lrow + 32 * i) * ldb + k0 + 64 + lkc);
        }
#pragma unroll
        for (int ks = 0; ks < 2; ++ks) {
            bf16x8 af[4], bfr[NJ];
#pragma unroll
            for (int i = 0; i < 4; ++i) af[i] = *(const bf16x8*)(smem + (wm * 64 + i * 16 + fr) * 144 + (ks * 32 + fq * 8) * 2);
#pragma unroll
            for (int j = 0; j < NJ; ++j) bfr[j] = *(const bf16x8*)(smem + 18432 + (wn * NJ * 16 + j * 16 + fr) * 144 + (ks * 32 + fq * 8) * 2);
#pragma unroll
            for (int i = 0; i < 4; ++i)
#pragma unroll
                for (int j = 0; j < NJ; ++j)
                    acc[i][j] = SWAP ? __builtin_amdgcn_mfma_f32_16x16x32_bf16(bfr[j], af[i], acc[i][j], 0, 0, 0)
                                     : __builtin_amdgcn_mfma_f32_16x16x32_bf16(af[i], bfr[j], acc[i][j], 0, 0, 0);
        }
    }
}


namespace g256 {
constexpr int BK = 64, HALF = 128, HT = HALF * BK;
__device__ __forceinline__ int lds_byte(int r, int c) { int st = (r >> 4) * 2 + (c >> 5), rr = r & 15, cc = c & 31, ob = rr * 64 + cc * 2; return st * 1024 + (ob ^ (((ob >> 9) & 1) << 5)); }
__device__ __forceinline__ void stage_rc(unsigned b, unsigned& R, unsigned& Cc) { const unsigned st = b >> 10, sb = b & 1023u, swz = sb ^ (((sb >> 9) & 1u) << 5); R = (st >> 1) * 16u + (swz >> 6); Cc = (st & 1u) * 32u + ((swz & 63u) >> 1); }
}
__device__ __forceinline__ void gemm256(const Ctx& C, f32x4 (&acc)[2][2][4][2], const bf16_t* __restrict__ A, const bf16_t* __restrict__ Bt, const int K, const int brow, const int bcol) {
    using namespace g256;
    bf16_t* shm = (bf16_t*)dyn_smem;
    const int tidx = C.tid;
    #define SA(b,h) (shm+((b)*2+(h))*HT)
    #define SB(b,h) (shm+(4+(b)*2+(h))*HT)
    #define STAGE(Pp,BASE,br,kt) do{const char* _ub=(const char*)((BASE)+(long)(br)*K+(long)(kt)*BK); asm volatile("" : "+s"(_ub)); \
        __builtin_amdgcn_global_load_lds((const unsigned*)(_ub+goff0), \
          (__attribute__((address_space(3))) unsigned*)((__attribute__((address_space(3))) char*)(Pp)+tidx*16),16,0,0); \
        __builtin_amdgcn_global_load_lds((const unsigned*)(_ub+goff1), \
          (__attribute__((address_space(3))) unsigned*)((__attribute__((address_space(3))) char*)(Pp)+tidx*16+8192),16,0,0);}while(0)
    #define LDA(dst,b,h) for(int m=0;m<4;++m)for(int k=0;k<2;++k) \
      dst[m][k]=*reinterpret_cast<const bf16x8*>(a_ptr+((b)*2+(h))*16384+m*2048+k*1024)
    #define LDB(dst,b,h) for(int n=0;n<2;++n)for(int k=0;k<2;++k) \
      dst[n][k]=*reinterpret_cast<const bf16x8*>(b_ptr+((b)*2+(h))*16384+n*2048+k*1024)
    #define MMA(ai,bj,Atx,Btx) do{__builtin_amdgcn_s_setprio(1); \
      for(int m=0;m<4;++m)for(int n=0;n<2;++n)for(int k=0;k<2;++k) \
        acc[ai][bj][m][n]=__builtin_amdgcn_mfma_f32_16x16x32_bf16(Btx[n][k],Atx[m][k],acc[ai][bj][m][n],0,0,0); \
      __builtin_amdgcn_s_setprio(0);}while(0)
    #define WAIT_V(n) asm volatile("s_waitcnt vmcnt(" #n ")":::"memory")
    #define WAIT_L(n) asm volatile("s_waitcnt lgkmcnt(" #n ")":::"memory")
    #define BAR __builtin_amdgcn_s_barrier()
    #define SCHED __builtin_amdgcn_sched_barrier(0)
    const int wid = tidx >> 6, lane = tidx & 63, wr = wid >> 2, wc = wid & 3, fr = lane & 15, fq = lane >> 4;
    const int swz = (fr * 64 + fq * 16) ^ ((fr >> 3) << 5);
    const char* a_ptr = (const char*)dyn_smem + wr * 8192 + swz;
    const char* b_ptr = (const char*)dyn_smem + 65536 + wc * 4096 + swz;
#pragma unroll
    for (int a = 0; a < 2; ++a)
#pragma unroll
        for (int b = 0; b < 2; ++b)
#pragma unroll
            for (int m = 0; m < 4; ++m) { acc[a][b][m][0] = (f32x4){0.f, 0.f, 0.f, 0.f}; acc[a][b][m][1] = (f32x4){0.f, 0.f, 0.f, 0.f}; }
    bf16x8 At[4][2], B0[2][2], B1[2][2];
    const int nt = K / BK;
    unsigned goff0, goff1;
    { unsigned r0, c0, r1, c1; stage_rc((unsigned)tidx * 16u, r0, c0); stage_rc((unsigned)tidx * 16u + 8192u, r1, c1); goff0 = (r0 * (unsigned)K + c0) * 2u; goff1 = (r1 * (unsigned)K + c1) * 2u; }
    WAIT_V(0); __syncthreads();
    STAGE(SB(0,0),Bt,bcol,0); STAGE(SA(0,0),A,brow,0);
    STAGE(SB(0,1),Bt,bcol+HALF,0); STAGE(SA(0,1),A,brow+HALF,0);
    if(wr==1)BAR;
    WAIT_V(4); BAR;
    STAGE(SB(1,0),Bt,bcol,1); STAGE(SA(1,0),A,brow,1); STAGE(SB(1,1),Bt,bcol+HALF,1);
    WAIT_V(6); BAR;
    for(int t=0;t<nt-2;t+=2){
      LDB(B0,0,0); SCHED; LDA(At,0,0); STAGE(SA(1,1),A,brow+HALF,t+1);
      WAIT_L(8); BAR; WAIT_L(0); MMA(0,0,At,B0); BAR; SCHED;
      LDB(B1,0,1); STAGE(SB(0,0),Bt,bcol,t+2);
      BAR; WAIT_L(0); MMA(0,1,At,B1); BAR;
      LDA(At,0,1); STAGE(SA(0,0),A,brow,t+2);
      BAR; WAIT_L(0); MMA(1,0,At,B0); BAR; SCHED;
      STAGE(SB(0,1),Bt,bcol+HALF,t+2);
      WAIT_V(6); BAR; MMA(1,1,At,B1); BAR;
      LDB(B0,1,0); SCHED; LDA(At,1,0); STAGE(SA(0,1),A,brow+HALF,t+2);
      WAIT_L(8); BAR; WAIT_L(0); MMA(0,0,At,B0); BAR; SCHED;
      LDB(B1,1,1); STAGE(SB(1,0),Bt,bcol,t+3);
      BAR; WAIT_L(0); MMA(0,1,At,B1); BAR;
      LDA(At,1,1); STAGE(SA(1,0),A,brow,t+3);
      BAR; WAIT_L(0); MMA(1,0,At,B0); BAR; SCHED;
      STAGE(SB(1,1),Bt,bcol+HALF,t+3);
      WAIT_V(6); BAR; MMA(1,1,At,B1); BAR;
    }
    { LDB(B0,0,0); LDA(At,0,0); STAGE(SA(1,1),A,brow+HALF,nt-1);
      BAR; WAIT_L(0); MMA(0,0,At,B0); BAR;
      LDB(B1,0,1); BAR; WAIT_L(0); MMA(0,1,At,B1); BAR;
      LDA(At,0,1); WAIT_V(4); BAR; WAIT_L(0); MMA(1,0,At,B0); MMA(1,1,At,B1); BAR; }
    { LDB(B0,1,0); LDA(At,1,0); WAIT_V(2); BAR; WAIT_L(0); MMA(0,0,At,B0); BAR;
      LDB(B1,1,1); WAIT_V(0); BAR; WAIT_L(0); MMA(0,1,At,B1); BAR;
      LDA(At,1,1); BAR; WAIT_L(0); MMA(1,0,At,B0); MMA(1,1,At,B1); BAR; }
    if(wr==0)BAR;
    #undef SA
    #undef SB
    #undef STAGE
    #undef LDA
    #undef LDB
    #undef MMA
    #undef WAIT_V
    #undef WAIT_L
    #undef BAR
    #undef SCHED
}
__device__ __forceinline__ bool tile_order(int i, int G, int c, int nM, int nN, int& pm, int& pn) {
    const int nwg = nM * nN; const long L = (long)i * G + c; if (L >= nwg) return false;
    int wgid = (int)L; { const int q = nwg / 8, r = nwg % 8, xcd = wgid % 8, off = wgid / 8; wgid = (xcd < r ? xcd * (q + 1) : r * (q + 1) + (xcd - r) * q) + off; }
    const int nig = 8 * nN, gid = wgid / nig, fm = gid * 8, gsz = (nM - fm) < 8 ? (nM - fm) : 8;
    pm = fm + ((wgid % nig) % gsz); pn = (wgid % nig) / gsz; return true;
}

struct ConvJob { const float* src; int ld, K, nbegin, ncount, map; bf16_t* dst; };
__device__ __forceinline__ ConvJob conv_job(const PV& P, int j) {
    const int l = j >> 4, q = j & 15; bf16_t* W = wl(P, l); ConvJob c; c.map = 0; c.nbegin = 0;
    switch (q) {
        case 0: c.src = P.inp(8) + (size_t)l * 1024 * 5632; c.ld = 5632; c.K = 1024; c.ncount = 5632; c.dst = W + OW_FA_IN; c.map = 1; break;
        case 1: c.src = P.inp(9) + (size_t)l * 2816 * 1024; c.ld = 1024; c.K = 2816; c.ncount = 1024; c.dst = W + OW_FA_OUT; break;
        case 2: c.src = P.inp(10) + (size_t)l * 1024 * 5632; c.ld = 5632; c.K = 1024; c.ncount = 5632; c.dst = W + OW_FB_IN; c.map = 1; break;
        case 3: c.src = P.inp(11) + (size_t)l * 2816 * 1024; c.ld = 1024; c.K = 2816; c.ncount = 1024; c.dst = W + OW_FB_OUT; break;
        case 4: c.src = P.inp(12) + (size_t)l * 1024 * 8576; c.ld = 8576; c.K = 1024; c.ncount = 3456; c.dst = W + OW_WIN; break;
        case 5: c.src = P.inp(12) + (size_t)l * 1024 * 8576; c.ld = 8576; c.K = 1024; c.nbegin = 3968; c.ncount = 4608; c.dst = W + OW_WIN + (size_t)3968 * 1024; break;
        case 6: case 7: case 8: case 9: { const int n = q - 6; c.src = P.inp(27) + (size_t)(l * 4 + n) * 512 * 1024; c.ld = 1024; c.K = 512; c.ncount = 1024; c.dst = W + OW_WBR + (size_t)n * 1024 * 512; } break;
        case 10: c.src = P.inp(28) + (size_t)l * 1024 * 1024; c.ld = 1024; c.K = 1024; c.ncount = 1024; c.dst = W + OW_WOUT; break;
        case 11: case 12: { const int d = q - 11; c.src = P.inp(15) + (size_t)(l * 2 + d) * 64 * 512; c.ld = 512; c.K = 64; c.ncount = 512; c.dst = W + OW_W2T + (size_t)d * 512 * 64; } break;
        case 13: case 14: { const int d = q - 13; c.src = P.inp(17) + (size_t)(l * 2 + d) * 64 * 512; c.ld = 512; c.K = 64; c.ncount = 512; c.dst = W + OW_A2T + (size_t)d * 512 * 64; } break;
        default: c.src = P.inp(18) + (size_t)l * 128 * 512; c.ld = 512; c.K = 128; c.ncount = 512; c.dst = W + OW_G2T; break;
    }
    return c;
}

__device__ __forceinline__ void prep_phase(const Ctx& C, const PV& P, unsigned char* smem) {
    const int tid = C.tid;
    {
        int total = 0;
        for (int j = 0; j < 32; ++j) { ConvJob c = conv_job(P, j); total += (c.K >> 6) * (c.ncount >> 6); }
        float* tile = (float*)smem;
        const int tx = tid & 63, ty = tid >> 6;
        for (int t = C.bid; t < total; t += C.nblk) {
            int tt = t, j = 0; ConvJob c = conv_job(P, 0);
            for (;;) { const int n = (c.K >> 6) * (c.ncount >> 6); if (tt < n) break; tt -= n; ++j; c = conv_job(P, j); }
            const int nkt = c.K >> 6, kt = tt % nkt, nt = tt / nkt, k0 = kt * 64, n0 = nt * 64;
            int col = c.nbegin + n0 + tx;
            if (c.map) { const int np = n0 + tx, blk = np >> 5, w = np & 31, f = blk * 16 + (w & 15); col = (w < 16) ? f : 2816 + f; }
            __syncthreads();
#pragma unroll 4
            for (int i = 0; i < 8; ++i) { const int kk = ty + 8 * i; tile[kk * 65 + tx] = c.src[(size_t)(k0 + kk) * c.ld + col]; }
            __syncthreads();
#pragma unroll 4
            for (int i = 0; i < 8; ++i) { const int nn = ty + 8 * i; c.dst[(size_t)(n0 + nn) * c.K + k0 + tx] = f2bf(tile[tx * 65 + nn]); }
        }
        __syncthreads();
    }
    {
        float* wt = (float*)smem;
        float* cosT = (float*)(smem + 64 * 129 * 4);
        for (int it = C.bid; it < 2 * 4 * 16; it += C.nblk) {
            const int l = it >> 6, g = (it >> 4) & 3, kc = it & 15, k0 = kc * 64;
            const float* src = P.inp(12) + (size_t)l * 1024 * 8576 + 3456 + g * 128;
            __syncthreads();
            for (int e = tid; e < 64 * 128; e += NT) { const int kk = e >> 7, c = e & 127; wt[kk * 129 + c] = src[(size_t)(k0 + kk) * 8576 + c]; }
            if (tid < 128) cosT[tid] = cospif((float)tid * (1.0f / 64.0f));
            __syncthreads();
            bf16_t* dst = wl(P, l) + OW_WIN + (size_t)(3456 + g * 128) * 1024;
            const int kk = tid & 63;
            for (int i = 0; i < 16; ++i) {
                const int j2 = (tid >> 6) + 8 * i, cc = j2 >> 1, part = j2 & 1;
                float s = 0.f;
                if (cc == 0) {
                    if (part == 0) { for (int c = 0; c < 128; ++c) s += wt[kk * 129 + c]; }
                    else { for (int c = 0; c < 128; ++c) s += (c & 1) ? -wt[kk * 129 + c] : wt[kk * 129 + c]; }
                } else if (part == 0) {
                    for (int c = 0; c < 128; ++c) s += wt[kk * 129 + c] * cosT[(cc * c) & 127];
                } else {
                    for (int c = 0; c < 128; ++c) s -= wt[kk * 129 + c] * cosT[(cc * c - 32) & 127];
                }
                dst[(size_t)j2 * 1024 + k0 + kk] = f2bf(s);
            }
        }
        __syncthreads();
    }
    if (C.bid == 0 && tid < 16) ((unsigned*)(P.ws + WS_CTR))[tid] = 0u;
    {
        float2* tw = (float2*)(P.ws + WS_TW);
        for (int m = C.bid * NT + tid; m < 4096; m += C.nblk * NT) { const float x = (float)m * (1.0f / 4096.0f); tw[m] = make_float2(cospif(x), -sinpif(x)); }
    }
    {
        float* sc = (float*)smem;
        float* red = (float*)(smem + 18 * 512 * 4);
        float* mod = (float*)(P.ws + WS_MOD);
        for (int it = C.bid; it < 2 * 144; it += C.nblk) {
            const int l = it / 144, n0 = (it % 144) * 64, nl = tid & 63, ks = tid >> 6;
            const float* aw = P.inp(4) + (size_t)l * 1024 * 9216;
            float acc[18];
#pragma unroll
            for (int b = 0; b < 18; ++b) acc[b] = 0.f;
            for (int half = 0; half < 2; ++half) {
                __syncthreads();
                for (int e = tid; e < 18 * 512; e += NT) {
                    const int b = e >> 9, kk = e & 511, k = half * 512 + kk;
                    const float cv = b < 2 ? P.inp(2)[b * 1024 + k] : P.inp(3)[(b - 2) * 1024 + k];
                    sc[e] = cv / (1.0f + __expf(-cv));
                }
                __syncthreads();
                for (int kk = ks * 64; kk < ks * 64 + 64; ++kk) {
                    const float w = aw[(size_t)(half * 512 + kk) * 9216 + n0 + nl];
#pragma unroll
                    for (int b = 0; b < 18; ++b) acc[b] += sc[b * 512 + kk] * w;
                }
            }
            __syncthreads();
#pragma unroll
            for (int b = 0; b < 18; ++b) red[(ks * 18 + b) * 64 + nl] = acc[b];
            __syncthreads();
            for (int e = tid; e < 18 * 64; e += NT) {
                const int b = e >> 6, n = e & 63;
                float s = 0.f;
#pragma unroll
                for (int k8 = 0; k8 < 8; ++k8) s += red[(k8 * 18 + b) * 64 + n];
                mod[((size_t)l * 18 + b) * 9216 + n0 + n] = s + P.inp(5)[(size_t)l * 9216 + n0 + n];
            }
        }
        __syncthreads();
    }
}

__device__ __forceinline__ void norm_phase(const Ctx& C, const PV& P, int pass, const float* lng, const float* lnb, int mod_layer, int j, bool from_input, bool write_x) {
    const int lane = C.tid & 63, wave = C.tid >> 6;
    bf16_t* hmod = (bf16_t*)(P.ws + WS_HMOD);
    const float* mod = (const float*)(P.ws + WS_MOD);
    const int nw = C.nblk * NWV;
    for (int lt0 = C.bid * NWV + wave; lt0 < TP; lt0 += 2 * nw) {
        f32x4 v[2][4]; int gr[2], bb[2]; bool ok[2];
#pragma unroll
        for (int u = 0; u < 2; ++u) {
            const int lt = lt0 + u * nw; ok[u] = lt < TP;
            const int ltc = ok[u] ? lt : lt0;
            gr[u] = grow_of(pass, ltc); bb[u] = brow_of(pass, ltc);
            const float* src = from_input ? (gr[u] < 16384 ? P.inp(0) + (size_t)gr[u] * 1024 : P.inp(1) + (size_t)(gr[u] - 16384) * 1024) : P.out + (size_t)gr[u] * 1024;
#pragma unroll
            for (int i = 0; i < 4; ++i) v[u][i] = *(const f32x4*)(src + i * 256 + lane * 4);
        }
        if (lng) {
            float s[2], q[2], mu[2], rs[2];
#pragma unroll
            for (int u = 0; u < 2; ++u) { s[u] = 0.f;
#pragma unroll
                for (int i = 0; i < 4; ++i) s[u] += (v[u][i][0] + v[u][i][1]) + (v[u][i][2] + v[u][i][3]); }
#pragma unroll
            for (int o = 32; o > 0; o >>= 1) { s[0] += __shfl_xor(s[0], o); s[1] += __shfl_xor(s[1], o); }
#pragma unroll
            for (int u = 0; u < 2; ++u) { mu[u] = s[u] * (1.0f / 1024.0f); q[u] = 0.f;
#pragma unroll
                for (int i = 0; i < 4; ++i) { const f32x4 dd = v[u][i] - mu[u]; q[u] += (dd[0] * dd[0] + dd[1] * dd[1]) + (dd[2] * dd[2] + dd[3] * dd[3]); } }
#pragma unroll
            for (int o = 32; o > 0; o >>= 1) { q[0] += __shfl_xor(q[0], o); q[1] += __shfl_xor(q[1], o); }
#pragma unroll
            for (int u = 0; u < 2; ++u) {
                rs[u] = rsqrtf(q[u] * (1.0f / 1024.0f) + 1e-5f);
                if (ok[u] && lane == 0) *(f32x2*)(P.ws + WS_STATS + (size_t)(lt0 + u * nw) * 8) = (f32x2){mu[u], rs[u]};
            }
#pragma unroll
            for (int i = 0; i < 4; ++i) {
                const f32x4 g = *(const f32x4*)(lng + i * 256 + lane * 4), be = *(const f32x4*)(lnb + i * 256 + lane * 4);
                v[0][i] = (v[0][i] - mu[0]) * rs[0] * g + be; v[1][i] = (v[1][i] - mu[1]) * rs[1] * g + be;
            }
        }
        if (write_x) {
#pragma unroll
            for (int u = 0; u < 2; ++u) if (ok[u]) {
#pragma unroll
                for (int i = 0; i < 4; ++i) *(f32x4*)(P.out + (size_t)gr[u] * 1024 + i * 256 + lane * 4) = v[u][i];
            }
        }
        if (j >= 0) {
            float s[2], q[2], mu[2], rs[2];
#pragma unroll
            for (int u = 0; u < 2; ++u) { s[u] = 0.f;
#pragma unroll
                for (int i = 0; i < 4; ++i) s[u] += (v[u][i][0] + v[u][i][1]) + (v[u][i][2] + v[u][i][3]); }
#pragma unroll
            for (int o = 32; o > 0; o >>= 1) { s[0] += __shfl_xor(s[0], o); s[1] += __shfl_xor(s[1], o); }
#pragma unroll
            for (int u = 0; u < 2; ++u) { mu[u] = s[u] * (1.0f / 1024.0f); q[u] = 0.f;
#pragma unroll
                for (int i = 0; i < 4; ++i) { const f32x4 dd = v[u][i] - mu[u]; q[u] += (dd[0] * dd[0] + dd[1] * dd[1]) + (dd[2] * dd[2] + dd[3] * dd[3]); } }
#pragma unroll
            for (int o = 32; o > 0; o >>= 1) { q[0] += __shfl_xor(q[0], o); q[1] += __shfl_xor(q[1], o); }
#pragma unroll
            for (int u = 0; u < 2; ++u) {
                rs[u] = rsqrtf(q[u] * (1.0f / 1024.0f) + 1e-5f);
                if (!ok[u]) continue;
                const float* mb = mod + ((size_t)mod_layer * 18 + bb[u]) * 9216 + (size_t)(3 * j) * 1024;
                const int lt = lt0 + u * nw;
#pragma unroll
                for (int i = 0; i < 4; ++i) {
                    const f32x4 sh = *(const f32x4*)(mb + i * 256 + lane * 4), scl = *(const f32x4*)(mb + 1024 + i * 256 + lane * 4);
                    const f32x4 hh = (v[u][i] - mu[u]) * rs[u] * (1.0f + scl) + sh;
                    u32x2 o; o.x = pack2bf(hh[0], hh[1]); o.y = pack2bf(hh[2], hh[3]);
                    *(u32x2*)(hmod + (size_t)lt * 1024 + i * 256 + lane * 4) = o;
                }
            }
        }
    }
}

__device__ __forceinline__ void ffn_up_phase(const Ctx& C, const PV& P, const bf16_t* Wt) {
    const bf16_t* hmod = (const bf16_t*)(P.ws + WS_HMOD);
    bf16_t* act = (bf16_t*)(P.ws + WS_R + R_ACT);
    int pm, pn;
    for (int it = 0; tile_order(it, C.nblk, C.bid, TP / 256, 22, pm, pn); ++it) {
        f32x4 acc[2][2][4][2];
        gemm256(C, acc, hmod, Wt, 1024, pm * 256, pn * 256);
        int z2 = 0; asm volatile("" : "+s"(z2));
        const int tid2 = tid_now(C.wave_s, z2), lane = tid2 & 63, wid = tid2 >> 6, wr = wid >> 2, wc = wid & 3, fr = lane & 15, fq = lane >> 4;
#pragma unroll
        for (int ai = 0; ai < 2; ++ai)
#pragma unroll
            for (int m = 0; m < 4; ++m) {
                const int row = pm * 256 + ai * 128 + wr * 64 + m * 16 + fr;
#pragma unroll
                for (int bj = 0; bj < 2; ++bj) {
                    const int colbase = pn * 256 + bj * 128 + wc * 32, f = (colbase >> 5) * 16 + fq * 4;
                    const f32x4 a = acc[ai][bj][m][0], bb = acc[ai][bj][m][1];
                    float o[4];
#pragma unroll
                    for (int r = 0; r < 4; ++r) o[r] = a[r] / (1.0f + __expf(-a[r])) * bb[r];
                    u32x2 w; w.x = pack2bf(o[0], o[1]); w.y = pack2bf(o[2], o[3]);
                    *(u32x2*)(act + (size_t)row * 2816 + f) = w;
                }
            }
    }
}

__device__ __forceinline__ void resid_gemm_phase(const Ctx& C, const PV& P, int pass, const bf16_t* A, int K, const bf16_t* Wt, int layer, int j, float scale, const float* xg, const float* xb) {
    const float* mod = (const float*)(P.ws + WS_MOD);
    int pm, pn;
    for (int it = 0; tile_order(it, C.nblk, C.bid, TP / 256, 4, pm, pn); ++it) {
        f32x4 acc[2][2][4][2];
        gemm256(C, acc, A, Wt, K, pm * 256, pn * 256);
        int z2 = 0; asm volatile("" : "+s"(z2));
        const int tid2 = tid_now(C.wave_s, z2), lane = tid2 & 63, wid = tid2 >> 6, wr = wid >> 2, wc = wid & 3, fr = lane & 15, fq = lane >> 4;
#pragma unroll
        for (int ai = 0; ai < 2; ++ai)
#pragma unroll
            for (int m = 0; m < 4; ++m) {
                const int lt = pm * 256 + ai * 128 + wr * 64 + m * 16 + fr;
                const int gr = grow_of(pass, lt), b = brow_of(pass, lt);
                const float* gate = mod + ((size_t)layer * 18 + b) * 9216 + (size_t)(3 * j + 2) * 1024;
                const float* xsrc = xg ? P.out + (size_t)gr * 1024 : (gr < 16384 ? P.inp(0) + (size_t)gr * 1024 : P.inp(1) + (size_t)(gr - 16384) * 1024);
                f32x2 st = (f32x2){0.f, 1.f};
                if (xg) st = *(const f32x2*)(P.ws + WS_STATS + (size_t)lt * 8);
#pragma unroll
                for (int bj = 0; bj < 2; ++bj)
#pragma unroll
                    for (int n = 0; n < 2; ++n) {
                        const int col = pn * 256 + bj * 128 + wc * 32 + n * 16 + fq * 4;
                        f32x4 x = *(const f32x4*)(xsrc + col);
                        if (xg) x = (x - st[0]) * st[1] * *(const f32x4*)(xg + col) + *(const f32x4*)(xb + col);
                        const f32x4 g = *(const f32x4*)(gate + col);
                        *(f32x4*)(P.out + (size_t)gr * 1024 + col) = ALPHA * x + (1.0f + g) * scale * acc[ai][bj][m][n];
                    }
                asm volatile("" ::: "memory");
            }
    }
}

__device__ __forceinline__ void win_phase(const Ctx& C, const PV& P, int layer) {
    const bf16_t* hmod = (const bf16_t*)(P.ws + WS_HMOD);
    const bf16_t* Wt = wl(P, layer) + OW_WIN;
    unsigned char* R = P.ws + WS_R;
    f16* raw = (f16*)(R + R_RAW); bf16_t* Qb = (bf16_t*)(R + R_Q); bf16_t* Kb = (bf16_t*)(R + R_K); bf16_t* Vt = (bf16_t*)(R + R_VT);
    f16* Zc = (f16*)(R + R_ZC); f16* poolp = (f16*)(R + R_POOLP);
    typedef f16 f16x4 __attribute__((ext_vector_type(4)));
    typedef f16 f16x2 __attribute__((ext_vector_type(2)));
    int pm, pn;
    for (int it = 0; tile_order(it, C.nblk, C.bid, TP / 256, 18, pm, pn); ++it) {
        const int lt_t = pm * 256, sq = lt_t < 8192 ? 0 : 1 + ((lt_t - 8192) >> 12), lt0 = seqbase_of(sq), S = seqlen_of(sq);
        f32x4 acc[2][2][4][2];
        gemm256(C, acc, hmod, Wt, 1024, pm * 256, pn * 256);
        int z2 = 0; asm volatile("" : "+s"(z2));
        const int tid2 = tid_now(C.wave_s, z2), lane = tid2 & 63, wid = tid2 >> 6, wr = wid >> 2, wc = wid & 3, fr = lane & 15, fq = lane >> 4;
#pragma unroll
        for (int bj = 0; bj < 2; ++bj) {
            const int tn = pn * 2 + bj;
            if (tn >= 35) continue;
#pragma unroll
            for (int ai = 0; ai < 2; ++ai)
#pragma unroll
                for (int m = 0; m < 4; ++m) {
                    const int lt = pm * 256 + ai * 128 + wr * 64 + m * 16 + fr, pos = lt - lt0;
#pragma unroll
                    for (int n = 0; n < 2; ++n) {
                        const int col = tn * 128 + wc * 32 + n * 16 + fq * 4;
                        f32x4 v = acc[ai][bj][m][n];
                        if (tn < 15) {
                            f16x4 h; h[0] = (f16)v[0]; h[1] = (f16)v[1]; h[2] = (f16)v[2]; h[3] = (f16)v[3];
                            *(f16x4*)(raw + (size_t)lt * 1920 + col) = h;
                        } else if (tn < 23) {
                            const int nq = (col - 1920) & 511, hc = nq >> 6, d = nq & 63;
                            if (n == 0 && (wc & 1) == 0) {
#pragma unroll
                                for (int r = 0; r < 4; ++r) {
                                    const float invlo = r == 0 ? 1.0f : r == 1 ? 0.1939227432012558f : r == 2 ? 0.03760603070259094f : 0.007292664609849453f;
                                    const float invhi = r == 0 ? 0.0014142135623842478f : r == 1 ? 0.00027424818836152554f : r == 2 ? 5.3182957344688475e-05f : 1.0313385246263351e-05f;
                                    const float ang = (float)pos * ((fq & 1) ? invhi : invlo);
                                    const float hi = ang * 0.15915493667125702f;
                                    const float lo = __builtin_fmaf(ang, 0.15915493667125702f, -hi) + ang * 6.4206382432985265e-09f;
                                    const float rr = (hi - floorf(hi)) + lo;
                                    const float cs = __builtin_amdgcn_cosf(rr), sn = __builtin_amdgcn_sinf(rr);
                                    const float other = __shfl_xor(v[r], 32);
                                    v[r] = (fq < 2) ? (v[r] * cs - other * sn) : (other * sn + v[r] * cs);
                                }
                            }
                            bf16_t* dst = (tn < 19) ? Qb : Kb;
                            const float sc = (tn < 19) ? 0.125f * 1.44269504088896f : 1.0f;
                            u32x2 w; w.x = pack2bf(v[0] * sc, v[1] * sc); w.y = pack2bf(v[2] * sc, v[3] * sc);
                            *(u32x2*)(dst + (size_t)lt0 * 512 + ((size_t)hc * S + pos) * 64 + d) = w;
                        } else if (tn < 27) {
                            const int nv = col - 2944;
                            bf16_t* vb = Vt + (size_t)lt0 * 512 + (size_t)nv * S + pos;
                            vb[0] = f2bf(v[0]); vb[(size_t)S] = f2bf(v[1]); vb[(size_t)2 * S] = f2bf(v[2]); vb[(size_t)3 * S] = f2bf(v[3]);
                        } else if (tn < 31) {
                            const int nz = col - 3456, g = nz >> 7, cc = (nz & 127) >> 1;
                            f16x2 z0, z1; z0[0] = (f16)v[0]; z0[1] = (f16)v[1]; z1[0] = (f16)v[2]; z1[1] = (f16)v[3];
                            f16x2* zb = (f16x2*)Zc + (size_t)lt0 * 256;
                            zb[(size_t)(g * 64 + cc) * S + pos] = z0;
                            zb[(size_t)(g * 64 + cc + 1) * S + pos] = z1;
                        } else {
                            f16x4 h; h[0] = (f16)v[0]; h[1] = (f16)v[1]; h[2] = (f16)v[2]; h[3] = (f16)v[3];
                            *(f16x4*)(poolp + (size_t)lt * 512 + (col - 3968)) = h;
                        }
                    }
                    asm volatile("" ::: "memory");
                }
        }
    }
}

__device__ __forceinline__ float shiftv(const f16* __restrict__ raw, int lt, int t, int S, int col, float mu) {
    const float p = (float)raw[(size_t)lt * 1920 + col];
    const float pr = t > 0 ? (float)raw[(size_t)(lt - 1) * 1920 + col] : 0.f;
    const float nx = t < S - 1 ? (float)raw[(size_t)(lt + 1) * 1920 + col] : 0.f;
    return p + (0.5f * (pr + nx) - p) * mu;
}

typedef f16 f16x4_t __attribute__((ext_vector_type(4)));
typedef f16 f16x8_t __attribute__((ext_vector_type(8)));
__device__ __forceinline__ void lin_pool_phase(const Ctx& C, const PV& P, int layer) {
    unsigned char* R = P.ws + WS_R;
    const f16* raw = (const f16*)(R + R_RAW); bf16_t* lin = (bf16_t*)(R + R_LIN);
    const f16* poolp = (const f16*)(R + R_POOLP); bf16_t* ypool = (bf16_t*)(R + R_YB) + 3 * SZ512;
    const float* mu = P.inp(13) + (size_t)layer * 1920; const float* pscale = P.inp(26) + (size_t)layer * 512;
    const int gsz = C.nblk * NT, gid = C.bid * NT + C.tid;
    for (int e = gid; e < TP * 96; e += gsz) {
        const int lt = e / 96, c = (e % 96) * 4, col = 1536 + c;
        const int pos = pos_of(lt), S = lt < 8192 ? 8192 : 4096;
        const f16x4_t p0 = *(const f16x4_t*)(raw + (size_t)lt * 1920 + col);
        const f16x4_t pm = *(const f16x4_t*)(raw + (size_t)(pos > 0 ? lt - 1 : lt) * 1920 + col);
        const f16x4_t pp = *(const f16x4_t*)(raw + (size_t)(pos < S - 1 ? lt + 1 : lt) * 1920 + col);
        const f32x4 m4 = *(const f32x4*)(mu + col);
        const float wm = pos > 0 ? 0.5f : 0.f, wp = pos < S - 1 ? 0.5f : 0.f;
        float o[4];
#pragma unroll
        for (int r = 0; r < 4; ++r) {
            const float p = (float)p0[r];
            float v = p + (wm * (float)pm[r] + wp * (float)pp[r] - p) * m4[r];
            if (c < 128) v = 1.0f - 2.0f / (__expf(2.0f * v) + 1.0f);
            else if (c >= 256) v = sigmoidf_(v);
            o[r] = v;
        }
        u32x2 w; w.x = pack2bf(o[0], o[1]); w.y = pack2bf(o[2], o[3]);
        *(u32x2*)(lin + (size_t)lt * 384 + c) = w;
    }
    for (int e = gid; e < TP * 128; e += gsz) {
        const int lt = e >> 7, c = (e & 127) * 4, g = c >> 7, half = 1 << g;
        const int pos = pos_of(lt), S = lt < 8192 ? 8192 : 4096;
        const int lo = max(pos - half, 0), hi = min(pos + half, S);
        const f16* base = poolp + (size_t)(lt - pos) * 512 + c;
        float s0 = 0.f, s1 = 0.f, s2 = 0.f, s3 = 0.f;
#pragma unroll
        for (int o = -8; o < 8; ++o) {
            const int tt = pos + o;
            const bool in = (o >= -half) && (o < half) && tt >= 0 && tt < S;
            if (in) { const f16x4_t v = *(const f16x4_t*)(base + (size_t)tt * 512); s0 += (float)v[0]; s1 += (float)v[1]; s2 += (float)v[2]; s3 += (float)v[3]; }
        }
        const f16x4_t x = *(const f16x4_t*)(base + (size_t)pos * 512);
        const f32x4 ps = *(const f32x4*)(pscale + c);
        const float ic = 1.0f / (float)(hi - lo);
        u32x2 w; w.x = pack2bf((s0 * ic - (float)x[0]) * ps[0], (s1 * ic - (float)x[1]) * ps[1]); w.y = pack2bf((s2 * ic - (float)x[2]) * ps[2], (s3 * ic - (float)x[3]) * ps[3]);
        *(u32x2*)(ypool + (size_t)lt * 512 + c) = w;
    }
    {
        float* invn = (float*)(P.ws + WS_INVN);
        const float* k_k = P.inp(19) + (size_t)layer * 512;
        const int lane = C.tid & 63, wave = C.tid >> 6;
        for (int lt = C.bid * NWV + wave; lt < TP; lt += C.nblk * NWV) {
            const int pos = pos_of(lt), S = lt < 8192 ? 8192 : 4096;
            float ss[8];
#pragma unroll
            for (int h = 0; h < 8; ++h) {
                const int c = h * 64 + lane;
                const float k = shiftv(raw, lt, pos, S, 512 + c, mu[512 + c]) * k_k[c];
                ss[h] = k * k;
            }
#pragma unroll
            for (int h = 0; h < 8; ++h) ss[h] = wsum(ss[h]);
            if (lane < 8) {
                float sel = ss[0];
#pragma unroll
                for (int h = 1; h < 8; ++h) sel = lane == h ? ss[h] : sel;
                invn[(size_t)lt * 8 + lane] = 1.0f / fmaxf(sqrtf(sel), 1e-12f);
            }
        }
    }
}

__device__ __forceinline__ void lora_phase(const Ctx& C, const PV& P, int layer, unsigned char* smem) {
    unsigned char* R = P.ws + WS_R;
    const bf16_t* lin = (const bf16_t*)(R + R_LIN); f16* wa = (f16*)(R + R_WA); f16* gbuf = (f16*)(R + R_G);
    const bf16_t* W = wl(P, layer);
    const int lane = C.tid & 63, wave = (C.tid >> 6) & 3, wm = wave >> 1, wn = wave & 1, fr = lane & 15, fq = lane >> 4;
    for (int t2 = C.bid; t2 < 5 * MT * 2; t2 += C.nblk) {
        const int t = t2 * 2 + (C.tid >> 8);
        const int which = t / (MT * 4), tt = t % (MT * 4), tm = tt >> 2, tn = tt & 3;
        const bf16_t* Bt; int K, acol; const float* bias = nullptr; f16* dst;
        if (which < 2) { Bt = W + OW_W2T + (size_t)which * 512 * 64; K = 64; acol = which * 64; bias = P.inp(14) + (size_t)(layer * 2 + which) * 512; dst = wa + (size_t)which * SZ512; }
        else if (which < 4) { const int d = which - 2; Bt = W + OW_A2T + (size_t)d * 512 * 64; K = 64; acol = 128 + d * 64; bias = P.inp(16) + (size_t)(layer * 2 + d) * 512; dst = wa + (size_t)which * SZ512; }
        else { Bt = W + OW_G2T; K = 128; acol = 256; dst = gbuf; }
        f32x4 acc[4][4];
        gemm_core<4, true>(C, acc, lin + (size_t)tm * 128 * 384 + acol, 384, Bt + (size_t)tn * 128 * K, K, K, smem);
#pragma unroll
        for (int i = 0; i < 4; ++i) {
            const int lt = tm * 128 + wm * 64 + i * 16 + fr;
#pragma unroll
            for (int jn = 0; jn < 4; ++jn) {
                const int n = tn * 128 + wn * 64 + jn * 16 + fq * 4;
                typedef f16 f16x4 __attribute__((ext_vector_type(4)));
                f16x4 h;
#pragma unroll
                for (int r = 0; r < 4; ++r) {
                    float v = acc[i][jn][r];
                    if (which < 2) {
                        const float z = bias[n + r] + v;
                        v = __expf(-0.6065306597126334f * sigmoidf_(z));
                    } else if (which < 4) { v = sigmoidf_(bias[n + r] + v); }
                    h[r] = (f16)v;
                }
                *(f16x4*)(dst + (size_t)lt * 512 + n) = h;
            }
        }
    }
}

__device__ __forceinline__ void attn_items(const Ctx& C, const PV& P, int layer, int ctr_idx, unsigned char* smem) {
    unsigned char* R = P.ws + WS_R;
    const bf16_t* Qall = (const bf16_t*)(R + R_Q); const bf16_t* Kall = (const bf16_t*)(R + R_K); const bf16_t* Vall = (const bf16_t*)(R + R_VT);
    bf16_t* ydiff = (bf16_t*)(R + R_YB) + 1 * SZ512;
    const int tid = C.tid, lane = tid & 63, wave = tid >> 6, comp = wave & 1, rg = wave >> 1, fr = lane & 15, fq = lane >> 4;
    const float lam_init = layer == 0 ? 0.2f : (0.8f - 0.6f * 0.7408182206817179f);
    float lam_full;
    {
        const float* lm = P.inp(24) + (size_t)layer * 256;
        float s1 = 0.f, s2 = 0.f;
        for (int i = 0; i < 64; ++i) { s1 += lm[i] * lm[64 + i]; s2 += lm[128 + i] * lm[192 + i]; }
        lam_full = expf(s1) - expf(s2) + lam_init;
    }
    const float* normg = P.inp(25) + (size_t)layer * 128;
    unsigned* ctr = (unsigned*)(P.ws + WS_CTR) + ctr_idx;
    volatile unsigned* bc = (volatile unsigned*)(smem + 131088);
    for (;;) {
        __syncthreads();
        if (tid == 0) *bc = atomicAdd(ctr, 1u);
        __syncthreads();
        const int item = (int)*bc;
        if (item >= 1280) break;
        int sq, h, qb;
        if (item < 256) { sq = 0; h = item >> 6; qb = item & 63; } else { const int i2 = item - 256; sq = 1 + (i2 >> 7); h = (i2 >> 5) & 3; qb = i2 & 31; }
        const int lt0 = seqbase_of(sq), S = seqlen_of(sq);
        const bf16_t* Qb = Qall + (size_t)lt0 * 512; const bf16_t* Kb = Kall + (size_t)lt0 * 512; const bf16_t* Vb = Vall + (size_t)lt0 * 512 + (size_t)h * 128 * S;
        const int q0 = qb * 128 + rg * 32;
        bf16x8 bq[2][2];
#pragma unroll
        for (int qs = 0; qs < 2; ++qs)
#pragma unroll
            for (int ks = 0; ks < 2; ++ks) bq[qs][ks] = *(const bf16x8*)(Qb + ((size_t)(h * 2 + comp) * S + q0 + qs * 16 + fr) * 64 + ks * 32 + fq * 8);
        float m_run[2] = {-1e30f, -1e30f}, l_run[2] = {0.f, 0.f};
        f32x4 O[8][2];
#pragma unroll
        for (int a = 0; a < 8; ++a) { O[a][0] = (f32x4){0.f, 0.f, 0.f, 0.f}; O[a][1] = (f32x4){0.f, 0.f, 0.f, 0.f}; }
        u32x4 rk[2], rv[2];
        const int lrow = tid >> 3, lkc = (tid & 7) * 8;
#pragma unroll
        for (int i = 0; i < 2; ++i) {
            const int row = lrow + 64 * i, cm = row >> 6, key = row & 63;
            rk[i] = *(const u32x4*)(Kb + ((size_t)(h * 2 + cm) * S + key) * 64 + lkc);
            rv[i] = *(const u32x4*)(Vb + (size_t)row * S + lkc);
        }
        for (int kt0 = 0; kt0 < S; kt0 += 64) {
            __syncthreads();
#pragma unroll
            for (int i = 0; i < 2; ++i) {
                const int row = lrow + 64 * i;
                *(u32x4*)(smem + row * 144 + lkc * 2) = rk[i];
                *(u32x4*)(smem + 18432 + row * 144 + lkc * 2) = rv[i];
            }
            __syncthreads();
            if (kt0 + 64 < S) {
#pragma unroll
                for (int i = 0; i < 2; ++i) {
                    const int row = lrow + 64 * i, cm = row >> 6, key = row & 63;
                    rk[i] = *(const u32x4*)(Kb + ((size_t)(h * 2 + cm) * S + kt0 + 64 + key) * 64 + lkc);
                    rv[i] = *(const u32x4*)(Vb + (size_t)row * S + kt0 + 64 + lkc);
                }
            }
            f32x4 st[4][2];
#pragma unroll
            for (int t = 0; t < 4; ++t) {
                st[t][0] = (f32x4){0.f, 0.f, 0.f, 0.f}; st[t][1] = (f32x4){0.f, 0.f, 0.f, 0.f};
#pragma unroll
                for (int ks = 0; ks < 2; ++ks) {
                    const bf16x8 kf = *(const bf16x8*)(smem + (comp * 64 + t * 16 + fr) * 144 + (ks * 32 + fq * 8) * 2);
                    st[t][0] = __builtin_amdgcn_mfma_f32_16x16x32_bf16(kf, bq[0][ks], st[t][0], 0, 0, 0);
                    st[t][1] = __builtin_amdgcn_mfma_f32_16x16x32_bf16(kf, bq[1][ks], st[t][1], 0, 0, 0);
                }
            }
            bf16x8 pb[2][2];
#pragma unroll
            for (int qs = 0; qs < 2; ++qs) {
                float mx = -1e30f;
#pragma unroll
                for (int t = 0; t < 4; ++t)
#pragma unroll
                    for (int r = 0; r < 4; ++r) mx = fmaxf(mx, st[t][qs][r]);
                mx = fmaxf(mx, __shfl_xor(mx, 16)); mx = fmaxf(mx, __shfl_xor(mx, 32));
                const float mnew = fmaxf(m_run[qs], mx);
                const float alpha = __builtin_amdgcn_exp2f(m_run[qs] - mnew);
                m_run[qs] = mnew;
                float ls = 0.f;
                float pv[4][4];
#pragma unroll
                for (int t = 0; t < 4; ++t)
#pragma unroll
                    for (int r = 0; r < 4; ++r) { pv[t][r] = __builtin_amdgcn_exp2f(st[t][qs][r] - mnew); ls += pv[t][r]; }
                l_run[qs] = l_run[qs] * alpha + ls;
                if (__builtin_amdgcn_ballot_w64(alpha != 1.0f) != 0ull) {
#pragma unroll
                    for (int a = 0; a < 8; ++a) O[a][qs] = O[a][qs] * alpha;
                }
#pragma unroll
                for (int u = 0; u < 2; ++u) {
                    union { bf16x8 v; unsigned w[4]; } pk;
                    pk.w[0] = pack2bf(pv[2 * u][0], pv[2 * u][1]); pk.w[1] = pack2bf(pv[2 * u][2], pv[2 * u][3]);
                    pk.w[2] = pack2bf(pv[2 * u + 1][0], pv[2 * u + 1][1]); pk.w[3] = pack2bf(pv[2 * u + 1][2], pv[2 * u + 1][3]);
                    pb[qs][u] = pk.v;
                }
            }
#pragma unroll
            for (int u = 0; u < 2; ++u)
#pragma unroll
                for (int a = 0; a < 8; ++a) {
                    union { bf16x8 v; uint2 h[2]; } vf;
                    vf.h[0] = *(const uint2*)(smem + 18432 + (a * 16 + fr) * 144 + (u * 32 + fq * 4) * 2);
                    vf.h[1] = *(const uint2*)(smem + 18432 + (a * 16 + fr) * 144 + (u * 32 + 16 + fq * 4) * 2);
                    O[a][0] = __builtin_amdgcn_mfma_f32_16x16x32_bf16(vf.v, pb[0][u], O[a][0], 0, 0, 0);
                    O[a][1] = __builtin_amdgcn_mfma_f32_16x16x32_bf16(vf.v, pb[1][u], O[a][1], 0, 0, 0);
                }
        }
#pragma unroll
        for (int qs = 0; qs < 2; ++qs) {
            float l = l_run[qs]; l += __shfl_xor(l, 16); l += __shfl_xor(l, 32);
            const float inv = 1.0f / l;
#pragma unroll
            for (int a = 0; a < 8; ++a) O[a][qs] = O[a][qs] * inv;
        }
        __syncthreads();
        float* Ox = (float*)smem;
        if (comp == 1) {
#pragma unroll
            for (int qs = 0; qs < 2; ++qs)
#pragma unroll
                for (int a = 0; a < 8; ++a)
#pragma unroll
                    for (int r = 0; r < 4; ++r) Ox[(rg * 128 + a * 16 + fq * 4 + r) * 32 + qs * 16 + fr] = O[a][qs][r];
        }
        __syncthreads();
        if (comp == 0) {
#pragma unroll
            for (int qs = 0; qs < 2; ++qs) {
                float ss = 0.f;
#pragma unroll
                for (int a = 0; a < 8; ++a)
#pragma unroll
                    for (int r = 0; r < 4; ++r) {
                        const float o = O[a][qs][r] - lam_full * Ox[(rg * 128 + a * 16 + fq * 4 + r) * 32 + qs * 16 + fr];
                        O[a][qs][r] = o; ss += o * o;
                    }
                ss += __shfl_xor(ss, 16); ss += __shfl_xor(ss, 32);
                const float sc = rsqrtf(ss * (1.0f / 128.0f) + 1e-5f) * (1.0f - lam_init);
                const int lt = lt0 + q0 + qs * 16 + fr;
#pragma unroll
                for (int a = 0; a < 8; ++a) {
                    const int dv = a * 16 + fq * 4;
                    const float4 g = *(const float4*)(normg + dv);
                    uint2 w; w.x = pack2bf(O[a][qs][0] * sc * g.x, O[a][qs][1] * sc * g.y); w.y = pack2bf(O[a][qs][2] * sc * g.z, O[a][qs][3] * sc * g.w);
                    *(uint2*)(ydiff + (size_t)lt * 512 + h * 128 + dv) = w;
                }
            }
        }
    }
    __syncthreads();
}

__device__ __forceinline__ void fft_items(const Ctx& C, const PV& P, unsigned char* smem) {
    unsigned char* R = P.ws + WS_R;
    typedef f16 f16x2 __attribute__((ext_vector_type(2)));
    const f16x2* Zall = (const f16x2*)(R + R_ZC);
    bf16_t* yf = (bf16_t*)(R + R_YB) + 2 * SZ512;
    const float2* tw = (const float2*)(P.ws + WS_TW);
    float2* sm = (float2*)smem;
    const int tid = C.tid;
    for (int item = C.bid; item < NSEQ * 256; item += C.nblk) {
        const int sq = item >> 8, col = item & 255, g = col >> 6, cc = col & 63;
        const int lt0 = seqbase_of(sq), S = seqlen_of(sq), lg = sq == 0 ? 13 : 12;
        const f16x2* z = Zall + (size_t)lt0 * 256 + (size_t)col * S;
        __syncthreads();
        for (int s = tid; s < S; s += NT) { const f16x2 v = z[s]; sm[__brev((unsigned)s) >> (32 - lg)] = make_float2((float)v[0], (float)v[1]); }
        __syncthreads();
        for (int st = 0; st < lg; ++st) {
            const int half = 1 << st, tshift = 12 - st;
            for (int b = tid; b < (S >> 1); b += NT) {
                const int j = b & (half - 1), i0 = ((b >> st) << (st + 1)) + j, i1 = i0 + half;
                const float2 w = tw[j << tshift], u = sm[i0], x = sm[i1];
                const float2 tv = make_float2(w.x * x.x - w.y * x.y, w.x * x.y + w.y * x.x);
                sm[i0] = make_float2(u.x + tv.x, u.y + tv.y); sm[i1] = make_float2(u.x - tv.x, u.y - tv.y);
            }
            __syncthreads();
        }
        const float nrm = rsqrtf((float)S * 128.0f);
        for (int k = tid; k < S; k += NT) {
            const float2 a = sm[k], b = sm[(S - k) & (S - 1)];
            bf16_t* row = yf + (size_t)(lt0 + k) * 512 + g * 128;
            if (cc == 0) { row[0] = f2bf(0.5f * (a.x + b.x) * nrm); row[64] = f2bf(0.5f * (a.y + b.y) * nrm); }
            else { row[cc] = f2bf(a.x * nrm); row[128 - cc] = f2bf(b.x * nrm); }
        }
    }
    __syncthreads();
}

template <int KT>
__device__ __forceinline__ void scan_block(const Ctx& C, const PV& P, int layer, int sq, int h, int d, int row0, unsigned char* smem) {
    constexpr int TPR = 64 / KT, ROWS = NT / TPR, CH = 16, YP = TPR / 4, NV = ROWS / 32;
    unsigned char* R = P.ws + WS_R;
    const f16* raw = (const f16*)(R + R_RAW); const f16* wa = (const f16*)(R + R_WA); f16* yfb = (f16*)(R + R_YFB);
    const float* invn = (const float*)(P.ws + WS_INVN);
    const float* mu = P.inp(13) + (size_t)layer * 1920; const float* k_k = P.inp(19) + (size_t)layer * 512; const float* k_a = P.inp(20) + (size_t)layer * 512;
    const int tid = C.tid, row = tid / TPR, q = tid % TPR;
    const int lt0 = seqbase_of(sq), S = seqlen_of(sq);
    const int ch = tid & 63, c = h * 64 + ch;
    const float mu_r = mu[c], mu_k = mu[512 + c], kkw = k_k[c], kaw = k_a[c];
    const int vr = (ROWS == 32) ? (tid & 31) : (tid & 63);
    const int vcol = 1024 + h * 64 + row0 + vr; const float mu_v = mu[vcol];
    const f16* wdec = wa + (size_t)d * SZ512; const f16* aact = wa + (size_t)(2 + d) * SZ512;
    f16* ydst = yfb + (size_t)d * SZ512;
    f32x2 s[KT / 2];
#pragma unroll
    for (int j = 0; j < KT / 2; ++j) s[j] = (f32x2){0.f, 0.f};
    f16 pr_[2][3], pk_[2][3], pa_[2], pw_[2], pv_[NV][3]; float pn_[2];
    auto prefetch = [&](int c0) {
#pragma unroll
        for (int j = 0; j < 2; ++j) {
            const int i = (tid >> 6) + 8 * j, tstep = c0 + i, t = d == 0 ? tstep : S - 1 - tstep, lt = lt0 + t;
            const int tm = t > 0 ? lt - 1 : lt, tp = t < S - 1 ? lt + 1 : lt;
            pr_[j][0] = raw[(size_t)tm * 1920 + c]; pr_[j][1] = raw[(size_t)lt * 1920 + c]; pr_[j][2] = raw[(size_t)tp * 1920 + c];
            pk_[j][0] = raw[(size_t)tm * 1920 + 512 + c]; pk_[j][1] = raw[(size_t)lt * 1920 + 512 + c]; pk_[j][2] = raw[(size_t)tp * 1920 + 512 + c];
            pa_[j] = aact[(size_t)lt * 512 + c]; pw_[j] = wdec[(size_t)lt * 512 + c]; pn_[j] = invn[(size_t)lt * 8 + h];
        }
#pragma unroll
        for (int j = 0; j < NV; ++j) {
            const int i = (ROWS == 32) ? (tid >> 5) : ((tid >> 6) + 8 * j), tstep = c0 + i, t = d == 0 ? tstep : S - 1 - tstep, lt = lt0 + t;
            const int tm = t > 0 ? lt - 1 : lt, tp = t < S - 1 ? lt + 1 : lt;
            pv_[j][0] = raw[(size_t)tm * 1920 + vcol]; pv_[j][1] = raw[(size_t)lt * 1920 + vcol]; pv_[j][2] = raw[(size_t)tp * 1920 + vcol];
        }
    };
    auto stage = [&](int c0, unsigned char* buf) {
        float* vec = (float*)buf; float* vbuf = (float*)(buf + 20480);
#pragma unroll
        for (int j = 0; j < 2; ++j) {
            const int i = (tid >> 6) + 8 * j, tstep = c0 + i, t = d == 0 ? tstep : S - 1 - tstep;
            const float rm = t > 0 ? (float)pr_[j][0] : 0.f, rp = t < S - 1 ? (float)pr_[j][2] : 0.f, km = t > 0 ? (float)pk_[j][0] : 0.f, kp = t < S - 1 ? (float)pk_[j][2] : 0.f;
            const float r1 = (float)pr_[j][1], k1 = (float)pk_[j][1];
            const float r = r1 + (0.5f * (rm + rp) - r1) * mu_r;
            const float k = k1 + (0.5f * (km + kp) - k1) * mu_k;
            const float kk = k * kkw * pn_[j], a = (float)pa_[j];
            vec[(0 * CH + i) * 64 + ch] = kk;
            vec[(1 * CH + i) * 64 + ch] = (float)pw_[j];
            vec[(2 * CH + i) * 64 + ch] = kk * a;
            vec[(3 * CH + i) * 64 + ch] = k * (1.0f + (a - 1.0f) * kaw);
            vec[(4 * CH + i) * 64 + ch] = r;
        }
#pragma unroll
        for (int j = 0; j < NV; ++j) {
            const int i = (ROWS == 32) ? (tid >> 5) : ((tid >> 6) + 8 * j), tstep = c0 + i, t = d == 0 ? tstep : S - 1 - tstep;
            const float vm = t > 0 ? (float)pv_[j][0] : 0.f, vp = t < S - 1 ? (float)pv_[j][2] : 0.f, v1 = (float)pv_[j][1];
            vbuf[i * 64 + vr] = v1 + (0.5f * (vm + vp) - v1) * mu_v;
        }
    };
    __syncthreads();
    prefetch(0);
    stage(0, smem);
    __syncthreads();
    const int nch = S / CH;
    for (int cix = 0; cix < nch; ++cix) {
        unsigned char* buf = smem + (cix & 1) * 32768;
        if (cix + 1 < nch) prefetch((cix + 1) * CH);
        {
            const float* vec = (const float*)buf; const float* vbuf = (const float*)(buf + 20480); float* ybuf = (float*)(buf + 24576);
            const f32x4* vp0 = (const f32x4*)(vec + q * KT);
            f32x4 nx[5][KT / 4]; float nvv;
#pragma unroll
            for (int u = 0; u < KT / 4; ++u)
#pragma unroll
                for (int a5 = 0; a5 < 5; ++a5) nx[a5][u] = vp0[a5 * CH * 16 + u];
            nvv = vbuf[row];
            float yv[CH];
#pragma unroll
            for (int i = 0; i < CH; ++i) {
                f32x2 kk2[KT / 2], w2[KT / 2], b2[KT / 2], kd2[KT / 2], r2[KT / 2];
#pragma unroll
                for (int u = 0; u < KT / 4; ++u) {
                    kk2[2 * u] = (f32x2){nx[0][u][0], nx[0][u][1]}; kk2[2 * u + 1] = (f32x2){nx[0][u][2], nx[0][u][3]};
                    w2[2 * u] = (f32x2){nx[1][u][0], nx[1][u][1]}; w2[2 * u + 1] = (f32x2){nx[1][u][2], nx[1][u][3]};
                    b2[2 * u] = (f32x2){nx[2][u][0], nx[2][u][1]}; b2[2 * u + 1] = (f32x2){nx[2][u][2], nx[2][u][3]};
                    kd2[2 * u] = (f32x2){nx[3][u][0], nx[3][u][1]}; kd2[2 * u + 1] = (f32x2){nx[3][u][2], nx[3][u][3]};
                    r2[2 * u] = (f32x2){nx[4][u][0], nx[4][u][1]}; r2[2 * u + 1] = (f32x2){nx[4][u][2], nx[4][u][3]};
                }
                const float vv = nvv;
                if (i + 1 < CH) {
#pragma unroll
                    for (int u = 0; u < KT / 4; ++u)
#pragma unroll
                        for (int a5 = 0; a5 < 5; ++a5) nx[a5][u] = vp0[(i + 1) * 16 + a5 * CH * 16 + u];
                    nvv = vbuf[(i + 1) * 64 + row];
                }
                f32x2 acc2 = s[0] * kk2[0];
#pragma unroll
                for (int j = 1; j < KT / 2; ++j) acc2 = __builtin_elementwise_fma(s[j], kk2[j], acc2);
                float sa = acc2[0] + acc2[1];
                sa += dppf<0xB1>(sa); sa += dppf<0x4E>(sa); sa += dppf<0x141>(sa);
                if (TPR == 16) sa += dppf<0x140>(sa);
                sa = -sa;
                const f32x2 sa2 = (f32x2){sa, sa}, vv2 = (f32x2){vv, vv};
                f32x2 y2 = (f32x2){0.f, 0.f};
#pragma unroll
                for (int j = 0; j < KT / 2; ++j) {
                    s[j] = __builtin_elementwise_fma(s[j], w2[j], __builtin_elementwise_fma(sa2, b2[j], vv2 * kd2[j]));
                    y2 = __builtin_elementwise_fma(s[j], r2[j], y2);
                }
                float y = y2[0] + y2[1];
                y += dppf<0xB1>(y); y += dppf<0x4E>(y);
                yv[i] = y;
            }
            if ((q & 3) == 0) {
#pragma unroll
                for (int i = 0; i < CH; ++i) ybuf[i * 128 + row * YP + (q >> 2)] = yv[i];
            }
        }
        if (cix + 1 < nch) stage((cix + 1) * CH, smem + ((cix + 1) & 1) * 32768);
        __syncthreads();
        {
            const float* ybuf = (const float*)(buf + 24576);
#pragma unroll
            for (int j = 0; j < NV; ++j) {
                const int i = (ROWS == 32) ? (tid >> 5) : ((tid >> 6) + 8 * j), rr = vr, tstep = cix * CH + i, t = d == 0 ? tstep : S - 1 - tstep;
                float y = 0.f;
#pragma unroll
                for (int p = 0; p < YP; ++p) y += ybuf[i * 128 + rr * YP + p];
                ydst[(size_t)(lt0 + t) * 512 + h * 64 + row0 + rr] = (f16)y;
            }
        }
    }
    __syncthreads();
}

__device__ __forceinline__ void finish_phase(const Ctx& C, const PV& P, int layer) {
    unsigned char* R = P.ws + WS_R;
    const f16* raw = (const f16*)(R + R_RAW); const f16* wa = (const f16*)(R + R_WA); const f16* gbuf = (const f16*)(R + R_G); const f16* yfb = (const f16*)(R + R_YFB);
    bf16_t* yr = (bf16_t*)(R + R_YB);
    const float* mu = P.inp(13) + (size_t)layer * 1920; const float* k_a = P.inp(20) + (size_t)layer * 512; const float* r_k = P.inp(21) + (size_t)layer * 512;
    const float* lg = P.inp(22) + (size_t)layer * 512; const float* lb = P.inp(23) + (size_t)layer * 512;
    const int lane = C.tid & 63, wave = C.tid >> 6, c = lane * 8;
    for (int lt = C.bid * NWV + wave; lt < TP; lt += C.nblk * NWV) {
        const int pos = pos_of(lt), S = lt < 8192 ? 8192 : 4096;
        const size_t rm = (size_t)(pos > 0 ? lt - 1 : lt) * 1920, r0 = (size_t)lt * 1920, rp = (size_t)(pos < S - 1 ? lt + 1 : lt) * 1920;
        const float wm = pos > 0 ? 0.5f : 0.f, wp = pos < S - 1 ? 0.5f : 0.f;
        const f16x8_t rA = *(const f16x8_t*)(raw + rm + c), rB = *(const f16x8_t*)(raw + r0 + c), rC = *(const f16x8_t*)(raw + rp + c);
        const f16x8_t kA = *(const f16x8_t*)(raw + rm + 512 + c), kB = *(const f16x8_t*)(raw + r0 + 512 + c), kC = *(const f16x8_t*)(raw + rp + 512 + c);
        const f16x8_t vA = *(const f16x8_t*)(raw + rm + 1024 + c), vB = *(const f16x8_t*)(raw + r0 + 1024 + c), vC = *(const f16x8_t*)(raw + rp + 1024 + c);
        const f16x8_t af = *(const f16x8_t*)(wa + 2 * SZ512 + (size_t)lt * 512 + c), ab = *(const f16x8_t*)(wa + 3 * SZ512 + (size_t)lt * 512 + c);
        const f16x8_t gg = *(const f16x8_t*)(gbuf + (size_t)lt * 512 + c);
        const f16x8_t yF = *(const f16x8_t*)(yfb + (size_t)lt * 512 + c), yB = *(const f16x8_t*)(yfb + SZ512 + (size_t)lt * 512 + c);
        float y[8], vv[8], bsum = 0.f, ysum = 0.f;
#pragma unroll
        for (int j = 0; j < 8; ++j) {
            const float r_ = (float)rB[j], k_ = (float)kB[j], v_ = (float)vB[j];
            const float r = r_ + (wm * (float)rA[j] + wp * (float)rC[j] - r_) * mu[c + j];
            const float k = k_ + (wm * (float)kA[j] + wp * (float)kC[j] - k_) * mu[512 + c + j];
            vv[j] = v_ + (wm * (float)vA[j] + wp * (float)vC[j] - v_) * mu[1024 + c + j];
            const float ka = k_a[c + j];
            const float ksum = k * (1.f + ((float)af[j] - 1.f) * ka) + k * (1.f + ((float)ab[j] - 1.f) * ka);
            bsum += r * (0.5f * ksum) * r_k[c + j];
            y[j] = (float)yF[j] + (float)yB[j]; ysum += y[j];
        }
        const float ym = red8(ysum) * (1.0f / 64.0f);
        float q = 0.f;
#pragma unroll
        for (int j = 0; j < 8; ++j) { const float dy = y[j] - ym; q += dy * dy; }
        const float rs = rsqrtf(red8(q) * (1.0f / 64.0f) + 64e-5f);
        const float bonus = red8(bsum);
        float o[8];
#pragma unroll
        for (int j = 0; j < 8; ++j) o[j] = ((y[j] - ym) * rs * lg[c + j] + lb[c + j] + bonus * vv[j]) * (float)gg[j];
        u32x4 w; w.x = pack2bf(o[0], o[1]); w.y = pack2bf(o[2], o[3]); w.z = pack2bf(o[4], o[5]); w.w = pack2bf(o[6], o[7]);
        *(u32x4*)(yr + (size_t)lt * 512 + c) = w;
    }
}

__device__ __forceinline__ void gates_phase(const Ctx& C, const PV& P, int layer) {
    const bf16_t* hmod = (const bf16_t*)(P.ws + WS_HMOD);
    const bf16_t* Wt = wl(P, layer) + OW_WIN + (size_t)4480 * 1024;
    bf16_t* gates = (bf16_t*)(P.ws + WS_R + R_GATES);
    int pm, pn;
    for (int it = 0; tile_order(it, C.nblk, C.bid, TP / 256, 16, pm, pn); ++it) {
        f32x4 acc[2][2][4][2];
        gemm256(C, acc, hmod, Wt, 1024, pm * 256, pn * 256);
        int z2 = 0; asm volatile("" : "+s"(z2));
        const int tid2 = tid_now(C.wave_s, z2), lane = tid2 & 63, wid = tid2 >> 6, wr = wid >> 2, wc = wid & 3, fr = lane & 15, fq = lane >> 4;
#pragma unroll
        for (int ai = 0; ai < 2; ++ai)
#pragma unroll
            for (int m = 0; m < 4; ++m) {
                const int lt = pm * 256 + ai * 128 + wr * 64 + m * 16 + fr;
#pragma unroll
                for (int bj = 0; bj < 2; ++bj)
#pragma unroll
                    for (int n = 0; n < 2; ++n) {
                        const int col = pn * 256 + bj * 128 + wc * 32 + n * 16 + fq * 4;
                        const f32x4 v = acc[ai][bj][m][n];
                        u32x2 w; w.x = pack2bf(sigmoidf_(v[0]), sigmoidf_(v[1])); w.y = pack2bf(sigmoidf_(v[2]), sigmoidf_(v[3]));
                        *(u32x2*)(gates + (size_t)lt * 4096 + col) = w;
                    }
            }
    }
}
__device__ __forceinline__ void branch_phase(const Ctx& C, const PV& P, int layer) {
    unsigned char* R = P.ws + WS_R;
    const bf16_t* yb = (const bf16_t*)(R + R_YB); const bf16_t* gates = (const bf16_t*)(R + R_GATES);
    float* m32 = (float*)(R + R_M32); bf16_t* merged = (bf16_t*)(R + R_MERGED);
    const bf16_t* W = wl(P, layer) + OW_WBR;
    int pm, pn;
    for (int it = 0; tile_order(it, C.nblk, C.bid, TP / 256, 4, pm, pn); ++it) {
        for (int nb = 0; nb < 4; ++nb) {
            f32x4 acc[2][2][4][2];
            gemm256(C, acc, yb + (size_t)nb * SZ512, W + (size_t)nb * 1024 * 512, 512, pm * 256, pn * 256);
            int z2 = 0; asm volatile("" : "+s"(z2));
            const int tid2 = tid_now(C.wave_s, z2), lane = tid2 & 63, wid = tid2 >> 6, wr = wid >> 2, wc = wid & 3, fr = lane & 15, fq = lane >> 4;
#pragma unroll
            for (int ai = 0; ai < 2; ++ai)
#pragma unroll
                for (int m = 0; m < 4; ++m) {
                    const int lt = pm * 256 + ai * 128 + wr * 64 + m * 16 + fr;
#pragma unroll
                    for (int bj = 0; bj < 2; ++bj)
#pragma unroll
                        for (int n = 0; n < 2; ++n) {
                            const int col = pn * 256 + bj * 128 + wc * 32 + n * 16 + fq * 4;
                            const u32x2 gw = *(const u32x2*)(gates + (size_t)lt * 4096 + nb * 1024 + col);
                            f32x4 g; g[0] = __uint_as_float(gw.x << 16); g[1] = __uint_as_float(gw.x & 0xffff0000u); g[2] = __uint_as_float(gw.y << 16); g[3] = __uint_as_float(gw.y & 0xffff0000u);
                            f32x4 mv = g * acc[ai][bj][m][n];
                            f32x4* mp = (f32x4*)(m32 + (size_t)lt * 1024 + col);
                            if (nb > 0) mv += *mp;
                            if (nb < 3) *mp = mv;
                            else { u32x2 w; w.x = pack2bf(mv[0], mv[1]); w.y = pack2bf(mv[2], mv[3]); *(u32x2*)(merged + (size_t)lt * 1024 + col) = w; }
                        }
                    asm volatile("" ::: "memory");
                }
        }
    }
}


#define XB_TMO      128
#define XB_XCNT(j)  (256  + 64 * (j))
#define XB_XSUB(j)  (1280 + 64 * (j))
#define XB_XGEN(j)  (2304 + 64 * (j))
#define XB_TOP      3328
#define XB_TOPGEN   3392
#define XCD_BAR_WORDS 3456
#define XB_SPIN_CAP (1u << 18)
#define LAS __attribute__((address_space(3)))
__device__ __forceinline__ unsigned xb_ld(unsigned* p)              { return __hip_atomic_load(p, __ATOMIC_RELAXED, __HIP_MEMORY_SCOPE_AGENT); }
__device__ __forceinline__ unsigned xb_add(unsigned* p, unsigned v) { return __hip_atomic_fetch_add(p, v, __ATOMIC_RELAXED, __HIP_MEMORY_SCOPE_AGENT); }
__device__ __forceinline__ unsigned xb_xcc_id() { return (unsigned)__builtin_amdgcn_s_getreg((3 << 11) | 20) & 0xFu; }
#define XB_SPIN(cond, bar) do { unsigned _sp = 0; while (cond) { __builtin_amdgcn_s_sleep(1); \
    if ((++_sp & 255u) == 0u) { if (xb_ld(&(bar)[XB_TMO])) break; if (_sp > XB_SPIN_CAP) { atomicAdd(&(bar)[XB_TMO], 1u); break; } } } } while (0)
struct XcdBarrier { unsigned* bar; unsigned x; volatile LAS unsigned* st; };
__device__ __forceinline__ XcdBarrier xcd_barrier_post(unsigned* bar, volatile LAS unsigned* st) {
    XcdBarrier b; b.bar = bar; b.x = xb_xcc_id(); b.st = st;
    if (threadIdx.x == 0) (void)xb_add(&bar[XB_XCNT(b.x)], 1u);
    return b;
}
__device__ __forceinline__ void xcd_barrier_complete(unsigned* bar, unsigned x, unsigned& nloc, unsigned& nx) {
    const unsigned G = gridDim.x * gridDim.y * gridDim.z;
    unsigned sum, cnt, mine, sp = 0u;
    for (;;) {
        sum = 0u; cnt = 0u; mine = 0u;
#pragma unroll
        for (unsigned j = 0; j < 16; ++j) { const unsigned c = xb_ld(&bar[XB_XCNT(j)]); sum += c; cnt += (c > 0u) ? 1u : 0u; mine = (j == x) ? c : mine; }
        if (sum == G) break;
        __builtin_amdgcn_s_sleep(1);
        if ((++sp & 255u) == 0u) { if (xb_ld(&bar[XB_TMO])) break; if (sp > XB_SPIN_CAP) { atomicAdd(&bar[XB_TMO], 1u); break; } }
    }
    nloc = mine > 0u ? mine : 1u; nx = cnt > 0u ? cnt : 1u;
}
__device__ __forceinline__ void xcd_barrier(const XcdBarrier& b) {
    asm volatile("s_waitcnt vmcnt(0)" ::: "memory");
    __syncthreads();
    if (threadIdx.x == 0) {
        unsigned* bar = b.bar;
        __builtin_amdgcn_s_waitcnt(0);
        unsigned nloc = b.st[0], nx = b.st[1];
        if (nloc == 0u) { xcd_barrier_complete(bar, b.x, nloc, nx); b.st[0] = nloc; b.st[1] = nx; }
        const unsigned old = xb_add(&bar[XB_XSUB(b.x)], 1u);
        const unsigned gen = old / nloc;
        if (old + 1u == (gen + 1u) * nloc) {
            __builtin_amdgcn_fence(__ATOMIC_RELEASE, "agent");
            asm volatile("s_waitcnt vmcnt(0)" ::: "memory");
            const unsigned og = xb_add(&bar[XB_TOP], 1u);
            const unsigned tg = og / nx;
            if (og + 1u == (tg + 1u) * nx) xb_add(&bar[XB_TOPGEN], 1u);
            else XB_SPIN(xb_ld(&bar[XB_TOPGEN]) == tg, bar);
            __builtin_amdgcn_fence(__ATOMIC_ACQUIRE, "agent");
            xb_add(&bar[XB_XGEN(b.x)], 1u);
            asm volatile("s_waitcnt vmcnt(0)" ::: "memory");
        } else {
            XB_SPIN(xb_ld(&bar[XB_XGEN(b.x)]) == gen, bar);
            __builtin_amdgcn_fence(__ATOMIC_ACQUIRE, "agent");
            asm volatile("s_waitcnt vmcnt(0)" ::: "memory");
        }
    }
    __syncthreads();
}

constexpr int PH_PER_LAYER = 15, PH_PER_PASS = 2 * PH_PER_LAYER + 1, NPHASE = 1 + NPASS * PH_PER_PASS;

__global__ void __launch_bounds__(512, 2) mk_forward(Params P0, int ph_lo, int ph_hi) {
    unsigned char* smem = dyn_smem;
    const int wave_s = __builtin_amdgcn_readfirstlane((int)threadIdx.x >> 6);
    volatile LAS unsigned* xst = (volatile LAS unsigned*)(LAS unsigned char*)(dyn_smem + 131072);
    if (threadIdx.x == 0) { xst[0] = 0u; xst[1] = 0u; }
    __syncthreads();
    const XcdBarrier xb = xcd_barrier_post((unsigned*)(P0.ws + WS_BAR), xst);
    for (int it_ = 2 * ph_lo; it_ < 2 * ph_hi; ++it_) {
        const int ph = it_ >> 1;
        if (it_ & 1) {
            if (PROBE_MASK == 0 || ph == 0) continue;
            const int r_ = (ph - 1) % PH_PER_PASS;
            if (r_ == PH_PER_PASS - 1 || !((PROBE_MASK >> (r_ % PH_PER_LAYER)) & 1)) continue;
        }
        if (it_ > 2 * ph_lo) { if (it_ == 2 * ph_lo + 2) cg::this_grid().sync(); else xcd_barrier(xb); }
        int z = 0; asm volatile("" : "+s"(z));
        Ctx C; C.tid = tid_now(wave_s, z); C.bid = (int)blockIdx.x + z; C.nblk = (int)gridDim.x + z; C.wave_s = wave_s;
        ptrtab_t tab = (ptrtab_t)__builtin_amdgcn_kernarg_segment_ptr();
        asm volatile("" : "+s"(tab));
        const PV P{tab, (float*)tab[29], (unsigned char*)tab[30]};
        if (ph == 0) { prep_phase(C, P, smem); continue; }
        const int q = ph - 1, pass = q / PH_PER_PASS, r = q % PH_PER_PASS;
        if (r == PH_PER_PASS - 1) { norm_phase(C, P, pass, P.inp(6) + (size_t)(1 * 3 + 2) * 1024, P.inp(7) + (size_t)(1 * 3 + 2) * 1024, 0, -1, false, true); continue; }
        const int layer = r / PH_PER_LAYER, lp = r % PH_PER_LAYER;
        const bf16_t* W = wl(P, layer);
        const float* lng = P.inp(6) + (size_t)layer * 3 * 1024; const float* lnb = P.inp(7) + (size_t)layer * 3 * 1024;
        const float* lngp = P.inp(6) + (size_t)((layer > 0 ? layer - 1 : 0) * 3 + 2) * 1024; const float* lnbp = P.inp(7) + (size_t)((layer > 0 ? layer - 1 : 0) * 3 + 2) * 1024;
        unsigned char* R = P.ws + WS_R;
        switch (lp) {
            case 0:
                if (layer == 0) norm_phase(C, P, pass, nullptr, nullptr, 0, 0, true, false);
                else norm_phase(C, P, pass, lngp, lnbp, layer, 0, false, false);
                break;
            case 1: ffn_up_phase(C, P, W + OW_FA_IN); break;
            case 2: resid_gemm_phase(C, P, pass, (const bf16_t*)(R + R_ACT), 2816, W + OW_FA_OUT, layer, 0, 0.5f, layer == 0 ? nullptr : lngp, lnbp); break;
            case 3: norm_phase(C, P, pass, lng, lnb, layer, 1, false, false); break;
            case 4: win_phase(C, P, layer); break;
            case 5: lin_pool_phase(C, P, layer); break;
            case 6: lora_phase(C, P, layer, smem); break;
            case 7:
                if (C.bid < 32) scan_block<4>(C, P, layer, 0, C.bid >> 2, (C.bid >> 1) & 1, (C.bid & 1) * 32, smem);
                else if (C.bid < 160) { const int i2 = C.bid - 32; scan_block<8>(C, P, layer, 1 + (i2 >> 4), (i2 >> 1) & 7, i2 & 1, 0, smem); }
                attn_items(C, P, layer, pass * 2 + layer, smem); fft_items(C, P, smem); break;
            case 8: finish_phase(C, P, layer); break;
            case 9: gates_phase(C, P, layer); break;
            case 10: branch_phase(C, P, layer); break;
            case 11: resid_gemm_phase(C, P, pass, (const bf16_t*)(R + R_MERGED), 1024, W + OW_WOUT, layer, 1, 1.0f, lng, lnb); break;
            case 12: norm_phase(C, P, pass, lng + 1024, lnb + 1024, layer, 2, false, false); break;
            case 13: ffn_up_phase(C, P, W + OW_FB_IN); break;
            default: resid_gemm_phase(C, P, pass, (const bf16_t*)(R + R_ACT), 2816, W + OW_FB_OUT, layer, 2, 0.5f, lng + 1024, lnb + 1024); break;
        }
    }
}

extern "C" void kernel_launch(void* const* d_in, const int* in_sizes, int n_in, void* d_out, int out_size, void* d_ws, size_t ws_size, hipStream_t stream) {
    static int grid_blocks = 0;
    if (!grid_blocks) {
        int dev = 0, cus = 0, per_cu = 0;
        (void)hipGetDevice(&dev);
        (void)hipDeviceGetAttribute(&cus, hipDeviceAttributeMultiprocessorCount, dev);
        (void)hipFuncSetAttribute((const void*)mk_forward, hipFuncAttributeMaxDynamicSharedMemorySize, LDS_BYTES);
        (void)hipOccupancyMaxActiveBlocksPerMultiprocessor(&per_cu, mk_forward, NT, LDS_BYTES);
        if (per_cu < 1) per_cu = 1;
        if (per_cu > 1) per_cu = 1;
        grid_blocks = cus * per_cu;
    }
    Params p{};
    for (int i = 0; i < 29; ++i) p.in[i] = (const float*)d_in[i];
    p.out = (float*)d_out; p.ws = (unsigned char*)d_ws;
    (void)hipMemsetAsync((unsigned char*)d_ws + WS_BAR, 0, XCD_BAR_WORDS * 4, stream);
#if ONE_LAUNCH
    int lo = 0, hi = NPHASE;
    void* args[] = {&p, &lo, &hi};
    hipError_t e = hipLaunchCooperativeKernel((void*)mk_forward, dim3(grid_blocks), dim3(NT), args, LDS_BYTES, stream);
    if (e != hipSuccess) fprintf(stderr, "cooperative launch failed: %s (grid %d)\n", hipGetErrorString(e), grid_blocks);
#else
    for (int ph = 0; ph < NPHASE; ++ph) {
        int lo = ph, hi = ph + 1;
        void* args[] = {&p, &lo, &hi};
        (void)hipLaunchCooperativeKernel((void*)mk_forward, dim3(grid_blocks), dim3(NT), args, LDS_BYTES, stream);
    }
#endif
}
```

```cpp
#include <hip/hip_runtime.h>
#include <hip/hip_cooperative_groups.h>
#include <cstdio>
#include <cstdint>
namespace cg = cooperative_groups;

typedef unsigned short bf16_t;
typedef _Float16 f16;
typedef short bf16x8 __attribute__((ext_vector_type(8)));
typedef float f32x4 __attribute__((ext_vector_type(4)));
typedef unsigned u32x4 __attribute__((ext_vector_type(4)));
typedef unsigned u32x2 __attribute__((ext_vector_type(2)));
typedef float f32x2 __attribute__((ext_vector_type(2)));

#ifndef ONE_LAUNCH
#define ONE_LAUNCH 1
#endif
#ifndef PROBE_MASK
#define PROBE_MASK 0
#endif

constexpr int TP = 40960;
constexpr int NPASS = 2;
constexpr int NSEQ = 9;
constexpr int MT = TP / 128;
constexpr int N_IN_FULL = 8576;
constexpr float ALPHA = 1.41421356237f;

constexpr size_t OW_FA_IN = 0, OW_FA_OUT = 5767168, OW_FB_IN = 8650752, OW_FB_OUT = 14417920, OW_WIN = 17301504,
                 OW_WBR = 26083328, OW_WOUT = 28180480, OW_W2T = 29229056, OW_A2T = 29294592, OW_G2T = 29360128, WL_TOTAL = 29425664;
constexpr size_t WS_W = 0, WS_TW = 117702656, WS_MOD = 117735424, WS_HMOD = 119062528, WS_R = 202948608, WS_INVN = 1062780928, WS_CTR = 1064091648, WS_STATS = 1064091904, WS_BAR = 1064419584;
constexpr size_t R_RAW = 0, R_LIN = 157286400, R_WA = 188743680, R_G = 356515840, R_Q = 398458880, R_K = 440401920, R_VT = 482344960,
                 R_YFB = 524288000, R_ZC = 608174080, R_POOLP = 650117120, R_YB = 692060160, R_ACT = 0,
                 R_GATES = 0  , R_M32 = 398458880  , R_MERGED = 566231040  ;
constexpr size_t SZ512 = (size_t)TP * 512;

struct Params { const float* in[29]; float* out; unsigned char* ws; };
struct Ctx { int tid, bid, nblk, wave_s; };
__device__ __forceinline__ int tid_now(int wave_s, int z) { return wave_s * 64 + (int)__builtin_amdgcn_mbcnt_hi(~0u, __builtin_amdgcn_mbcnt_lo(~0u, (unsigned)z)); }
typedef const float* const __attribute__((address_space(4)))* ptrtab_t;
struct PV { ptrtab_t tab; float* out; unsigned char* ws;
    __device__ __forceinline__ const float* inp(int i) const { return tab[i]; } };
constexpr int NT = 512, NWV = 8;
extern __shared__ __attribute__((aligned(16))) unsigned char dyn_smem[];
constexpr int LDS_BYTES = 131072 + 64;

__device__ __forceinline__ bf16_t f2bf(float f) { unsigned u = __float_as_uint(f); u += 0x7fffu + ((u >> 16) & 1u); return (bf16_t)(u >> 16); }
__device__ __forceinline__ float bf2f(bf16_t b) { return __uint_as_float(((unsigned)b) << 16); }
__device__ __forceinline__ unsigned pack2bf(float a, float b) { unsigned r; asm("v_cvt_pk_bf16_f32 %0, %1, %2" : "=v"(r) : "v"(a), "v"(b)); return r; }
__device__ __forceinline__ float wsum(float v) {
#pragma unroll
    for (int o = 32; o > 0; o >>= 1) v += __shfl_xor(v, o);
    return v;
}
__device__ __forceinline__ float sigmoidf_(float x) { return 1.0f / (1.0f + __expf(-x)); }
template <int CTRL> __device__ __forceinline__ float dppf(float v) { return __int_as_float(__builtin_amdgcn_update_dpp(0, __float_as_int(v), CTRL, 0xF, 0xF, true)); }
__device__ __forceinline__ float red8(float v) { v += dppf<0xB1>(v); v += dppf<0x4E>(v); v += dppf<0x141>(v); return v; }

__device__ __forceinline__ int grow_of(int pass, int lt) { return lt < 8192 ? pass * 8192 + lt : 16384 + pass * 32768 + (lt - 8192); }
__device__ __forceinline__ int brow_of(int pass, int lt) { return lt < 8192 ? pass : 2 + pass * 8 + ((lt - 8192) >> 12); }
__device__ __forceinline__ int pos_of(int lt) { return lt < 8192 ? lt : ((lt - 8192) & 4095); }
__device__ __forceinline__ int seqbase_of(int sq) { return sq == 0 ? 0 : 8192 + (sq - 1) * 4096; }
__device__ __forceinline__ int seqlen_of(int sq) { return sq == 0 ? 8192 : 4096; }

__device__ __forceinline__ bf16_t* wl(const PV& P, int layer) { return (bf16_t*)(P.ws + WS_W) + (size_t)layer * WL_TOTAL; }

template <int NJ, bool SWAP>
__device__ __forceinline__ void gemm_core(const Ctx& C, f32x4 (&acc)[4][NJ], const bf16_t* __restrict__ A, int lda, const bf16_t* __restrict__ B, int ldb, int K, unsigned char* smem) {
    const int tid = C.tid & 255, lane = tid & 63, wave = tid >> 6, wm = wave >> 1, wn = wave & 1, fr = lane & 15, fq = lane >> 4;
    smem += (C.tid >> 8) * 36864;
    u32x4 ra[4], rb[NJ];
#pragma unroll
    for (int i = 0; i < 4; ++i)
#pragma unroll
        for (int j = 0; j < NJ; ++j) acc[i][j] = (f32x4){0.f, 0.f, 0.f, 0.f};
    const int lrow = tid >> 3, lkc = (tid & 7) * 8;
#pragma unroll
    for (int i = 0; i < 4; ++i) ra[i] = *(const u32x4*)(A + (size_t)(lrow + 32 * i) * lda + lkc);
#pragma unroll
    for (int i = 0; i < NJ; ++i) rb[i] = *(const u32x4*)(B + (size_t)(lrow + 32 * i) * ldb + lkc);
    for (int k0 = 0; k0 < K; k0 += 64) {
        __syncthreads();
#pragma unroll
        for (int i = 0; i < 4; ++i) *(u32x4*)(smem + (lrow + 32 * i) * 144 + lkc * 2) = ra[i];
#pragma unroll
        for (int i = 0; i < NJ; ++i) *(u32x4*)(smem + 18432 + (lrow + 32 * i) * 144 + lkc * 2) = rb[i];
        __syncthreads();
        if (k0 + 64 < K) {
#pragma unroll
            for (int i = 0; i < 4; ++i) ra[i] = *(const u32x4*)(A + (size_t)(lrow + 32 * i) * lda + k0 + 64 + lkc);
#pragma unroll
            for (int i = 0; i < NJ; ++i) rb[i] = *(const u32x4*)(B + (size_t)(lrow + 32 * i) * ldb + k0 + 64 + lkc);
        }
#pragma unroll
        for (int ks = 0; ks < 2; ++ks) {
            bf16x8 af[4], bfr[NJ];
#pragma unroll
            for (int i = 0; i < 4; ++i) af[i] = *(const bf16x8*)(smem + (wm * 64 + i * 16 + fr) * 144 + (ks * 32 + fq * 8) * 2);
#pragma unroll
            for (int j = 0; j < NJ; ++j) bfr[j] = *(const bf16x8*)(smem + 18432 + (wn * NJ * 16 + j * 16 + fr) * 144 + (ks * 32 + fq * 8) * 2);
#pragma unroll
            for (int i = 0; i < 4; ++i)
#pragma unroll
                for (int j = 0; j < NJ; ++j)
                    acc[i][j] = SWAP ? __builtin_amdgcn_mfma_f32_16x16x32_bf16(bfr[j], af[i], acc[i][j], 0, 0, 0)
                                     : __builtin_amdgcn_mfma_f32_16x16x32_bf16(af[i], bfr[j], acc[i][j], 0, 0, 0);
        }
    }
}


namespace g256 {
constexpr int BK = 64, HALF = 128, HT = HALF * BK;
__device__ __forceinline__ int lds_byte(int r, int c) { int st = (r >> 4) * 2 + (c >> 5), rr = r & 15, cc = c & 31, ob = rr * 64 + cc * 2; return st * 1024 + (ob ^ (((ob >> 9) & 1) << 5)); }
__device__ __forceinline__ void stage_rc(unsigned b, unsigned& R, unsigned& Cc) { const unsigned st = b >> 10, sb = b & 1023u, swz = sb ^ (((sb >> 9) & 1u) << 5); R = (st >> 1) * 16u + (swz >> 6); Cc = (st & 1u) * 32u + ((swz & 63u) >> 1); }
}
__device__ __forceinline__ void gemm256(const Ctx& C, f32x4 (&acc)[2][2][4][2], const bf16_t* __restrict__ A, const bf16_t* __restrict__ Bt, const int K, const int brow, const int bcol) {
    using namespace g256;
    bf16_t* shm = (bf16_t*)dyn_smem;
    const int tidx = C.tid;
    #define SA(b,h) (shm+((b)*2+(h))*HT)
    #define SB(b,h) (shm+(4+(b)*2+(h))*HT)
    #define STAGE(Pp,BASE,br,kt) do{const char* _ub=(const char*)((BASE)+(long)(br)*K+(long)(kt)*BK); asm volatile("" : "+s"(_ub)); \
        __builtin_amdgcn_global_load_lds((const unsigned*)(_ub+goff0), \
          (__attribute__((address_space(3))) unsigned*)((__attribute__((address_space(3))) char*)(Pp)+tidx*16),16,0,0); \
        __builtin_amdgcn_global_load_lds((const unsigned*)(_ub+goff1), \
          (__attribute__((address_space(3))) unsigned*)((__attribute__((address_space(3))) char*)(Pp)+tidx*16+8192),16,0,0);}while(0)
    #define LDA(dst,b,h) for(int m=0;m<4;++m)for(int k=0;k<2;++k) \
      dst[m][k]=*reinterpret_cast<const bf16x8*>(a_ptr+((b)*2+(h))*16384+m*2048+k*1024)
    #define LDB(dst,b,h) for(int n=0;n<2;++n)for(int k=0;k<2;++k) \
      dst[n][k]=*reinterpret_cast<const bf16x8*>(b_ptr+((b)*2+(h))*16384+n*2048+k*1024)
    #define MMA(ai,bj,Atx,Btx) do{__builtin_amdgcn_s_setprio(1); \
      for(int m=0;m<4;++m)for(int n=0;n<2;++n)for(int k=0;k<2;++k) \
        acc[ai][bj][m][n]=__builtin_amdgcn_mfma_f32_16x16x32_bf16(Btx[n][k],Atx[m][k],acc[ai][bj][m][n],0,0,0); \
      __builtin_amdgcn_s_setprio(0);}while(0)
    #define WAIT_V(n) asm volatile("s_waitcnt vmcnt(" #n ")":::"memory")
    #define WAIT_L(n) asm volatile("s_waitcnt lgkmcnt(" #n ")":::"memory")
    #define BAR __builtin_amdgcn_s_barrier()
    #define SCHED __builtin_amdgcn_sched_barrier(0)
    const int wid = tidx >> 6, lane = tidx & 63, wr = wid >> 2, wc = wid & 3, fr = lane & 15, fq = lane >> 4;
    const int swz = (fr * 64 + fq * 16) ^ ((fr >> 3) << 5);
    const char* a_ptr = (const char*)dyn_smem + wr * 8192 + swz;
    const char* b_ptr = (const char*)dyn_smem + 65536 + wc * 4096 + swz;
#pragma unroll
    for (int a = 0; a < 2; ++a)
#pragma unroll
        for (int b = 0; b < 2; ++b)
#pragma unroll
            for (int m = 0; m < 4; ++m) { acc[a][b][m][0] = (f32x4){0.f, 0.f, 0.f, 0.f}; acc[a][b][m][1] = (f32x4){0.f, 0.f, 0.f, 0.f}; }
    bf16x8 At[4][2], B0[2][2], B1[2][2];
    const int nt = K / BK;
    unsigned goff0, goff1;
    { unsigned r0, c0, r1, c1; stage_rc((unsigned)tidx * 16u, r0, c0); stage_rc((unsigned)tidx * 16u + 8192u, r1, c1); goff0 = (r0 * (unsigned)K + c0) * 2u; goff1 = (r1 * (unsigned)K + c1) * 2u; }
    WAIT_V(0); __syncthreads();
    STAGE(SB(0,0),Bt,bcol,0); STAGE(SA(0,0),A,brow,0);
    STAGE(SB(0,1),Bt,bcol+HALF,0); STAGE(SA(0,1),A,brow+HALF,0);
    if(wr==1)BAR;
    WAIT_V(4); BAR;
    STAGE(SB(1,0),Bt,bcol,1); STAGE(SA(1,0),A,brow,1); STAGE(SB(1,1),Bt,bcol+HALF,1);
    WAIT_V(6); BAR;
    for(int t=0;t<nt-2;t+=2){
      LDB(B0,0,0); SCHED; LDA(At,0,0); STAGE(SA(1,1),A,brow+HALF,t+1);
      WAIT_L(8); BAR; WAIT_L(0); MMA(0,0,At,B0); BAR; SCHED;
      LDB(B1,0,1); STAGE(SB(0,0),Bt,bcol,t+2);
      BAR; WAIT_L(0); MMA(0,1,At,B1); BAR;
      LDA(At,0,1); STAGE(SA(0,0),A,brow,t+2);
      BAR; WAIT_L(0); MMA(1,0,At,B0); BAR; SCHED;
      STAGE(SB(0,1),Bt,bcol+HALF,t+2);
      WAIT_V(6); BAR; MMA(1,1,At,B1); BAR;
      LDB(B0,1,0); SCHED; LDA(At,1,0); STAGE(SA(0,1),A,brow+HALF,t+2);
      WAIT_L(8); BAR; WAIT_L(0); MMA(0,0,At,B0); BAR; SCHED;
      LDB(B1,1,1); STAGE(SB(1,0),Bt,bcol,t+3);
      BAR; WAIT_L(0); MMA(0,1,At,B1); BAR;
      LDA(At,1,1); STAGE(SA(1,0),A,brow,t+3);
      BAR; WAIT_L(0); MMA(1,0,At,B0); BAR; SCHED;
      STAGE(SB(1,1),Bt,bcol+HALF,t+3);
      WAIT_V(6); BAR; MMA(1,1,At,B1); BAR;
    }
    { LDB(B0,0,0); LDA(At,0,0); STAGE(SA(1,1),A,brow+HALF,nt-1);
      BAR; WAIT_L(0); MMA(0,0,At,B0); BAR;
      LDB(B1,0,1); BAR; WAIT_L(0); MMA(0,1,At,B1); BAR;
      LDA(At,0,1); WAIT_V(4); BAR; WAIT_L(0); MMA(1,0,At,B0); MMA(1,1,At,B1); BAR; }
    { LDB(B0,1,0); LDA(At,1,0); WAIT_V(2); BAR; WAIT_L(0); MMA(0,0,At,B0); BAR;
      LDB(B1,1,1); WAIT_V(0); BAR; WAIT_L(0); MMA(0,1,At,B1); BAR;
      LDA(At,1,1); BAR; WAIT_L(0); MMA(1,0,At,B0); MMA(1,1,At,B1); BAR; }
    if(wr==0)BAR;
    #undef SA
    #undef SB
    #undef STAGE
    #undef LDA
    #undef LDB
    #undef MMA
    #undef WAIT_V
    #undef WAIT_L
    #undef BAR
    #undef SCHED
}
__device__ __forceinline__ bool tile_order(int i, int G, int c, int nM, int nN, int& pm, int& pn) {
    const int nwg = nM * nN; const long L = (long)i * G + c; if (L >= nwg) return false;
    int wgid = (int)L; { const int q = nwg / 8, r = nwg % 8, xcd = wgid % 8, off = wgid / 8; wgid = (xcd < r ? xcd * (q + 1) : r * (q + 1) + (xcd - r) * q) + off; }
    const int nig = 8 * nN, gid = wgid / nig, fm = gid * 8, gsz = (nM - fm) < 8 ? (nM - fm) : 8;
    pm = fm + ((wgid % nig) % gsz); pn = (wgid % nig) / gsz; return true;
}

struct ConvJob { const float* src; int ld, K, nbegin, ncount, map; bf16_t* dst; };
__device__ __forceinline__ ConvJob conv_job(const PV& P, int j) {
    const int l = j >> 4, q = j & 15; bf16_t* W = wl(P, l); ConvJob c; c.map = 0; c.nbegin = 0;
    switch (q) {
        case 0: c.src = P.inp(8) + (size_t)l * 1024 * 5632; c.ld = 5632; c.K = 1024; c.ncount = 5632; c.dst = W + OW_FA_IN; c.map = 1; break;
        case 1: c.src = P.inp(9) + (size_t)l * 2816 * 1024; c.ld = 1024; c.K = 2816; c.ncount = 1024; c.dst = W + OW_FA_OUT; break;
        case 2: c.src = P.inp(10) + (size_t)l * 1024 * 5632; c.ld = 5632; c.K = 1024; c.ncount = 5632; c.dst = W + OW_FB_IN; c.map = 1; break;
        case 3: c.src = P.inp(11) + (size_t)l * 2816 * 1024; c.ld = 1024; c.K = 2816; c.ncount = 1024; c.dst = W + OW_FB_OUT; break;
        case 4: c.src = P.inp(12) + (size_t)l * 1024 * 8576; c.ld = 8576; c.K = 1024; c.ncount = 3456; c.dst = W + OW_WIN; break;
        case 5: c.src = P.inp(12) + (size_t)l * 1024 * 8576; c.ld = 8576; c.K = 1024; c.nbegin = 3968; c.ncount = 4608; c.dst = W + OW_WIN + (size_t)3968 * 1024; break;
        case 6: case 7: case 8: case 9: { const int n = q - 6; c.src = P.inp(27) + (size_t)(l * 4 + n) * 512 * 1024; c.ld = 1024; c.K = 512; c.ncount = 1024; c.dst = W + OW_WBR + (size_t)n * 1024 * 512; } break;
        case 10: c.src = P.inp(28) + (size_t)l * 1024 * 1024; c.ld = 1024; c.K = 1024; c.ncount = 1024; c.dst = W + OW_WOUT; break;
        case 11: case 12: { const int d = q - 11; c.src = P.inp(15) + (size_t)(l * 2 + d) * 64 * 512; c.ld = 512; c.K = 64; c.ncount = 512; c.dst = W + OW_W2T + (size_t)d * 512 * 64; } break;
        case 13: case 14: { const int d = q - 13; c.src = P.inp(17) + (size_t)(l * 2 + d) * 64 * 512; c.ld = 512; c.K = 64; c.ncount = 512; c.dst = W + OW_A2T + (size_t)d * 512 * 64; } break;
        default: c.src = P.inp(18) + (size_t)l * 128 * 512; c.ld = 512; c.K = 128; c.ncount = 512; c.dst = W + OW_G2T; break;
    }
    return c;
}

__device__ __forceinline__ void prep_phase(const Ctx& C, const PV& P, unsigned char* smem) {
    const int tid = C.tid;
    {
        int total = 0;
        for (int j = 0; j < 32; ++j) { ConvJob c = conv_job(P, j); total += (c.K >> 6) * (c.ncount >> 6); }
        float* tile = (float*)smem;
        const int tx = tid & 63, ty = tid >> 6;
        for (int t = C.bid; t < total; t += C.nblk) {
            int tt = t, j = 0; ConvJob c = conv_job(P, 0);
            for (;;) { const int n = (c.K >> 6) * (c.ncount >> 6); if (tt < n) break; tt -= n; ++j; c = conv_job(P, j); }
            const int nkt = c.K >> 6, kt = tt % nkt, nt = tt / nkt, k0 = kt * 64, n0 = nt * 64;
            int col = c.nbegin + n0 + tx;
            if (c.map) { const int np = n0 + tx, blk = np >> 5, w = np & 31, f = blk * 16 + (w & 15); col = (w < 16) ? f : 2816 + f; }
            __syncthreads();
#pragma unroll 4
            for (int i = 0; i < 8; ++i) { const int kk = ty + 8 * i; tile[kk * 65 + tx] = c.src[(size_t)(k0 + kk) * c.ld + col]; }
            __syncthreads();
#pragma unroll 4
            for (int i = 0; i < 8; ++i) { const int nn = ty + 8 * i; c.dst[(size_t)(n0 + nn) * c.K + k0 + tx] = f2bf(tile[tx * 65 + nn]); }
        }
        __syncthreads();
    }
    {
        float* wt = (float*)smem;
        float* cosT = (float*)(smem + 64 * 129 * 4);
        for (int it = C.bid; it < 2 * 4 * 16; it += C.nblk) {
            const int l = it >> 6, g = (it >> 4) & 3, kc = it & 15, k0 = kc * 64;
            const float* src = P.inp(12) + (size_t)l * 1024 * 8576 + 3456 + g * 128;
            __syncthreads();
            for (int e = tid; e < 64 * 128; e += NT) { const int kk = e >> 7, c = e & 127; wt[kk * 129 + c] = src[(size_t)(k0 + kk) * 8576 + c]; }
            if (tid < 128) cosT[tid] = cospif((float)tid * (1.0f / 64.0f));
            __syncthreads();
            bf16_t* dst = wl(P, l) + OW_WIN + (size_t)(3456 + g * 128) * 1024;
            const int kk = tid & 63;
            for (int i = 0; i < 16; ++i) {
                const int j2 = (tid >> 6) + 8 * i, cc = j2 >> 1, part = j2 & 1;
                float s = 0.f;
                if (cc == 0) {
                    if (part == 0) { for (int c = 0; c < 128; ++c) s += wt[kk * 129 + c]; }
                    else { for (int c = 0; c < 128; ++c) s += (c & 1) ? -wt[kk * 129 + c] : wt[kk * 129 + c]; }
                } else if (part == 0) {
                    for (int c = 0; c < 128; ++c) s += wt[kk * 129 + c] * cosT[(cc * c) & 127];
                } else {
                    for (int c = 0; c < 128; ++c) s -= wt[kk * 129 + c] * cosT[(cc * c - 32) & 127];
                }
                dst[(size_t)j2 * 1024 + k0 + kk] = f2bf(s);
            }
        }
        __syncthreads();
    }
    if (C.bid == 0 && tid < 16) ((unsigned*)(P.ws + WS_CTR))[tid] = 0u;
    {
        float2* tw = (float2*)(P.ws + WS_TW);
        for (int m = C.bid * NT + tid; m < 4096; m += C.nblk * NT) { const float x = (float)m * (1.0f / 4096.0f); tw[m] = make_float2(cospif(x), -sinpif(x)); }
    }
    {
        float* sc = (float*)smem;
        float* red = (float*)(smem + 18 * 512 * 4);
        float* mod = (float*)(P.ws + WS_MOD);
        for (int it = C.bid; it < 2 * 144; it += C.nblk) {
            const int l = it / 144, n0 = (it % 144) * 64, nl = tid & 63, ks = tid >> 6;
            const float* aw = P.inp(4) + (size_t)l * 1024 * 9216;
            float acc[18];
#pragma unroll
            for (int b = 0; b < 18; ++b) acc[b] = 0.f;
            for (int half = 0; half < 2; ++half) {
                __syncthreads();
                for (int e = tid; e < 18 * 512; e += NT) {
                    const int b = e >> 9, kk = e & 511, k = half * 512 + kk;
                    const float cv = b < 2 ? P.inp(2)[b * 1024 + k] : P.inp(3)[(b - 2) * 1024 + k];
                    sc[e] = cv / (1.0f + __expf(-cv));
                }
                __syncthreads();
                for (int kk = ks * 64; kk < ks * 64 + 64; ++kk) {
                    const float w = aw[(size_t)(half * 512 + kk) * 9216 + n0 + nl];
#pragma unroll
                    for (int b = 0; b < 18; ++b) acc[b] += sc[b * 512 + kk] * w;
                }
            }
            __syncthreads();
#pragma unroll
            for (int b = 0; b < 18; ++b) red[(ks * 18 + b) * 64 + nl] = acc[b];
            __syncthreads();
            for (int e = tid; e < 18 * 64; e += NT) {
                const int b = e >> 6, n = e & 63;
                float s = 0.f;
#pragma unroll
                for (int k8 = 0; k8 < 8; ++k8) s += red[(k8 * 18 + b) * 64 + n];
                mod[((size_t)l * 18 + b) * 9216 + n0 + n] = s + P.inp(5)[(size_t)l * 9216 + n0 + n];
            }
        }
        __syncthreads();
    }
}

__device__ __forceinline__ void norm_phase(const Ctx& C, const PV& P, int pass, const float* lng, const float* lnb, int mod_layer, int j, bool from_input, bool write_x) {
    const int lane = C.tid & 63, wave = C.tid >> 6;
    bf16_t* hmod = (bf16_t*)(P.ws + WS_HMOD);
    const float* mod = (const float*)(P.ws + WS_MOD);
    const int nw = C.nblk * NWV;
    for (int lt0 = C.bid * NWV + wave; lt0 < TP; lt0 += 2 * nw) {
        f32x4 v[2][4]; int gr[2], bb[2]; bool ok[2];
#pragma unroll
        for (int u = 0; u < 2; ++u) {
            const int lt = lt0 + u * nw; ok[u] = lt < TP;
            const int ltc = ok[u] ? lt : lt0;
            gr[u] = grow_of(pass, ltc); bb[u] = brow_of(pass, ltc);
            const float* src = from_input ? (gr[u] < 16384 ? P.inp(0) + (size_t)gr[u] * 1024 : P.inp(1) + (size_t)(gr[u] - 16384) * 1024) : P.out + (size_t)gr[u] * 1024;
#pragma unroll
            for (int i = 0; i < 4; ++i) v[u][i] = *(const f32x4*)(src + i * 256 + lane * 4);
        }
        if (lng) {
            float s[2], q[2], mu[2], rs[2];
#pragma unroll
            for (int u = 0; u < 2; ++u) { s[u] = 0.f;
#pragma unroll
                for (int i = 0; i < 4; ++i) s[u] += (v[u][i][0] + v[u][i][1]) + (v[u][i][2] + v[u][i][3]); }
#pragma unroll
            for (int o = 32; o > 0; o >>= 1) { s[0] += __shfl_xor(s[0], o); s[1] += __shfl_xor(s[1], o); }
#pragma unroll
            for (int u = 0; u < 2; ++u) { mu[u] = s[u] * (1.0f / 1024.0f); q[u] = 0.f;
#pragma unroll
                for (int i = 0; i < 4; ++i) { const f32x4 dd = v[u][i] - mu[u]; q[u] += (dd[0] * dd[0] + dd[1] * dd[1]) + (dd[2] * dd[2] + dd[3] * dd[3]); } }
#pragma unroll
            for (int o = 32; o > 0; o >>= 1) { q[0] += __shfl_xor(q[0], o); q[1] += __shfl_xor(q[1], o); }
#pragma unroll
            for (int u = 0; u < 2; ++u) {
                rs[u] = rsqrtf(q[u] * (1.0f / 1024.0f) + 1e-5f);
                if (ok[u] && lane == 0) *(f32x2*)(P.ws + WS_STATS + (size_t)(lt0 + u * nw) * 8) = (f32x2){mu[u], rs[u]};
            }
#pragma unroll
            for (int i = 0; i < 4; ++i) {
                const f32x4 g = *(const f32x4*)(lng + i * 256 + lane * 4), be = *(const f32x4*)(lnb + i * 256 + lane * 4);
                v[0][i] = (v[0][i] - mu[0]) * rs[0] * g + be; v[1][i] = (v[1][i] - mu[1]) * rs[1] * g + be;
            }
        }
        if (write_x) {
#pragma unroll
            for (int u = 0; u < 2; ++u) if (ok[u]) {
#pragma unroll
                for (int i = 0; i < 4; ++i) *(f32x4*)(P.out + (size_t)gr[u] * 1024 + i * 256 + lane * 4) = v[u][i];
            }
        }
        if (j >= 0) {
            float s[2], q[2], mu[2], rs[2];
#pragma unroll
            for (int u = 0; u < 2; ++u) { s[u] = 0.f;
#pragma unroll
                for (int i = 0; i < 4; ++i) s[u] += (v[u][i][0] + v[u][i][1]) + (v[u][i][2] + v[u][i][3]); }
#pragma unroll
            for (int o = 32; o > 0; o >>= 1) { s[0] += __shfl_xor(s[0], o); s[1] += __shfl_xor(s[1], o); }
#pragma unroll
            for (int u = 0; u < 2; ++u) { mu[u] = s[u] * (1.0f / 1024.0f); q[u] = 0.f;
#pragma unroll
                for (int i = 0; i < 4; ++i) { const f32x4 dd = v[u][i] - mu[u]; q[u] += (dd[0] * dd[0] + dd[1] * dd[1]) + (dd[2] * dd[2] + dd[3] * dd[3]); } }
#pragma unroll
            for (int o = 32; o > 0; o >>= 1) { q[0] += __shfl_xor(q[0], o); q[1] += __shfl_xor(q[1], o); }
#pragma unroll
            for (int u = 0; u < 2; ++u) {
                rs[u] = rsqrtf(q[u] * (1.0f / 1024.0f) + 1e-5f);
                if (!ok[u]) continue;
                const float* mb = mod + ((size_t)mod_layer * 18 + bb[u]) * 9216 + (size_t)(3 * j) * 1024;
                const int lt = lt0 + u * nw;
#pragma unroll
                for (int i = 0; i < 4; ++i) {
                    const f32x4 sh = *(const f32x4*)(mb + i * 256 + lane * 4), scl = *(const f32x4*)(mb + 1024 + i * 256 + lane * 4);
                    const f32x4 hh = (v[u][i] - mu[u]) * rs[u] * (1.0f + scl) + sh;
                    u32x2 o; o.x = pack2bf(hh[0], hh[1]); o.y = pack2bf(hh[2], hh[3]);
                    *(u32x2*)(hmod + (size_t)lt * 1024 + i * 256 + lane * 4) = o;
                }
            }
        }
    }
}

__device__ __forceinline__ void ffn_up_phase(const Ctx& C, const PV& P, const bf16_t* Wt) {
    const bf16_t* hmod = (const bf16_t*)(P.ws + WS_HMOD);
    bf16_t* act = (bf16_t*)(P.ws + WS_R + R_ACT);
    int pm, pn;
    for (int it = 0; tile_order(it, C.nblk, C.bid, TP / 256, 22, pm, pn); ++it) {
        f32x4 acc[2][2][4][2];
        gemm256(C, acc, hmod, Wt, 1024, pm * 256, pn * 256);
        int z2 = 0; asm volatile("" : "+s"(z2));
        const int tid2 = tid_now(C.wave_s, z2), lane = tid2 & 63, wid = tid2 >> 6, wr = wid >> 2, wc = wid & 3, fr = lane & 15, fq = lane >> 4;
#pragma unroll
        for (int ai = 0; ai < 2; ++ai)
#pragma unroll
            for (int m = 0; m < 4; ++m) {
                const int row = pm * 256 + ai * 128 + wr * 64 + m * 16 + fr;
#pragma unroll
                for (int bj = 0; bj < 2; ++bj) {
                    const int colbase = pn * 256 + bj * 128 + wc * 32, f = (colbase >> 5) * 16 + fq * 4;
                    const f32x4 a = acc[ai][bj][m][0], bb = acc[ai][bj][m][1];
                    float o[4];
#pragma unroll
                    for (int r = 0; r < 4; ++r) o[r] = a[r] / (1.0f + __expf(-a[r])) * bb[r];
                    u32x2 w; w.x = pack2bf(o[0], o[1]); w.y = pack2bf(o[2], o[3]);
                    *(u32x2*)(act + (size_t)row * 2816 + f) = w;
                }
            }
    }
}

__device__ __forceinline__ void resid_gemm_phase(const Ctx& C, const PV& P, int pass, const bf16_t* A, int K, const bf16_t* Wt, int layer, int j, float scale, const float* xg, const float* xb) {
    const float* mod = (const float*)(P.ws + WS_MOD);
    int pm, pn;
    for (int it = 0; tile_order(it, C.nblk, C.bid, TP / 256, 4, pm, pn); ++it) {
        f32x4 acc[2][2][4][2];
        gemm256(C, acc, A, Wt, K, pm * 256, pn * 256);
        int z2 = 0; asm volatile("" : "+s"(z2));
        const int tid2 = tid_now(C.wave_s, z2), lane = tid2 & 63, wid = tid2 >> 6, wr = wid >> 2, wc = wid & 3, fr = lane & 15, fq = lane >> 4;
#pragma unroll
        for (int ai = 0; ai < 2; ++ai)
#pragma unroll
            for (int m = 0; m < 4; ++m) {
                const int lt = pm * 256 + ai * 128 + wr * 64 + m * 16 + fr;
                const int gr = grow_of(pass, lt), b = brow_of(pass, lt);
                const float* gate = mod + ((size_t)layer * 18 + b) * 9216 + (size_t)(3 * j + 2) * 1024;
                const float* xsrc = xg ? P.out + (size_t)gr * 1024 : (gr < 16384 ? P.inp(0) + (size_t)gr * 1024 : P.inp(1) + (size_t)(gr - 16384) * 1024);
                f32x2 st = (f32x2){0.f, 1.f};
                if (xg) st = *(const f32x2*)(P.ws + WS_STATS + (size_t)lt * 8);
#pragma unroll
                for (int bj = 0; bj < 2; ++bj)
#pragma unroll
                    for (int n = 0; n < 2; ++n) {
                        const int col = pn * 256 + bj * 128 + wc * 32 + n * 16 + fq * 4;
                        f32x4 x = *(const f32x4*)(xsrc + col);
                        if (xg) x = (x - st[0]) * st[1] * *(const f32x4*)(xg + col) + *(const f32x4*)(xb + col);
                        const f32x4 g = *(const f32x4*)(gate + col);
                        *(f32x4*)(P.out + (size_t)gr * 1024 + col) = ALPHA * x + (1.0f + g) * scale * acc[ai][bj][m][n];
                    }
                asm volatile("" ::: "memory");
            }
    }
}

__device__ __forceinline__ void win_phase(const Ctx& C, const PV& P, int layer) {
    const bf16_t* hmod = (const bf16_t*)(P.ws + WS_HMOD);
    const bf16_t* Wt = wl(P, layer) + OW_WIN;
    unsigned char* R = P.ws + WS_R;
    f16* raw = (f16*)(R + R_RAW); bf16_t* Qb = (bf16_t*)(R + R_Q); bf16_t* Kb = (bf16_t*)(R + R_K); bf16_t* Vt = (bf16_t*)(R + R_VT);
    f16* Zc = (f16*)(R + R_ZC); f16* poolp = (f16*)(R + R_POOLP);
    typedef f16 f16x4 __attribute__((ext_vector_type(4)));
    typedef f16 f16x2 __attribute__((ext_vector_type(2)));
    int pm, pn;
    for (int it = 0; tile_order(it, C.nblk, C.bid, TP / 256, 18, pm, pn); ++it) {
        const int lt_t = pm * 256, sq = lt_t < 8192 ? 0 : 1 + ((lt_t - 8192) >> 12), lt0 = seqbase_of(sq), S = seqlen_of(sq);
        f32x4 acc[2][2][4][2];
        gemm256(C, acc, hmod, Wt, 1024, pm * 256, pn * 256);
        int z2 = 0; asm volatile("" : "+s"(z2));
        const int tid2 = tid_now(C.wave_s, z2), lane = tid2 & 63, wid = tid2 >> 6, wr = wid >> 2, wc = wid & 3, fr = lane & 15, fq = lane >> 4;
#pragma unroll
        for (int bj = 0; bj < 2; ++bj) {
            const int tn = pn * 2 + bj;
            if (tn >= 35) continue;
#pragma unroll
            for (int ai = 0; ai < 2; ++ai)
#pragma unroll
                for (int m = 0; m < 4; ++m) {
                    const int lt = pm * 256 + ai * 128 + wr * 64 + m * 16 + fr, pos = lt - lt0;
#pragma unroll
                    for (int n = 0; n < 2; ++n) {
                        const int col = tn * 128 + wc * 32 + n * 16 + fq * 4;
                        f32x4 v = acc[ai][bj][m][n];
                        if (tn < 15) {
                            f16x4 h; h[0] = (f16)v[0]; h[1] = (f16)v[1]; h[2] = (f16)v[2]; h[3] = (f16)v[3];
                            *(f16x4*)(raw + (size_t)lt * 1920 + col) = h;
                        } else if (tn < 23) {
                            const int nq = (col - 1920) & 511, hc = nq >> 6, d = nq & 63;
                            if (n == 0 && (wc & 1) == 0) {
#pragma unroll
                                for (int r = 0; r < 4; ++r) {
                                    const float invlo = r == 0 ? 1.0f : r == 1 ? 0.1939227432012558f : r == 2 ? 0.03760603070259094f : 0.007292664609849453f;
                                    const float invhi = r == 0 ? 0.0014142135623842478f : r == 1 ? 0.00027424818836152554f : r == 2 ? 5.3182957344688475e-05f : 1.0313385246263351e-05f;
                                    const float ang = (float)pos * ((fq & 1) ? invhi : invlo);
                                    const float hi = ang * 0.15915493667125702f;
                                    const float lo = __builtin_fmaf(ang, 0.15915493667125702f, -hi) + ang * 6.4206382432985265e-09f;
                                    const float rr = (hi - floorf(hi)) + lo;
                                    const float cs = __builtin_amdgcn_cosf(rr), sn = __builtin_amdgcn_sinf(rr);
                                    const float other = __shfl_xor(v[r], 32);
                                    v[r] = (fq < 2) ? (v[r] * cs - other * sn) : (other * sn + v[r] * cs);
                                }
                            }
                            bf16_t* dst = (tn < 19) ? Qb : Kb;
                            const float sc = (tn < 19) ? 0.125f * 1.44269504088896f : 1.0f;
                            u32x2 w; w.x = pack2bf(v[0] * sc, v[1] * sc); w.y = pack2bf(v[2] * sc, v[3] * sc);
                            *(u32x2*)(dst + (size_t)lt0 * 512 + ((size_t)hc * S + pos) * 64 + d) = w;
                        } else if (tn < 27) {
                            const int nv = col - 2944;
                            bf16_t* vb = Vt + (size_t)lt0 * 512 + (size_t)nv * S + pos;
                            vb[0] = f2bf(v[0]); vb[(size_t)S] = f2bf(v[1]); vb[(size_t)2 * S] = f2bf(v[2]); vb[(size_t)3 * S] = f2bf(v[3]);
                        } else if (tn < 31) {
                            const int nz = col - 3456, g = nz >> 7, cc = (nz & 127) >> 1;
                            f16x2 z0, z1; z0[0] = (f16)v[0]; z0[1] = (f16)v[1]; z1[0] = (f16)v[2]; z1[1] = (f16)v[3];
                            f16x2* zb = (f16x2*)Zc + (size_t)lt0 * 256;
                            zb[(size_t)(g * 64 + cc) * S + pos] = z0;
                            zb[(size_t)(g * 64 + cc + 1) * S + pos] = z1;
                        } else {
                            f16x4 h; h[0] = (f16)v[0]; h[1] = (f16)v[1]; h[2] = (f16)v[2]; h[3] = (f16)v[3];
                            *(f16x4*)(poolp + (size_t)lt * 512 + (col - 3968)) = h;
                        }
                    }
                    asm volatile("" ::: "memory");
                }
        }
    }
}

__device__ __forceinline__ float shiftv(const f16* __restrict__ raw, int lt, int t, int S, int col, float mu) {
    const float p = (float)raw[(size_t)lt * 1920 + col];
    const float pr = t > 0 ? (float)raw[(size_t)(lt - 1) * 1920 + col] : 0.f;
    const float nx = t < S - 1 ? (float)raw[(size_t)(lt + 1) * 1920 + col] : 0.f;
    return p + (0.5f * (pr + nx) - p) * mu;
}

typedef f16 f16x4_t __attribute__((ext_vector_type(4)));
typedef f16 f16x8_t __attribute__((ext_vector_type(8)));
__device__ __forceinline__ void lin_pool_phase(const Ctx& C, const PV& P, int layer) {
    unsigned char* R = P.ws + WS_R;
    const f16* raw = (const f16*)(R + R_RAW); bf16_t* lin = (bf16_t*)(R + R_LIN);
    const f16* poolp = (const f16*)(R + R_POOLP); bf16_t* ypool = (bf16_t*)(R + R_YB) + 3 * SZ512;
    const float* mu = P.inp(13) + (size_t)layer * 1920; const float* pscale = P.inp(26) + (size_t)layer * 512;
    const int gsz = C.nblk * NT, gid = C.bid * NT + C.tid;
    for (int e0 = gid; e0 < TP * 96; e0 += 2 * gsz) {
        f16x4_t p0[2], pm[2], pp[2]; f32x4 m4[2]; int lt_[2], c_[2]; float wm_[2], wp_[2]; bool ok[2];
#pragma unroll
        for (int u = 0; u < 2; ++u) {
            const int e1 = e0 + u * gsz; ok[u] = e1 < TP * 96; const int e = ok[u] ? e1 : e0;
            const int lt = e / 96, c = (e % 96) * 4, col = 1536 + c;
            const int pos = pos_of(lt), S = lt < 8192 ? 8192 : 4096;
            lt_[u] = lt; c_[u] = c; wm_[u] = pos > 0 ? 0.5f : 0.f; wp_[u] = pos < S - 1 ? 0.5f : 0.f;
            p0[u] = *(const f16x4_t*)(raw + (size_t)lt * 1920 + col);
            pm[u] = *(const f16x4_t*)(raw + (size_t)(pos > 0 ? lt - 1 : lt) * 1920 + col);
            pp[u] = *(const f16x4_t*)(raw + (size_t)(pos < S - 1 ? lt + 1 : lt) * 1920 + col);
            m4[u] = *(const f32x4*)(mu + col);
        }
#pragma unroll
        for (int u = 0; u < 2; ++u) {
            float o[4];
#pragma unroll
            for (int r = 0; r < 4; ++r) {
                const float p = (float)p0[u][r];
                float v = p + (wm_[u] * (float)pm[u][r] + wp_[u] * (float)pp[u][r] - p) * m4[u][r];
                if (c_[u] < 128) v = 1.0f - 2.0f / (__expf(2.0f * v) + 1.0f);
                else if (c_[u] >= 256) v = sigmoidf_(v);
                o[r] = v;
            }
            u32x2 w; w.x = pack2bf(o[0], o[1]); w.y = pack2bf(o[2], o[3]);
            if (ok[u]) *(u32x2*)(lin + (size_t)lt_[u] * 384 + c_[u]) = w;
        }
    }
    for (int e0 = gid; e0 < TP * 128; e0 += 2 * gsz) {
        f16x4_t tv[2][16], xv[2]; int lt_[2], c_[2], cnt_[2]; bool ok[2];
#pragma unroll
        for (int u = 0; u < 2; ++u) {
            const int e1 = e0 + u * gsz; ok[u] = e1 < TP * 128; const int e = ok[u] ? e1 : e0;
            const int lt = e >> 7, c = (e & 127) * 4, g = c >> 7, half = 1 << g;
            const int pos = pos_of(lt), S = lt < 8192 ? 8192 : 4096;
            const int lo = max(pos - half, 0), hi = min(pos + half, S);
            lt_[u] = lt; c_[u] = c; cnt_[u] = hi - lo;
            const f16* base = poolp + (size_t)(lt - pos) * 512 + c;
#pragma unroll
            for (int o = -8; o < 8; ++o) {
                const int tt = pos + o;
                const bool in = (o >= -half) && (o < half) && tt >= 0 && tt < S;
                f16x4_t z; z[0] = (f16)0.f; z[1] = (f16)0.f; z[2] = (f16)0.f; z[3] = (f16)0.f;
                tv[u][o + 8] = in ? *(const f16x4_t*)(base + (size_t)tt * 512) : z;
            }
            xv[u] = *(const f16x4_t*)(base + (size_t)pos * 512);
        }
#pragma unroll
        for (int u = 0; u < 2; ++u) {
            float s0 = 0.f, s1 = 0.f, s2 = 0.f, s3 = 0.f;
#pragma unroll
            for (int o = 0; o < 16; ++o) { s0 += (float)tv[u][o][0]; s1 += (float)tv[u][o][1]; s2 += (float)tv[u][o][2]; s3 += (float)tv[u][o][3]; }
            const f32x4 ps = *(const f32x4*)(pscale + c_[u]);
            const float ic = 1.0f / (float)cnt_[u];
            u32x2 w; w.x = pack2bf((s0 * ic - (float)xv[u][0]) * ps[0], (s1 * ic - (float)xv[u][1]) * ps[1]); w.y = pack2bf((s2 * ic - (float)xv[u][2]) * ps[2], (s3 * ic - (float)xv[u][3]) * ps[3]);
            if (ok[u]) *(u32x2*)(ypool + (size_t)lt_[u] * 512 + c_[u]) = w;
        }
    }
    {
        float* invn = (float*)(P.ws + WS_INVN);
        const float* k_k = P.inp(19) + (size_t)layer * 512;
        const int lane = C.tid & 63, wave = C.tid >> 6;
        for (int lt = C.bid * NWV + wave; lt < TP; lt += C.nblk * NWV) {
            const int pos = pos_of(lt), S = lt < 8192 ? 8192 : 4096;
            float ss[8];
#pragma unroll
            for (int h = 0; h < 8; ++h) {
                const int c = h * 64 + lane;
                const float k = shiftv(raw, lt, pos, S, 512 + c, mu[512 + c]) * k_k[c];
                ss[h] = k * k;
            }
#pragma unroll
            for (int h = 0; h < 8; ++h) ss[h] = wsum(ss[h]);
            if (lane < 8) {
                float sel = ss[0];
#pragma unroll
                for (int h = 1; h < 8; ++h) sel = lane == h ? ss[h] : sel;
                invn[(size_t)lt * 8 + lane] = 1.0f / fmaxf(sqrtf(sel), 1e-12f);
            }
        }
    }
}

__device__ __forceinline__ void lora_phase(const Ctx& C, const PV& P, int layer, unsigned char* smem) {
    unsigned char* R = P.ws + WS_R;
    const bf16_t* lin = (const bf16_t*)(R + R_LIN); f16* wa = (f16*)(R + R_WA); f16* gbuf = (f16*)(R + R_G);
    const bf16_t* W = wl(P, layer);
    const int lane = C.tid & 63, wave = (C.tid >> 6) & 3, wm = wave >> 1, wn = wave & 1, fr = lane & 15, fq = lane >> 4;
    for (int t2 = C.bid; t2 < 5 * MT * 2; t2 += C.nblk) {
        const int t = t2 * 2 + (C.tid >> 8);
        const int which = t / (MT * 4), tt = t % (MT * 4), tm = tt >> 2, tn = tt & 3;
        const bf16_t* Bt; int K, acol; const float* bias = nullptr; f16* dst;
        if (which < 2) { Bt = W + OW_W2T + (size_t)which * 512 * 64; K = 64; acol = which * 64; bias = P.inp(14) + (size_t)(layer * 2 + which) * 512; dst = wa + (size_t)which * SZ512; }
        else if (which < 4) { const int d = which - 2; Bt = W + OW_A2T + (size_t)d * 512 * 64; K = 64; acol = 128 + d * 64; bias = P.inp(16) + (size_t)(layer * 2 + d) * 512; dst = wa + (size_t)which * SZ512; }
        else { Bt = W + OW_G2T; K = 128; acol = 256; dst = gbuf; }
        f32x4 acc[4][4];
        gemm_core<4, true>(C, acc, lin + (size_t)tm * 128 * 384 + acol, 384, Bt + (size_t)tn * 128 * K, K, K, smem);
#pragma unroll
        for (int i = 0; i < 4; ++i) {
            const int lt = tm * 128 + wm * 64 + i * 16 + fr;
#pragma unroll
            for (int jn = 0; jn < 4; ++jn) {
                const int n = tn * 128 + wn * 64 + jn * 16 + fq * 4;
                typedef f16 f16x4 __attribute__((ext_vector_type(4)));
                f16x4 h;
#pragma unroll
                for (int r = 0; r < 4; ++r) {
                    float v = acc[i][jn][r];
                    if (which < 2) {
                        const float z = bias[n + r] + v;
                        v = __expf(-0.6065306597126334f * sigmoidf_(z));
                    } else if (which < 4) { v = sigmoidf_(bias[n + r] + v); }
                    h[r] = (f16)v;
                }
                *(f16x4*)(dst + (size_t)lt * 512 + n) = h;
            }
        }
    }
}

__device__ __forceinline__ void attn_items(const Ctx& C, const PV& P, int layer, int ctr_idx, unsigned char* smem) {
    unsigned char* R = P.ws + WS_R;
    const bf16_t* Qall = (const bf16_t*)(R + R_Q); const bf16_t* Kall = (const bf16_t*)(R + R_K); const bf16_t* Vall = (const bf16_t*)(R + R_VT);
    bf16_t* ydiff = (bf16_t*)(R + R_YB) + 1 * SZ512;
    const int tid = C.tid, lane = tid & 63, wave = tid >> 6, comp = wave & 1, rg = wave >> 1, fr = lane & 15, fq = lane >> 4;
    const float lam_init = layer == 0 ? 0.2f : (0.8f - 0.6f * 0.7408182206817179f);
    float lam_full;
    {
        const float* lm = P.inp(24) + (size_t)layer * 256;
        float s1 = 0.f, s2 = 0.f;
        for (int i = 0; i < 64; ++i) { s1 += lm[i] * lm[64 + i]; s2 += lm[128 + i] * lm[192 + i]; }
        lam_full = expf(s1) - expf(s2) + lam_init;
    }
    const float* normg = P.inp(25) + (size_t)layer * 128;
    unsigned* ctr = (unsigned*)(P.ws + WS_CTR) + ctr_idx;
    volatile unsigned* bc = (volatile unsigned*)(smem + 131088);
    for (;;) {
        __syncthreads();
        if (tid == 0) *bc = atomicAdd(ctr, 1u);
        __syncthreads();
        const int item = (int)*bc;
        if (item >= 1280) break;
        int sq, h, qb;
        if (item < 256) { sq = 0; h = item >> 6; qb = item & 63; } else { const int i2 = item - 256; sq = 1 + (i2 >> 7); h = (i2 >> 5) & 3; qb = i2 & 31; }
        const int lt0 = seqbase_of(sq), S = seqlen_of(sq);
        const bf16_t* Qb = Qall + (size_t)lt0 * 512; const bf16_t* Kb = Kall + (size_t)lt0 * 512; const bf16_t* Vb = Vall + (size_t)lt0 * 512 + (size_t)h * 128 * S;
        const int q0 = qb * 128 + rg * 32;
        bf16x8 bq[2][2];
#pragma unroll
        for (int qs = 0; qs < 2; ++qs)
#pragma unroll
            for (int ks = 0; ks < 2; ++ks) bq[qs][ks] = *(const bf16x8*)(Qb + ((size_t)(h * 2 + comp) * S + q0 + qs * 16 + fr) * 64 + ks * 32 + fq * 8);
        float m_run[2] = {-1e30f, -1e30f}, l_run[2] = {0.f, 0.f};
        f32x4 O[8][2];
#pragma unroll
        for (int a = 0; a < 8; ++a) { O[a][0] = (f32x4){0.f, 0.f, 0.f, 0.f}; O[a][1] = (f32x4){0.f, 0.f, 0.f, 0.f}; }
        u32x4 rk[2], rv[2];
        const int lrow = tid >> 3, lkc = (tid & 7) * 8;
        auto gload = [&](int kt0) {
#pragma unroll
            for (int i = 0; i < 2; ++i) {
                const int row = lrow + 64 * i, cm = row >> 6, key = row & 63;
                rk[i] = *(const u32x4*)(Kb + ((size_t)(h * 2 + cm) * S + kt0 + key) * 64 + lkc);
                rv[i] = *(const u32x4*)(Vb + (size_t)row * S + kt0 + lkc);
            }
        };
        auto lstore = [&](int b) {
            unsigned char* sb = smem + b * 36864;
#pragma unroll
            for (int i = 0; i < 2; ++i) {
                const int row = lrow + 64 * i;
                *(u32x4*)(sb + row * 144 + lkc * 2) = rk[i];
                *(u32x4*)(sb + 18432 + row * 144 + lkc * 2) = rv[i];
            }
        };
        bf16x8 pb[2][2];
        auto H1 = [&](int b) {
            const unsigned char* sb = smem + b * 36864;
            f32x4 st[4][2];
#pragma unroll
            for (int t = 0; t < 4; ++t) {
                st[t][0] = (f32x4){0.f, 0.f, 0.f, 0.f}; st[t][1] = (f32x4){0.f, 0.f, 0.f, 0.f};
#pragma unroll
                for (int ks = 0; ks < 2; ++ks) {
                    const bf16x8 kf = *(const bf16x8*)(sb + (comp * 64 + t * 16 + fr) * 144 + (ks * 32 + fq * 8) * 2);
                    st[t][0] = __builtin_amdgcn_mfma_f32_16x16x32_bf16(kf, bq[0][ks], st[t][0], 0, 0, 0);
                    st[t][1] = __builtin_amdgcn_mfma_f32_16x16x32_bf16(kf, bq[1][ks], st[t][1], 0, 0, 0);
                }
            }
#pragma unroll
            for (int qs = 0; qs < 2; ++qs) {
                float mx = -1e30f;
#pragma unroll
                for (int t = 0; t < 4; ++t)
#pragma unroll
                    for (int r = 0; r < 4; ++r) mx = fmaxf(mx, st[t][qs][r]);
                mx = fmaxf(mx, __shfl_xor(mx, 16)); mx = fmaxf(mx, __shfl_xor(mx, 32));
                const float mnew = fmaxf(m_run[qs], mx);
                const float alpha = __builtin_amdgcn_exp2f(m_run[qs] - mnew);
                m_run[qs] = mnew;
                float ls = 0.f;
                float pv[4][4];
#pragma unroll
                for (int t = 0; t < 4; ++t)
#pragma unroll
                    for (int r = 0; r < 4; ++r) { pv[t][r] = __builtin_amdgcn_exp2f(st[t][qs][r] - mnew); ls += pv[t][r]; }
                l_run[qs] = l_run[qs] * alpha + ls;
                if (__builtin_amdgcn_ballot_w64(alpha != 1.0f) != 0ull) {
#pragma unroll
                    for (int a = 0; a < 8; ++a) O[a][qs] = O[a][qs] * alpha;
                }
#pragma unroll
                for (int u = 0; u < 2; ++u) {
                    union { bf16x8 v; unsigned w[4]; } pk;
                    pk.w[0] = pack2bf(pv[2 * u][0], pv[2 * u][1]); pk.w[1] = pack2bf(pv[2 * u][2], pv[2 * u][3]);
                    pk.w[2] = pack2bf(pv[2 * u + 1][0], pv[2 * u + 1][1]); pk.w[3] = pack2bf(pv[2 * u + 1][2], pv[2 * u + 1][3]);
                    pb[qs][u] = pk.v;
                }
            }
        };
        auto H2 = [&](int b) {
            const unsigned char* sb = smem + b * 36864 + 18432;
#pragma unroll
            for (int u = 0; u < 2; ++u)
#pragma unroll
                for (int a = 0; a < 8; ++a) {
                    union { bf16x8 v; u32x2 h[2]; } vf;
                    vf.h[0] = *(const u32x2*)(sb + (a * 16 + fr) * 144 + (u * 32 + fq * 4) * 2);
                    vf.h[1] = *(const u32x2*)(sb + (a * 16 + fr) * 144 + (u * 32 + 16 + fq * 4) * 2);
                    O[a][0] = __builtin_amdgcn_mfma_f32_16x16x32_bf16(vf.v, pb[0][u], O[a][0], 0, 0, 0);
                    O[a][1] = __builtin_amdgcn_mfma_f32_16x16x32_bf16(vf.v, pb[1][u], O[a][1], 0, 0, 0);
                }
        };
        const int grp = wave >> 2, T = S >> 6;
        gload(0);
        lstore(0);
        __syncthreads();
        for (int t = 0; t < T; ++t) {
            if (t + 1 < T) gload((t + 1) * 64);
            if (grp == 0) H1(t & 1); else if (t > 0) H2((t - 1) & 1);
            __syncthreads();
            if (t + 1 < T) lstore((t + 1) & 1);
            if (grp == 0) H2(t & 1); else H1(t & 1);
            __syncthreads();
        }
        if (grp == 1) H2((T - 1) & 1);
#pragma unroll
        for (int qs = 0; qs < 2; ++qs) {
            float l = l_run[qs]; l += __shfl_xor(l, 16); l += __shfl_xor(l, 32);
            const float inv = 1.0f / l;
#pragma unroll
            for (int a = 0; a < 8; ++a) O[a][qs] = O[a][qs] * inv;
        }
        __syncthreads();
        float* Ox = (float*)smem;
        if (comp == 1) {
#pragma unroll
            for (int qs = 0; qs < 2; ++qs)
#pragma unroll
                for (int a = 0; a < 8; ++a)
#pragma unroll
                    for (int r = 0; r < 4; ++r) Ox[(rg * 128 + a * 16 + fq * 4 + r) * 32 + qs * 16 + fr] = O[a][qs][r];
        }
        __syncthreads();
        if (comp == 0) {
#pragma unroll
            for (int qs = 0; qs < 2; ++qs) {
                float ss = 0.f;
#pragma unroll
                for (int a = 0; a < 8; ++a)
#pragma unroll
                    for (int r = 0; r < 4; ++r) {
                        const float o = O[a][qs][r] - lam_full * Ox[(rg * 128 + a * 16 + fq * 4 + r) * 32 + qs * 16 + fr];
                        O[a][qs][r] = o; ss += o * o;
                    }
                ss += __shfl_xor(ss, 16); ss += __shfl_xor(ss, 32);
                const float sc = rsqrtf(ss * (1.0f / 128.0f) + 1e-5f) * (1.0f - lam_init);
                const int lt = lt0 + q0 + qs * 16 + fr;
#pragma unroll
                for (int a = 0; a < 8; ++a) {
                    const int dv = a * 16 + fq * 4;
                    const float4 g = *(const float4*)(normg + dv);
                    uint2 w; w.x = pack2bf(O[a][qs][0] * sc * g.x, O[a][qs][1] * sc * g.y); w.y = pack2bf(O[a][qs][2] * sc * g.z, O[a][qs][3] * sc * g.w);
                    *(uint2*)(ydiff + (size_t)lt * 512 + h * 128 + dv) = w;
                }
            }
        }
    }
    __syncthreads();
}

__device__ __forceinline__ void fft_items(const Ctx& C, const PV& P, unsigned char* smem) {
    unsigned char* R = P.ws + WS_R;
    typedef f16 f16x2 __attribute__((ext_vector_type(2)));
    const f16x2* Zall = (const f16x2*)(R + R_ZC);
    bf16_t* yf = (bf16_t*)(R + R_YB) + 2 * SZ512;
    const float2* tw = (const float2*)(P.ws + WS_TW);
    float2* sm = (float2*)smem;
    const int tid = C.tid;
    for (int item = C.bid; item < NSEQ * 256; item += C.nblk) {
        const int sq = item >> 8, col = item & 255, g = col >> 6, cc = col & 63;
        const int lt0 = seqbase_of(sq), S = seqlen_of(sq), lg = sq == 0 ? 13 : 12;
        const f16x2* z = Zall + (size_t)lt0 * 256 + (size_t)col * S;
        __syncthreads();
        for (int s = tid; s < S; s += NT) { const f16x2 v = z[s]; sm[__brev((unsigned)s) >> (32 - lg)] = make_float2((float)v[0], (float)v[1]); }
        __syncthreads();
        for (int st = 0; st < lg; ++st) {
            const int half = 1 << st, tshift = 12 - st;
            for (int b = tid; b < (S >> 1); b += NT) {
                const int j = b & (half - 1), i0 = ((b >> st) << (st + 1)) + j, i1 = i0 + half;
                const float2 w = tw[j << tshift], u = sm[i0], x = sm[i1];
                const float2 tv = make_float2(w.x * x.x - w.y * x.y, w.x * x.y + w.y * x.x);
                sm[i0] = make_float2(u.x + tv.x, u.y + tv.y); sm[i1] = make_float2(u.x - tv.x, u.y - tv.y);
            }
            __syncthreads();
        }
        const float nrm = rsqrtf((float)S * 128.0f);
        for (int k = tid; k < S; k += NT) {
            const float2 a = sm[k], b = sm[(S - k) & (S - 1)];
            bf16_t* row = yf + (size_t)(lt0 + k) * 512 + g * 128;
            if (cc == 0) { row[0] = f2bf(0.5f * (a.x + b.x) * nrm); row[64] = f2bf(0.5f * (a.y + b.y) * nrm); }
            else { row[cc] = f2bf(a.x * nrm); row[128 - cc] = f2bf(b.x * nrm); }
        }
    }
    __syncthreads();
}

template <int KT>
__device__ __forceinline__ void scan_block(const Ctx& C, const PV& P, int layer, int sq, int h, int d, int row0, unsigned char* smem) {
    constexpr int TPR = 64 / KT, ROWS = NT / TPR, CH = 16, YP = TPR / 4, NV = ROWS / 32;
    unsigned char* R = P.ws + WS_R;
    const f16* raw = (const f16*)(R + R_RAW); const f16* wa = (const f16*)(R + R_WA); f16* yfb = (f16*)(R + R_YFB);
    const float* invn = (const float*)(P.ws + WS_INVN);
    const float* mu = P.inp(13) + (size_t)layer * 1920; const float* k_k = P.inp(19) + (size_t)layer * 512; const float* k_a = P.inp(20) + (size_t)layer * 512;
    const int tid = C.tid, row = tid / TPR, q = tid % TPR;
    const int lt0 = seqbase_of(sq), S = seqlen_of(sq);
    const int ch = tid & 63, c = h * 64 + ch;
    const float mu_r = mu[c], mu_k = mu[512 + c], kkw = k_k[c], kaw = k_a[c];
    const int vr = (ROWS == 32) ? (tid & 31) : (tid & 63);
    const int vcol = 1024 + h * 64 + row0 + vr; const float mu_v = mu[vcol];
    const f16* wdec = wa + (size_t)d * SZ512; const f16* aact = wa + (size_t)(2 + d) * SZ512;
    f16* ydst = yfb + (size_t)d * SZ512;
    f32x2 s[KT / 2];
#pragma unroll
    for (int j = 0; j < KT / 2; ++j) s[j] = (f32x2){0.f, 0.f};
    f16 pr_[2][3], pk_[2][3], pa_[2], pw_[2], pv_[NV][3]; float pn_[2];
    auto prefetch = [&](int c0) {
#pragma unroll
        for (int j = 0; j < 2; ++j) {
            const int i = (tid >> 6) + 8 * j, tstep = c0 + i, t = d == 0 ? tstep : S - 1 - tstep, lt = lt0 + t;
            const int tm = t > 0 ? lt - 1 : lt, tp = t < S - 1 ? lt + 1 : lt;
            pr_[j][0] = raw[(size_t)tm * 1920 + c]; pr_[j][1] = raw[(size_t)lt * 1920 + c]; pr_[j][2] = raw[(size_t)tp * 1920 + c];
            pk_[j][0] = raw[(size_t)tm * 1920 + 512 + c]; pk_[j][1] = raw[(size_t)lt * 1920 + 512 + c]; pk_[j][2] = raw[(size_t)tp * 1920 + 512 + c];
            pa_[j] = aact[(size_t)lt * 512 + c]; pw_[j] = wdec[(size_t)lt * 512 + c]; pn_[j] = invn[(size_t)lt * 8 + h];
        }
#pragma unroll
        for (int j = 0; j < NV; ++j) {
            const int i = (ROWS == 32) ? (tid >> 5) : ((tid >> 6) + 8 * j), tstep = c0 + i, t = d == 0 ? tstep : S - 1 - tstep, lt = lt0 + t;
            const int tm = t > 0 ? lt - 1 : lt, tp = t < S - 1 ? lt + 1 : lt;
            pv_[j][0] = raw[(size_t)tm * 1920 + vcol]; pv_[j][1] = raw[(size_t)lt * 1920 + vcol]; pv_[j][2] = raw[(size_t)tp * 1920 + vcol];
        }
    };
    auto stage = [&](int c0, unsigned char* buf) {
        float* vec = (float*)buf; float* vbuf = (float*)(buf + 20480);
#pragma unroll
        for (int j = 0; j < 2; ++j) {
            const int i = (tid >> 6) + 8 * j, tstep = c0 + i, t = d == 0 ? tstep : S - 1 - tstep;
            const float rm = t > 0 ? (float)pr_[j][0] : 0.f, rp = t < S - 1 ? (float)pr_[j][2] : 0.f, km = t > 0 ? (float)pk_[j][0] : 0.f, kp = t < S - 1 ? (float)pk_[j][2] : 0.f;
            const float r1 = (float)pr_[j][1], k1 = (float)pk_[j][1];
            const float r = r1 + (0.5f * (rm + rp) - r1) * mu_r;
            const float k = k1 + (0.5f * (km + kp) - k1) * mu_k;
            const float kk = k * kkw * pn_[j], a = (float)pa_[j];
            vec[(0 * CH + i) * 64 + ch] = kk;
            vec[(1 * CH + i) * 64 + ch] = (float)pw_[j];
            vec[(2 * CH + i) * 64 + ch] = kk * a;
            vec[(3 * CH + i) * 64 + ch] = k * (1.0f + (a - 1.0f) * kaw);
            vec[(4 * CH + i) * 64 + ch] = r;
        }
#pragma unroll
        for (int j = 0; j < NV; ++j) {
            const int i = (ROWS == 32) ? (tid >> 5) : ((tid >> 6) + 8 * j), tstep = c0 + i, t = d == 0 ? tstep : S - 1 - tstep;
            const float vm = t > 0 ? (float)pv_[j][0] : 0.f, vp = t < S - 1 ? (float)pv_[j][2] : 0.f, v1 = (float)pv_[j][1];
            vbuf[i * 64 + vr] = v1 + (0.5f * (vm + vp) - v1) * mu_v;
        }
    };
    __syncthreads();
    prefetch(0);
    stage(0, smem);
    __syncthreads();
    const int nch = S / CH;
    for (int cix = 0; cix < nch; ++cix) {
        unsigned char* buf = smem + (cix & 1) * 32768;
        if (cix + 1 < nch) prefetch((cix + 1) * CH);
        {
            const float* vec = (const float*)buf; const float* vbuf = (const float*)(buf + 20480); float* ybuf = (float*)(buf + 24576);
            const f32x4* vp0 = (const f32x4*)(vec + q * KT);
            f32x4 nx[5][KT / 4]; float nvv;
#pragma unroll
            for (int u = 0; u < KT / 4; ++u)
#pragma unroll
                for (int a5 = 0; a5 < 5; ++a5) nx[a5][u] = vp0[a5 * CH * 16 + u];
            nvv = vbuf[row];
            float yv[CH];
#pragma unroll
            for (int i = 0; i < CH; ++i) {
                f32x2 kk2[KT / 2], w2[KT / 2], b2[KT / 2], kd2[KT / 2], r2[KT / 2];
#pragma unroll
                for (int u = 0; u < KT / 4; ++u) {
                    kk2[2 * u] = (f32x2){nx[0][u][0], nx[0][u][1]}; kk2[2 * u + 1] = (f32x2){nx[0][u][2], nx[0][u][3]};
                    w2[2 * u] = (f32x2){nx[1][u][0], nx[1][u][1]}; w2[2 * u + 1] = (f32x2){nx[1][u][2], nx[1][u][3]};
                    b2[2 * u] = (f32x2){nx[2][u][0], nx[2][u][1]}; b2[2 * u + 1] = (f32x2){nx[2][u][2], nx[2][u][3]};
                    kd2[2 * u] = (f32x2){nx[3][u][0], nx[3][u][1]}; kd2[2 * u + 1] = (f32x2){nx[3][u][2], nx[3][u][3]};
                    r2[2 * u] = (f32x2){nx[4][u][0], nx[4][u][1]}; r2[2 * u + 1] = (f32x2){nx[4][u][2], nx[4][u][3]};
                }
                const float vv = nvv;
                if (i + 1 < CH) {
#pragma unroll
                    for (int u = 0; u < KT / 4; ++u)
#pragma unroll
                        for (int a5 = 0; a5 < 5; ++a5) nx[a5][u] = vp0[(i + 1) * 16 + a5 * CH * 16 + u];
                    nvv = vbuf[(i + 1) * 64 + row];
                }
                f32x2 acc2 = s[0] * kk2[0];
#pragma unroll
                for (int j = 1; j < KT / 2; ++j) acc2 = __builtin_elementwise_fma(s[j], kk2[j], acc2);
                float sa = acc2[0] + acc2[1];
                sa += dppf<0xB1>(sa); sa += dppf<0x4E>(sa); sa += dppf<0x141>(sa);
                if (TPR == 16) sa += dppf<0x140>(sa);
                sa = -sa;
                const f32x2 sa2 = (f32x2){sa, sa}, vv2 = (f32x2){vv, vv};
                f32x2 y2 = (f32x2){0.f, 0.f};
#pragma unroll
                for (int j = 0; j < KT / 2; ++j) {
                    s[j] = __builtin_elementwise_fma(s[j], w2[j], __builtin_elementwise_fma(sa2, b2[j], vv2 * kd2[j]));
                    y2 = __builtin_elementwise_fma(s[j], r2[j], y2);
                }
                float y = y2[0] + y2[1];
                y += dppf<0xB1>(y); y += dppf<0x4E>(y);
                yv[i] = y;
            }
            if ((q & 3) == 0) {
#pragma unroll
                for (int i = 0; i < CH; ++i) ybuf[i * 128 + row * YP + (q >> 2)] = yv[i];
            }
        }
        if (cix + 1 < nch) stage((cix + 1) * CH, smem + ((cix + 1) & 1) * 32768);
        __syncthreads();
        {
            const float* ybuf = (const float*)(buf + 24576);
#pragma unroll
            for (int j = 0; j < NV; ++j) {
                const int i = (ROWS == 32) ? (tid >> 5) : ((tid >> 6) + 8 * j), rr = vr, tstep = cix * CH + i, t = d == 0 ? tstep : S - 1 - tstep;
                float y = 0.f;
#pragma unroll
                for (int p = 0; p < YP; ++p) y += ybuf[i * 128 + rr * YP + p];
                ydst[(size_t)(lt0 + t) * 512 + h * 64 + row0 + rr] = (f16)y;
            }
        }
    }
    __syncthreads();
}

__device__ __forceinline__ void finish_phase(const Ctx& C, const PV& P, int layer) {
    unsigned char* R = P.ws + WS_R;
    const f16* raw = (const f16*)(R + R_RAW); const f16* wa = (const f16*)(R + R_WA); const f16* gbuf = (const f16*)(R + R_G); const f16* yfb = (const f16*)(R + R_YFB);
    bf16_t* yr = (bf16_t*)(R + R_YB);
    const float* mu = P.inp(13) + (size_t)layer * 1920; const float* k_a = P.inp(20) + (size_t)layer * 512; const float* r_k = P.inp(21) + (size_t)layer * 512;
    const float* lg = P.inp(22) + (size_t)layer * 512; const float* lb = P.inp(23) + (size_t)layer * 512;
    const int lane = C.tid & 63, wave = C.tid >> 6, c = lane * 8;
    const int nw = C.nblk * NWV;
    for (int ltb = C.bid * NWV + wave; ltb < TP; ltb += 2 * nw) {
        f16x8_t rA[2], rB[2], rC[2], kA[2], kB[2], kC[2], vA[2], vB[2], vC[2], af[2], ab[2], gg[2], yF[2], yB[2]; float wm_[2], wp_[2]; bool ok[2];
#pragma unroll
        for (int u = 0; u < 2; ++u) {
            const int lt1 = ltb + u * nw; ok[u] = lt1 < TP; const int lt = ok[u] ? lt1 : ltb;
            const int pos = pos_of(lt), S = lt < 8192 ? 8192 : 4096;
            const size_t rm = (size_t)(pos > 0 ? lt - 1 : lt) * 1920, r0 = (size_t)lt * 1920, rp = (size_t)(pos < S - 1 ? lt + 1 : lt) * 1920;
            wm_[u] = pos > 0 ? 0.5f : 0.f; wp_[u] = pos < S - 1 ? 0.5f : 0.f;
            rA[u] = *(const f16x8_t*)(raw + rm + c); rB[u] = *(const f16x8_t*)(raw + r0 + c); rC[u] = *(const f16x8_t*)(raw + rp + c);
            kA[u] = *(const f16x8_t*)(raw + rm + 512 + c); kB[u] = *(const f16x8_t*)(raw + r0 + 512 + c); kC[u] = *(const f16x8_t*)(raw + rp + 512 + c);
            vA[u] = *(const f16x8_t*)(raw + rm + 1024 + c); vB[u] = *(const f16x8_t*)(raw + r0 + 1024 + c); vC[u] = *(const f16x8_t*)(raw + rp + 1024 + c);
            af[u] = *(const f16x8_t*)(wa + 2 * SZ512 + (size_t)lt * 512 + c); ab[u] = *(const f16x8_t*)(wa + 3 * SZ512 + (size_t)lt * 512 + c);
            gg[u] = *(const f16x8_t*)(gbuf + (size_t)lt * 512 + c);
            yF[u] = *(const f16x8_t*)(yfb + (size_t)lt * 512 + c); yB[u] = *(const f16x8_t*)(yfb + SZ512 + (size_t)lt * 512 + c);
        }
#pragma unroll
        for (int u = 0; u < 2; ++u) {
            float y[8], vv[8], bsum = 0.f, ysum = 0.f;
#pragma unroll
            for (int j = 0; j < 8; ++j) {
                const float r_ = (float)rB[u][j], k_ = (float)kB[u][j], v_ = (float)vB[u][j];
                const float r = r_ + (wm_[u] * (float)rA[u][j] + wp_[u] * (float)rC[u][j] - r_) * mu[c + j];
                const float k = k_ + (wm_[u] * (float)kA[u][j] + wp_[u] * (float)kC[u][j] - k_) * mu[512 + c + j];
                vv[j] = v_ + (wm_[u] * (float)vA[u][j] + wp_[u] * (float)vC[u][j] - v_) * mu[1024 + c + j];
                const float ka = k_a[c + j];
                const float ksum = k * (1.f + ((float)af[u][j] - 1.f) * ka) + k * (1.f + ((float)ab[u][j] - 1.f) * ka);
                bsum += r * (0.5f * ksum) * r_k[c + j];
                y[j] = (float)yF[u][j] + (float)yB[u][j]; ysum += y[j];
            }
            const float ym = red8(ysum) * (1.0f / 64.0f);
            float q = 0.f;
#pragma unroll
            for (int j = 0; j < 8; ++j) { const float dy = y[j] - ym; q += dy * dy; }
            const float rs = rsqrtf(red8(q) * (1.0f / 64.0f) + 64e-5f);
            const float bonus = red8(bsum);
            float o[8];
#pragma unroll
            for (int j = 0; j < 8; ++j) o[j] = ((y[j] - ym) * rs * lg[c + j] + lb[c + j] + bonus * vv[j]) * (float)gg[u][j];
            u32x4 w; w.x = pack2bf(o[0], o[1]); w.y = pack2bf(o[2], o[3]); w.z = pack2bf(o[4], o[5]); w.w = pack2bf(o[6], o[7]);
            if (ok[u]) *(u32x4*)(yr + (size_t)(ltb + u * nw) * 512 + c) = w;
        }
    }
}

__device__ __forceinline__ void gates_phase(const Ctx& C, const PV& P, int layer) {
    const bf16_t* hmod = (const bf16_t*)(P.ws + WS_HMOD);
    const bf16_t* Wt = wl(P, layer) + OW_WIN + (size_t)4480 * 1024;
    bf16_t* gates = (bf16_t*)(P.ws + WS_R + R_GATES);
    int pm, pn;
    for (int it = 0; tile_order(it, C.nblk, C.bid, TP / 256, 16, pm, pn); ++it) {
        f32x4 acc[2][2][4][2];
        gemm256(C, acc, hmod, Wt, 1024, pm * 256, pn * 256);
        int z2 = 0; asm volatile("" : "+s"(z2));
        const int tid2 = tid_now(C.wave_s, z2), lane = tid2 & 63, wid = tid2 >> 6, wr = wid >> 2, wc = wid & 3, fr = lane & 15, fq = lane >> 4;
#pragma unroll
        for (int ai = 0; ai < 2; ++ai)
#pragma unroll
            for (int m = 0; m < 4; ++m) {
                const int lt = pm * 256 + ai * 128 + wr * 64 + m * 16 + fr;
#pragma unroll
                for (int bj = 0; bj < 2; ++bj)
#pragma unroll
                    for (int n = 0; n < 2; ++n) {
                        const int col = pn * 256 + bj * 128 + wc * 32 + n * 16 + fq * 4;
                        const f32x4 v = acc[ai][bj][m][n];
                        u32x2 w; w.x = pack2bf(sigmoidf_(v[0]), sigmoidf_(v[1])); w.y = pack2bf(sigmoidf_(v[2]), sigmoidf_(v[3]));
                        *(u32x2*)(gates + (size_t)lt * 4096 + col) = w;
                    }
            }
    }
}
__device__ __forceinline__ void branch_phase(const Ctx& C, const PV& P, int layer) {
    unsigned char* R = P.ws + WS_R;
    const bf16_t* yb = (const bf16_t*)(R + R_YB); const bf16_t* gates = (const bf16_t*)(R + R_GATES);
    float* m32 = (float*)(R + R_M32); bf16_t* merged = (bf16_t*)(R + R_MERGED);
    const bf16_t* W = wl(P, layer) + OW_WBR;
    int pm, pn;
    for (int it = 0; tile_order(it, C.nblk, C.bid, TP / 256, 4, pm, pn); ++it) {
        for (int nb = 0; nb < 4; ++nb) {
            f32x4 acc[2][2][4][2];
            gemm256(C, acc, yb + (size_t)nb * SZ512, W + (size_t)nb * 1024 * 512, 512, pm * 256, pn * 256);
            int z2 = 0; asm volatile("" : "+s"(z2));
            const int tid2 = tid_now(C.wave_s, z2), lane = tid2 & 63, wid = tid2 >> 6, wr = wid >> 2, wc = wid & 3, fr = lane & 15, fq = lane >> 4;
#pragma unroll
            for (int ai = 0; ai < 2; ++ai)
#pragma unroll
                for (int m = 0; m < 4; ++m) {
                    const int lt = pm * 256 + ai * 128 + wr * 64 + m * 16 + fr;
#pragma unroll
                    for (int bj = 0; bj < 2; ++bj)
#pragma unroll
                        for (int n = 0; n < 2; ++n) {
                            const int col = pn * 256 + bj * 128 + wc * 32 + n * 16 + fq * 4;
                            const u32x2 gw = *(const u32x2*)(gates + (size_t)lt * 4096 + nb * 1024 + col);
                            f32x4 g; g[0] = __uint_as_float(gw.x << 16); g[1] = __uint_as_float(gw.x & 0xffff0000u); g[2] = __uint_as_float(gw.y << 16); g[3] = __uint_as_float(gw.y & 0xffff0000u);
                            f32x4 mv = g * acc[ai][bj][m][n];
                            f32x4* mp = (f32x4*)(m32 + (size_t)lt * 1024 + col);
                            if (nb > 0) mv += *mp;
                            if (nb < 3) *mp = mv;
                            else { u32x2 w; w.x = pack2bf(mv[0], mv[1]); w.y = pack2bf(mv[2], mv[3]); *(u32x2*)(merged + (size_t)lt * 1024 + col) = w; }
                        }
                    asm volatile("" ::: "memory");
                }
        }
    }
}


#define XB_TMO      128
#define XB_XCNT(j)  (256  + 64 * (j))
#define XB_XSUB(j)  (1280 + 64 * (j))
#define XB_XGEN(j)  (2304 + 64 * (j))
#define XB_TOP      3328
#define XB_TOPGEN   3392
#define XCD_BAR_WORDS 3456
#define XB_SPIN_CAP (1u << 18)
#define LAS __attribute__((address_space(3)))
__device__ __forceinline__ unsigned xb_ld(unsigned* p)              { return __hip_atomic_load(p, __ATOMIC_RELAXED, __HIP_MEMORY_SCOPE_AGENT); }
__device__ __forceinline__ unsigned xb_add(unsigned* p, unsigned v) { return __hip_atomic_fetch_add(p, v, __ATOMIC_RELAXED, __HIP_MEMORY_SCOPE_AGENT); }
__device__ __forceinline__ unsigned xb_xcc_id() { return (unsigned)__builtin_amdgcn_s_getreg((3 << 11) | 20) & 0xFu; }
#define XB_SPIN(cond, bar) do { unsigned _sp = 0; while (cond) { __builtin_amdgcn_s_sleep(1); \
    if ((++_sp & 255u) == 0u) { if (xb_ld(&(bar)[XB_TMO])) break; if (_sp > XB_SPIN_CAP) { atomicAdd(&(bar)[XB_TMO], 1u); break; } } } } while (0)
struct XcdBarrier { unsigned* bar; unsigned x; volatile LAS unsigned* st; };
__device__ __forceinline__ XcdBarrier xcd_barrier_post(unsigned* bar, volatile LAS unsigned* st) {
    XcdBarrier b; b.bar = bar; b.x = xb_xcc_id(); b.st = st;
    if (threadIdx.x == 0) (void)xb_add(&bar[XB_XCNT(b.x)], 1u);
    return b;
}
__device__ __forceinline__ void xcd_barrier_complete(unsigned* bar, unsigned x, unsigned& nloc, unsigned& nx) {
    const unsigned G = gridDim.x * gridDim.y * gridDim.z;
    unsigned sum, cnt, mine, sp = 0u;
    for (;;) {
        sum = 0u; cnt = 0u; mine = 0u;
#pragma unroll
        for (unsigned j = 0; j < 16; ++j) { const unsigned c = xb_ld(&bar[XB_XCNT(j)]); sum += c; cnt += (c > 0u) ? 1u : 0u; mine = (j == x) ? c : mine; }
        if (sum == G) break;
        __builtin_amdgcn_s_sleep(1);
        if ((++sp & 255u) == 0u) { if (xb_ld(&bar[XB_TMO])) break; if (sp > XB_SPIN_CAP) { atomicAdd(&bar[XB_TMO], 1u); break; } }
    }
    nloc = mine > 0u ? mine : 1u; nx = cnt > 0u ? cnt : 1u;
}
__device__ __forceinline__ void xcd_barrier(const XcdBarrier& b) {
    asm volatile("s_waitcnt vmcnt(0)" ::: "memory");
    __syncthreads();
    if (threadIdx.x == 0) {
        unsigned* bar = b.bar;
        __builtin_amdgcn_s_waitcnt(0);
        unsigned nloc = b.st[0], nx = b.st[1];
        if (nloc == 0u) { xcd_barrier_complete(bar, b.x, nloc, nx); b.st[0] = nloc; b.st[1] = nx; }
        const unsigned old = xb_add(&bar[XB_XSUB(b.x)], 1u);
        const unsigned gen = old / nloc;
        if (old + 1u == (gen + 1u) * nloc) {
            __builtin_amdgcn_fence(__ATOMIC_RELEASE, "agent");
            asm volatile("s_waitcnt vmcnt(0)" ::: "memory");
            const unsigned og = xb_add(&bar[XB_TOP], 1u);
            const unsigned tg = og / nx;
            if (og + 1u == (tg + 1u) * nx) xb_add(&bar[XB_TOPGEN], 1u);
            else XB_SPIN(xb_ld(&bar[XB_TOPGEN]) == tg, bar);
            __builtin_amdgcn_fence(__ATOMIC_ACQUIRE, "agent");
            xb_add(&bar[XB_XGEN(b.x)], 1u);
            asm volatile("s_waitcnt vmcnt(0)" ::: "memory");
        } else {
            XB_SPIN(xb_ld(&bar[XB_XGEN(b.x)]) == gen, bar);
            __builtin_amdgcn_fence(__ATOMIC_ACQUIRE, "agent");
            asm volatile("s_waitcnt vmcnt(0)" ::: "memory");
        }
    }
    __syncthreads();
}

constexpr int PH_PER_LAYER = 15, PH_PER_PASS = 2 * PH_PER_LAYER + 1, NPHASE = 1 + NPASS * PH_PER_PASS;

__global__ void __launch_bounds__(512, 2) mk_forward(Params P0, int ph_lo, int ph_hi) {
    unsigned char* smem = dyn_smem;
    const int wave_s = __builtin_amdgcn_readfirstlane((int)threadIdx.x >> 6);
    volatile LAS unsigned* xst = (volatile LAS unsigned*)(LAS unsigned char*)(dyn_smem + 131072);
    if (threadIdx.x == 0) { xst[0] = 0u; xst[1] = 0u; }
    __syncthreads();
    const XcdBarrier xb = xcd_barrier_post((unsigned*)(P0.ws + WS_BAR), xst);
    for (int it_ = 2 * ph_lo; it_ < 2 * ph_hi; ++it_) {
        const int ph = it_ >> 1;
        if (it_ & 1) {
            if (PROBE_MASK == 0 || ph == 0) continue;
            const int r_ = (ph - 1) % PH_PER_PASS;
            if (r_ == PH_PER_PASS - 1 || !((PROBE_MASK >> (r_ % PH_PER_LAYER)) & 1)) continue;
        }
        if (it_ > 2 * ph_lo) { if (it_ == 2 * ph_lo + 2) cg::this_grid().sync(); else xcd_barrier(xb); }
        int z = 0; asm volatile("" : "+s"(z));
        Ctx C; C.tid = tid_now(wave_s, z); C.bid = (int)blockIdx.x + z; C.nblk = (int)gridDim.x + z; C.wave_s = wave_s;
        ptrtab_t tab = (ptrtab_t)__builtin_amdgcn_kernarg_segment_ptr();
        asm volatile("" : "+s"(tab));
        const PV P{tab, (float*)tab[29], (unsigned char*)tab[30]};
        if (ph == 0) { prep_phase(C, P, smem); continue; }
        const int q = ph - 1, pass = q / PH_PER_PASS, r = q % PH_PER_PASS;
        if (r == PH_PER_PASS - 1) { norm_phase(C, P, pass, P.inp(6) + (size_t)(1 * 3 + 2) * 1024, P.inp(7) + (size_t)(1 * 3 + 2) * 1024, 0, -1, false, true); continue; }
        const int layer = r / PH_PER_LAYER, lp = r % PH_PER_LAYER;
        const bf16_t* W = wl(P, layer);
        const float* lng = P.inp(6) + (size_t)layer * 3 * 1024; const float* lnb = P.inp(7) + (size_t)layer * 3 * 1024;
        const float* lngp = P.inp(6) + (size_t)((layer > 0 ? layer - 1 : 0) * 3 + 2) * 1024; const float* lnbp = P.inp(7) + (size_t)((layer > 0 ? layer - 1 : 0) * 3 + 2) * 1024;
        unsigned char* R = P.ws + WS_R;
        switch (lp) {
            case 0:
                if (layer == 0) norm_phase(C, P, pass, nullptr, nullptr, 0, 0, true, false);
                else norm_phase(C, P, pass, lngp, lnbp, layer, 0, false, false);
                break;
            case 1: ffn_up_phase(C, P, W + OW_FA_IN); break;
            case 2: resid_gemm_phase(C, P, pass, (const bf16_t*)(R + R_ACT), 2816, W + OW_FA_OUT, layer, 0, 0.5f, layer == 0 ? nullptr : lngp, lnbp); break;
            case 3: norm_phase(C, P, pass, lng, lnb, layer, 1, false, false); break;
            case 4: win_phase(C, P, layer); break;
            case 5: lin_pool_phase(C, P, layer); break;
            case 6: lora_phase(C, P, layer, smem); break;
            case 7:
                if (C.bid < 32) scan_block<4>(C, P, layer, 0, C.bid >> 2, (C.bid >> 1) & 1, (C.bid & 1) * 32, smem);
                else if (C.bid < 160) { const int i2 = C.bid - 32; scan_block<8>(C, P, layer, 1 + (i2 >> 4), (i2 >> 1) & 7, i2 & 1, 0, smem); }
                attn_items(C, P, layer, pass * 2 + layer, smem); fft_items(C, P, smem); break;
            case 8: finish_phase(C, P, layer); break;
            case 9: gates_phase(C, P, layer); break;
            case 10: branch_phase(C, P, layer); break;
            case 11: resid_gemm_phase(C, P, pass, (const bf16_t*)(R + R_MERGED), 1024, W + OW_WOUT, layer, 1, 1.0f, lng, lnb); break;
            case 12: norm_phase(C, P, pass, lng + 1024, lnb + 1024, layer, 2, false, false); break;
            case 13: ffn_up_phase(C, P, W + OW_FB_IN); break;
            default: resid_gemm_phase(C, P, pass, (const bf16_t*)(R + R_ACT), 2816, W + OW_FB_OUT, layer, 2, 0.5f, lng + 1024, lnb + 1024); break;
        }
    }
}

extern "C" void kernel_launch(void* const* d_in, const int* in_sizes, int n_in, void* d_out, int out_size, void* d_ws, size_t ws_size, hipStream_t stream) {
    static int grid_blocks = 0;
    if (!grid_blocks) {
        int dev = 0, cus = 0, per_cu = 0;
        (void)hipGetDevice(&dev);
        (void)hipDeviceGetAttribute(&cus, hipDeviceAttributeMultiprocessorCount, dev);
        (void)hipFuncSetAttribute((const void*)mk_forward, hipFuncAttributeMaxDynamicSharedMemorySize, LDS_BYTES);
        (void)hipOccupancyMaxActiveBlocksPerMultiprocessor(&per_cu, mk_forward, NT, LDS_BYTES);
        if (per_cu < 1) per_cu = 1;
        if (per_cu > 1) per_cu = 1;
        grid_blocks = cus * per_cu;
    }
    Params p{};
    for (int i = 0; i < 29; ++i) p.in[i] = (const float*)d_in[i];
    p.out = (float*)d_out; p.ws = (unsigned char*)d_ws;
    (void)hipMemsetAsync((unsigned char*)d_ws + WS_BAR, 0, XCD_BAR_WORDS * 4, stream);
#if ONE_LAUNCH
    int lo = 0, hi = NPHASE;
    void* args[] = {&p, &lo, &hi};
    hipError_t e = hipLaunchCooperativeKernel((void*)mk_forward, dim3(grid_blocks), dim3(NT), args, LDS_BYTES, stream);
    if (e != hipSuccess) fprintf(stderr, "cooperative launch failed: %s (grid %d)\n", hipGetErrorString(e), grid_blocks);
#else
    for (int ph = 0; ph < NPHASE; ++ph) {
        int lo = ph, hi = ph + 1;
        void* args[] = {&p, &lo, &hi};
        (void)hipLaunchCooperativeKernel((void*)mk_forward, dim3(grid_blocks), dim3(NT), args, LDS_BYTES, stream);
    }
#endif
}
```

```cpp
#include <hip/hip_runtime.h>
#include <hip/hip_cooperative_groups.h>
#include <cstdio>
#include <cstdint>
namespace cg = cooperative_groups;

typedef unsigned short bf16_t;
typedef _Float16 f16;
typedef short bf16x8 __attribute__((ext_vector_type(8)));
typedef float f32x4 __attribute__((ext_vector_type(4)));
typedef unsigned u32x4 __attribute__((ext_vector_type(4)));
typedef unsigned u32x2 __attribute__((ext_vector_type(2)));
typedef float f32x2 __attribute__((ext_vector_type(2)));

#ifndef ONE_LAUNCH
#define ONE_LAUNCH 1
#endif
#ifndef PROBE_MASK
#define PROBE_MASK 0
#endif

constexpr int TP = 40960;
constexpr int NPASS = 2;
constexpr int NSEQ = 9;
constexpr int MT = TP / 128;
constexpr int N_IN_FULL = 8576;
constexpr float ALPHA = 1.41421356237f;

constexpr size_t OW_FA_IN = 0, OW_FA_OUT = 5767168, OW_FB_IN = 8650752, OW_FB_OUT = 14417920, OW_WIN = 17301504,
                 OW_WBR = 26083328, OW_WOUT = 28180480, OW_W2T = 29229056, OW_A2T = 29294592, OW_G2T = 29360128, WL_TOTAL = 29425664;
constexpr size_t WS_W = 0, WS_TW = 117702656, WS_MOD = 117735424, WS_HMOD = 119062528, WS_R = 202948608, WS_INVN = 1062780928, WS_STATS = 1064091904, WS_BAR = 1064419584, WS_CTR = 1064433408  ;
constexpr size_t R_RAW = 0, R_LIN = 157286400, R_WA = 188743680, R_G = 356515840, R_Q = 398458880, R_K = 440401920, R_VT = 482344960,
                 R_YFB = 524288000, R_ZC = 608174080, R_POOLP = 650117120, R_YB = 692060160, R_ACT = 0,
                 R_GATES = 0  , R_M32 = 398458880  , R_MERGED = 566231040  ;
constexpr size_t SZ512 = (size_t)TP * 512;

struct Params { const float* in[29]; float* out; unsigned char* ws; };
struct Ctx { int tid, bid, nblk, wave_s; };
__device__ __forceinline__ int tid_now(int wave_s, int z) { return wave_s * 64 + (int)__builtin_amdgcn_mbcnt_hi(~0u, __builtin_amdgcn_mbcnt_lo(~0u, (unsigned)z)); }
typedef const float* const __attribute__((address_space(4)))* ptrtab_t;
struct PV { ptrtab_t tab; float* out; unsigned char* ws;
    __device__ __forceinline__ const float* inp(int i) const { return tab[i]; } };
constexpr int NT = 512, NWV = 8;
extern __shared__ __attribute__((aligned(16))) unsigned char dyn_smem[];
constexpr int LDS_BYTES = 131072 + 64;

__device__ __forceinline__ bf16_t f2bf(float f) { unsigned u = __float_as_uint(f); u += 0x7fffu + ((u >> 16) & 1u); return (bf16_t)(u >> 16); }
__device__ __forceinline__ float bf2f(bf16_t b) { return __uint_as_float(((unsigned)b) << 16); }
__device__ __forceinline__ unsigned pack2bf(float a, float b) { unsigned r; asm("v_cvt_pk_bf16_f32 %0, %1, %2" : "=v"(r) : "v"(a), "v"(b)); return r; }
__device__ __forceinline__ float wsum(float v) {
#pragma unroll
    for (int o = 32; o > 0; o >>= 1) v += __shfl_xor(v, o);
    return v;
}
__device__ __forceinline__ float sigmoidf_(float x) { return 1.0f / (1.0f + __expf(-x)); }
template <int CTRL> __device__ __forceinline__ float dppf(float v) { return __int_as_float(__builtin_amdgcn_update_dpp(0, __float_as_int(v), CTRL, 0xF, 0xF, true)); }
__device__ __forceinline__ float red8(float v) { v += dppf<0xB1>(v); v += dppf<0x4E>(v); v += dppf<0x141>(v); return v; }

__device__ __forceinline__ int grow_of(int pass, int lt) { return lt < 8192 ? pass * 8192 + lt : 16384 + pass * 32768 + (lt - 8192); }
__device__ __forceinline__ int brow_of(int pass, int lt) { return lt < 8192 ? pass : 2 + pass * 8 + ((lt - 8192) >> 12); }
__device__ __forceinline__ int pos_of(int lt) { return lt < 8192 ? lt : ((lt - 8192) & 4095); }
__device__ __forceinline__ int seqbase_of(int sq) { return sq == 0 ? 0 : 8192 + (sq - 1) * 4096; }
__device__ __forceinline__ int seqlen_of(int sq) { return sq == 0 ? 8192 : 4096; }

__device__ __forceinline__ bf16_t* wl(const PV& P, int layer) { return (bf16_t*)(P.ws + WS_W) + (size_t)layer * WL_TOTAL; }

template <int NJ, bool SWAP>
__device__ __forceinline__ void gemm_core(const Ctx& C, f32x4 (&acc)[4][NJ], const bf16_t* __restrict__ A, int lda, const bf16_t* __restrict__ B, int ldb, int K, unsigned char* smem) {
    const int tid = C.tid & 255, lane = tid & 63, wave = tid >> 6, wm = wave >> 1, wn = wave & 1, fr = lane & 15, fq = lane >> 4;
    smem += (C.tid >> 8) * 36864;
    u32x4 ra[4], rb[NJ];
#pragma unroll
    for (int i = 0; i < 4; ++i)
#pragma unroll
        for (int j = 0; j < NJ; ++j) acc[i][j] = (f32x4){0.f, 0.f, 0.f, 0.f};
    const int lrow = tid >> 3, lkc = (tid & 7) * 8;
#pragma unroll
    for (int i = 0; i < 4; ++i) ra[i] = *(const u32x4*)(A + (size_t)(lrow + 32 * i) * lda + lkc);
#pragma unroll
    for (int i = 0; i < NJ; ++i) rb[i] = *(const u32x4*)(B + (size_t)(lrow + 32 * i) * ldb + lkc);
    for (int k0 = 0; k0 < K; k0 += 64) {
        __syncthreads();
#pragma unroll
        for (int i = 0; i < 4; ++i) *(u32x4*)(smem + (lrow + 32 * i) * 144 + lkc * 2) = ra[i];
#pragma unroll
        for (int i = 0; i < NJ; ++i) *(u32x4*)(smem + 18432 + (lrow + 32 * i) * 144 + lkc * 2) = rb[i];
        __syncthreads();
        if (k0 + 64 < K) {
#pragma unroll
            for (int i = 0; i < 4; ++i) ra[i] = *(const u32x4*)(A + (size_t)(lrow + 32 * i) * lda + k0 + 64 + lkc);
#pragma unroll
            for (int i = 0; i < NJ; ++i) rb[i] = *(const u32x4*)(B + (size_t)(lrow + 32 * i) * ldb + k0 + 64 + lkc);
        }
#pragma unroll
        for (int ks = 0; ks < 2; ++ks) {
            bf16x8 af[4], bfr[NJ];
#pragma unroll
            for (int i = 0; i < 4; ++i) af[i] = *(const bf16x8*)(smem + (wm * 64 + i * 16 + fr) * 144 + (ks * 32 + fq * 8) * 2);
#pragma unroll
            for (int j = 0; j < NJ; ++j) bfr[j] = *(const bf16x8*)(smem + 18432 + (wn * NJ * 16 + j * 16 + fr) * 144 + (ks * 32 + fq * 8) * 2);
#pragma unroll
            for (int i = 0; i < 4; ++i)
#pragma unroll
                for (int j = 0; j < NJ; ++j)
                    acc[i][j] = SWAP ? __builtin_amdgcn_mfma_f32_16x16x32_bf16(bfr[j], af[i], acc[i][j], 0, 0, 0)
                                     : __builtin_amdgcn_mfma_f32_16x16x32_bf16(af[i], bfr[j], acc[i][j], 0, 0, 0);
        }
    }
}


namespace g256 {
constexpr int BK = 64, HALF = 128, HT = HALF * BK;
__device__ __forceinline__ int lds_byte(int r, int c) { int st = (r >> 4) * 2 + (c >> 5), rr = r & 15, cc = c & 31, ob = rr * 64 + cc * 2; return st * 1024 + (ob ^ (((ob >> 9) & 1) << 5)); }
__device__ __forceinline__ void stage_rc(unsigned b, unsigned& R, unsigned& Cc) { const unsigned st = b >> 10, sb = b & 1023u, swz = sb ^ (((sb >> 9) & 1u) << 5); R = (st >> 1) * 16u + (swz >> 6); Cc = (st & 1u) * 32u + ((swz & 63u) >> 1); }
}
__device__ __forceinline__ void gemm256(const Ctx& C, f32x4 (&acc)[2][2][4][2], const bf16_t* __restrict__ A, const bf16_t* __restrict__ Bt, const int K, const int brow, const int bcol) {
    using namespace g256;
    bf16_t* shm = (bf16_t*)dyn_smem;
    const int tidx = C.tid;
    #define SA(b,h) (shm+((b)*2+(h))*HT)
    #define SB(b,h) (shm+(4+(b)*2+(h))*HT)
    #define STAGE(Pp,BASE,br,kt) do{const char* _ub=(const char*)((BASE)+(long)(br)*K+(long)(kt)*BK); asm volatile("" : "+s"(_ub)); \
        __builtin_amdgcn_global_load_lds((const unsigned*)(_ub+goff0), \
          (__attribute__((address_space(3))) unsigned*)((__attribute__((address_space(3))) char*)(Pp)+tidx*16),16,0,0); \
        __builtin_amdgcn_global_load_lds((const unsigned*)(_ub+goff1), \
          (__attribute__((address_space(3))) unsigned*)((__attribute__((address_space(3))) char*)(Pp)+tidx*16+8192),16,0,0);}while(0)
    #define LDA(dst,b,h) for(int m=0;m<4;++m)for(int k=0;k<2;++k) \
      dst[m][k]=*reinterpret_cast<const bf16x8*>(a_ptr+((b)*2+(h))*16384+m*2048+k*1024)
    #define LDB(dst,b,h) for(int n=0;n<2;++n)for(int k=0;k<2;++k) \
      dst[n][k]=*reinterpret_cast<const bf16x8*>(b_ptr+((b)*2+(h))*16384+n*2048+k*1024)
    #define MMA(ai,bj,Atx,Btx) do{__builtin_amdgcn_s_setprio(1); \
      for(int m=0;m<4;++m)for(int n=0;n<2;++n)for(int k=0;k<2;++k) \
        acc[ai][bj][m][n]=__builtin_amdgcn_mfma_f32_16x16x32_bf16(Btx[n][k],Atx[m][k],acc[ai][bj][m][n],0,0,0); \
      __builtin_amdgcn_s_setprio(0);}while(0)
    #define WAIT_V(n) asm volatile("s_waitcnt vmcnt(" #n ")":::"memory")
    #define WAIT_L(n) asm volatile("s_waitcnt lgkmcnt(" #n ")":::"memory")
    #define BAR __builtin_amdgcn_s_barrier()
    #define SCHED __builtin_amdgcn_sched_barrier(0)
    const int wid = tidx >> 6, lane = tidx & 63, wr = wid >> 2, wc = wid & 3, fr = lane & 15, fq = lane >> 4;
    const int swz = (fr * 64 + fq * 16) ^ ((fr >> 3) << 5);
    const char* a_ptr = (const char*)dyn_smem + wr * 8192 + swz;
    const char* b_ptr = (const char*)dyn_smem + 65536 + wc * 4096 + swz;
#pragma unroll
    for (int a = 0; a < 2; ++a)
#pragma unroll
        for (int b = 0; b < 2; ++b)
#pragma unroll
            for (int m = 0; m < 4; ++m) { acc[a][b][m][0] = (f32x4){0.f, 0.f, 0.f, 0.f}; acc[a][b][m][1] = (f32x4){0.f, 0.f, 0.f, 0.f}; }
    bf16x8 At[4][2], B0[2][2], B1[2][2];
    const int nt = K / BK;
    unsigned goff0, goff1;
    { unsigned r0, c0, r1, c1; stage_rc((unsigned)tidx * 16u, r0, c0); stage_rc((unsigned)tidx * 16u + 8192u, r1, c1); goff0 = (r0 * (unsigned)K + c0) * 2u; goff1 = (r1 * (unsigned)K + c1) * 2u; }
    WAIT_V(0); __syncthreads();
    STAGE(SB(0,0),Bt,bcol,0); STAGE(SA(0,0),A,brow,0);
    STAGE(SB(0,1),Bt,bcol+HALF,0); STAGE(SA(0,1),A,brow+HALF,0);
    if(wr==1)BAR;
    WAIT_V(4); BAR;
    STAGE(SB(1,0),Bt,bcol,1); STAGE(SA(1,0),A,brow,1); STAGE(SB(1,1),Bt,bcol+HALF,1);
    WAIT_V(6); BAR;
    for(int t=0;t<nt-2;t+=2){
      LDB(B0,0,0); SCHED; LDA(At,0,0); STAGE(SA(1,1),A,brow+HALF,t+1);
      WAIT_L(8); BAR; WAIT_L(0); MMA(0,0,At,B0); BAR; SCHED;
      LDB(B1,0,1); STAGE(SB(0,0),Bt,bcol,t+2);
      BAR; WAIT_L(0); MMA(0,1,At,B1); BAR;
      LDA(At,0,1); STAGE(SA(0,0),A,brow,t+2);
      BAR; WAIT_L(0); MMA(1,0,At,B0); BAR; SCHED;
      STAGE(SB(0,1),Bt,bcol+HALF,t+2);
      WAIT_V(6); BAR; MMA(1,1,At,B1); BAR;
      LDB(B0,1,0); SCHED; LDA(At,1,0); STAGE(SA(0,1),A,brow+HALF,t+2);
      WAIT_L(8); BAR; WAIT_L(0); MMA(0,0,At,B0); BAR; SCHED;
      LDB(B1,1,1); STAGE(SB(1,0),Bt,bcol,t+3);
      BAR; WAIT_L(0); MMA(0,1,At,B1); BAR;
      LDA(At,1,1); STAGE(SA(1,0),A,brow,t+3);
      BAR; WAIT_L(0); MMA(1,0,At,B0); BAR; SCHED;
      STAGE(SB(1,1),Bt,bcol+HALF,t+3);
      WAIT_V(6); BAR; MMA(1,1,At,B1); BAR;
    }
    { LDB(B0,0,0); LDA(At,0,0); STAGE(SA(1,1),A,brow+HALF,nt-1);
      BAR; WAIT_L(0); MMA(0,0,At,B0); BAR;
      LDB(B1,0,1); BAR; WAIT_L(0); MMA(0,1,At,B1); BAR;
      LDA(At,0,1); WAIT_V(4); BAR; WAIT_L(0); MMA(1,0,At,B0); MMA(1,1,At,B1); BAR; }
    { LDB(B0,1,0); LDA(At,1,0); WAIT_V(2); BAR; WAIT_L(0); MMA(0,0,At,B0); BAR;
      LDB(B1,1,1); WAIT_V(0); BAR; WAIT_L(0); MMA(0,1,At,B1); BAR;
      LDA(At,1,1); BAR; WAIT_L(0); MMA(1,0,At,B0); MMA(1,1,At,B1); BAR; }
    if(wr==0)BAR;
    #undef SA
    #undef SB
    #undef STAGE
    #undef LDA
    #undef LDB
    #undef MMA
    #undef WAIT_V
    #undef WAIT_L
    #undef BAR
    #undef SCHED
}
__device__ __forceinline__ bool tile_order(int i, int G, int c, int nM, int nN, int& pm, int& pn) {
    const int nwg = nM * nN; const long L = (long)i * G + c; if (L >= nwg) return false;
    int wgid = (int)L; { const int q = nwg / 8, r = nwg % 8, xcd = wgid % 8, off = wgid / 8; wgid = (xcd < r ? xcd * (q + 1) : r * (q + 1) + (xcd - r) * q) + off; }
    const int nig = 8 * nN, gid = wgid / nig, fm = gid * 8, gsz = (nM - fm) < 8 ? (nM - fm) : 8;
    pm = fm + ((wgid % nig) % gsz); pn = (wgid % nig) / gsz; return true;
}

struct ConvJob { const float* src; int ld, K, nbegin, ncount, map; bf16_t* dst; };
__device__ __forceinline__ ConvJob conv_job(const PV& P, int j) {
    const int l = j >> 4, q = j & 15; bf16_t* W = wl(P, l); ConvJob c; c.map = 0; c.nbegin = 0;
    switch (q) {
        case 0: c.src = P.inp(8) + (size_t)l * 1024 * 5632; c.ld = 5632; c.K = 1024; c.ncount = 5632; c.dst = W + OW_FA_IN; c.map = 1; break;
        case 1: c.src = P.inp(9) + (size_t)l * 2816 * 1024; c.ld = 1024; c.K = 2816; c.ncount = 1024; c.dst = W + OW_FA_OUT; break;
        case 2: c.src = P.inp(10) + (size_t)l * 1024 * 5632; c.ld = 5632; c.K = 1024; c.ncount = 5632; c.dst = W + OW_FB_IN; c.map = 1; break;
        case 3: c.src = P.inp(11) + (size_t)l * 2816 * 1024; c.ld = 1024; c.K = 2816; c.ncount = 1024; c.dst = W + OW_FB_OUT; break;
        case 4: c.src = P.inp(12) + (size_t)l * 1024 * 8576; c.ld = 8576; c.K = 1024; c.ncount = 3456; c.dst = W + OW_WIN; break;
        case 5: c.src = P.inp(12) + (size_t)l * 1024 * 8576; c.ld = 8576; c.K = 1024; c.nbegin = 3968; c.ncount = 4608; c.dst = W + OW_WIN + (size_t)3968 * 1024; break;
        case 6: case 7: case 8: case 9: { const int n = q - 6; c.src = P.inp(27) + (size_t)(l * 4 + n) * 512 * 1024; c.ld = 1024; c.K = 512; c.ncount = 1024; c.dst = W + OW_WBR + (size_t)n * 1024 * 512; } break;
        case 10: c.src = P.inp(28) + (size_t)l * 1024 * 1024; c.ld = 1024; c.K = 1024; c.ncount = 1024; c.dst = W + OW_WOUT; break;
        case 11: case 12: { const int d = q - 11; c.src = P.inp(15) + (size_t)(l * 2 + d) * 64 * 512; c.ld = 512; c.K = 64; c.ncount = 512; c.dst = W + OW_W2T + (size_t)d * 512 * 64; } break;
        case 13: case 14: { const int d = q - 13; c.src = P.inp(17) + (size_t)(l * 2 + d) * 64 * 512; c.ld = 512; c.K = 64; c.ncount = 512; c.dst = W + OW_A2T + (size_t)d * 512 * 64; } break;
        default: c.src = P.inp(18) + (size_t)l * 128 * 512; c.ld = 512; c.K = 128; c.ncount = 512; c.dst = W + OW_G2T; break;
    }
    return c;
}

__device__ __forceinline__ void prep_phase(const Ctx& C, const PV& P, unsigned char* smem) {
    const int tid = C.tid;
    {
        int total = 0;
        for (int j = 0; j < 32; ++j) { ConvJob c = conv_job(P, j); total += (c.K >> 6) * (c.ncount >> 6); }
        float* tile = (float*)smem;
        const int tx = tid & 63, ty = tid >> 6;
        for (int t = C.bid; t < total; t += C.nblk) {
            int tt = t, j = 0; ConvJob c = conv_job(P, 0);
            for (;;) { const int n = (c.K >> 6) * (c.ncount >> 6); if (tt < n) break; tt -= n; ++j; c = conv_job(P, j); }
            const int nkt = c.K >> 6, kt = tt % nkt, nt = tt / nkt, k0 = kt * 64, n0 = nt * 64;
            int col = c.nbegin + n0 + tx;
            if (c.map) { const int np = n0 + tx, blk = np >> 5, w = np & 31, f = blk * 16 + (w & 15); col = (w < 16) ? f : 2816 + f; }
            __syncthreads();
#pragma unroll 4
            for (int i = 0; i < 8; ++i) { const int kk = ty + 8 * i; tile[kk * 65 + tx] = c.src[(size_t)(k0 + kk) * c.ld + col]; }
            __syncthreads();
#pragma unroll 4
            for (int i = 0; i < 8; ++i) { const int nn = ty + 8 * i; c.dst[(size_t)(n0 + nn) * c.K + k0 + tx] = f2bf(tile[tx * 65 + nn]); }
        }
        __syncthreads();
    }
    {
        float* wt = (float*)smem;
        float* cosT = (float*)(smem + 64 * 129 * 4);
        for (int it = C.bid; it < 2 * 4 * 16; it += C.nblk) {
            const int l = it >> 6, g = (it >> 4) & 3, kc = it & 15, k0 = kc * 64;
            const float* src = P.inp(12) + (size_t)l * 1024 * 8576 + 3456 + g * 128;
            __syncthreads();
            for (int e = tid; e < 64 * 128; e += NT) { const int kk = e >> 7, c = e & 127; wt[kk * 129 + c] = src[(size_t)(k0 + kk) * 8576 + c]; }
            if (tid < 128) cosT[tid] = cospif((float)tid * (1.0f / 64.0f));
            __syncthreads();
            bf16_t* dst = wl(P, l) + OW_WIN + (size_t)(3456 + g * 128) * 1024;
            const int kk = tid & 63;
            for (int i = 0; i < 16; ++i) {
                const int j2 = (tid >> 6) + 8 * i, cc = j2 >> 1, part = j2 & 1;
                float s = 0.f;
                if (cc == 0) {
                    if (part == 0) { for (int c = 0; c < 128; ++c) s += wt[kk * 129 + c]; }
                    else { for (int c = 0; c < 128; ++c) s += (c & 1) ? -wt[kk * 129 + c] : wt[kk * 129 + c]; }
                } else if (part == 0) {
                    for (int c = 0; c < 128; ++c) s += wt[kk * 129 + c] * cosT[(cc * c) & 127];
                } else {
                    for (int c = 0; c < 128; ++c) s -= wt[kk * 129 + c] * cosT[(cc * c - 32) & 127];
                }
                dst[(size_t)j2 * 1024 + k0 + kk] = f2bf(s);
            }
        }
        __syncthreads();
    }
    {
        float2* tw = (float2*)(P.ws + WS_TW);
        for (int m = C.bid * NT + tid; m < 4096; m += C.nblk * NT) { const float x = (float)m * (1.0f / 4096.0f); tw[m] = make_float2(cospif(x), -sinpif(x)); }
    }
    {
        float* sc = (float*)smem;
        float* red = (float*)(smem + 18 * 512 * 4);
        float* mod = (float*)(P.ws + WS_MOD);
        for (int it = C.bid; it < 2 * 144; it += C.nblk) {
            const int l = it / 144, n0 = (it % 144) * 64, nl = tid & 63, ks = tid >> 6;
            const float* aw = P.inp(4) + (size_t)l * 1024 * 9216;
            float acc[18];
#pragma unroll
            for (int b = 0; b < 18; ++b) acc[b] = 0.f;
            for (int half = 0; half < 2; ++half) {
                __syncthreads();
                for (int e = tid; e < 18 * 512; e += NT) {
                    const int b = e >> 9, kk = e & 511, k = half * 512 + kk;
                    const float cv = b < 2 ? P.inp(2)[b * 1024 + k] : P.inp(3)[(b - 2) * 1024 + k];
                    sc[e] = cv / (1.0f + __expf(-cv));
                }
                __syncthreads();
                for (int kk = ks * 64; kk < ks * 64 + 64; ++kk) {
                    const float w = aw[(size_t)(half * 512 + kk) * 9216 + n0 + nl];
#pragma unroll
                    for (int b = 0; b < 18; ++b) acc[b] += sc[b * 512 + kk] * w;
                }
            }
            __syncthreads();
#pragma unroll
            for (int b = 0; b < 18; ++b) red[(ks * 18 + b) * 64 + nl] = acc[b];
            __syncthreads();
            for (int e = tid; e < 18 * 64; e += NT) {
                const int b = e >> 6, n = e & 63;
                float s = 0.f;
#pragma unroll
                for (int k8 = 0; k8 < 8; ++k8) s += red[(k8 * 18 + b) * 64 + n];
                mod[((size_t)l * 18 + b) * 9216 + n0 + n] = s + P.inp(5)[(size_t)l * 9216 + n0 + n];
            }
        }
        __syncthreads();
    }
}

__device__ __forceinline__ void norm_phase(const Ctx& C, const PV& P, int pass, const float* lng, const float* lnb, int mod_layer, int j, bool from_input, bool write_x) {
    const int lane = C.tid & 63, wave = C.tid >> 6;
    bf16_t* hmod = (bf16_t*)(P.ws + WS_HMOD);
    const float* mod = (const float*)(P.ws + WS_MOD);
    const int nw = C.nblk * NWV;
    for (int lt0 = C.bid * NWV + wave; lt0 < TP; lt0 += 2 * nw) {
        f32x4 v[2][4]; int gr[2], bb[2]; bool ok[2];
#pragma unroll
        for (int u = 0; u < 2; ++u) {
            const int lt = lt0 + u * nw; ok[u] = lt < TP;
            const int ltc = ok[u] ? lt : lt0;
            gr[u] = grow_of(pass, ltc); bb[u] = brow_of(pass, ltc);
            const float* src = from_input ? (gr[u] < 16384 ? P.inp(0) + (size_t)gr[u] * 1024 : P.inp(1) + (size_t)(gr[u] - 16384) * 1024) : P.out + (size_t)gr[u] * 1024;
#pragma unroll
            for (int i = 0; i < 4; ++i) v[u][i] = *(const f32x4*)(src + i * 256 + lane * 4);
        }
        if (lng) {
            float s[2], q[2], mu[2], rs[2];
#pragma unroll
            for (int u = 0; u < 2; ++u) { s[u] = 0.f;
#pragma unroll
                for (int i = 0; i < 4; ++i) s[u] += (v[u][i][0] + v[u][i][1]) + (v[u][i][2] + v[u][i][3]); }
#pragma unroll
            for (int o = 32; o > 0; o >>= 1) { s[0] += __shfl_xor(s[0], o); s[1] += __shfl_xor(s[1], o); }
#pragma unroll
            for (int u = 0; u < 2; ++u) { mu[u] = s[u] * (1.0f / 1024.0f); q[u] = 0.f;
#pragma unroll
                for (int i = 0; i < 4; ++i) { const f32x4 dd = v[u][i] - mu[u]; q[u] += (dd[0] * dd[0] + dd[1] * dd[1]) + (dd[2] * dd[2] + dd[3] * dd[3]); } }
#pragma unroll
            for (int o = 32; o > 0; o >>= 1) { q[0] += __shfl_xor(q[0], o); q[1] += __shfl_xor(q[1], o); }
#pragma unroll
            for (int u = 0; u < 2; ++u) {
                rs[u] = rsqrtf(q[u] * (1.0f / 1024.0f) + 1e-5f);
                if (ok[u] && lane == 0) *(f32x2*)(P.ws + WS_STATS + (size_t)(lt0 + u * nw) * 8) = (f32x2){mu[u], rs[u]};
            }
#pragma unroll
            for (int i = 0; i < 4; ++i) {
                const f32x4 g = *(const f32x4*)(lng + i * 256 + lane * 4), be = *(const f32x4*)(lnb + i * 256 + lane * 4);
                v[0][i] = (v[0][i] - mu[0]) * rs[0] * g + be; v[1][i] = (v[1][i] - mu[1]) * rs[1] * g + be;
            }
        }
        if (write_x) {
#pragma unroll
            for (int u = 0; u < 2; ++u) if (ok[u]) {
#pragma unroll
                for (int i = 0; i < 4; ++i) *(f32x4*)(P.out + (size_t)gr[u] * 1024 + i * 256 + lane * 4) = v[u][i];
            }
        }
        if (j >= 0) {
            float s[2], q[2], mu[2], rs[2];
#pragma unroll
            for (int u = 0; u < 2; ++u) { s[u] = 0.f;
#pragma unroll
                for (int i = 0; i < 4; ++i) s[u] += (v[u][i][0] + v[u][i][1]) + (v[u][i][2] + v[u][i][3]); }
#pragma unroll
            for (int o = 32; o > 0; o >>= 1) { s[0] += __shfl_xor(s[0], o); s[1] += __shfl_xor(s[1], o); }
#pragma unroll
            for (int u = 0; u < 2; ++u) { mu[u] = s[u] * (1.0f / 1024.0f); q[u] = 0.f;
#pragma unroll
                for (int i = 0; i < 4; ++i) { const f32x4 dd = v[u][i] - mu[u]; q[u] += (dd[0] * dd[0] + dd[1] * dd[1]) + (dd[2] * dd[2] + dd[3] * dd[3]); } }
#pragma unroll
            for (int o = 32; o > 0; o >>= 1) { q[0] += __shfl_xor(q[0], o); q[1] += __shfl_xor(q[1], o); }
#pragma unroll
            for (int u = 0; u < 2; ++u) {
                rs[u] = rsqrtf(q[u] * (1.0f / 1024.0f) + 1e-5f);
                if (!ok[u]) continue;
                const float* mb = mod + ((size_t)mod_layer * 18 + bb[u]) * 9216 + (size_t)(3 * j) * 1024;
                const int lt = lt0 + u * nw;
#pragma unroll
                for (int i = 0; i < 4; ++i) {
                    const f32x4 sh = *(const f32x4*)(mb + i * 256 + lane * 4), scl = *(const f32x4*)(mb + 1024 + i * 256 + lane * 4);
                    const f32x4 hh = (v[u][i] - mu[u]) * rs[u] * (1.0f + scl) + sh;
                    u32x2 o; o.x = pack2bf(hh[0], hh[1]); o.y = pack2bf(hh[2], hh[3]);
                    *(u32x2*)(hmod + (size_t)lt * 1024 + i * 256 + lane * 4) = o;
                }
            }
        }
    }
}

__device__ __forceinline__ void ffn_up_phase(const Ctx& C, const PV& P, const bf16_t* Wt) {
    const bf16_t* hmod = (const bf16_t*)(P.ws + WS_HMOD);
    bf16_t* act = (bf16_t*)(P.ws + WS_R + R_ACT);
    int pm, pn;
    for (int it = 0; tile_order(it, C.nblk, C.bid, TP / 256, 22, pm, pn); ++it) {
        f32x4 acc[2][2][4][2];
        gemm256(C, acc, hmod, Wt, 1024, pm * 256, pn * 256);
        int z2 = 0; asm volatile("" : "+s"(z2));
        const int tid2 = tid_now(C.wave_s, z2), lane = tid2 & 63, wid = tid2 >> 6, wr = wid >> 2, wc = wid & 3, fr = lane & 15, fq = lane >> 4;
#pragma unroll
        for (int ai = 0; ai < 2; ++ai)
#pragma unroll
            for (int m = 0; m < 4; ++m) {
                const int row = pm * 256 + ai * 128 + wr * 64 + m * 16 + fr;
#pragma unroll
                for (int bj = 0; bj < 2; ++bj) {
                    const int colbase = pn * 256 + bj * 128 + wc * 32, f = (colbase >> 5) * 16 + fq * 4;
                    const f32x4 a = acc[ai][bj][m][0], bb = acc[ai][bj][m][1];
                    float o[4];
#pragma unroll
                    for (int r = 0; r < 4; ++r) o[r] = a[r] / (1.0f + __expf(-a[r])) * bb[r];
                    u32x2 w; w.x = pack2bf(o[0], o[1]); w.y = pack2bf(o[2], o[3]);
                    *(u32x2*)(act + (size_t)row * 2816 + f) = w;
                }
            }
    }
}

__device__ __forceinline__ void resid_gemm_phase(const Ctx& C, const PV& P, int pass, const bf16_t* A, int K, const bf16_t* Wt, int layer, int j, float scale, const float* xg, const float* xb) {
    const float* mod = (const float*)(P.ws + WS_MOD);
    int pm, pn;
    for (int it = 0; tile_order(it, C.nblk, C.bid, TP / 256, 4, pm, pn); ++it) {
        f32x4 acc[2][2][4][2];
        gemm256(C, acc, A, Wt, K, pm * 256, pn * 256);
        int z2 = 0; asm volatile("" : "+s"(z2));
        const int tid2 = tid_now(C.wave_s, z2), lane = tid2 & 63, wid = tid2 >> 6, wr = wid >> 2, wc = wid & 3, fr = lane & 15, fq = lane >> 4;
#pragma unroll
        for (int ai = 0; ai < 2; ++ai)
#pragma unroll
            for (int m = 0; m < 4; ++m) {
                const int lt = pm * 256 + ai * 128 + wr * 64 + m * 16 + fr;
                const int gr = grow_of(pass, lt), b = brow_of(pass, lt);
                const float* gate = mod + ((size_t)layer * 18 + b) * 9216 + (size_t)(3 * j + 2) * 1024;
                const float* xsrc = xg ? P.out + (size_t)gr * 1024 : (gr < 16384 ? P.inp(0) + (size_t)gr * 1024 : P.inp(1) + (size_t)(gr - 16384) * 1024);
                f32x2 st = (f32x2){0.f, 1.f};
                if (xg) st = *(const f32x2*)(P.ws + WS_STATS + (size_t)lt * 8);
#pragma unroll
                for (int bj = 0; bj < 2; ++bj)
#pragma unroll
                    for (int n = 0; n < 2; ++n) {
                        const int col = pn * 256 + bj * 128 + wc * 32 + n * 16 + fq * 4;
                        f32x4 x = *(const f32x4*)(xsrc + col);
                        if (xg) x = (x - st[0]) * st[1] * *(const f32x4*)(xg + col) + *(const f32x4*)(xb + col);
                        const f32x4 g = *(const f32x4*)(gate + col);
                        *(f32x4*)(P.out + (size_t)gr * 1024 + col) = ALPHA * x + (1.0f + g) * scale * acc[ai][bj][m][n];
                    }
                asm volatile("" ::: "memory");
            }
    }
}

__device__ __forceinline__ void win_phase(const Ctx& C, const PV& P, int layer) {
    const bf16_t* hmod = (const bf16_t*)(P.ws + WS_HMOD);
    const bf16_t* Wt = wl(P, layer) + OW_WIN;
    unsigned char* R = P.ws + WS_R;
    f16* raw = (f16*)(R + R_RAW); bf16_t* Qb = (bf16_t*)(R + R_Q); bf16_t* Kb = (bf16_t*)(R + R_K); bf16_t* Vt = (bf16_t*)(R + R_VT);
    f16* Zc = (f16*)(R + R_ZC); f16* poolp = (f16*)(R + R_POOLP);
    typedef f16 f16x4 __attribute__((ext_vector_type(4)));
    typedef f16 f16x2 __attribute__((ext_vector_type(2)));
    int pm, pn;
    for (int it = 0; tile_order(it, C.nblk, C.bid, TP / 256, 18, pm, pn); ++it) {
        const int lt_t = pm * 256, sq = lt_t < 8192 ? 0 : 1 + ((lt_t - 8192) >> 12), lt0 = seqbase_of(sq), S = seqlen_of(sq);
        f32x4 acc[2][2][4][2];
        gemm256(C, acc, hmod, Wt, 1024, pm * 256, pn * 256);
        int z2 = 0; asm volatile("" : "+s"(z2));
        const int tid2 = tid_now(C.wave_s, z2), lane = tid2 & 63, wid = tid2 >> 6, wr = wid >> 2, wc = wid & 3, fr = lane & 15, fq = lane >> 4;
#pragma unroll
        for (int bj = 0; bj < 2; ++bj) {
            const int tn = pn * 2 + bj;
            if (tn >= 35) continue;
#pragma unroll
            for (int ai = 0; ai < 2; ++ai)
#pragma unroll
                for (int m = 0; m < 4; ++m) {
                    const int lt = pm * 256 + ai * 128 + wr * 64 + m * 16 + fr, pos = lt - lt0;
#pragma unroll
                    for (int n = 0; n < 2; ++n) {
                        const int col = tn * 128 + wc * 32 + n * 16 + fq * 4;
                        f32x4 v = acc[ai][bj][m][n];
                        if (tn < 15) {
                            f16x4 h; h[0] = (f16)v[0]; h[1] = (f16)v[1]; h[2] = (f16)v[2]; h[3] = (f16)v[3];
                            *(f16x4*)(raw + (size_t)lt * 1920 + col) = h;
                        } else if (tn < 23) {
                            const int nq = (col - 1920) & 511, hc = nq >> 6, d = nq & 63;
                            if (n == 0 && (wc & 1) == 0) {
#pragma unroll
                                for (int r = 0; r < 4; ++r) {
                                    const float invlo = r == 0 ? 1.0f : r == 1 ? 0.1939227432012558f : r == 2 ? 0.03760603070259094f : 0.007292664609849453f;
                                    const float invhi = r == 0 ? 0.0014142135623842478f : r == 1 ? 0.00027424818836152554f : r == 2 ? 5.3182957344688475e-05f : 1.0313385246263351e-05f;
                                    const float ang = (float)pos * ((fq & 1) ? invhi : invlo);
                                    const float hi = ang * 0.15915493667125702f;
                                    const float lo = __builtin_fmaf(ang, 0.15915493667125702f, -hi) + ang * 6.4206382432985265e-09f;
                                    const float rr = (hi - floorf(hi)) + lo;
                                    const float cs = __builtin_amdgcn_cosf(rr), sn = __builtin_amdgcn_sinf(rr);
                                    const float other = __shfl_xor(v[r], 32);
                                    v[r] = (fq < 2) ? (v[r] * cs - other * sn) : (other * sn + v[r] * cs);
                                }
                            }
                            bf16_t* dst = (tn < 19) ? Qb : Kb;
                            const float sc = (tn < 19) ? 0.125f * 1.44269504088896f : 1.0f;
                            u32x2 w; w.x = pack2bf(v[0] * sc, v[1] * sc); w.y = pack2bf(v[2] * sc, v[3] * sc);
                            *(u32x2*)(dst + (size_t)lt0 * 512 + ((size_t)hc * S + pos) * 64 + d) = w;
                        } else if (tn < 27) {
                            const int nv = col - 2944;
                            bf16_t* vb = Vt + (size_t)lt0 * 512 + (size_t)nv * S + pos;
                            vb[0] = f2bf(v[0]); vb[(size_t)S] = f2bf(v[1]); vb[(size_t)2 * S] = f2bf(v[2]); vb[(size_t)3 * S] = f2bf(v[3]);
                        } else if (tn < 31) {
                            const int nz = col - 3456, g = nz >> 7, cc = (nz & 127) >> 1;
                            f16x2 z0, z1; z0[0] = (f16)v[0]; z0[1] = (f16)v[1]; z1[0] = (f16)v[2]; z1[1] = (f16)v[3];
                            f16x2* zb = (f16x2*)Zc + (size_t)lt0 * 256;
                            zb[(size_t)(g * 64 + cc) * S + pos] = z0;
                            zb[(size_t)(g * 64 + cc + 1) * S + pos] = z1;
                        } else {
                            f16x4 h; h[0] = (f16)v[0]; h[1] = (f16)v[1]; h[2] = (f16)v[2]; h[3] = (f16)v[3];
                            *(f16x4*)(poolp + (size_t)lt * 512 + (col - 3968)) = h;
                        }
                    }
                    asm volatile("" ::: "memory");
                }
        }
    }
}

__device__ __forceinline__ float shiftv(const f16* __restrict__ raw, int lt, int t, int S, int col, float mu) {
    const float p = (float)raw[(size_t)lt * 1920 + col];
    const float pr = t > 0 ? (float)raw[(size_t)(lt - 1) * 1920 + col] : 0.f;
    const float nx = t < S - 1 ? (float)raw[(size_t)(lt + 1) * 1920 + col] : 0.f;
    return p + (0.5f * (pr + nx) - p) * mu;
}

typedef f16 f16x4_t __attribute__((ext_vector_type(4)));
typedef f16 f16x8_t __attribute__((ext_vector_type(8)));
__device__ __forceinline__ void lin_pool_phase(const Ctx& C, const PV& P, int layer) {
    unsigned char* R = P.ws + WS_R;
    const f16* raw = (const f16*)(R + R_RAW); bf16_t* lin = (bf16_t*)(R + R_LIN);
    const f16* poolp = (const f16*)(R + R_POOLP); bf16_t* ypool = (bf16_t*)(R + R_YB) + 3 * SZ512;
    const float* mu = P.inp(13) + (size_t)layer * 1920; const float* pscale = P.inp(26) + (size_t)layer * 512;
    const int gsz = C.nblk * NT, gid = C.bid * NT + C.tid;
    for (int e0 = gid; e0 < TP * 96; e0 += 2 * gsz) {
        f16x4_t p0[2], pm[2], pp[2]; f32x4 m4[2]; int lt_[2], c_[2]; float wm_[2], wp_[2]; bool ok[2];
#pragma unroll
        for (int u = 0; u < 2; ++u) {
            const int e1 = e0 + u * gsz; ok[u] = e1 < TP * 96; const int e = ok[u] ? e1 : e0;
            const int lt = e / 96, c = (e % 96) * 4, col = 1536 + c;
            const int pos = pos_of(lt), S = lt < 8192 ? 8192 : 4096;
            lt_[u] = lt; c_[u] = c; wm_[u] = pos > 0 ? 0.5f : 0.f; wp_[u] = pos < S - 1 ? 0.5f : 0.f;
            p0[u] = *(const f16x4_t*)(raw + (size_t)lt * 1920 + col);
            pm[u] = *(const f16x4_t*)(raw + (size_t)(pos > 0 ? lt - 1 : lt) * 1920 + col);
            pp[u] = *(const f16x4_t*)(raw + (size_t)(pos < S - 1 ? lt + 1 : lt) * 1920 + col);
            m4[u] = *(const f32x4*)(mu + col);
        }
#pragma unroll
        for (int u = 0; u < 2; ++u) {
            float o[4];
#pragma unroll
            for (int r = 0; r < 4; ++r) {
                const float p = (float)p0[u][r];
                float v = p + (wm_[u] * (float)pm[u][r] + wp_[u] * (float)pp[u][r] - p) * m4[u][r];
                if (c_[u] < 128) v = 1.0f - 2.0f / (__expf(2.0f * v) + 1.0f);
                else if (c_[u] >= 256) v = sigmoidf_(v);
                o[r] = v;
            }
            u32x2 w; w.x = pack2bf(o[0], o[1]); w.y = pack2bf(o[2], o[3]);
            if (ok[u]) *(u32x2*)(lin + (size_t)lt_[u] * 384 + c_[u]) = w;
        }
    }
    for (int e0 = gid; e0 < TP * 128; e0 += 2 * gsz) {
        f16x4_t tv[2][16], xv[2]; int lt_[2], c_[2], cnt_[2]; bool ok[2];
#pragma unroll
        for (int u = 0; u < 2; ++u) {
            const int e1 = e0 + u * gsz; ok[u] = e1 < TP * 128; const int e = ok[u] ? e1 : e0;
            const int lt = e >> 7, c = (e & 127) * 4, g = c >> 7, half = 1 << g;
            const int pos = pos_of(lt), S = lt < 8192 ? 8192 : 4096;
            const int lo = max(pos - half, 0), hi = min(pos + half, S);
            lt_[u] = lt; c_[u] = c; cnt_[u] = hi - lo;
            const f16* base = poolp + (size_t)(lt - pos) * 512 + c;
#pragma unroll
            for (int o = -8; o < 8; ++o) {
                const int tt = pos + o;
                const bool in = (o >= -half) && (o < half) && tt >= 0 && tt < S;
                f16x4_t z; z[0] = (f16)0.f; z[1] = (f16)0.f; z[2] = (f16)0.f; z[3] = (f16)0.f;
                tv[u][o + 8] = in ? *(const f16x4_t*)(base + (size_t)tt * 512) : z;
            }
            xv[u] = *(const f16x4_t*)(base + (size_t)pos * 512);
        }
#pragma unroll
        for (int u = 0; u < 2; ++u) {
            float s0 = 0.f, s1 = 0.f, s2 = 0.f, s3 = 0.f;
#pragma unroll
            for (int o = 0; o < 16; ++o) { s0 += (float)tv[u][o][0]; s1 += (float)tv[u][o][1]; s2 += (float)tv[u][o][2]; s3 += (float)tv[u][o][3]; }
            const f32x4 ps = *(const f32x4*)(pscale + c_[u]);
            const float ic = 1.0f / (float)cnt_[u];
            u32x2 w; w.x = pack2bf((s0 * ic - (float)xv[u][0]) * ps[0], (s1 * ic - (float)xv[u][1]) * ps[1]); w.y = pack2bf((s2 * ic - (float)xv[u][2]) * ps[2], (s3 * ic - (float)xv[u][3]) * ps[3]);
            if (ok[u]) *(u32x2*)(ypool + (size_t)lt_[u] * 512 + c_[u]) = w;
        }
    }
    {
        float* invn = (float*)(P.ws + WS_INVN);
        const float* k_k = P.inp(19) + (size_t)layer * 512;
        const int lane = C.tid & 63, wave = C.tid >> 6;
        for (int lt = C.bid * NWV + wave; lt < TP; lt += C.nblk * NWV) {
            const int pos = pos_of(lt), S = lt < 8192 ? 8192 : 4096;
            float ss[8];
#pragma unroll
            for (int h = 0; h < 8; ++h) {
                const int c = h * 64 + lane;
                const float k = shiftv(raw, lt, pos, S, 512 + c, mu[512 + c]) * k_k[c];
                ss[h] = k * k;
            }
#pragma unroll
            for (int h = 0; h < 8; ++h) ss[h] = wsum(ss[h]);
            if (lane < 8) {
                float sel = ss[0];
#pragma unroll
                for (int h = 1; h < 8; ++h) sel = lane == h ? ss[h] : sel;
                invn[(size_t)lt * 8 + lane] = 1.0f / fmaxf(sqrtf(sel), 1e-12f);
            }
        }
    }
}

__device__ __forceinline__ void lora_phase(const Ctx& C, const PV& P, int layer, unsigned char* smem) {
    unsigned char* R = P.ws + WS_R;
    const bf16_t* lin = (const bf16_t*)(R + R_LIN); f16* wa = (f16*)(R + R_WA); f16* gbuf = (f16*)(R + R_G);
    const bf16_t* W = wl(P, layer);
    const int lane = C.tid & 63, wave = (C.tid >> 6) & 3, wm = wave >> 1, wn = wave & 1, fr = lane & 15, fq = lane >> 4;
    for (int t2 = C.bid; t2 < 5 * MT * 2; t2 += C.nblk) {
        const int t = t2 * 2 + (C.tid >> 8);
        const int which = t / (MT * 4), tt = t % (MT * 4), tm = tt >> 2, tn = tt & 3;
        const bf16_t* Bt; int K, acol; const float* bias = nullptr; f16* dst;
        if (which < 2) { Bt = W + OW_W2T + (size_t)which * 512 * 64; K = 64; acol = which * 64; bias = P.inp(14) + (size_t)(layer * 2 + which) * 512; dst = wa + (size_t)which * SZ512; }
        else if (which < 4) { const int d = which - 2; Bt = W + OW_A2T + (size_t)d * 512 * 64; K = 64; acol = 128 + d * 64; bias = P.inp(16) + (size_t)(layer * 2 + d) * 512; dst = wa + (size_t)which * SZ512; }
        else { Bt = W + OW_G2T; K = 128; acol = 256; dst = gbuf; }
        f32x4 acc[4][4];
        gemm_core<4, true>(C, acc, lin + (size_t)tm * 128 * 384 + acol, 384, Bt + (size_t)tn * 128 * K, K, K, smem);
#pragma unroll
        for (int i = 0; i < 4; ++i) {
            const int lt = tm * 128 + wm * 64 + i * 16 + fr;
#pragma unroll
            for (int jn = 0; jn < 4; ++jn) {
                const int n = tn * 128 + wn * 64 + jn * 16 + fq * 4;
                typedef f16 f16x4 __attribute__((ext_vector_type(4)));
                f16x4 h;
#pragma unroll
                for (int r = 0; r < 4; ++r) {
                    float v = acc[i][jn][r];
                    if (which < 2) {
                        const float z = bias[n + r] + v;
                        v = __expf(-0.6065306597126334f * sigmoidf_(z));
                    } else if (which < 4) { v = sigmoidf_(bias[n + r] + v); }
                    h[r] = (f16)v;
                }
                *(f16x4*)(dst + (size_t)lt * 512 + n) = h;
            }
        }
    }
}

__device__ __forceinline__ void attn_items(const Ctx& C, const PV& P, int layer, int ctr_idx, unsigned char* smem) {
    unsigned char* R = P.ws + WS_R;
    const bf16_t* Qall = (const bf16_t*)(R + R_Q); const bf16_t* Kall = (const bf16_t*)(R + R_K); const bf16_t* Vall = (const bf16_t*)(R + R_VT);
    bf16_t* ydiff = (bf16_t*)(R + R_YB) + 1 * SZ512;
    const int tid = C.tid, lane = tid & 63, wave = tid >> 6, comp = wave & 1, rg = wave >> 1, fr = lane & 15, fq = lane >> 4;
    const float lam_init = layer == 0 ? 0.2f : (0.8f - 0.6f * 0.7408182206817179f);
    float lam_full;
    {
        const float* lm = P.inp(24) + (size_t)layer * 256;
        float s1 = 0.f, s2 = 0.f;
        for (int i = 0; i < 64; ++i) { s1 += lm[i] * lm[64 + i]; s2 += lm[128 + i] * lm[192 + i]; }
        lam_full = expf(s1) - expf(s2) + lam_init;
    }
    const float* normg = P.inp(25) + (size_t)layer * 128;
    unsigned* ctr = (unsigned*)(P.ws + WS_CTR) + ctr_idx * 16;
    volatile unsigned* bc = (volatile unsigned*)(smem + 131088);
    for (;;) {
        __syncthreads();
        if (tid == 0) *bc = atomicAdd(ctr, 1u);
        __syncthreads();
        const int item = (int)*bc;
        if (item >= 1280) break;
        int sq, h, qb;
        if (item < 256) { sq = 0; h = item >> 6; qb = item & 63; } else { const int i2 = item - 256; sq = 1 + (i2 >> 7); h = (i2 >> 5) & 3; qb = i2 & 31; }
        const int lt0 = seqbase_of(sq), S = seqlen_of(sq);
        const bf16_t* Qb = Qall + (size_t)lt0 * 512; const bf16_t* Kb = Kall + (size_t)lt0 * 512; const bf16_t* Vb = Vall + (size_t)lt0 * 512 + (size_t)h * 128 * S;
        const int q0 = qb * 128 + rg * 32;
        bf16x8 bq[2][2];
#pragma unroll
        for (int qs = 0; qs < 2; ++qs)
#pragma unroll
            for (int ks = 0; ks < 2; ++ks) bq[qs][ks] = *(const bf16x8*)(Qb + ((size_t)(h * 2 + comp) * S + q0 + qs * 16 + fr) * 64 + ks * 32 + fq * 8);
        float m_run[2] = {-1e30f, -1e30f}, l_run[2] = {0.f, 0.f};
        f32x4 O[8][2];
#pragma unroll
        for (int a = 0; a < 8; ++a) { O[a][0] = (f32x4){0.f, 0.f, 0.f, 0.f}; O[a][1] = (f32x4){0.f, 0.f, 0.f, 0.f}; }
        u32x4 rk[2], rv[2];
        const int lrow = tid >> 3, lkc = (tid & 7) * 8;
        auto gload = [&](int kt0) {
#pragma unroll
            for (int i = 0; i < 2; ++i) {
                const int row = lrow + 64 * i, cm = row >> 6, key = row & 63;
                rk[i] = *(const u32x4*)(Kb + ((size_t)(h * 2 + cm) * S + kt0 + key) * 64 + lkc);
                rv[i] = *(const u32x4*)(Vb + (size_t)row * S + kt0 + lkc);
            }
        };
        auto lstore = [&](int b) {
            unsigned char* sb = smem + b * 36864;
#pragma unroll
            for (int i = 0; i < 2; ++i) {
                const int row = lrow + 64 * i;
                *(u32x4*)(sb + row * 144 + lkc * 2) = rk[i];
                *(u32x4*)(sb + 18432 + row * 144 + lkc * 2) = rv[i];
            }
        };
        bf16x8 pb[2][2];
        auto H1 = [&](int b) {
            const unsigned char* sb = smem + b * 36864;
            f32x4 st[4][2];
#pragma unroll
            for (int t = 0; t < 4; ++t) {
                st[t][0] = (f32x4){0.f, 0.f, 0.f, 0.f}; st[t][1] = (f32x4){0.f, 0.f, 0.f, 0.f};
#pragma unroll
                for (int ks = 0; ks < 2; ++ks) {
                    const bf16x8 kf = *(const bf16x8*)(sb + (comp * 64 + t * 16 + fr) * 144 + (ks * 32 + fq * 8) * 2);
                    st[t][0] = __builtin_amdgcn_mfma_f32_16x16x32_bf16(kf, bq[0][ks], st[t][0], 0, 0, 0);
                    st[t][1] = __builtin_amdgcn_mfma_f32_16x16x32_bf16(kf, bq[1][ks], st[t][1], 0, 0, 0);
                }
            }
#pragma unroll
            for (int qs = 0; qs < 2; ++qs) {
                float mx = -1e30f;
#pragma unroll
                for (int t = 0; t < 4; ++t)
#pragma unroll
                    for (int r = 0; r < 4; ++r) mx = fmaxf(mx, st[t][qs][r]);
                mx = fmaxf(mx, __shfl_xor(mx, 16)); mx = fmaxf(mx, __shfl_xor(mx, 32));
                const float mnew = fmaxf(m_run[qs], mx);
                const float alpha = __builtin_amdgcn_exp2f(m_run[qs] - mnew);
                m_run[qs] = mnew;
                float ls = 0.f;
                float pv[4][4];
#pragma unroll
                for (int t = 0; t < 4; ++t)
#pragma unroll
                    for (int r = 0; r < 4; ++r) { pv[t][r] = __builtin_amdgcn_exp2f(st[t][qs][r] - mnew); ls += pv[t][r]; }
                l_run[qs] = l_run[qs] * alpha + ls;
                if (__builtin_amdgcn_ballot_w64(alpha != 1.0f) != 0ull) {
#pragma unroll
                    for (int a = 0; a < 8; ++a) O[a][qs] = O[a][qs] * alpha;
                }
#pragma unroll
                for (int u = 0; u < 2; ++u) {
                    union { bf16x8 v; unsigned w[4]; } pk;
                    pk.w[0] = pack2bf(pv[2 * u][0], pv[2 * u][1]); pk.w[1] = pack2bf(pv[2 * u][2], pv[2 * u][3]);
                    pk.w[2] = pack2bf(pv[2 * u + 1][0], pv[2 * u + 1][1]); pk.w[3] = pack2bf(pv[2 * u + 1][2], pv[2 * u + 1][3]);
                    pb[qs][u] = pk.v;
                }
            }
        };
        auto H2 = [&](int b) {
            const unsigned char* sb = smem + b * 36864 + 18432;
#pragma unroll
            for (int u = 0; u < 2; ++u)
#pragma unroll
                for (int a = 0; a < 8; ++a) {
                    union { bf16x8 v; u32x2 h[2]; } vf;
                    vf.h[0] = *(const u32x2*)(sb + (a * 16 + fr) * 144 + (u * 32 + fq * 4) * 2);
                    vf.h[1] = *(const u32x2*)(sb + (a * 16 + fr) * 144 + (u * 32 + 16 + fq * 4) * 2);
                    O[a][0] = __builtin_amdgcn_mfma_f32_16x16x32_bf16(vf.v, pb[0][u], O[a][0], 0, 0, 0);
                    O[a][1] = __builtin_amdgcn_mfma_f32_16x16x32_bf16(vf.v, pb[1][u], O[a][1], 0, 0, 0);
                }
        };
        const int grp = wave >> 2, T = S >> 6;
        gload(0);
        lstore(0);
        __syncthreads();
        for (int t = 0; t < T; ++t) {
            if (t + 1 < T) gload((t + 1) * 64);
            if (grp == 0) H1(t & 1); else if (t > 0) H2((t - 1) & 1);
            __syncthreads();
            if (t + 1 < T) lstore((t + 1) & 1);
            if (grp == 0) H2(t & 1); else H1(t & 1);
            __syncthreads();
        }
        if (grp == 1) H2((T - 1) & 1);
#pragma unroll
        for (int qs = 0; qs < 2; ++qs) {
            float l = l_run[qs]; l += __shfl_xor(l, 16); l += __shfl_xor(l, 32);
            const float inv = 1.0f / l;
#pragma unroll
            for (int a = 0; a < 8; ++a) O[a][qs] = O[a][qs] * inv;
        }
        __syncthreads();
        float* Ox = (float*)smem;
        if (comp == 1) {
#pragma unroll
            for (int qs = 0; qs < 2; ++qs)
#pragma unroll
                for (int a = 0; a < 8; ++a)
#pragma unroll
                    for (int r = 0; r < 4; ++r) Ox[(rg * 128 + a * 16 + fq * 4 + r) * 32 + qs * 16 + fr] = O[a][qs][r];
        }
        __syncthreads();
        if (comp == 0) {
#pragma unroll
            for (int qs = 0; qs < 2; ++qs) {
                float ss = 0.f;
#pragma unroll
                for (int a = 0; a < 8; ++a)
#pragma unroll
                    for (int r = 0; r < 4; ++r) {
                        const float o = O[a][qs][r] - lam_full * Ox[(rg * 128 + a * 16 + fq * 4 + r) * 32 + qs * 16 + fr];
                        O[a][qs][r] = o; ss += o * o;
                    }
                ss += __shfl_xor(ss, 16); ss += __shfl_xor(ss, 32);
                const float sc = rsqrtf(ss * (1.0f / 128.0f) + 1e-5f) * (1.0f - lam_init);
                const int lt = lt0 + q0 + qs * 16 + fr;
#pragma unroll
                for (int a = 0; a < 8; ++a) {
                    const int dv = a * 16 + fq * 4;
                    const float4 g = *(const float4*)(normg + dv);
                    uint2 w; w.x = pack2bf(O[a][qs][0] * sc * g.x, O[a][qs][1] * sc * g.y); w.y = pack2bf(O[a][qs][2] * sc * g.z, O[a][qs][3] * sc * g.w);
                    *(uint2*)(ydiff + (size_t)lt * 512 + h * 128 + dv) = w;
                }
            }
        }
    }
    __syncthreads();
}

__device__ __forceinline__ void fft_items(const Ctx& C, const PV& P, unsigned char* smem) {
    unsigned char* R = P.ws + WS_R;
    typedef f16 f16x2 __attribute__((ext_vector_type(2)));
    const f16x2* Zall = (const f16x2*)(R + R_ZC);
    bf16_t* yf = (bf16_t*)(R + R_YB) + 2 * SZ512;
    const float2* tw = (const float2*)(P.ws + WS_TW);
    float2* sm = (float2*)smem;
    const int tid = C.tid;
    for (int item = C.bid; item < NSEQ * 256; item += C.nblk) {
        const int sq = item >> 8, col = item & 255, g = col >> 6, cc = col & 63;
        const int lt0 = seqbase_of(sq), S = seqlen_of(sq), lg = sq == 0 ? 13 : 12;
        const f16x2* z = Zall + (size_t)lt0 * 256 + (size_t)col * S;
        __syncthreads();
        for (int s = tid; s < S; s += NT) { const f16x2 v = z[s]; sm[__brev((unsigned)s) >> (32 - lg)] = make_float2((float)v[0], (float)v[1]); }
        __syncthreads();
        for (int st = 0; st < lg; ++st) {
            const int half = 1 << st, tshift = 12 - st;
            for (int b = tid; b < (S >> 1); b += NT) {
                const int j = b & (half - 1), i0 = ((b >> st) << (st + 1)) + j, i1 = i0 + half;
                const float2 w = tw[j << tshift], u = sm[i0], x = sm[i1];
                const float2 tv = make_float2(w.x * x.x - w.y * x.y, w.x * x.y + w.y * x.x);
                sm[i0] = make_float2(u.x + tv.x, u.y + tv.y); sm[i1] = make_float2(u.x - tv.x, u.y - tv.y);
            }
            __syncthreads();
        }
        const float nrm = rsqrtf((float)S * 128.0f);
        for (int k = tid; k < S; k += NT) {
            const float2 a = sm[k], b = sm[(S - k) & (S - 1)];
            bf16_t* row = yf + (size_t)(lt0 + k) * 512 + g * 128;
            if (cc == 0) { row[0] = f2bf(0.5f * (a.x + b.x) * nrm); row[64] = f2bf(0.5f * (a.y + b.y) * nrm); }
            else { row[cc] = f2bf(a.x * nrm); row[128 - cc] = f2bf(b.x * nrm); }
        }
    }
    __syncthreads();
}

template <int KT>
__device__ __forceinline__ void scan_block(const Ctx& C, const PV& P, int layer, int sq, int h, int d, int row0, unsigned char* smem) {
    constexpr int TPR = 64 / KT, ROWS = NT / TPR, CH = 16, YP = TPR / 4, NV = ROWS / 32;
    unsigned char* R = P.ws + WS_R;
    const f16* raw = (const f16*)(R + R_RAW); const f16* wa = (const f16*)(R + R_WA); f16* yfb = (f16*)(R + R_YFB);
    const float* invn = (const float*)(P.ws + WS_INVN);
    const float* mu = P.inp(13) + (size_t)layer * 1920; const float* k_k = P.inp(19) + (size_t)layer * 512; const float* k_a = P.inp(20) + (size_t)layer * 512;
    const int tid = C.tid, row = tid / TPR, q = tid % TPR;
    const int lt0 = seqbase_of(sq), S = seqlen_of(sq);
    const int ch = tid & 63, c = h * 64 + ch;
    const float mu_r = mu[c], mu_k = mu[512 + c], kkw = k_k[c], kaw = k_a[c];
    const int vr = (ROWS == 32) ? (tid & 31) : (tid & 63);
    const int vcol = 1024 + h * 64 + row0 + vr; const float mu_v = mu[vcol];
    const f16* wdec = wa + (size_t)d * SZ512; const f16* aact = wa + (size_t)(2 + d) * SZ512;
    f16* ydst = yfb + (size_t)d * SZ512;
    f32x2 s[KT / 2];
#pragma unroll
    for (int j = 0; j < KT / 2; ++j) s[j] = (f32x2){0.f, 0.f};
    f16 pr_[2][3], pk_[2][3], pa_[2], pw_[2], pv_[NV][3]; float pn_[2];
    auto prefetch = [&](int c0) {
#pragma unroll
        for (int j = 0; j < 2; ++j) {
            const int i = (tid >> 6) + 8 * j, tstep = c0 + i, t = d == 0 ? tstep : S - 1 - tstep, lt = lt0 + t;
            const int tm = t > 0 ? lt - 1 : lt, tp = t < S - 1 ? lt + 1 : lt;
            pr_[j][0] = raw[(size_t)tm * 1920 + c]; pr_[j][1] = raw[(size_t)lt * 1920 + c]; pr_[j][2] = raw[(size_t)tp * 1920 + c];
            pk_[j][0] = raw[(size_t)tm * 1920 + 512 + c]; pk_[j][1] = raw[(size_t)lt * 1920 + 512 + c]; pk_[j][2] = raw[(size_t)tp * 1920 + 512 + c];
            pa_[j] = aact[(size_t)lt * 512 + c]; pw_[j] = wdec[(size_t)lt * 512 + c]; pn_[j] = invn[(size_t)lt * 8 + h];
        }
#pragma unroll
        for (int j = 0; j < NV; ++j) {
            const int i = (ROWS == 32) ? (tid >> 5) : ((tid >> 6) + 8 * j), tstep = c0 + i, t = d == 0 ? tstep : S - 1 - tstep, lt = lt0 + t;
            const int tm = t > 0 ? lt - 1 : lt, tp = t < S - 1 ? lt + 1 : lt;
            pv_[j][0] = raw[(size_t)tm * 1920 + vcol]; pv_[j][1] = raw[(size_t)lt * 1920 + vcol]; pv_[j][2] = raw[(size_t)tp * 1920 + vcol];
        }
    };
    auto stage = [&](int c0, unsigned char* buf) {
        float* vec = (float*)buf; float* vbuf = (float*)(buf + 20480);
#pragma unroll
        for (int j = 0; j < 2; ++j) {
            const int i = (tid >> 6) + 8 * j, tstep = c0 + i, t = d == 0 ? tstep : S - 1 - tstep;
            const float rm = t > 0 ? (float)pr_[j][0] : 0.f, rp = t < S - 1 ? (float)pr_[j][2] : 0.f, km = t > 0 ? (float)pk_[j][0] : 0.f, kp = t < S - 1 ? (float)pk_[j][2] : 0.f;
            const float r1 = (float)pr_[j][1], k1 = (float)pk_[j][1];
            const float r = r1 + (0.5f * (rm + rp) - r1) * mu_r;
            const float k = k1 + (0.5f * (km + kp) - k1) * mu_k;
            const float kk = k * kkw * pn_[j], a = (float)pa_[j];
            vec[(0 * CH + i) * 64 + ch] = kk;
            vec[(1 * CH + i) * 64 + ch] = (float)pw_[j];
            vec[(2 * CH + i) * 64 + ch] = kk * a;
            vec[(3 * CH + i) * 64 + ch] = k * (1.0f + (a - 1.0f) * kaw);
            vec[(4 * CH + i) * 64 + ch] = r;
        }
#pragma unroll
        for (int j = 0; j < NV; ++j) {
            const int i = (ROWS == 32) ? (tid >> 5) : ((tid >> 6) + 8 * j), tstep = c0 + i, t = d == 0 ? tstep : S - 1 - tstep;
            const float vm = t > 0 ? (float)pv_[j][0] : 0.f, vp = t < S - 1 ? (float)pv_[j][2] : 0.f, v1 = (float)pv_[j][1];
            vbuf[i * 64 + vr] = v1 + (0.5f * (vm + vp) - v1) * mu_v;
        }
    };
    __syncthreads();
    prefetch(0);
    stage(0, smem);
    __syncthreads();
    const int nch = S / CH;
    for (int cix = 0; cix < nch; ++cix) {
        unsigned char* buf = smem + (cix & 1) * 32768;
        if (cix + 1 < nch) prefetch((cix + 1) * CH);
        {
            const float* vec = (const float*)buf; const float* vbuf = (const float*)(buf + 20480); float* ybuf = (float*)(buf + 24576);
            const f32x4* vp0 = (const f32x4*)(vec + q * KT);
            f32x4 nx[5][KT / 4]; float nvv;
#pragma unroll
            for (int u = 0; u < KT / 4; ++u)
#pragma unroll
                for (int a5 = 0; a5 < 5; ++a5) nx[a5][u] = vp0[a5 * CH * 16 + u];
            nvv = vbuf[row];
            float yv[CH];
#pragma unroll
            for (int i = 0; i < CH; ++i) {
                f32x2 kk2[KT / 2], w2[KT / 2], b2[KT / 2], kd2[KT / 2], r2[KT / 2];
#pragma unroll
                for (int u = 0; u < KT / 4; ++u) {
                    kk2[2 * u] = (f32x2){nx[0][u][0], nx[0][u][1]}; kk2[2 * u + 1] = (f32x2){nx[0][u][2], nx[0][u][3]};
                    w2[2 * u] = (f32x2){nx[1][u][0], nx[1][u][1]}; w2[2 * u + 1] = (f32x2){nx[1][u][2], nx[1][u][3]};
                    b2[2 * u] = (f32x2){nx[2][u][0], nx[2][u][1]}; b2[2 * u + 1] = (f32x2){nx[2][u][2], nx[2][u][3]};
                    kd2[2 * u] = (f32x2){nx[3][u][0], nx[3][u][1]}; kd2[2 * u + 1] = (f32x2){nx[3][u][2], nx[3][u][3]};
                    r2[2 * u] = (f32x2){nx[4][u][0], nx[4][u][1]}; r2[2 * u + 1] = (f32x2){nx[4][u][2], nx[4][u][3]};
                }
                const float vv = nvv;
                if (i + 1 < CH) {
#pragma unroll
                    for (int u = 0; u < KT / 4; ++u)
#pragma unroll
                        for (int a5 = 0; a5 < 5; ++a5) nx[a5][u] = vp0[(i + 1) * 16 + a5 * CH * 16 + u];
                    nvv = vbuf[(i + 1) * 64 + row];
                }
                f32x2 acc2 = s[0] * kk2[0];
#pragma unroll
                for (int j = 1; j < KT / 2; ++j) acc2 = __builtin_elementwise_fma(s[j], kk2[j], acc2);
                float sa = acc2[0] + acc2[1];
                sa += dppf<0xB1>(sa); sa += dppf<0x4E>(sa); sa += dppf<0x141>(sa);
                if (TPR == 16) sa += dppf<0x140>(sa);
                sa = -sa;
                const f32x2 sa2 = (f32x2){sa, sa}, vv2 = (f32x2){vv, vv};
                f32x2 y2 = (f32x2){0.f, 0.f};
#pragma unroll
                for (int j = 0; j < KT / 2; ++j) {
                    s[j] = __builtin_elementwise_fma(s[j], w2[j], __builtin_elementwise_fma(sa2, b2[j], vv2 * kd2[j]));
                    y2 = __builtin_elementwise_fma(s[j], r2[j], y2);
                }
                float y = y2[0] + y2[1];
                y += dppf<0xB1>(y); y += dppf<0x4E>(y);
                yv[i] = y;
            }
            if ((q & 3) == 0) {
#pragma unroll
                for (int i = 0; i < CH; ++i) ybuf[i * 128 + row * YP + (q >> 2)] = yv[i];
            }
        }
        if (cix + 1 < nch) stage((cix + 1) * CH, smem + ((cix + 1) & 1) * 32768);
        __syncthreads();
        {
            const float* ybuf = (const float*)(buf + 24576);
#pragma unroll
            for (int j = 0; j < NV; ++j) {
                const int i = (ROWS == 32) ? (tid >> 5) : ((tid >> 6) + 8 * j), rr = vr, tstep = cix * CH + i, t = d == 0 ? tstep : S - 1 - tstep;
                float y = 0.f;
#pragma unroll
                for (int p = 0; p < YP; ++p) y += ybuf[i * 128 + rr * YP + p];
                ydst[(size_t)(lt0 + t) * 512 + h * 64 + row0 + rr] = (f16)y;
            }
        }
    }
    __syncthreads();
}

__device__ __forceinline__ void finish_phase(const Ctx& C, const PV& P, int layer) {
    unsigned char* R = P.ws + WS_R;
    const f16* raw = (const f16*)(R + R_RAW); const f16* wa = (const f16*)(R + R_WA); const f16* gbuf = (const f16*)(R + R_G); const f16* yfb = (const f16*)(R + R_YFB);
    bf16_t* yr = (bf16_t*)(R + R_YB);
    const float* mu = P.inp(13) + (size_t)layer * 1920; const float* k_a = P.inp(20) + (size_t)layer * 512; const float* r_k = P.inp(21) + (size_t)layer * 512;
    const float* lg = P.inp(22) + (size_t)layer * 512; const float* lb = P.inp(23) + (size_t)layer * 512;
    const int lane = C.tid & 63, wave = C.tid >> 6, c = lane * 8;
    const int nw = C.nblk * NWV;
    for (int ltb = C.bid * NWV + wave; ltb < TP; ltb += 2 * nw) {
        f16x8_t rA[2], rB[2], rC[2], kA[2], kB[2], kC[2], vA[2], vB[2], vC[2], af[2], ab[2], gg[2], yF[2], yB[2]; float wm_[2], wp_[2]; bool ok[2];
#pragma unroll
        for (int u = 0; u < 2; ++u) {
            const int lt1 = ltb + u * nw; ok[u] = lt1 < TP; const int lt = ok[u] ? lt1 : ltb;
            const int pos = pos_of(lt), S = lt < 8192 ? 8192 : 4096;
            const size_t rm = (size_t)(pos > 0 ? lt - 1 : lt) * 1920, r0 = (size_t)lt * 1920, rp = (size_t)(pos < S - 1 ? lt + 1 : lt) * 1920;
            wm_[u] = pos > 0 ? 0.5f : 0.f; wp_[u] = pos < S - 1 ? 0.5f : 0.f;
            rA[u] = *(const f16x8_t*)(raw + rm + c); rB[u] = *(const f16x8_t*)(raw + r0 + c); rC[u] = *(const f16x8_t*)(raw + rp + c);
            kA[u] = *(const f16x8_t*)(raw + rm + 512 + c); kB[u] = *(const f16x8_t*)(raw + r0 + 512 + c); kC[u] = *(const f16x8_t*)(raw + rp + 512 + c);
            vA[u] = *(const f16x8_t*)(raw + rm + 1024 + c); vB[u] = *(const f16x8_t*)(raw + r0 + 1024 + c); vC[u] = *(const f16x8_t*)(raw + rp + 1024 + c);
            af[u] = *(const f16x8_t*)(wa + 2 * SZ512 + (size_t)lt * 512 + c); ab[u] = *(const f16x8_t*)(wa + 3 * SZ512 + (size_t)lt * 512 + c);
            gg[u] = *(const f16x8_t*)(gbuf + (size_t)lt * 512 + c);
            yF[u] = *(const f16x8_t*)(yfb + (size_t)lt * 512 + c); yB[u] = *(const f16x8_t*)(yfb + SZ512 + (size_t)lt * 512 + c);
        }
#pragma unroll
        for (int u = 0; u < 2; ++u) {
            float y[8], vv[8], bsum = 0.f, ysum = 0.f;
#pragma unroll
            for (int j = 0; j < 8; ++j) {
                const float r_ = (float)rB[u][j], k_ = (float)kB[u][j], v_ = (float)vB[u][j];
                const float r = r_ + (wm_[u] * (float)rA[u][j] + wp_[u] * (float)rC[u][j] - r_) * mu[c + j];
                const float k = k_ + (wm_[u] * (float)kA[u][j] + wp_[u] * (float)kC[u][j] - k_) * mu[512 + c + j];
                vv[j] = v_ + (wm_[u] * (float)vA[u][j] + wp_[u] * (float)vC[u][j] - v_) * mu[1024 + c + j];
                const float ka = k_a[c + j];
                const float ksum = k * (1.f + ((float)af[u][j] - 1.f) * ka) + k * (1.f + ((float)ab[u][j] - 1.f) * ka);
                bsum += r * (0.5f * ksum) * r_k[c + j];
                y[j] = (float)yF[u][j] + (float)yB[u][j]; ysum += y[j];
            }
            const float ym = red8(ysum) * (1.0f / 64.0f);
            float q = 0.f;
#pragma unroll
            for (int j = 0; j < 8; ++j) { const float dy = y[j] - ym; q += dy * dy; }
            const float rs = rsqrtf(red8(q) * (1.0f / 64.0f) + 64e-5f);
            const float bonus = red8(bsum);
            float o[8];
#pragma unroll
            for (int j = 0; j < 8; ++j) o[j] = ((y[j] - ym) * rs * lg[c + j] + lb[c + j] + bonus * vv[j]) * (float)gg[u][j];
            u32x4 w; w.x = pack2bf(o[0], o[1]); w.y = pack2bf(o[2], o[3]); w.z = pack2bf(o[4], o[5]); w.w = pack2bf(o[6], o[7]);
            if (ok[u]) *(u32x4*)(yr + (size_t)(ltb + u * nw) * 512 + c) = w;
        }
    }
}

__device__ __forceinline__ void gates_phase(const Ctx& C, const PV& P, int layer) {
    const bf16_t* hmod = (const bf16_t*)(P.ws + WS_HMOD);
    const bf16_t* Wt = wl(P, layer) + OW_WIN + (size_t)4480 * 1024;
    bf16_t* gates = (bf16_t*)(P.ws + WS_R + R_GATES);
    int pm, pn;
    for (int it = 0; tile_order(it, C.nblk, C.bid, TP / 256, 16, pm, pn); ++it) {
        f32x4 acc[2][2][4][2];
        gemm256(C, acc, hmod, Wt, 1024, pm * 256, pn * 256);
        int z2 = 0; asm volatile("" : "+s"(z2));
        const int tid2 = tid_now(C.wave_s, z2), lane = tid2 & 63, wid = tid2 >> 6, wr = wid >> 2, wc = wid & 3, fr = lane & 15, fq = lane >> 4;
#pragma unroll
        for (int ai = 0; ai < 2; ++ai)
#pragma unroll
            for (int m = 0; m < 4; ++m) {
                const int lt = pm * 256 + ai * 128 + wr * 64 + m * 16 + fr;
#pragma unroll
                for (int bj = 0; bj < 2; ++bj)
#pragma unroll
                    for (int n = 0; n < 2; ++n) {
                        const int col = pn * 256 + bj * 128 + wc * 32 + n * 16 + fq * 4;
                        const f32x4 v = acc[ai][bj][m][n];
                        u32x2 w; w.x = pack2bf(sigmoidf_(v[0]), sigmoidf_(v[1])); w.y = pack2bf(sigmoidf_(v[2]), sigmoidf_(v[3]));
                        *(u32x2*)(gates + (size_t)lt * 4096 + col) = w;
                    }
            }
    }
}
__device__ __forceinline__ void branch_phase(const Ctx& C, const PV& P, int layer) {
    unsigned char* R = P.ws + WS_R;
    const bf16_t* yb = (const bf16_t*)(R + R_YB); const bf16_t* gates = (const bf16_t*)(R + R_GATES);
    float* m32 = (float*)(R + R_M32); bf16_t* merged = (bf16_t*)(R + R_MERGED);
    const bf16_t* W = wl(P, layer) + OW_WBR;
    int pm, pn;
    for (int it = 0; tile_order(it, C.nblk, C.bid, TP / 256, 4, pm, pn); ++it) {
        for (int nb = 0; nb < 4; ++nb) {
            f32x4 acc[2][2][4][2];
            gemm256(C, acc, yb + (size_t)nb * SZ512, W + (size_t)nb * 1024 * 512, 512, pm * 256, pn * 256);
            int z2 = 0; asm volatile("" : "+s"(z2));
            const int tid2 = tid_now(C.wave_s, z2), lane = tid2 & 63, wid = tid2 >> 6, wr = wid >> 2, wc = wid & 3, fr = lane & 15, fq = lane >> 4;
#pragma unroll
            for (int ai = 0; ai < 2; ++ai)
#pragma unroll
                for (int m = 0; m < 4; ++m) {
                    const int lt = pm * 256 + ai * 128 + wr * 64 + m * 16 + fr;
#pragma unroll
                    for (int bj = 0; bj < 2; ++bj)
#pragma unroll
                        for (int n = 0; n < 2; ++n) {
                            const int col = pn * 256 + bj * 128 + wc * 32 + n * 16 + fq * 4;
                            const u32x2 gw = *(const u32x2*)(gates + (size_t)lt * 4096 + nb * 1024 + col);
                            f32x4 g; g[0] = __uint_as_float(gw.x << 16); g[1] = __uint_as_float(gw.x & 0xffff0000u); g[2] = __uint_as_float(gw.y << 16); g[3] = __uint_as_float(gw.y & 0xffff0000u);
                            f32x4 mv = g * acc[ai][bj][m][n];
                            f32x4* mp = (f32x4*)(m32 + (size_t)lt * 1024 + col);
                            if (nb > 0) mv += *mp;
                            if (nb < 3) *mp = mv;
                            else { u32x2 w; w.x = pack2bf(mv[0], mv[1]); w.y = pack2bf(mv[2], mv[3]); *(u32x2*)(merged + (size_t)lt * 1024 + col) = w; }
                        }
                    asm volatile("" ::: "memory");
                }
        }
    }
}


#define XB_TMO      128
#define XB_XCNT(j)  (256  + 64 * (j))
#define XB_XSUB(j)  (1280 + 64 * (j))
#define XB_XGEN(j)  (2304 + 64 * (j))
#define XB_TOP      3328
#define XB_TOPGEN   3392
#define XCD_BAR_WORDS 3456
#define XB_SPIN_CAP (1u << 21)
#define LAS __attribute__((address_space(3)))
__device__ __forceinline__ unsigned xb_ld(unsigned* p)              { return __hip_atomic_load(p, __ATOMIC_RELAXED, __HIP_MEMORY_SCOPE_AGENT); }
__device__ __forceinline__ unsigned xb_add(unsigned* p, unsigned v) { return __hip_atomic_fetch_add(p, v, __ATOMIC_RELAXED, __HIP_MEMORY_SCOPE_AGENT); }
__device__ __forceinline__ unsigned xb_xcc_id() { return (unsigned)__builtin_amdgcn_s_getreg((3 << 11) | 20) & 0xFu; }
#define XB_SPIN(cond, bar) do { unsigned _sp = 0; while (cond) { __builtin_amdgcn_s_sleep(1); \
    if ((++_sp & 255u) == 0u) { if (xb_ld(&(bar)[XB_TMO])) break; if (_sp > XB_SPIN_CAP) { atomicAdd(&(bar)[XB_TMO], 1u); break; } } } } while (0)
struct XcdBarrier { unsigned* bar; unsigned x; volatile LAS unsigned* st; };
__device__ __forceinline__ XcdBarrier xcd_barrier_post(unsigned* bar, volatile LAS unsigned* st) {
    XcdBarrier b; b.bar = bar; b.x = xb_xcc_id(); b.st = st;
    if (threadIdx.x == 0) (void)xb_add(&bar[XB_XCNT(b.x)], 1u);
    return b;
}
__device__ __forceinline__ void xcd_barrier_complete(unsigned* bar, unsigned x, unsigned& nloc, unsigned& nx) {
    const unsigned G = gridDim.x * gridDim.y * gridDim.z;
    unsigned sum, cnt, mine, sp = 0u;
    for (;;) {
        sum = 0u; cnt = 0u; mine = 0u;
#pragma unroll
        for (unsigned j = 0; j < 16; ++j) { const unsigned c = xb_ld(&bar[XB_XCNT(j)]); sum += c; cnt += (c > 0u) ? 1u : 0u; mine = (j == x) ? c : mine; }
        if (sum == G) break;
        __builtin_amdgcn_s_sleep(1);
        if ((++sp & 255u) == 0u) { if (xb_ld(&bar[XB_TMO])) break; if (sp > XB_SPIN_CAP) { atomicAdd(&bar[XB_TMO], 1u); break; } }
    }
    nloc = mine > 0u ? mine : 1u; nx = cnt > 0u ? cnt : 1u;
}
__device__ __forceinline__ void xcd_barrier(const XcdBarrier& b) {
    asm volatile("s_waitcnt vmcnt(0)" ::: "memory");
    __syncthreads();
    if (threadIdx.x == 0) {
        unsigned* bar = b.bar;
        __builtin_amdgcn_s_waitcnt(0);
        unsigned nloc = b.st[0], nx = b.st[1];
        if (nloc == 0u) { xcd_barrier_complete(bar, b.x, nloc, nx); b.st[0] = nloc; b.st[1] = nx; }
        const unsigned old = xb_add(&bar[XB_XSUB(b.x)], 1u);
        const unsigned gen = old / nloc;
        if (old + 1u == (gen + 1u) * nloc) {
            __builtin_amdgcn_fence(__ATOMIC_RELEASE, "agent");
            asm volatile("s_waitcnt vmcnt(0)" ::: "memory");
            const unsigned og = xb_add(&bar[XB_TOP], 1u);
            const unsigned tg = og / nx;
            if (og + 1u == (tg + 1u) * nx) xb_add(&bar[XB_TOPGEN], 1u);
            else XB_SPIN(xb_ld(&bar[XB_TOPGEN]) == tg, bar);
            __builtin_amdgcn_fence(__ATOMIC_ACQUIRE, "agent");
            xb_add(&bar[XB_XGEN(b.x)], 1u);
            asm volatile("s_waitcnt vmcnt(0)" ::: "memory");
        } else {
            XB_SPIN(xb_ld(&bar[XB_XGEN(b.x)]) == gen, bar);
            __builtin_amdgcn_fence(__ATOMIC_ACQUIRE, "agent");
            asm volatile("s_waitcnt vmcnt(0)" ::: "memory");
        }
    }
    __syncthreads();
}

constexpr int PH_PER_LAYER = 15, PH_PER_PASS = 2 * PH_PER_LAYER + 1, NPHASE = 1 + NPASS * PH_PER_PASS;

__global__ void __launch_bounds__(512, 2) mk_forward(Params P0, int ph_lo, int ph_hi) {
    unsigned char* smem = dyn_smem;
    const int wave_s = __builtin_amdgcn_readfirstlane((int)threadIdx.x >> 6);
    volatile LAS unsigned* xst = (volatile LAS unsigned*)(LAS unsigned char*)(dyn_smem + 131072);
    if (threadIdx.x == 0) { xst[0] = 0u; xst[1] = 0u; }
    __syncthreads();
    const XcdBarrier xb = xcd_barrier_post((unsigned*)(P0.ws + WS_BAR), xst);
    for (int it_ = 2 * ph_lo; it_ < 2 * ph_hi; ++it_) {
        const int ph = it_ >> 1;
        if (it_ & 1) {
            if (PROBE_MASK == 0 || ph == 0) continue;
            const int r_ = (ph - 1) % PH_PER_PASS;
            if (r_ == PH_PER_PASS - 1 || !((PROBE_MASK >> (r_ % PH_PER_LAYER)) & 1)) continue;
        }
        if (it_ > 2 * ph_lo) { if (it_ == 2 * ph_lo + 2) cg::this_grid().sync(); else xcd_barrier(xb); }
        int z = 0; asm volatile("" : "+s"(z));
        Ctx C; C.tid = tid_now(wave_s, z); C.bid = (int)blockIdx.x + z; C.nblk = (int)gridDim.x + z; C.wave_s = wave_s;
        ptrtab_t tab = (ptrtab_t)__builtin_amdgcn_kernarg_segment_ptr();
        asm volatile("" : "+s"(tab));
        const PV P{tab, (float*)tab[29], (unsigned char*)tab[30]};
        if (ph == 0) { prep_phase(C, P, smem); continue; }
        const int q = ph - 1, pass = q / PH_PER_PASS, r = q % PH_PER_PASS;
        if (r == PH_PER_PASS - 1) { norm_phase(C, P, pass, P.inp(6) + (size_t)(1 * 3 + 2) * 1024, P.inp(7) + (size_t)(1 * 3 + 2) * 1024, 0, -1, false, true); continue; }
        const int layer = r / PH_PER_LAYER, lp = r % PH_PER_LAYER;
        const bf16_t* W = wl(P, layer);
        const float* lng = P.inp(6) + (size_t)layer * 3 * 1024; const float* lnb = P.inp(7) + (size_t)layer * 3 * 1024;
        const float* lngp = P.inp(6) + (size_t)((layer > 0 ? layer - 1 : 0) * 3 + 2) * 1024; const float* lnbp = P.inp(7) + (size_t)((layer > 0 ? layer - 1 : 0) * 3 + 2) * 1024;
        unsigned char* R = P.ws + WS_R;
        switch (lp) {
            case 0:
                if (layer == 0) norm_phase(C, P, pass, nullptr, nullptr, 0, 0, true, false);
                else norm_phase(C, P, pass, lngp, lnbp, layer, 0, false, false);
                break;
            case 1: ffn_up_phase(C, P, W + OW_FA_IN); break;
            case 2: resid_gemm_phase(C, P, pass, (const bf16_t*)(R + R_ACT), 2816, W + OW_FA_OUT, layer, 0, 0.5f, layer == 0 ? nullptr : lngp, lnbp); break;
            case 3: norm_phase(C, P, pass, lng, lnb, layer, 1, false, false); break;
            case 4: win_phase(C, P, layer); break;
            case 5: lin_pool_phase(C, P, layer); break;
            case 6: lora_phase(C, P, layer, smem); break;
            case 7:
                if (C.bid < 32) scan_block<4>(C, P, layer, 0, C.bid >> 2, (C.bid >> 1) & 1, (C.bid & 1) * 32, smem);
                else if (C.bid < 160) { const int i2 = C.bid - 32; scan_block<8>(C, P, layer, 1 + (i2 >> 4), (i2 >> 1) & 7, i2 & 1, 0, smem); }
                attn_items(C, P, layer, pass * 2 + layer, smem); fft_items(C, P, smem); break;
            case 8: finish_phase(C, P, layer); break;
            case 9: gates_phase(C, P, layer); break;
            case 10: branch_phase(C, P, layer); break;
            case 11: resid_gemm_phase(C, P, pass, (const bf16_t*)(R + R_MERGED), 1024, W + OW_WOUT, layer, 1, 1.0f, lng, lnb); break;
            case 12: norm_phase(C, P, pass, lng + 1024, lnb + 1024, layer, 2, false, false); break;
            case 13: ffn_up_phase(C, P, W + OW_FB_IN); break;
            default: resid_gemm_phase(C, P, pass, (const bf16_t*)(R + R_ACT), 2816, W + OW_FB_OUT, layer, 2, 0.5f, lng + 1024, lnb + 1024); break;
        }
    }
}

extern "C" void kernel_launch(void* const* d_in, const int* in_sizes, int n_in, void* d_out, int out_size, void* d_ws, size_t ws_size, hipStream_t stream) {
    static int grid_blocks = 0;
    if (!grid_blocks) {
        int dev = 0, cus = 0, per_cu = 0;
        (void)hipGetDevice(&dev);
        (void)hipDeviceGetAttribute(&cus, hipDeviceAttributeMultiprocessorCount, dev);
        (void)hipFuncSetAttribute((const void*)mk_forward, hipFuncAttributeMaxDynamicSharedMemorySize, LDS_BYTES);
        (void)hipOccupancyMaxActiveBlocksPerMultiprocessor(&per_cu, mk_forward, NT, LDS_BYTES);
        if (per_cu < 1) per_cu = 1;
        if (per_cu > 1) per_cu = 1;
        grid_blocks = cus * per_cu;
    }
    Params p{};
    for (int i = 0; i < 29; ++i) p.in[i] = (const float*)d_in[i];
    p.out = (float*)d_out; p.ws = (unsigned char*)d_ws;
    (void)hipMemsetAsync((unsigned char*)d_ws + WS_BAR, 0, XCD_BAR_WORDS * 4 + 256, stream);
#if ONE_LAUNCH
    int lo = 0, hi = NPHASE;
    void* args[] = {&p, &lo, &hi};
    hipError_t e = hipLaunchCooperativeKernel((void*)mk_forward, dim3(grid_blocks), dim3(NT), args, LDS_BYTES, stream);
    if (e != hipSuccess) fprintf(stderr, "cooperative launch failed: %s (grid %d)\n", hipGetErrorString(e), grid_blocks);
#else
    for (int ph = 0; ph < NPHASE; ++ph) {
        int lo = ph, hi = ph + 1;
        void* args[] = {&p, &lo, &hi};
        (void)hipLaunchCooperativeKernel((void*)mk_forward, dim3(grid_blocks), dim3(NT), args, LDS_BYTES, stream);
    }
#endif
}
```

```cpp
#include <hip/hip_runtime.h>
#include <hip/hip_cooperative_groups.h>
#include <cstdio>
#include <cstdint>
namespace cg = cooperative_groups;

typedef unsigned short bf16_t;
typedef _Float16 f16;
typedef short bf16x8 __attribute__((ext_vector_type(8)));
typedef float f32x4 __attribute__((ext_vector_type(4)));
typedef unsigned u32x4 __attribute__((ext_vector_type(4)));
typedef unsigned u32x2 __attribute__((ext_vector_type(2)));
typedef float f32x2 __attribute__((ext_vector_type(2)));

#ifndef ONE_LAUNCH
#define ONE_LAUNCH 1
#endif
#ifndef PROBE_MASK
#define PROBE_MASK 0
#endif

constexpr int TP = 40960;
constexpr int NPASS = 2;
constexpr int NSEQ = 9;
constexpr int MT = TP / 128;
constexpr int N_IN_FULL = 8576;
constexpr float ALPHA = 1.41421356237f;

constexpr size_t OW_FA_IN = 0, OW_FA_OUT = 5767168, OW_FB_IN = 8650752, OW_FB_OUT = 14417920, OW_WIN = 17301504,
                 OW_WBR = 26083328, OW_WOUT = 28180480, OW_W2T = 29229056, OW_A2T = 29294592, OW_G2T = 29360128, WL_TOTAL = 29425664;
constexpr size_t WS_W = 0, WS_TW = 117702656, WS_MOD = 117735424, WS_HMOD = 119062528, WS_R = 202948608, WS_INVN = 1062780928, WS_STATS = 1064091904, WS_BAR = 1064419584, WS_CTR = 1064433408  ;
constexpr size_t R_RAW = 0, R_LIN = 157286400, R_WA = 188743680, R_G = 356515840, R_Q = 398458880, R_K = 440401920, R_VT = 482344960,
                 R_YFB = 524288000, R_ZC = 608174080, R_POOLP = 650117120, R_YB = 692060160, R_ACT = 0,
                 R_GATES = 0  , R_M32 = 398458880  , R_MERGED = 566231040  ;
constexpr size_t SZ512 = (size_t)TP * 512;

struct Params { const float* in[29]; float* out; unsigned char* ws; };
struct Ctx { int tid, bid, nblk, wave_s; };
__device__ __forceinline__ int tid_now(int wave_s, int z) { return wave_s * 64 + (int)__builtin_amdgcn_mbcnt_hi(~0u, __builtin_amdgcn_mbcnt_lo(~0u, (unsigned)z)); }
typedef const float* const __attribute__((address_space(4)))* ptrtab_t;
struct PV { ptrtab_t tab; float* out; unsigned char* ws;
    __device__ __forceinline__ const float* inp(int i) const { return tab[i]; } };
constexpr int NT = 512, NWV = 8;
extern __shared__ __attribute__((aligned(16))) unsigned char dyn_smem[];
constexpr int LDS_BYTES = 131072 + 64;

__device__ __forceinline__ bf16_t f2bf(float f) { unsigned u = __float_as_uint(f); u += 0x7fffu + ((u >> 16) & 1u); return (bf16_t)(u >> 16); }
__device__ __forceinline__ float bf2f(bf16_t b) { return __uint_as_float(((unsigned)b) << 16); }
__device__ __forceinline__ unsigned pack2bf(float a, float b) { unsigned r; asm("v_cvt_pk_bf16_f32 %0, %1, %2" : "=v"(r) : "v"(a), "v"(b)); return r; }
__device__ __forceinline__ float wsum(float v) {
#pragma unroll
    for (int o = 32; o > 0; o >>= 1) v += __shfl_xor(v, o);
    return v;
}
__device__ __forceinline__ float sigmoidf_(float x) { return 1.0f / (1.0f + __expf(-x)); }
template <int CTRL> __device__ __forceinline__ float dppf(float v) { return __int_as_float(__builtin_amdgcn_update_dpp(0, __float_as_int(v), CTRL, 0xF, 0xF, true)); }
__device__ __forceinline__ float red8(float v) { v += dppf<0xB1>(v); v += dppf<0x4E>(v); v += dppf<0x141>(v); return v; }

__device__ __forceinline__ int grow_of(int pass, int lt) { return lt < 8192 ? pass * 8192 + lt : 16384 + pass * 32768 + (lt - 8192); }
__device__ __forceinline__ int brow_of(int pass, int lt) { return lt < 8192 ? pass : 2 + pass * 8 + ((lt - 8192) >> 12); }
__device__ __forceinline__ int pos_of(int lt) { return lt < 8192 ? lt : ((lt - 8192) & 4095); }
__device__ __forceinline__ int seqbase_of(int sq) { return sq == 0 ? 0 : 8192 + (sq - 1) * 4096; }
__device__ __forceinline__ int seqlen_of(int sq) { return sq == 0 ? 8192 : 4096; }

__device__ __forceinline__ bf16_t* wl(const PV& P, int layer) { return (bf16_t*)(P.ws + WS_W) + (size_t)layer * WL_TOTAL; }

template <int NJ, bool SWAP>
__device__ __forceinline__ void gemm_core(const Ctx& C, f32x4 (&acc)[4][NJ], const bf16_t* __restrict__ A, int lda, const bf16_t* __restrict__ B, int ldb, int K, unsigned char* smem) {
    const int tid = C.tid & 255, lane = tid & 63, wave = tid >> 6, wm = wave >> 1, wn = wave & 1, fr = lane & 15, fq = lane >> 4;
    smem += (C.tid >> 8) * 36864;
    u32x4 ra[4], rb[NJ];
#pragma unroll
    for (int i = 0; i < 4; ++i)
#pragma unroll
        for (int j = 0; j < NJ; ++j) acc[i][j] = (f32x4){0.f, 0.f, 0.f, 0.f};
    const int lrow = tid >> 3, lkc = (tid & 7) * 8;
#pragma unroll
    for (int i = 0; i < 4; ++i) ra[i] = *(const u32x4*)(A + (size_t)(lrow + 32 * i) * lda + lkc);
#pragma unroll
    for (int i = 0; i < NJ; ++i) rb[i] = *(const u32x4*)(B + (size_t)(lrow + 32 * i) * ldb + lkc);
    for (int k0 = 0; k0 < K; k0 += 64) {
        __syncthreads();
#pragma unroll
        for (int i = 0; i < 4; ++i) *(u32x4*)(smem + (lrow + 32 * i) * 144 + lkc * 2) = ra[i];
#pragma unroll
        for (int i = 0; i < NJ; ++i) *(u32x4*)(smem + 18432 + (lrow + 32 * i) * 144 + lkc * 2) = rb[i];
        __syncthreads();
        if (k0 + 64 < K) {
#pragma unroll
            for (int i = 0; i < 4; ++i) ra[i] = *(const u32x4*)(A + (size_t)(lrow + 32 * i) * lda + k0 + 64 + lkc);
#pragma unroll
            for (int i = 0; i < NJ; ++i) rb[i] = *(const u32x4*)(B + (size_t)(lrow + 32 * i) * ldb + k0 + 64 + lkc);
        }
#pragma unroll
        for (int ks = 0; ks < 2; ++ks) {
            bf16x8 af[4], bfr[NJ];
#pragma unroll
            for (int i = 0; i < 4; ++i) af[i] = *(const bf16x8*)(smem + (wm * 64 + i * 16 + fr) * 144 + (ks * 32 + fq * 8) * 2);
#pragma unroll
            for (int j = 0; j < NJ; ++j) bfr[j] = *(const bf16x8*)(smem + 18432 + (wn * NJ * 16 + j * 16 + fr) * 144 + (ks * 32 + fq * 8) * 2);
#pragma unroll
            for (int i = 0; i < 4; ++i)
#pragma unroll
                for (int j = 0; j < NJ; ++j)
                    acc[i][j] = SWAP ? __builtin_amdgcn_mfma_f32_16x16x32_bf16(bfr[j], af[i], acc[i][j], 0, 0, 0)
                                     : __builtin_amdgcn_mfma_f32_16x16x32_bf16(af[i], bfr[j], acc[i][j], 0, 0, 0);
        }
    }
}


namespace g256 {
constexpr int BK = 64, HALF = 128, HT = HALF * BK;
__device__ __forceinline__ int lds_byte(int r, int c) { int st = (r >> 4) * 2 + (c >> 5), rr = r & 15, cc = c & 31, ob = rr * 64 + cc * 2; return st * 1024 + (ob ^ (((ob >> 9) & 1) << 5)); }
__device__ __forceinline__ void stage_rc(unsigned b, unsigned& R, unsigned& Cc) { const unsigned st = b >> 10, sb = b & 1023u, swz = sb ^ (((sb >> 9) & 1u) << 5); R = (st >> 1) * 16u + (swz >> 6); Cc = (st & 1u) * 32u + ((swz & 63u) >> 1); }
}
__device__ __forceinline__ void gemm256(const Ctx& C, f32x4 (&acc)[2][2][4][2], const bf16_t* __restrict__ A, const bf16_t* __restrict__ Bt, const int K, const int brow, const int bcol) {
    using namespace g256;
    bf16_t* shm = (bf16_t*)dyn_smem;
    const int tidx = C.tid;
    #define SA(b,h) (shm+((b)*2+(h))*HT)
    #define SB(b,h) (shm+(4+(b)*2+(h))*HT)
    #define STAGE(Pp,BASE,br,kt) do{const char* _ub=(const char*)((BASE)+(long)(br)*K+(long)(kt)*BK); asm volatile("" : "+s"(_ub)); \
        __builtin_amdgcn_global_load_lds((const unsigned*)(_ub+goff0), \
          (__attribute__((address_space(3))) unsigned*)((__attribute__((address_space(3))) char*)(Pp)+tidx*16),16,0,0); \
        __builtin_amdgcn_global_load_lds((const unsigned*)(_ub+goff1), \
          (__attribute__((address_space(3))) unsigned*)((__attribute__((address_space(3))) char*)(Pp)+tidx*16+8192),16,0,0);}while(0)
    #define LDA(dst,b,h) for(int m=0;m<4;++m)for(int k=0;k<2;++k) \
      dst[m][k]=*reinterpret_cast<const bf16x8*>(a_ptr+((b)*2+(h))*16384+m*2048+k*1024)
    #define LDB(dst,b,h) for(int n=0;n<2;++n)for(int k=0;k<2;++k) \
      dst[n][k]=*reinterpret_cast<const bf16x8*>(b_ptr+((b)*2+(h))*16384+n*2048+k*1024)
    #define MMA(ai,bj,Atx,Btx) do{__builtin_amdgcn_s_setprio(1); \
      for(int m=0;m<4;++m)for(int n=0;n<2;++n)for(int k=0;k<2;++k) \
        acc[ai][bj][m][n]=__builtin_amdgcn_mfma_f32_16x16x32_bf16(Btx[n][k],Atx[m][k],acc[ai][bj][m][n],0,0,0); \
      __builtin_amdgcn_s_setprio(0);}while(0)
    #define WAIT_V(n) asm volatile("s_waitcnt vmcnt(" #n ")":::"memory")
    #define WAIT_L(n) asm volatile("s_waitcnt lgkmcnt(" #n ")":::"memory")
    #define BAR __builtin_amdgcn_s_barrier()
    #define SCHED __builtin_amdgcn_sched_barrier(0)
    const int wid = tidx >> 6, lane = tidx & 63, wr = wid >> 2, wc = wid & 3, fr = lane & 15, fq = lane >> 4;
    const int swz = (fr * 64 + fq * 16) ^ ((fr >> 3) << 5);
    const char* a_ptr = (const char*)dyn_smem + wr * 8192 + swz;
    const char* b_ptr = (const char*)dyn_smem + 65536 + wc * 4096 + swz;
#pragma unroll
    for (int a = 0; a < 2; ++a)
#pragma unroll
        for (int b = 0; b < 2; ++b)
#pragma unroll
            for (int m = 0; m < 4; ++m) { acc[a][b][m][0] = (f32x4){0.f, 0.f, 0.f, 0.f}; acc[a][b][m][1] = (f32x4){0.f, 0.f, 0.f, 0.f}; }
    bf16x8 At[4][2], B0[2][2], B1[2][2];
    const int nt = K / BK;
    unsigned goff0, goff1;
    { unsigned r0, c0, r1, c1; stage_rc((unsigned)tidx * 16u, r0, c0); stage_rc((unsigned)tidx * 16u + 8192u, r1, c1); goff0 = (r0 * (unsigned)K + c0) * 2u; goff1 = (r1 * (unsigned)K + c1) * 2u; }
    WAIT_V(0); __syncthreads();
    STAGE(SB(0,0),Bt,bcol,0); STAGE(SA(0,0),A,brow,0);
    STAGE(SB(0,1),Bt,bcol+HALF,0); STAGE(SA(0,1),A,brow+HALF,0);
    if(wr==1)BAR;
    WAIT_V(4); BAR;
    STAGE(SB(1,0),Bt,bcol,1); STAGE(SA(1,0),A,brow,1); STAGE(SB(1,1),Bt,bcol+HALF,1);
    WAIT_V(6); BAR;
    for(int t=0;t<nt-2;t+=2){
      LDB(B0,0,0); SCHED; LDA(At,0,0); STAGE(SA(1,1),A,brow+HALF,t+1);
      WAIT_L(8); BAR; WAIT_L(0); MMA(0,0,At,B0); BAR; SCHED;
      LDB(B1,0,1); STAGE(SB(0,0),Bt,bcol,t+2);
      BAR; WAIT_L(0); MMA(0,1,At,B1); BAR;
      LDA(At,0,1); STAGE(SA(0,0),A,brow,t+2);
      BAR; WAIT_L(0); MMA(1,0,At,B0); BAR; SCHED;
      STAGE(SB(0,1),Bt,bcol+HALF,t+2);
      WAIT_V(6); BAR; MMA(1,1,At,B1); BAR;
      LDB(B0,1,0); SCHED; LDA(At,1,0); STAGE(SA(0,1),A,brow+HALF,t+2);
      WAIT_L(8); BAR; WAIT_L(0); MMA(0,0,At,B0); BAR; SCHED;
      LDB(B1,1,1); STAGE(SB(1,0),Bt,bcol,t+3);
      BAR; WAIT_L(0); MMA(0,1,At,B1); BAR;
      LDA(At,1,1); STAGE(SA(1,0),A,brow,t+3);
      BAR; WAIT_L(0); MMA(1,0,At,B0); BAR; SCHED;
      STAGE(SB(1,1),Bt,bcol+HALF,t+3);
      WAIT_V(6); BAR; MMA(1,1,At,B1); BAR;
    }
    { LDB(B0,0,0); LDA(At,0,0); STAGE(SA(1,1),A,brow+HALF,nt-1);
      BAR; WAIT_L(0); MMA(0,0,At,B0); BAR;
      LDB(B1,0,1); BAR; WAIT_L(0); MMA(0,1,At,B1); BAR;
      LDA(At,0,1); WAIT_V(4); BAR; WAIT_L(0); MMA(1,0,At,B0); MMA(1,1,At,B1); BAR; }
    { LDB(B0,1,0); LDA(At,1,0); WAIT_V(2); BAR; WAIT_L(0); MMA(0,0,At,B0); BAR;
      LDB(B1,1,1); WAIT_V(0); BAR; WAIT_L(0); MMA(0,1,At,B1); BAR;
      LDA(At,1,1); BAR; WAIT_L(0); MMA(1,0,At,B0); MMA(1,1,At,B1); BAR; }
    if(wr==0)BAR;
    #undef SA
    #undef SB
    #undef STAGE
    #undef LDA
    #undef LDB
    #undef MMA
    #undef WAIT_V
    #undef WAIT_L
    #undef BAR
    #undef SCHED
}
__device__ __forceinline__ bool tile_order(int i, int G, int c, int nM, int nN, int& pm, int& pn) {
    const int nwg = nM * nN; const long L = (long)i * G + c; if (L >= nwg) return false;
    int wgid = (int)L; { const int q = nwg / 8, r = nwg % 8, xcd = wgid % 8, off = wgid / 8; wgid = (xcd < r ? xcd * (q + 1) : r * (q + 1) + (xcd - r) * q) + off; }
    const int nig = 8 * nN, gid = wgid / nig, fm = gid * 8, gsz = (nM - fm) < 8 ? (nM - fm) : 8;
    pm = fm + ((wgid % nig) % gsz); pn = (wgid % nig) / gsz; return true;
}

struct ConvJob { const float* src; int ld, K, nbegin, ncount, map; bf16_t* dst; };
__device__ __forceinline__ ConvJob conv_job(const PV& P, int j) {
    const int l = j >> 4, q = j & 15; bf16_t* W = wl(P, l); ConvJob c; c.map = 0; c.nbegin = 0;
    switch (q) {
        case 0: c.src = P.inp(8) + (size_t)l * 1024 * 5632; c.ld = 5632; c.K = 1024; c.ncount = 5632; c.dst = W + OW_FA_IN; c.map = 1; break;
        case 1: c.src = P.inp(9) + (size_t)l * 2816 * 1024; c.ld = 1024; c.K = 2816; c.ncount = 1024; c.dst = W + OW_FA_OUT; break;
        case 2: c.src = P.inp(10) + (size_t)l * 1024 * 5632; c.ld = 5632; c.K = 1024; c.ncount = 5632; c.dst = W + OW_FB_IN; c.map = 1; break;
        case 3: c.src = P.inp(11) + (size_t)l * 2816 * 1024; c.ld = 1024; c.K = 2816; c.ncount = 1024; c.dst = W + OW_FB_OUT; break;
        case 4: c.src = P.inp(12) + (size_t)l * 1024 * 8576; c.ld = 8576; c.K = 1024; c.ncount = 3456; c.dst = W + OW_WIN; break;
        case 5: c.src = P.inp(12) + (size_t)l * 1024 * 8576; c.ld = 8576; c.K = 1024; c.nbegin = 3968; c.ncount = 4608; c.dst = W + OW_WIN + (size_t)3968 * 1024; break;
        case 6: case 7: case 8: case 9: { const int n = q - 6; c.src = P.inp(27) + (size_t)(l * 4 + n) * 512 * 1024; c.ld = 1024; c.K = 512; c.ncount = 1024; c.dst = W + OW_WBR + (size_t)n * 1024 * 512; } break;
        case 10: c.src = P.inp(28) + (size_t)l * 1024 * 1024; c.ld = 1024; c.K = 1024; c.ncount = 1024; c.dst = W + OW_WOUT; break;
        case 11: case 12: { const int d = q - 11; c.src = P.inp(15) + (size_t)(l * 2 + d) * 64 * 512; c.ld = 512; c.K = 64; c.ncount = 512; c.dst = W + OW_W2T + (size_t)d * 512 * 64; } break;
        case 13: case 14: { const int d = q - 13; c.src = P.inp(17) + (size_t)(l * 2 + d) * 64 * 512; c.ld = 512; c.K = 64; c.ncount = 512; c.dst = W + OW_A2T + (size_t)d * 512 * 64; } break;
        default: c.src = P.inp(18) + (size_t)l * 128 * 512; c.ld = 512; c.K = 128; c.ncount = 512; c.dst = W + OW_G2T; break;
    }
    return c;
}

__device__ __forceinline__ void prep_phase(const Ctx& C, const PV& P, unsigned char* smem) {
    const int tid = C.tid;
    {
        int total = 0;
        for (int j = 0; j < 32; ++j) { ConvJob c = conv_job(P, j); total += (c.K >> 6) * (c.ncount >> 6); }
        float* tile = (float*)smem;
        const int tx = tid & 63, ty = tid >> 6;
        for (int t = C.bid; t < total; t += C.nblk) {
            int tt = t, j = 0; ConvJob c = conv_job(P, 0);
            for (;;) { const int n = (c.K >> 6) * (c.ncount >> 6); if (tt < n) break; tt -= n; ++j; c = conv_job(P, j); }
            const int nkt = c.K >> 6, kt = tt % nkt, nt = tt / nkt, k0 = kt * 64, n0 = nt * 64;
            int col = c.nbegin + n0 + tx;
            if (c.map) { const int np = n0 + tx, blk = np >> 5, w = np & 31, f = blk * 16 + (w & 15); col = (w < 16) ? f : 2816 + f; }
            __syncthreads();
#pragma unroll 4
            for (int i = 0; i < 8; ++i) { const int kk = ty + 8 * i; tile[kk * 65 + tx] = c.src[(size_t)(k0 + kk) * c.ld + col]; }
            __syncthreads();
#pragma unroll 4
            for (int i = 0; i < 8; ++i) { const int nn = ty + 8 * i; c.dst[(size_t)(n0 + nn) * c.K + k0 + tx] = f2bf(tile[tx * 65 + nn]); }
        }
        __syncthreads();
    }
    {
        float* wt = (float*)smem;
        float* cosT = (float*)(smem + 64 * 129 * 4);
        for (int it = C.bid; it < 2 * 4 * 16; it += C.nblk) {
            const int l = it >> 6, g = (it >> 4) & 3, kc = it & 15, k0 = kc * 64;
            const float* src = P.inp(12) + (size_t)l * 1024 * 8576 + 3456 + g * 128;
            __syncthreads();
            for (int e = tid; e < 64 * 128; e += NT) { const int kk = e >> 7, c = e & 127; wt[kk * 129 + c] = src[(size_t)(k0 + kk) * 8576 + c]; }
            if (tid < 128) cosT[tid] = cospif((float)tid * (1.0f / 64.0f));
            __syncthreads();
            bf16_t* dst = wl(P, l) + OW_WIN + (size_t)(3456 + g * 128) * 1024;
            const int kk = tid & 63;
            for (int i = 0; i < 16; ++i) {
                const int j2 = (tid >> 6) + 8 * i, cc = j2 >> 1, part = j2 & 1;
                float s = 0.f;
                if (cc == 0) {
                    if (part == 0) { for (int c = 0; c < 128; ++c) s += wt[kk * 129 + c]; }
                    else { for (int c = 0; c < 128; ++c) s += (c & 1) ? -wt[kk * 129 + c] : wt[kk * 129 + c]; }
                } else if (part == 0) {
                    for (int c = 0; c < 128; ++c) s += wt[kk * 129 + c] * cosT[(cc * c) & 127];
                } else {
                    for (int c = 0; c < 128; ++c) s -= wt[kk * 129 + c] * cosT[(cc * c - 32) & 127];
                }
                dst[(size_t)j2 * 1024 + k0 + kk] = f2bf(s);
            }
        }
        __syncthreads();
    }
    {
        float2* tw = (float2*)(P.ws + WS_TW);
        for (int m = C.bid * NT + tid; m < 4096; m += C.nblk * NT) { const float x = (float)m * (1.0f / 4096.0f); tw[m] = make_float2(cospif(x), -sinpif(x)); }
    }
    {
        float* sc = (float*)smem;
        float* red = (float*)(smem + 18 * 512 * 4);
        float* mod = (float*)(P.ws + WS_MOD);
        for (int it = C.bid; it < 2 * 144; it += C.nblk) {
            const int l = it / 144, n0 = (it % 144) * 64, nl = tid & 63, ks = tid >> 6;
            const float* aw = P.inp(4) + (size_t)l * 1024 * 9216;
            float acc[18];
#pragma unroll
            for (int b = 0; b < 18; ++b) acc[b] = 0.f;
            for (int half = 0; half < 2; ++half) {
                __syncthreads();
                for (int e = tid; e < 18 * 512; e += NT) {
                    const int b = e >> 9, kk = e & 511, k = half * 512 + kk;
                    const float cv = b < 2 ? P.inp(2)[b * 1024 + k] : P.inp(3)[(b - 2) * 1024 + k];
                    sc[e] = cv / (1.0f + __expf(-cv));
                }
                __syncthreads();
                for (int kk = ks * 64; kk < ks * 64 + 64; ++kk) {
                    const float w = aw[(size_t)(half * 512 + kk) * 9216 + n0 + nl];
#pragma unroll
                    for (int b = 0; b < 18; ++b) acc[b] += sc[b * 512 + kk] * w;
                }
            }
            __syncthreads();
#pragma unroll
            for (int b = 0; b < 18; ++b) red[(ks * 18 + b) * 64 + nl] = acc[b];
            __syncthreads();
            for (int e = tid; e < 18 * 64; e += NT) {
                const int b = e >> 6, n = e & 63;
                float s = 0.f;
#pragma unroll
                for (int k8 = 0; k8 < 8; ++k8) s += red[(k8 * 18 + b) * 64 + n];
                mod[((size_t)l * 18 + b) * 9216 + n0 + n] = s + P.inp(5)[(size_t)l * 9216 + n0 + n];
            }
        }
        __syncthreads();
    }
}

__device__ __forceinline__ void norm_phase(const Ctx& C, const PV& P, int pass, const float* lng, const float* lnb, int mod_layer, int j, bool from_input, bool write_x) {
    const int lane = C.tid & 63, wave = C.tid >> 6;
    bf16_t* hmod = (bf16_t*)(P.ws + WS_HMOD);
    const float* mod = (const float*)(P.ws + WS_MOD);
    const int nw = C.nblk * NWV;
    for (int lt0 = C.bid * NWV + wave; lt0 < TP; lt0 += 2 * nw) {
        f32x4 v[2][4]; int gr[2], bb[2]; bool ok[2];
#pragma unroll
        for (int u = 0; u < 2; ++u) {
            const int lt = lt0 + u * nw; ok[u] = lt < TP;
            const int ltc = ok[u] ? lt : lt0;
            gr[u] = grow_of(pass, ltc); bb[u] = brow_of(pass, ltc);
            const float* src = from_input ? (gr[u] < 16384 ? P.inp(0) + (size_t)gr[u] * 1024 : P.inp(1) + (size_t)(gr[u] - 16384) * 1024) : P.out + (size_t)gr[u] * 1024;
#pragma unroll
            for (int i = 0; i < 4; ++i) v[u][i] = *(const f32x4*)(src + i * 256 + lane * 4);
        }
        if (lng) {
            float s[2], q[2], mu[2], rs[2];
#pragma unroll
            for (int u = 0; u < 2; ++u) { s[u] = 0.f;
#pragma unroll
                for (int i = 0; i < 4; ++i) s[u] += (v[u][i][0] + v[u][i][1]) + (v[u][i][2] + v[u][i][3]); }
#pragma unroll
            for (int o = 32; o > 0; o >>= 1) { s[0] += __shfl_xor(s[0], o); s[1] += __shfl_xor(s[1], o); }
#pragma unroll
            for (int u = 0; u < 2; ++u) { mu[u] = s[u] * (1.0f / 1024.0f); q[u] = 0.f;
#pragma unroll
                for (int i = 0; i < 4; ++i) { const f32x4 dd = v[u][i] - mu[u]; q[u] += (dd[0] * dd[0] + dd[1] * dd[1]) + (dd[2] * dd[2] + dd[3] * dd[3]); } }
#pragma unroll
            for (int o = 32; o > 0; o >>= 1) { q[0] += __shfl_xor(q[0], o); q[1] += __shfl_xor(q[1], o); }
#pragma unroll
            for (int u = 0; u < 2; ++u) {
                rs[u] = rsqrtf(q[u] * (1.0f / 1024.0f) + 1e-5f);
                if (ok[u] && lane == 0) *(f32x2*)(P.ws + WS_STATS + (size_t)(lt0 + u * nw) * 8) = (f32x2){mu[u], rs[u]};
            }
#pragma unroll
            for (int i = 0; i < 4; ++i) {
                const f32x4 g = *(const f32x4*)(lng + i * 256 + lane * 4), be = *(const f32x4*)(lnb + i * 256 + lane * 4);
                v[0][i] = (v[0][i] - mu[0]) * rs[0] * g + be; v[1][i] = (v[1][i] - mu[1]) * rs[1] * g + be;
            }
        }
        if (write_x) {
#pragma unroll
            for (int u = 0; u < 2; ++u) if (ok[u]) {
#pragma unroll
                for (int i = 0; i < 4; ++i) *(f32x4*)(P.out + (size_t)gr[u] * 1024 + i * 256 + lane * 4) = v[u][i];
            }
        }
        if (j >= 0) {
            float s[2], q[2], mu[2], rs[2];
#pragma unroll
            for (int u = 0; u < 2; ++u) { s[u] = 0.f;
#pragma unroll
                for (int i = 0; i < 4; ++i) s[u] += (v[u][i][0] + v[u][i][1]) + (v[u][i][2] + v[u][i][3]); }
#pragma unroll
            for (int o = 32; o > 0; o >>= 1) { s[0] += __shfl_xor(s[0], o); s[1] += __shfl_xor(s[1], o); }
#pragma unroll
            for (int u = 0; u < 2; ++u) { mu[u] = s[u] * (1.0f / 1024.0f); q[u] = 0.f;
#pragma unroll
                for (int i = 0; i < 4; ++i) { const f32x4 dd = v[u][i] - mu[u]; q[u] += (dd[0] * dd[0] + dd[1] * dd[1]) + (dd[2] * dd[2] + dd[3] * dd[3]); } }
#pragma unroll
            for (int o = 32; o > 0; o >>= 1) { q[0] += __shfl_xor(q[0], o); q[1] += __shfl_xor(q[1], o); }
#pragma unroll
            for (int u = 0; u < 2; ++u) {
                rs[u] = rsqrtf(q[u] * (1.0f / 1024.0f) + 1e-5f);
                if (!ok[u]) continue;
                const float* mb = mod + ((size_t)mod_layer * 18 + bb[u]) * 9216 + (size_t)(3 * j) * 1024;
                const int lt = lt0 + u * nw;
#pragma unroll
                for (int i = 0; i < 4; ++i) {
                    const f32x4 sh = *(const f32x4*)(mb + i * 256 + lane * 4), scl = *(const f32x4*)(mb + 1024 + i * 256 + lane * 4);
                    const f32x4 hh = (v[u][i] - mu[u]) * rs[u] * (1.0f + scl) + sh;
                    u32x2 o; o.x = pack2bf(hh[0], hh[1]); o.y = pack2bf(hh[2], hh[3]);
                    *(u32x2*)(hmod + (size_t)lt * 1024 + i * 256 + lane * 4) = o;
                }
            }
        }
    }
}

__device__ __forceinline__ void ffn_up_phase(const Ctx& C, const PV& P, const bf16_t* Wt) {
    const bf16_t* hmod = (const bf16_t*)(P.ws + WS_HMOD);
    bf16_t* act = (bf16_t*)(P.ws + WS_R + R_ACT);
    int pm, pn;
    for (int it = 0; tile_order(it, C.nblk, C.bid, TP / 256, 22, pm, pn); ++it) {
        f32x4 acc[2][2][4][2];
        gemm256(C, acc, hmod, Wt, 1024, pm * 256, pn * 256);
        int z2 = 0; asm volatile("" : "+s"(z2));
        const int tid2 = tid_now(C.wave_s, z2), lane = tid2 & 63, wid = tid2 >> 6, wr = wid >> 2, wc = wid & 3, fr = lane & 15, fq = lane >> 4;
#pragma unroll
        for (int ai = 0; ai < 2; ++ai)
#pragma unroll
            for (int m = 0; m < 4; ++m) {
                const int row = pm * 256 + ai * 128 + wr * 64 + m * 16 + fr;
#pragma unroll
                for (int bj = 0; bj < 2; ++bj) {
                    const int colbase = pn * 256 + bj * 128 + wc * 32, f = (colbase >> 5) * 16 + fq * 4;
                    const f32x4 a = acc[ai][bj][m][0], bb = acc[ai][bj][m][1];
                    float o[4];
#pragma unroll
                    for (int r = 0; r < 4; ++r) o[r] = a[r] / (1.0f + __expf(-a[r])) * bb[r];
                    u32x2 w; w.x = pack2bf(o[0], o[1]); w.y = pack2bf(o[2], o[3]);
                    *(u32x2*)(act + (size_t)row * 2816 + f) = w;
                }
            }
    }
}

__device__ __forceinline__ void resid_gemm_phase(const Ctx& C, const PV& P, int pass, const bf16_t* A, int K, const bf16_t* Wt, int layer, int j, float scale, const float* xg, const float* xb) {
    const float* mod = (const float*)(P.ws + WS_MOD);
    int pm, pn;
    for (int it = 0; tile_order(it, C.nblk, C.bid, TP / 256, 4, pm, pn); ++it) {
        f32x4 acc[2][2][4][2];
        gemm256(C, acc, A, Wt, K, pm * 256, pn * 256);
        int z2 = 0; asm volatile("" : "+s"(z2));
        const int tid2 = tid_now(C.wave_s, z2), lane = tid2 & 63, wid = tid2 >> 6, wr = wid >> 2, wc = wid & 3, fr = lane & 15, fq = lane >> 4;
#pragma unroll
        for (int ai = 0; ai < 2; ++ai)
#pragma unroll
            for (int m = 0; m < 4; ++m) {
                const int lt = pm * 256 + ai * 128 + wr * 64 + m * 16 + fr;
                const int gr = grow_of(pass, lt), b = brow_of(pass, lt);
                const float* gate = mod + ((size_t)layer * 18 + b) * 9216 + (size_t)(3 * j + 2) * 1024;
                const float* xsrc = xg ? P.out + (size_t)gr * 1024 : (gr < 16384 ? P.inp(0) + (size_t)gr * 1024 : P.inp(1) + (size_t)(gr - 16384) * 1024);
                f32x2 st = (f32x2){0.f, 1.f};
                if (xg) st = *(const f32x2*)(P.ws + WS_STATS + (size_t)lt * 8);
#pragma unroll
                for (int bj = 0; bj < 2; ++bj)
#pragma unroll
                    for (int n = 0; n < 2; ++n) {
                        const int col = pn * 256 + bj * 128 + wc * 32 + n * 16 + fq * 4;
                        f32x4 x = *(const f32x4*)(xsrc + col);
                        if (xg) x = (x - st[0]) * st[1] * *(const f32x4*)(xg + col) + *(const f32x4*)(xb + col);
                        const f32x4 g = *(const f32x4*)(gate + col);
                        *(f32x4*)(P.out + (size_t)gr * 1024 + col) = ALPHA * x + (1.0f + g) * scale * acc[ai][bj][m][n];
                    }
                asm volatile("" ::: "memory");
            }
    }
}

__device__ __forceinline__ void win_phase(const Ctx& C, const PV& P, int layer) {
    const bf16_t* hmod = (const bf16_t*)(P.ws + WS_HMOD);
    const bf16_t* Wt = wl(P, layer) + OW_WIN;
    unsigned char* R = P.ws + WS_R;
    f16* raw = (f16*)(R + R_RAW); bf16_t* Qb = (bf16_t*)(R + R_Q); bf16_t* Kb = (bf16_t*)(R + R_K); bf16_t* Vt = (bf16_t*)(R + R_VT);
    f16* Zc = (f16*)(R + R_ZC); f16* poolp = (f16*)(R + R_POOLP);
    typedef f16 f16x4 __attribute__((ext_vector_type(4)));
    typedef f16 f16x2 __attribute__((ext_vector_type(2)));
    int pm, pn;
    for (int it = 0; tile_order(it, C.nblk, C.bid, TP / 256, 18, pm, pn); ++it) {
        const int lt_t = pm * 256, sq = lt_t < 8192 ? 0 : 1 + ((lt_t - 8192) >> 12), lt0 = seqbase_of(sq), S = seqlen_of(sq);
        f32x4 acc[2][2][4][2];
        gemm256(C, acc, hmod, Wt, 1024, pm * 256, pn * 256);
        int z2 = 0; asm volatile("" : "+s"(z2));
        const int tid2 = tid_now(C.wave_s, z2), lane = tid2 & 63, wid = tid2 >> 6, wr = wid >> 2, wc = wid & 3, fr = lane & 15, fq = lane >> 4;
#pragma unroll
        for (int bj = 0; bj < 2; ++bj) {
            const int tn = pn * 2 + bj;
            if (tn >= 35) continue;
#pragma unroll
            for (int ai = 0; ai < 2; ++ai)
#pragma unroll
                for (int m = 0; m < 4; ++m) {
                    const int lt = pm * 256 + ai * 128 + wr * 64 + m * 16 + fr, pos = lt - lt0;
#pragma unroll
                    for (int n = 0; n < 2; ++n) {
                        const int col = tn * 128 + wc * 32 + n * 16 + fq * 4;
                        f32x4 v = acc[ai][bj][m][n];
                        if (tn < 15) {
                            f16x4 h; h[0] = (f16)v[0]; h[1] = (f16)v[1]; h[2] = (f16)v[2]; h[3] = (f16)v[3];
                            *(f16x4*)(raw + (size_t)lt * 1920 + col) = h;
                        } else if (tn < 23) {
                            const int nq = (col - 1920) & 511, hc = nq >> 6, d = nq & 63;
                            if (n == 0 && (wc & 1) == 0) {
#pragma unroll
                                for (int r = 0; r < 4; ++r) {
                                    const float invlo = r == 0 ? 1.0f : r == 1 ? 0.1939227432012558f : r == 2 ? 0.03760603070259094f : 0.007292664609849453f;
                                    const float invhi = r == 0 ? 0.0014142135623842478f : r == 1 ? 0.00027424818836152554f : r == 2 ? 5.3182957344688475e-05f : 1.0313385246263351e-05f;
                                    const float ang = (float)pos * ((fq & 1) ? invhi : invlo);
                                    const float hi = ang * 0.15915493667125702f;
                                    const float lo = __builtin_fmaf(ang, 0.15915493667125702f, -hi) + ang * 6.4206382432985265e-09f;
                                    const float rr = (hi - floorf(hi)) + lo;
                                    const float cs = __builtin_amdgcn_cosf(rr), sn = __builtin_amdgcn_sinf(rr);
                                    const float other = __shfl_xor(v[r], 32);
                                    v[r] = (fq < 2) ? (v[r] * cs - other * sn) : (other * sn + v[r] * cs);
                                }
                            }
                            bf16_t* dst = (tn < 19) ? Qb : Kb;
                            const float sc = (tn < 19) ? 0.125f * 1.44269504088896f : 1.0f;
                            u32x2 w; w.x = pack2bf(v[0] * sc, v[1] * sc); w.y = pack2bf(v[2] * sc, v[3] * sc);
                            *(u32x2*)(dst + (size_t)lt0 * 512 + ((size_t)hc * S + pos) * 64 + d) = w;
                        } else if (tn < 27) {
                            const int nv = col - 2944;
                            bf16_t* vb = Vt + (size_t)lt0 * 512 + (size_t)nv * S + pos;
                            vb[0] = f2bf(v[0]); vb[(size_t)S] = f2bf(v[1]); vb[(size_t)2 * S] = f2bf(v[2]); vb[(size_t)3 * S] = f2bf(v[3]);
                        } else if (tn < 31) {
                            const int nz = col - 3456, g = nz >> 7, cc = (nz & 127) >> 1;
                            f16x2 z0, z1; z0[0] = (f16)v[0]; z0[1] = (f16)v[1]; z1[0] = (f16)v[2]; z1[1] = (f16)v[3];
                            f16x2* zb = (f16x2*)Zc + (size_t)lt0 * 256;
                            zb[(size_t)(g * 64 + cc) * S + pos] = z0;
                            zb[(size_t)(g * 64 + cc + 1) * S + pos] = z1;
                        } else {
                            f16x4 h; h[0] = (f16)v[0]; h[1] = (f16)v[1]; h[2] = (f16)v[2]; h[3] = (f16)v[3];
                            *(f16x4*)(poolp + (size_t)lt * 512 + (col - 3968)) = h;
                        }
                    }
                    asm volatile("" ::: "memory");
                }
        }
    }
}

__device__ __forceinline__ float shiftv(const f16* __restrict__ raw, int lt, int t, int S, int col, float mu) {
    const float p = (float)raw[(size_t)lt * 1920 + col];
    const float pr = t > 0 ? (float)raw[(size_t)(lt - 1) * 1920 + col] : 0.f;
    const float nx = t < S - 1 ? (float)raw[(size_t)(lt + 1) * 1920 + col] : 0.f;
    return p + (0.5f * (pr + nx) - p) * mu;
}

typedef f16 f16x4_t __attribute__((ext_vector_type(4)));
typedef f16 f16x8_t __attribute__((ext_vector_type(8)));
__device__ __forceinline__ void lin_pool_phase(const Ctx& C, const PV& P, int layer) {
    unsigned char* R = P.ws + WS_R;
    const f16* raw = (const f16*)(R + R_RAW); bf16_t* lin = (bf16_t*)(R + R_LIN);
    const f16* poolp = (const f16*)(R + R_POOLP); bf16_t* ypool = (bf16_t*)(R + R_YB) + 3 * SZ512;
    const float* mu = P.inp(13) + (size_t)layer * 1920; const float* pscale = P.inp(26) + (size_t)layer * 512;
    const int gsz = C.nblk * NT, gid = C.bid * NT + C.tid;
    for (int e0 = gid; e0 < TP * 96; e0 += 2 * gsz) {
        f16x4_t p0[2], pm[2], pp[2]; f32x4 m4[2]; int lt_[2], c_[2]; float wm_[2], wp_[2]; bool ok[2];
#pragma unroll
        for (int u = 0; u < 2; ++u) {
            const int e1 = e0 + u * gsz; ok[u] = e1 < TP * 96; const int e = ok[u] ? e1 : e0;
            const int lt = e / 96, c = (e % 96) * 4, col = 1536 + c;
            const int pos = pos_of(lt), S = lt < 8192 ? 8192 : 4096;
            lt_[u] = lt; c_[u] = c; wm_[u] = pos > 0 ? 0.5f : 0.f; wp_[u] = pos < S - 1 ? 0.5f : 0.f;
            p0[u] = *(const f16x4_t*)(raw + (size_t)lt * 1920 + col);
            pm[u] = *(const f16x4_t*)(raw + (size_t)(pos > 0 ? lt - 1 : lt) * 1920 + col);
            pp[u] = *(const f16x4_t*)(raw + (size_t)(pos < S - 1 ? lt + 1 : lt) * 1920 + col);
            m4[u] = *(const f32x4*)(mu + col);
        }
#pragma unroll
        for (int u = 0; u < 2; ++u) {
            float o[4];
#pragma unroll
            for (int r = 0; r < 4; ++r) {
                const float p = (float)p0[u][r];
                float v = p + (wm_[u] * (float)pm[u][r] + wp_[u] * (float)pp[u][r] - p) * m4[u][r];
                if (c_[u] < 128) v = 1.0f - 2.0f / (__expf(2.0f * v) + 1.0f);
                else if (c_[u] >= 256) v = sigmoidf_(v);
                o[r] = v;
            }
            u32x2 w; w.x = pack2bf(o[0], o[1]); w.y = pack2bf(o[2], o[3]);
            if (ok[u]) *(u32x2*)(lin + (size_t)lt_[u] * 384 + c_[u]) = w;
        }
    }
    for (int e0 = gid; e0 < TP * 128; e0 += 2 * gsz) {
        f16x4_t tv[2][16], xv[2]; int lt_[2], c_[2], cnt_[2]; bool ok[2];
#pragma unroll
        for (int u = 0; u < 2; ++u) {
            const int e1 = e0 + u * gsz; ok[u] = e1 < TP * 128; const int e = ok[u] ? e1 : e0;
            const int lt = e >> 7, c = (e & 127) * 4, g = c >> 7, half = 1 << g;
            const int pos = pos_of(lt), S = lt < 8192 ? 8192 : 4096;
            const int lo = max(pos - half, 0), hi = min(pos + half, S);
            lt_[u] = lt; c_[u] = c; cnt_[u] = hi - lo;
            const f16* base = poolp + (size_t)(lt - pos) * 512 + c;
#pragma unroll
            for (int o = -8; o < 8; ++o) {
                const int tt = pos + o;
                const bool in = (o >= -half) && (o < half) && tt >= 0 && tt < S;
                f16x4_t z; z[0] = (f16)0.f; z[1] = (f16)0.f; z[2] = (f16)0.f; z[3] = (f16)0.f;
                tv[u][o + 8] = in ? *(const f16x4_t*)(base + (size_t)tt * 512) : z;
            }
            xv[u] = *(const f16x4_t*)(base + (size_t)pos * 512);
        }
#pragma unroll
        for (int u = 0; u < 2; ++u) {
            float s0 = 0.f, s1 = 0.f, s2 = 0.f, s3 = 0.f;
#pragma unroll
            for (int o = 0; o < 16; ++o) { s0 += (float)tv[u][o][0]; s1 += (float)tv[u][o][1]; s2 += (float)tv[u][o][2]; s3 += (float)tv[u][o][3]; }
            const f32x4 ps = *(const f32x4*)(pscale + c_[u]);
            const float ic = 1.0f / (float)cnt_[u];
            u32x2 w; w.x = pack2bf((s0 * ic - (float)xv[u][0]) * ps[0], (s1 * ic - (float)xv[u][1]) * ps[1]); w.y = pack2bf((s2 * ic - (float)xv[u][2]) * ps[2], (s3 * ic - (float)xv[u][3]) * ps[3]);
            if (ok[u]) *(u32x2*)(ypool + (size_t)lt_[u] * 512 + c_[u]) = w;
        }
    }
    {
        float* invn = (float*)(P.ws + WS_INVN);
        const float* k_k = P.inp(19) + (size_t)layer * 512;
        const int lane = C.tid & 63, wave = C.tid >> 6;
        for (int lt = C.bid * NWV + wave; lt < TP; lt += C.nblk * NWV) {
            const int pos = pos_of(lt), S = lt < 8192 ? 8192 : 4096;
            float ss[8];
#pragma unroll
            for (int h = 0; h < 8; ++h) {
                const int c = h * 64 + lane;
                const float k = shiftv(raw, lt, pos, S, 512 + c, mu[512 + c]) * k_k[c];
                ss[h] = k * k;
            }
#pragma unroll
            for (int h = 0; h < 8; ++h) ss[h] = wsum(ss[h]);
            if (lane < 8) {
                float sel = ss[0];
#pragma unroll
                for (int h = 1; h < 8; ++h) sel = lane == h ? ss[h] : sel;
                invn[(size_t)lt * 8 + lane] = 1.0f / fmaxf(sqrtf(sel), 1e-12f);
            }
        }
    }
}

__device__ __forceinline__ void lora_phase(const Ctx& C, const PV& P, int layer, unsigned char* smem) {
    unsigned char* R = P.ws + WS_R;
    const bf16_t* lin = (const bf16_t*)(R + R_LIN); f16* wa = (f16*)(R + R_WA); f16* gbuf = (f16*)(R + R_G);
    const bf16_t* W = wl(P, layer);
    const int lane = C.tid & 63, wave = (C.tid >> 6) & 3, wm = wave >> 1, wn = wave & 1, fr = lane & 15, fq = lane >> 4;
    for (int t2 = C.bid; t2 < 5 * MT * 2; t2 += C.nblk) {
        const int t = t2 * 2 + (C.tid >> 8);
        const int which = t / (MT * 4), tt = t % (MT * 4), tm = tt >> 2, tn = tt & 3;
        const bf16_t* Bt; int K, acol; const float* bias = nullptr; f16* dst;
        if (which < 2) { Bt = W + OW_W2T + (size_t)which * 512 * 64; K = 64; acol = which * 64; bias = P.inp(14) + (size_t)(layer * 2 + which) * 512; dst = wa + (size_t)which * SZ512; }
        else if (which < 4) { const int d = which - 2; Bt = W + OW_A2T + (size_t)d * 512 * 64; K = 64; acol = 128 + d * 64; bias = P.inp(16) + (size_t)(layer * 2 + d) * 512; dst = wa + (size_t)which * SZ512; }
        else { Bt = W + OW_G2T; K = 128; acol = 256; dst = gbuf; }
        f32x4 acc[4][4];
        gemm_core<4, true>(C, acc, lin + (size_t)tm * 128 * 384 + acol, 384, Bt + (size_t)tn * 128 * K, K, K, smem);
#pragma unroll
        for (int i = 0; i < 4; ++i) {
            const int lt = tm * 128 + wm * 64 + i * 16 + fr;
#pragma unroll
            for (int jn = 0; jn < 4; ++jn) {
                const int n = tn * 128 + wn * 64 + jn * 16 + fq * 4;
                typedef f16 f16x4 __attribute__((ext_vector_type(4)));
                f16x4 h;
#pragma unroll
                for (int r = 0; r < 4; ++r) {
                    float v = acc[i][jn][r];
                    if (which < 2) {
                        const float z = bias[n + r] + v;
                        v = __expf(-0.6065306597126334f * sigmoidf_(z));
                    } else if (which < 4) { v = sigmoidf_(bias[n + r] + v); }
                    h[r] = (f16)v;
                }
                *(f16x4*)(dst + (size_t)lt * 512 + n) = h;
            }
        }
    }
}

__device__ __forceinline__ void attn_items(const Ctx& C, const PV& P, int layer, int ctr_idx, unsigned char* smem) {
    unsigned char* R = P.ws + WS_R;
    const bf16_t* Qall = (const bf16_t*)(R + R_Q); const bf16_t* Kall = (const bf16_t*)(R + R_K); const bf16_t* Vall = (const bf16_t*)(R + R_VT);
    bf16_t* ydiff = (bf16_t*)(R + R_YB) + 1 * SZ512;
    const int tid = C.tid, lane = tid & 63, wave = tid >> 6, comp = wave & 1, rg = wave >> 1, fr = lane & 15, fq = lane >> 4;
    const float lam_init = layer == 0 ? 0.2f : (0.8f - 0.6f * 0.7408182206817179f);
    float lam_full;
    {
        const float* lm = P.inp(24) + (size_t)layer * 256;
        float s1 = 0.f, s2 = 0.f;
        for (int i = 0; i < 64; ++i) { s1 += lm[i] * lm[64 + i]; s2 += lm[128 + i] * lm[192 + i]; }
        lam_full = expf(s1) - expf(s2) + lam_init;
    }
    const float* normg = P.inp(25) + (size_t)layer * 128;
    unsigned* ctr = (unsigned*)(P.ws + WS_CTR) + ctr_idx * 16;
    volatile unsigned* bc = (volatile unsigned*)(smem + 131088);
    for (;;) {
        __syncthreads();
        if (tid == 0) *bc = atomicAdd(ctr, 1u);
        __syncthreads();
        const int item = (int)*bc;
        if (item >= 1280) break;
        int sq, h, qb;
        if (item < 256) { sq = 0; h = item >> 6; qb = item & 63; } else { const int i2 = item - 256; sq = 1 + (i2 >> 7); h = (i2 >> 5) & 3; qb = i2 & 31; }
        const int lt0 = seqbase_of(sq), S = seqlen_of(sq);
        const bf16_t* Qb = Qall + (size_t)lt0 * 512; const bf16_t* Kb = Kall + (size_t)lt0 * 512; const bf16_t* Vb = Vall + (size_t)lt0 * 512 + (size_t)h * 128 * S;
        const int q0 = qb * 128 + rg * 32;
        bf16x8 bq[2][2];
#pragma unroll
        for (int qs = 0; qs < 2; ++qs)
#pragma unroll
            for (int ks = 0; ks < 2; ++ks) bq[qs][ks] = *(const bf16x8*)(Qb + ((size_t)(h * 2 + comp) * S + q0 + qs * 16 + fr) * 64 + ks * 32 + fq * 8);
        float m_run[2] = {-1e30f, -1e30f}, l_run[2] = {0.f, 0.f};
        f32x4 O[8][2];
#pragma unroll
        for (int a = 0; a < 8; ++a) { O[a][0] = (f32x4){0.f, 0.f, 0.f, 0.f}; O[a][1] = (f32x4){0.f, 0.f, 0.f, 0.f}; }
        u32x4 rk[2], rv[2];
        const int lrow = tid >> 3, lkc = (tid & 7) * 8;
        auto gload = [&](int kt0) {
#pragma unroll
            for (int i = 0; i < 2; ++i) {
                const int row = lrow + 64 * i, cm = row >> 6, key = row & 63;
                rk[i] = *(const u32x4*)(Kb + ((size_t)(h * 2 + cm) * S + kt0 + key) * 64 + lkc);
                rv[i] = *(const u32x4*)(Vb + (size_t)row * S + kt0 + lkc);
            }
        };
        auto lstore = [&](int b) {
            unsigned char* sb = smem + b * 36864;
#pragma unroll
            for (int i = 0; i < 2; ++i) {
                const int row = lrow + 64 * i;
                *(u32x4*)(sb + row * 144 + lkc * 2) = rk[i];
                *(u32x4*)(sb + 18432 + row * 144 + lkc * 2) = rv[i];
            }
        };
        bf16x8 pb[2][2];
        auto H1 = [&](int b) {
            const unsigned char* sb = smem + b * 36864;
            f32x4 st[4][2];
#pragma unroll
            for (int t = 0; t < 4; ++t) {
                st[t][0] = (f32x4){0.f, 0.f, 0.f, 0.f}; st[t][1] = (f32x4){0.f, 0.f, 0.f, 0.f};
#pragma unroll
                for (int ks = 0; ks < 2; ++ks) {
                    const bf16x8 kf = *(const bf16x8*)(sb + (comp * 64 + t * 16 + fr) * 144 + (ks * 32 + fq * 8) * 2);
                    st[t][0] = __builtin_amdgcn_mfma_f32_16x16x32_bf16(kf, bq[0][ks], st[t][0], 0, 0, 0);
                    st[t][1] = __builtin_amdgcn_mfma_f32_16x16x32_bf16(kf, bq[1][ks], st[t][1], 0, 0, 0);
                }
            }
#pragma unroll
            for (int qs = 0; qs < 2; ++qs) {
                float mx = -1e30f;
#pragma unroll
                for (int t = 0; t < 4; ++t)
#pragma unroll
                    for (int r = 0; r < 4; ++r) mx = fmaxf(mx, st[t][qs][r]);
                mx = fmaxf(mx, __shfl_xor(mx, 16)); mx = fmaxf(mx, __shfl_xor(mx, 32));
                const float mnew = fmaxf(m_run[qs], mx);
                const float alpha = __builtin_amdgcn_exp2f(m_run[qs] - mnew);
                m_run[qs] = mnew;
                float ls = 0.f;
                float pv[4][4];
#pragma unroll
                for (int t = 0; t < 4; ++t)
#pragma unroll
                    for (int r = 0; r < 4; ++r) { pv[t][r] = __builtin_amdgcn_exp2f(st[t][qs][r] - mnew); ls += pv[t][r]; }
                l_run[qs] = l_run[qs] * alpha + ls;
                if (__builtin_amdgcn_ballot_w64(alpha != 1.0f) != 0ull) {
#pragma unroll
                    for (int a = 0; a < 8; ++a) O[a][qs] = O[a][qs] * alpha;
                }
#pragma unroll
                for (int u = 0; u < 2; ++u) {
                    union { bf16x8 v; unsigned w[4]; } pk;
                    pk.w[0] = pack2bf(pv[2 * u][0], pv[2 * u][1]); pk.w[1] = pack2bf(pv[2 * u][2], pv[2 * u][3]);
                    pk.w[2] = pack2bf(pv[2 * u + 1][0], pv[2 * u + 1][1]); pk.w[3] = pack2bf(pv[2 * u + 1][2], pv[2 * u + 1][3]);
                    pb[qs][u] = pk.v;
                }
            }
        };
        auto H2 = [&](int b) {
            const unsigned char* sb = smem + b * 36864 + 18432;
#pragma unroll
            for (int u = 0; u < 2; ++u)
#pragma unroll
                for (int a = 0; a < 8; ++a) {
                    union { bf16x8 v; u32x2 h[2]; } vf;
                    vf.h[0] = *(const u32x2*)(sb + (a * 16 + fr) * 144 + (u * 32 + fq * 4) * 2);
                    vf.h[1] = *(const u32x2*)(sb + (a * 16 + fr) * 144 + (u * 32 + 16 + fq * 4) * 2);
                    O[a][0] = __builtin_amdgcn_mfma_f32_16x16x32_bf16(vf.v, pb[0][u], O[a][0], 0, 0, 0);
                    O[a][1] = __builtin_amdgcn_mfma_f32_16x16x32_bf16(vf.v, pb[1][u], O[a][1], 0, 0, 0);
                }
        };
        const int grp = wave >> 2, T = S >> 6;
        gload(0);
        lstore(0);
        __syncthreads();
        for (int t = 0; t < T; ++t) {
            if (t + 1 < T) gload((t + 1) * 64);
            if (grp == 0) H1(t & 1); else if (t > 0) H2((t - 1) & 1);
            __syncthreads();
            if (t + 1 < T) lstore((t + 1) & 1);
            if (grp == 0) H2(t & 1); else H1(t & 1);
            __syncthreads();
        }
        if (grp == 1) H2((T - 1) & 1);
#pragma unroll
        for (int qs = 0; qs < 2; ++qs) {
            float l = l_run[qs]; l += __shfl_xor(l, 16); l += __shfl_xor(l, 32);
            const float inv = 1.0f / l;
#pragma unroll
            for (int a = 0; a < 8; ++a) O[a][qs] = O[a][qs] * inv;
        }
        __syncthreads();
        float* Ox = (float*)smem;
        if (comp == 1) {
#pragma unroll
            for (int qs = 0; qs < 2; ++qs)
#pragma unroll
                for (int a = 0; a < 8; ++a)
#pragma unroll
                    for (int r = 0; r < 4; ++r) Ox[(rg * 128 + a * 16 + fq * 4 + r) * 32 + qs * 16 + fr] = O[a][qs][r];
        }
        __syncthreads();
        if (comp == 0) {
#pragma unroll
            for (int qs = 0; qs < 2; ++qs) {
                float ss = 0.f;
#pragma unroll
                for (int a = 0; a < 8; ++a)
#pragma unroll
                    for (int r = 0; r < 4; ++r) {
                        const float o = O[a][qs][r] - lam_full * Ox[(rg * 128 + a * 16 + fq * 4 + r) * 32 + qs * 16 + fr];
                        O[a][qs][r] = o; ss += o * o;
                    }
                ss += __shfl_xor(ss, 16); ss += __shfl_xor(ss, 32);
                const float sc = rsqrtf(ss * (1.0f / 128.0f) + 1e-5f) * (1.0f - lam_init);
                const int lt = lt0 + q0 + qs * 16 + fr;
#pragma unroll
                for (int a = 0; a < 8; ++a) {
                    const int dv = a * 16 + fq * 4;
                    const float4 g = *(const float4*)(normg + dv);
                    uint2 w; w.x = pack2bf(O[a][qs][0] * sc * g.x, O[a][qs][1] * sc * g.y); w.y = pack2bf(O[a][qs][2] * sc * g.z, O[a][qs][3] * sc * g.w);
                    *(uint2*)(ydiff + (size_t)lt * 512 + h * 128 + dv) = w;
                }
            }
        }
    }
    __syncthreads();
}

__device__ __forceinline__ void fft_items(const Ctx& C, const PV& P, unsigned char* smem) {
    unsigned char* R = P.ws + WS_R;
    typedef f16 f16x2 __attribute__((ext_vector_type(2)));
    const f16x2* Zall = (const f16x2*)(R + R_ZC);
    bf16_t* yf = (bf16_t*)(R + R_YB) + 2 * SZ512;
    const float2* tw = (const float2*)(P.ws + WS_TW);
    float2* sm = (float2*)smem;
    const int tid = C.tid;
    for (int item = C.bid; item < NSEQ * 256; item += C.nblk) {
        const int sq = item >> 8, col = item & 255, g = col >> 6, cc = col & 63;
        const int lt0 = seqbase_of(sq), S = seqlen_of(sq), lg = sq == 0 ? 13 : 12;
        const f16x2* z = Zall + (size_t)lt0 * 256 + (size_t)col * S;
        __syncthreads();
        for (int s = tid; s < S; s += NT) { const f16x2 v = z[s]; sm[__brev((unsigned)s) >> (32 - lg)] = make_float2((float)v[0], (float)v[1]); }
        __syncthreads();
        int st = 0;
        for (; st + 1 < lg; st += 2) {
            const int half = 1 << st;
            for (int gq = tid; gq < (S >> 2); gq += NT) {
                const int j = gq & (half - 1), p0 = ((gq >> st) << (st + 2)) + j, p1 = p0 + half, p2 = p1 + half, p3 = p2 + half;
                const float2 w1 = tw[j << (12 - st)], wa = tw[j << (11 - st)], wb = tw[(j + half) << (11 - st)];
                const float2 x0 = sm[p0], x1 = sm[p1], x2 = sm[p2], x3 = sm[p3];
                const float2 t1 = make_float2(w1.x * x1.x - w1.y * x1.y, w1.x * x1.y + w1.y * x1.x);
                const float2 t3 = make_float2(w1.x * x3.x - w1.y * x3.y, w1.x * x3.y + w1.y * x3.x);
                const float2 a0 = make_float2(x0.x + t1.x, x0.y + t1.y), a1 = make_float2(x0.x - t1.x, x0.y - t1.y);
                const float2 a2 = make_float2(x2.x + t3.x, x2.y + t3.y), a3 = make_float2(x2.x - t3.x, x2.y - t3.y);
                const float2 u2 = make_float2(wa.x * a2.x - wa.y * a2.y, wa.x * a2.y + wa.y * a2.x);
                const float2 u3 = make_float2(wb.x * a3.x - wb.y * a3.y, wb.x * a3.y + wb.y * a3.x);
                sm[p0] = make_float2(a0.x + u2.x, a0.y + u2.y); sm[p2] = make_float2(a0.x - u2.x, a0.y - u2.y);
                sm[p1] = make_float2(a1.x + u3.x, a1.y + u3.y); sm[p3] = make_float2(a1.x - u3.x, a1.y - u3.y);
            }
            __syncthreads();
        }
        for (; st < lg; ++st) {
            const int half = 1 << st, tshift = 12 - st;
            for (int b = tid; b < (S >> 1); b += NT) {
                const int j = b & (half - 1), i0 = ((b >> st) << (st + 1)) + j, i1 = i0 + half;
                const float2 w = tw[j << tshift], u = sm[i0], x = sm[i1];
                const float2 tv = make_float2(w.x * x.x - w.y * x.y, w.x * x.y + w.y * x.x);
                sm[i0] = make_float2(u.x + tv.x, u.y + tv.y); sm[i1] = make_float2(u.x - tv.x, u.y - tv.y);
            }
            __syncthreads();
        }
        const float nrm = rsqrtf((float)S * 128.0f);
        for (int k = tid; k < S; k += NT) {
            const float2 a = sm[k], b = sm[(S - k) & (S - 1)];
            bf16_t* row = yf + (size_t)(lt0 + k) * 512 + g * 128;
            if (cc == 0) { row[0] = f2bf(0.5f * (a.x + b.x) * nrm); row[64] = f2bf(0.5f * (a.y + b.y) * nrm); }
            else { row[cc] = f2bf(a.x * nrm); row[128 - cc] = f2bf(b.x * nrm); }
        }
    }
    __syncthreads();
}

template <int KT>
__device__ __forceinline__ void scan_block(const Ctx& C, const PV& P, int layer, int sq, int h, int d, int row0, unsigned char* smem) {
    constexpr int TPR = 64 / KT, ROWS = NT / TPR, CH = 16, YP = TPR / 4, NV = ROWS / 32;
    unsigned char* R = P.ws + WS_R;
    const f16* raw = (const f16*)(R + R_RAW); const f16* wa = (const f16*)(R + R_WA); f16* yfb = (f16*)(R + R_YFB);
    const float* invn = (const float*)(P.ws + WS_INVN);
    const float* mu = P.inp(13) + (size_t)layer * 1920; const float* k_k = P.inp(19) + (size_t)layer * 512; const float* k_a = P.inp(20) + (size_t)layer * 512;
    const int tid = C.tid, row = tid / TPR, q = tid % TPR;
    const int lt0 = seqbase_of(sq), S = seqlen_of(sq);
    const int ch = tid & 63, c = h * 64 + ch;
    const float mu_r = mu[c], mu_k = mu[512 + c], kkw = k_k[c], kaw = k_a[c];
    const int vr = (ROWS == 32) ? (tid & 31) : (tid & 63);
    const int vcol = 1024 + h * 64 + row0 + vr; const float mu_v = mu[vcol];
    const f16* wdec = wa + (size_t)d * SZ512; const f16* aact = wa + (size_t)(2 + d) * SZ512;
    f16* ydst = yfb + (size_t)d * SZ512;
    f32x2 s[KT / 2];
#pragma unroll
    for (int j = 0; j < KT / 2; ++j) s[j] = (f32x2){0.f, 0.f};
    f16 pr_[2][3], pk_[2][3], pa_[2], pw_[2], pv_[NV][3]; float pn_[2];
    auto prefetch = [&](int c0) {
#pragma unroll
        for (int j = 0; j < 2; ++j) {
            const int i = (tid >> 6) + 8 * j, tstep = c0 + i, t = d == 0 ? tstep : S - 1 - tstep, lt = lt0 + t;
            const int tm = t > 0 ? lt - 1 : lt, tp = t < S - 1 ? lt + 1 : lt;
            pr_[j][0] = raw[(size_t)tm * 1920 + c]; pr_[j][1] = raw[(size_t)lt * 1920 + c]; pr_[j][2] = raw[(size_t)tp * 1920 + c];
            pk_[j][0] = raw[(size_t)tm * 1920 + 512 + c]; pk_[j][1] = raw[(size_t)lt * 1920 + 512 + c]; pk_[j][2] = raw[(size_t)tp * 1920 + 512 + c];
            pa_[j] = aact[(size_t)lt * 512 + c]; pw_[j] = wdec[(size_t)lt * 512 + c]; pn_[j] = invn[(size_t)lt * 8 + h];
        }
#pragma unroll
        for (int j = 0; j < NV; ++j) {
            const int i = (ROWS == 32) ? (tid >> 5) : ((tid >> 6) + 8 * j), tstep = c0 + i, t = d == 0 ? tstep : S - 1 - tstep, lt = lt0 + t;
            const int tm = t > 0 ? lt - 1 : lt, tp = t < S - 1 ? lt + 1 : lt;
            pv_[j][0] = raw[(size_t)tm * 1920 + vcol]; pv_[j][1] = raw[(size_t)lt * 1920 + vcol]; pv_[j][2] = raw[(size_t)tp * 1920 + vcol];
        }
    };
    auto stage = [&](int c0, unsigned char* buf) {
        float* vec = (float*)buf; float* vbuf = (float*)(buf + 20480);
#pragma unroll
        for (int j = 0; j < 2; ++j) {
            const int i = (tid >> 6) + 8 * j, tstep = c0 + i, t = d == 0 ? tstep : S - 1 - tstep;
            const float rm = t > 0 ? (float)pr_[j][0] : 0.f, rp = t < S - 1 ? (float)pr_[j][2] : 0.f, km = t > 0 ? (float)pk_[j][0] : 0.f, kp = t < S - 1 ? (float)pk_[j][2] : 0.f;
            const float r1 = (float)pr_[j][1], k1 = (float)pk_[j][1];
            const float r = r1 + (0.5f * (rm + rp) - r1) * mu_r;
            const float k = k1 + (0.5f * (km + kp) - k1) * mu_k;
            const float kk = k * kkw * pn_[j], a = (float)pa_[j];
            vec[(0 * CH + i) * 64 + ch] = kk;
            vec[(1 * CH + i) * 64 + ch] = (float)pw_[j];
            vec[(2 * CH + i) * 64 + ch] = kk * a;
            vec[(3 * CH + i) * 64 + ch] = k * (1.0f + (a - 1.0f) * kaw);
            vec[(4 * CH + i) * 64 + ch] = r;
        }
#pragma unroll
        for (int j = 0; j < NV; ++j) {
            const int i = (ROWS == 32) ? (tid >> 5) : ((tid >> 6) + 8 * j), tstep = c0 + i, t = d == 0 ? tstep : S - 1 - tstep;
            const float vm = t > 0 ? (float)pv_[j][0] : 0.f, vp = t < S - 1 ? (float)pv_[j][2] : 0.f, v1 = (float)pv_[j][1];
            vbuf[i * 64 + vr] = v1 + (0.5f * (vm + vp) - v1) * mu_v;
        }
    };
    __syncthreads();
    prefetch(0);
    stage(0, smem);
    __syncthreads();
    const int nch = S / CH;
    for (int cix = 0; cix < nch; ++cix) {
        unsigned char* buf = smem + (cix & 1) * 32768;
        if (cix + 1 < nch) prefetch((cix + 1) * CH);
        {
            const float* vec = (const float*)buf; const float* vbuf = (const float*)(buf + 20480); float* ybuf = (float*)(buf + 24576);
            const f32x4* vp0 = (const f32x4*)(vec + q * KT);
            f32x4 nx[5][KT / 4]; float nvv;
#pragma unroll
            for (int u = 0; u < KT / 4; ++u)
#pragma unroll
                for (int a5 = 0; a5 < 5; ++a5) nx[a5][u] = vp0[a5 * CH * 16 + u];
            nvv = vbuf[row];
            float yv[CH];
#pragma unroll
            for (int i = 0; i < CH; ++i) {
                f32x2 kk2[KT / 2], w2[KT / 2], b2[KT / 2], kd2[KT / 2], r2[KT / 2];
#pragma unroll
                for (int u = 0; u < KT / 4; ++u) {
                    kk2[2 * u] = (f32x2){nx[0][u][0], nx[0][u][1]}; kk2[2 * u + 1] = (f32x2){nx[0][u][2], nx[0][u][3]};
                    w2[2 * u] = (f32x2){nx[1][u][0], nx[1][u][1]}; w2[2 * u + 1] = (f32x2){nx[1][u][2], nx[1][u][3]};
                    b2[2 * u] = (f32x2){nx[2][u][0], nx[2][u][1]}; b2[2 * u + 1] = (f32x2){nx[2][u][2], nx[2][u][3]};
                    kd2[2 * u] = (f32x2){nx[3][u][0], nx[3][u][1]}; kd2[2 * u + 1] = (f32x2){nx[3][u][2], nx[3][u][3]};
                    r2[2 * u] = (f32x2){nx[4][u][0], nx[4][u][1]}; r2[2 * u + 1] = (f32x2){nx[4][u][2], nx[4][u][3]};
                }
                const float vv = nvv;
                if (i + 1 < CH) {
#pragma unroll
                    for (int u = 0; u < KT / 4; ++u)
#pragma unroll
                        for (int a5 = 0; a5 < 5; ++a5) nx[a5][u] = vp0[(i + 1) * 16 + a5 * CH * 16 + u];
                    nvv = vbuf[(i + 1) * 64 + row];
                }
                f32x2 acc2 = s[0] * kk2[0];
#pragma unroll
                for (int j = 1; j < KT / 2; ++j) acc2 = __builtin_elementwise_fma(s[j], kk2[j], acc2);
                float sa = acc2[0] + acc2[1];
                sa += dppf<0xB1>(sa); sa += dppf<0x4E>(sa); sa += dppf<0x141>(sa);
                if (TPR == 16) sa += dppf<0x140>(sa);
                sa = -sa;
                const f32x2 sa2 = (f32x2){sa, sa}, vv2 = (f32x2){vv, vv};
                f32x2 y2 = (f32x2){0.f, 0.f};
#pragma unroll
                for (int j = 0; j < KT / 2; ++j) {
                    s[j] = __builtin_elementwise_fma(s[j], w2[j], __builtin_elementwise_fma(sa2, b2[j], vv2 * kd2[j]));
                    y2 = __builtin_elementwise_fma(s[j], r2[j], y2);
                }
                float y = y2[0] + y2[1];
                y += dppf<0xB1>(y); y += dppf<0x4E>(y);
                yv[i] = y;
            }
            if ((q & 3) == 0) {
#pragma unroll
                for (int i = 0; i < CH; ++i) ybuf[i * 128 + row * YP + (q >> 2)] = yv[i];
            }
        }
        if (cix + 1 < nch) stage((cix + 1) * CH, smem + ((cix + 1) & 1) * 32768);
        __syncthreads();
        {
            const float* ybuf = (const float*)(buf + 24576);
#pragma unroll
            for (int j = 0; j < NV; ++j) {
                const int i = (ROWS == 32) ? (tid >> 5) : ((tid >> 6) + 8 * j), rr = vr, tstep = cix * CH + i, t = d == 0 ? tstep : S - 1 - tstep;
                float y = 0.f;
#pragma unroll
                for (int p = 0; p < YP; ++p) y += ybuf[i * 128 + rr * YP + p];
                ydst[(size_t)(lt0 + t) * 512 + h * 64 + row0 + rr] = (f16)y;
            }
        }
    }
    __syncthreads();
}

__device__ __forceinline__ void finish_phase(const Ctx& C, const PV& P, int layer) {
    unsigned char* R = P.ws + WS_R;
    const f16* raw = (const f16*)(R + R_RAW); const f16* wa = (const f16*)(R + R_WA); const f16* gbuf = (const f16*)(R + R_G); const f16* yfb = (const f16*)(R + R_YFB);
    bf16_t* yr = (bf16_t*)(R + R_YB);
    const float* mu = P.inp(13) + (size_t)layer * 1920; const float* k_a = P.inp(20) + (size_t)layer * 512; const float* r_k = P.inp(21) + (size_t)layer * 512;
    const float* lg = P.inp(22) + (size_t)layer * 512; const float* lb = P.inp(23) + (size_t)layer * 512;
    const int lane = C.tid & 63, wave = C.tid >> 6, c = lane * 8;
    const int nw = C.nblk * NWV;
    for (int ltb = C.bid * NWV + wave; ltb < TP; ltb += 2 * nw) {
        f16x8_t rA[2], rB[2], rC[2], kA[2], kB[2], kC[2], vA[2], vB[2], vC[2], af[2], ab[2], gg[2], yF[2], yB[2]; float wm_[2], wp_[2]; bool ok[2];
#pragma unroll
        for (int u = 0; u < 2; ++u) {
            const int lt1 = ltb + u * nw; ok[u] = lt1 < TP; const int lt = ok[u] ? lt1 : ltb;
            const int pos = pos_of(lt), S = lt < 8192 ? 8192 : 4096;
            const size_t rm = (size_t)(pos > 0 ? lt - 1 : lt) * 1920, r0 = (size_t)lt * 1920, rp = (size_t)(pos < S - 1 ? lt + 1 : lt) * 1920;
            wm_[u] = pos > 0 ? 0.5f : 0.f; wp_[u] = pos < S - 1 ? 0.5f : 0.f;
            rA[u] = *(const f16x8_t*)(raw + rm + c); rB[u] = *(const f16x8_t*)(raw + r0 + c); rC[u] = *(const f16x8_t*)(raw + rp + c);
            kA[u] = *(const f16x8_t*)(raw + rm + 512 + c); kB[u] = *(const f16x8_t*)(raw + r0 + 512 + c); kC[u] = *(const f16x8_t*)(raw + rp + 512 + c);
            vA[u] = *(const f16x8_t*)(raw + rm + 1024 + c); vB[u] = *(const f16x8_t*)(raw + r0 + 1024 + c); vC[u] = *(const f16x8_t*)(raw + rp + 1024 + c);
            af[u] = *(const f16x8_t*)(wa + 2 * SZ512 + (size_t)lt * 512 + c); ab[u] = *(const f16x8_t*)(wa + 3 * SZ512 + (size_t)lt * 512 + c);
            gg[u] = *(const f16x8_t*)(gbuf + (size_t)lt * 512 + c);
            yF[u] = *(const f16x8_t*)(yfb + (size_t)lt * 512 + c); yB[u] = *(const f16x8_t*)(yfb + SZ512 + (size_t)lt * 512 + c);
        }
#pragma unroll
        for (int u = 0; u < 2; ++u) {
            float y[8], vv[8], bsum = 0.f, ysum = 0.f;
#pragma unroll
            for (int j = 0; j < 8; ++j) {
                const float r_ = (float)rB[u][j], k_ = (float)kB[u][j], v_ = (float)vB[u][j];
                const float r = r_ + (wm_[u] * (float)rA[u][j] + wp_[u] * (float)rC[u][j] - r_) * mu[c + j];
                const float k = k_ + (wm_[u] * (float)kA[u][j] + wp_[u] * (float)kC[u][j] - k_) * mu[512 + c + j];
                vv[j] = v_ + (wm_[u] * (float)vA[u][j] + wp_[u] * (float)vC[u][j] - v_) * mu[1024 + c + j];
                const float ka = k_a[c + j];
                const float ksum = k * (1.f + ((float)af[u][j] - 1.f) * ka) + k * (1.f + ((float)ab[u][j] - 1.f) * ka);
                bsum += r * (0.5f * ksum) * r_k[c + j];
                y[j] = (float)yF[u][j] + (float)yB[u][j]; ysum += y[j];
            }
            const float ym = red8(ysum) * (1.0f / 64.0f);
            float q = 0.f;
#pragma unroll
            for (int j = 0; j < 8; ++j) { const float dy = y[j] - ym; q += dy * dy; }
            const float rs = rsqrtf(red8(q) * (1.0f / 64.0f) + 64e-5f);
            const float bonus = red8(bsum);
            float o[8];
#pragma unroll
            for (int j = 0; j < 8; ++j) o[j] = ((y[j] - ym) * rs * lg[c + j] + lb[c + j] + bonus * vv[j]) * (float)gg[u][j];
            u32x4 w; w.x = pack2bf(o[0], o[1]); w.y = pack2bf(o[2], o[3]); w.z = pack2bf(o[4], o[5]); w.w = pack2bf(o[6], o[7]);
            if (ok[u]) *(u32x4*)(yr + (size_t)(ltb + u * nw) * 512 + c) = w;
        }
    }
}

__device__ __forceinline__ void gates_phase(const Ctx& C, const PV& P, int layer) {
    const bf16_t* hmod = (const bf16_t*)(P.ws + WS_HMOD);
    const bf16_t* Wt = wl(P, layer) + OW_WIN + (size_t)4480 * 1024;
    bf16_t* gates = (bf16_t*)(P.ws + WS_R + R_GATES);
    int pm, pn;
    for (int it = 0; tile_order(it, C.nblk, C.bid, TP / 256, 16, pm, pn); ++it) {
        f32x4 acc[2][2][4][2];
        gemm256(C, acc, hmod, Wt, 1024, pm * 256, pn * 256);
        int z2 = 0; asm volatile("" : "+s"(z2));
        const int tid2 = tid_now(C.wave_s, z2), lane = tid2 & 63, wid = tid2 >> 6, wr = wid >> 2, wc = wid & 3, fr = lane & 15, fq = lane >> 4;
#pragma unroll
        for (int ai = 0; ai < 2; ++ai)
#pragma unroll
            for (int m = 0; m < 4; ++m) {
                const int lt = pm * 256 + ai * 128 + wr * 64 + m * 16 + fr;
#pragma unroll
                for (int bj = 0; bj < 2; ++bj)
#pragma unroll
                    for (int n = 0; n < 2; ++n) {
                        const int col = pn * 256 + bj * 128 + wc * 32 + n * 16 + fq * 4;
                        const f32x4 v = acc[ai][bj][m][n];
                        u32x2 w; w.x = pack2bf(sigmoidf_(v[0]), sigmoidf_(v[1])); w.y = pack2bf(sigmoidf_(v[2]), sigmoidf_(v[3]));
                        *(u32x2*)(gates + (size_t)lt * 4096 + col) = w;
                    }
            }
    }
}
__device__ __forceinline__ void branch_phase(const Ctx& C, const PV& P, int layer) {
    unsigned char* R = P.ws + WS_R;
    const bf16_t* yb = (const bf16_t*)(R + R_YB); const bf16_t* gates = (const bf16_t*)(R + R_GATES);
    float* m32 = (float*)(R + R_M32); bf16_t* merged = (bf16_t*)(R + R_MERGED);
    const bf16_t* W = wl(P, layer) + OW_WBR;
    int pm, pn;
    for (int it = 0; tile_order(it, C.nblk, C.bid, TP / 256, 4, pm, pn); ++it) {
        for (int nb = 0; nb < 4; ++nb) {
            f32x4 acc[2][2][4][2];
            gemm256(C, acc, yb + (size_t)nb * SZ512, W + (size_t)nb * 1024 * 512, 512, pm * 256, pn * 256);
            int z2 = 0; asm volatile("" : "+s"(z2));
            const int tid2 = tid_now(C.wave_s, z2), lane = tid2 & 63, wid = tid2 >> 6, wr = wid >> 2, wc = wid & 3, fr = lane & 15, fq = lane >> 4;
#pragma unroll
            for (int ai = 0; ai < 2; ++ai)
#pragma unroll
                for (int m = 0; m < 4; ++m) {
                    const int lt = pm * 256 + ai * 128 + wr * 64 + m * 16 + fr;
#pragma unroll
                    for (int bj = 0; bj < 2; ++bj)
#pragma unroll
                        for (int n = 0; n < 2; ++n) {
                            const int col = pn * 256 + bj * 128 + wc * 32 + n * 16 + fq * 4;
                            const u32x2 gw = *(const u32x2*)(gates + (size_t)lt * 4096 + nb * 1024 + col);
                            f32x4 g; g[0] = __uint_as_float(gw.x << 16); g[1] = __uint_as_float(gw.x & 0xffff0000u); g[2] = __uint_as_float(gw.y << 16); g[3] = __uint_as_float(gw.y & 0xffff0000u);
                            f32x4 mv = g * acc[ai][bj][m][n];
                            f32x4* mp = (f32x4*)(m32 + (size_t)lt * 1024 + col);
                            if (nb > 0) mv += *mp;
                            if (nb < 3) *mp = mv;
                            else { u32x2 w; w.x = pack2bf(mv[0], mv[1]); w.y = pack2bf(mv[2], mv[3]); *(u32x2*)(merged + (size_t)lt * 1024 + col) = w; }
                        }
                    asm volatile("" ::: "memory");
                }
        }
    }
}


#define XB_TMO      128
#define XB_XCNT(j)  (256  + 64 * (j))
#define XB_XSUB(j)  (1280 + 64 * (j))
#define XB_XGEN(j)  (2304 + 64 * (j))
#define XB_TOP      3328
#define XB_TOPGEN   3392
#define XCD_BAR_WORDS 3456
#define XB_SPIN_CAP (1u << 21)
#define LAS __attribute__((address_space(3)))
__device__ __forceinline__ unsigned xb_ld(unsigned* p)              { return __hip_atomic_load(p, __ATOMIC_RELAXED, __HIP_MEMORY_SCOPE_AGENT); }
__device__ __forceinline__ unsigned xb_add(unsigned* p, unsigned v) { return __hip_atomic_fetch_add(p, v, __ATOMIC_RELAXED, __HIP_MEMORY_SCOPE_AGENT); }
__device__ __forceinline__ unsigned xb_xcc_id() { return (unsigned)__builtin_amdgcn_s_getreg((3 << 11) | 20) & 0xFu; }
#define XB_SPIN(cond, bar) do { unsigned _sp = 0; while (cond) { __builtin_amdgcn_s_sleep(1); \
    if ((++_sp & 255u) == 0u) { if (xb_ld(&(bar)[XB_TMO])) break; if (_sp > XB_SPIN_CAP) { atomicAdd(&(bar)[XB_TMO], 1u); break; } } } } while (0)
struct XcdBarrier { unsigned* bar; unsigned x; volatile LAS unsigned* st; };
__device__ __forceinline__ XcdBarrier xcd_barrier_post(unsigned* bar, volatile LAS unsigned* st) {
    XcdBarrier b; b.bar = bar; b.x = xb_xcc_id(); b.st = st;
    if (threadIdx.x == 0) (void)xb_add(&bar[XB_XCNT(b.x)], 1u);
    return b;
}
__device__ __forceinline__ void xcd_barrier_complete(unsigned* bar, unsigned x, unsigned& nloc, unsigned& nx) {
    const unsigned G = gridDim.x * gridDim.y * gridDim.z;
    unsigned sum, cnt, mine, sp = 0u;
    for (;;) {
        sum = 0u; cnt = 0u; mine = 0u;
#pragma unroll
        for (unsigned j = 0; j < 16; ++j) { const unsigned c = xb_ld(&bar[XB_XCNT(j)]); sum += c; cnt += (c > 0u) ? 1u : 0u; mine = (j == x) ? c : mine; }
        if (sum == G) break;
        __builtin_amdgcn_s_sleep(1);
        if ((++sp & 255u) == 0u) { if (xb_ld(&bar[XB_TMO])) break; if (sp > XB_SPIN_CAP) { atomicAdd(&bar[XB_TMO], 1u); break; } }
    }
    nloc = mine > 0u ? mine : 1u; nx = cnt > 0u ? cnt : 1u;
}
__device__ __forceinline__ void xcd_barrier(const XcdBarrier& b) {
    asm volatile("s_waitcnt vmcnt(0)" ::: "memory");
    __syncthreads();
    if (threadIdx.x == 0) {
        unsigned* bar = b.bar;
        __builtin_amdgcn_s_waitcnt(0);
        unsigned nloc = b.st[0], nx = b.st[1];
        if (nloc == 0u) { xcd_barrier_complete(bar, b.x, nloc, nx); b.st[0] = nloc; b.st[1] = nx; }
        const unsigned old = xb_add(&bar[XB_XSUB(b.x)], 1u);
        const unsigned gen = old / nloc;
        if (old + 1u == (gen + 1u) * nloc) {
            __builtin_amdgcn_fence(__ATOMIC_RELEASE, "agent");
            asm volatile("s_waitcnt vmcnt(0)" ::: "memory");
            const unsigned og = xb_add(&bar[XB_TOP], 1u);
            const unsigned tg = og / nx;
            if (og + 1u == (tg + 1u) * nx) xb_add(&bar[XB_TOPGEN], 1u);
            else XB_SPIN(xb_ld(&bar[XB_TOPGEN]) == tg, bar);
            __builtin_amdgcn_fence(__ATOMIC_ACQUIRE, "agent");
            xb_add(&bar[XB_XGEN(b.x)], 1u);
            asm volatile("s_waitcnt vmcnt(0)" ::: "memory");
        } else {
            XB_SPIN(xb_ld(&bar[XB_XGEN(b.x)]) == gen, bar);
            __builtin_amdgcn_fence(__ATOMIC_ACQUIRE, "agent");
            asm volatile("s_waitcnt vmcnt(0)" ::: "memory");
        }
    }
    __syncthreads();
}

constexpr int PH_PER_LAYER = 15, PH_PER_PASS = 2 * PH_PER_LAYER + 1, NPHASE = 1 + NPASS * PH_PER_PASS;

__global__ void __launch_bounds__(512, 2) mk_forward(Params P0, int ph_lo, int ph_hi) {
    unsigned char* smem = dyn_smem;
    const int wave_s = __builtin_amdgcn_readfirstlane((int)threadIdx.x >> 6);
    volatile LAS unsigned* xst = (volatile LAS unsigned*)(LAS unsigned char*)(dyn_smem + 131072);
    if (threadIdx.x == 0) { xst[0] = 0u; xst[1] = 0u; }
    __syncthreads();
    const XcdBarrier xb = xcd_barrier_post((unsigned*)(P0.ws + WS_BAR), xst);
    for (int it_ = 2 * ph_lo; it_ < 2 * ph_hi; ++it_) {
        const int ph = it_ >> 1;
        if (it_ & 1) {
            if (PROBE_MASK == 0 || ph == 0) continue;
            const int r_ = (ph - 1) % PH_PER_PASS;
            if (r_ == PH_PER_PASS - 1 || !((PROBE_MASK >> (r_ % PH_PER_LAYER)) & 1)) continue;
        }
        if (it_ > 2 * ph_lo) { if (it_ == 2 * ph_lo + 2) cg::this_grid().sync(); else xcd_barrier(xb); }
        int z = 0; asm volatile("" : "+s"(z));
        Ctx C; C.tid = tid_now(wave_s, z); C.bid = (int)blockIdx.x + z; C.nblk = (int)gridDim.x + z; C.wave_s = wave_s;
        ptrtab_t tab = (ptrtab_t)__builtin_amdgcn_kernarg_segment_ptr();
        asm volatile("" : "+s"(tab));
        const PV P{tab, (float*)tab[29], (unsigned char*)tab[30]};
        if (ph == 0) { prep_phase(C, P, smem); continue; }
        const int q = ph - 1, pass = q / PH_PER_PASS, r = q % PH_PER_PASS;
        if (r == PH_PER_PASS - 1) { norm_phase(C, P, pass, P.inp(6) + (size_t)(1 * 3 + 2) * 1024, P.inp(7) + (size_t)(1 * 3 + 2) * 1024, 0, -1, false, true); continue; }
        const int layer = r / PH_PER_LAYER, lp = r % PH_PER_LAYER;
        const bf16_t* W = wl(P, layer);
        const float* lng = P.inp(6) + (size_t)layer * 3 * 1024; const float* lnb = P.inp(7) + (size_t)layer * 3 * 1024;
        const float* lngp = P.inp(6) + (size_t)((layer > 0 ? layer - 1 : 0) * 3 + 2) * 1024; const float* lnbp = P.inp(7) + (size_t)((layer > 0 ? layer - 1 : 0) * 3 + 2) * 1024;
        unsigned char* R = P.ws + WS_R;
        switch (lp) {
            case 0:
                if (layer == 0) norm_phase(C, P, pass, nullptr, nullptr, 0, 0, true, false);
                else norm_phase(C, P, pass, lngp, lnbp, layer, 0, false, false);
                break;
            case 1: ffn_up_phase(C, P, W + OW_FA_IN); break;
            case 2: resid_gemm_phase(C, P, pass, (const bf16_t*)(R + R_ACT), 2816, W + OW_FA_OUT, layer, 0, 0.5f, layer == 0 ? nullptr : lngp, lnbp); break;
            case 3: norm_phase(C, P, pass, lng, lnb, layer, 1, false, false); break;
            case 4: win_phase(C, P, layer); break;
            case 5: lin_pool_phase(C, P, layer); break;
            case 6: lora_phase(C, P, layer, smem); break;
            case 7:
                if (C.bid < 32) scan_block<4>(C, P, layer, 0, C.bid >> 2, (C.bid >> 1) & 1, (C.bid & 1) * 32, smem);
                else if (C.bid < 160) { const int i2 = C.bid - 32; scan_block<8>(C, P, layer, 1 + (i2 >> 4), (i2 >> 1) & 7, i2 & 1, 0, smem); }
                attn_items(C, P, layer, pass * 2 + layer, smem); fft_items(C, P, smem); break;
            case 8: finish_phase(C, P, layer); break;
            case 9: gates_phase(C, P, layer); break;
            case 10: branch_phase(C, P, layer); break;
            case 11: resid_gemm_phase(C, P, pass, (const bf16_t*)(R + R_MERGED), 1024, W + OW_WOUT, layer, 1, 1.0f, lng, lnb); break;
            case 12: norm_phase(C, P, pass, lng + 1024, lnb + 1024, layer, 2, false, false); break;
            case 13: ffn_up_phase(C, P, W + OW_FB_IN); break;
            default: resid_gemm_phase(C, P, pass, (const bf16_t*)(R + R_ACT), 2816, W + OW_FB_OUT, layer, 2, 0.5f, lng + 1024, lnb + 1024); break;
        }
    }
}

extern "C" void kernel_launch(void* const* d_in, const int* in_sizes, int n_in, void* d_out, int out_size, void* d_ws, size_t ws_size, hipStream_t stream) {
    static int grid_blocks = 0;
    if (!grid_blocks) {
        int dev = 0, cus = 0, per_cu = 0;
        (void)hipGetDevice(&dev);
        (void)hipDeviceGetAttribute(&cus, hipDeviceAttributeMultiprocessorCount, dev);
        (void)hipFuncSetAttribute((const void*)mk_forward, hipFuncAttributeMaxDynamicSharedMemorySize, LDS_BYTES);
        (void)hipOccupancyMaxActiveBlocksPerMultiprocessor(&per_cu, mk_forward, NT, LDS_BYTES);
        if (per_cu < 1) per_cu = 1;
        if (per_cu > 1) per_cu = 1;
        grid_blocks = cus * per_cu;
    }
    Params p{};
    for (int i = 0; i < 29; ++i) p.in[i] = (const float*)d_in[i];
    p.out = (float*)d_out; p.ws = (unsigned char*)d_ws;
    (void)hipMemsetAsync((unsigned char*)d_ws + WS_BAR, 0, XCD_BAR_WORDS * 4 + 256, stream);
#if ONE_LAUNCH
    int lo = 0, hi = NPHASE;
    void* args[] = {&p, &lo, &hi};
    hipError_t e = hipLaunchCooperativeKernel((void*)mk_forward, dim3(grid_blocks), dim3(NT), args, LDS_BYTES, stream);
    if (e != hipSuccess) fprintf(stderr, "cooperative launch failed: %s (grid %d)\n", hipGetErrorString(e), grid_blocks);
#else
    for (int ph = 0; ph < NPHASE; ++ph) {
        int lo = ph, hi = ph + 1;
        void* args[] = {&p, &lo, &hi};
        (void)hipLaunchCooperativeKernel((void*)mk_forward, dim3(grid_blocks), dim3(NT), args, LDS_BYTES, stream);
    }
#endif
}
```

```cpp
#include <hip/hip_runtime.h>
#include <hip/hip_cooperative_groups.h>
#include <cstdio>
#include <cstdint>
namespace cg = cooperative_groups;

typedef unsigned short bf16_t;
typedef _Float16 f16;
typedef short bf16x8 __attribute__((ext_vector_type(8)));
typedef float f32x4 __attribute__((ext_vector_type(4)));
typedef unsigned u32x4 __attribute__((ext_vector_type(4)));
typedef unsigned u32x2 __attribute__((ext_vector_type(2)));
typedef float f32x2 __attribute__((ext_vector_type(2)));

#ifndef ONE_LAUNCH
#define ONE_LAUNCH 1
#endif
#ifndef PROBE_MASK
#define PROBE_MASK 0
#endif

constexpr int TP = 40960;
constexpr int NPASS = 2;
constexpr int NSEQ = 9;
constexpr int MT = TP / 128;
constexpr int N_IN_FULL = 8576;
constexpr float ALPHA = 1.41421356237f;

constexpr size_t OW_FA_IN = 0, OW_FA_OUT = 5767168, OW_FB_IN = 8650752, OW_FB_OUT = 14417920, OW_WIN = 17301504,
                 OW_WBR = 26083328, OW_WOUT = 28180480, OW_W2T = 29229056, OW_A2T = 29294592, OW_G2T = 29360128, WL_TOTAL = 29425664;
constexpr size_t WS_W = 0, WS_TW = 117702656, WS_MOD = 117735424, WS_HMOD = 119062528, WS_R = 202948608, WS_INVN = 1062780928, WS_STATS = 1064091904, WS_BAR = 1064419584, WS_CTR = 1064433408  ;
constexpr size_t R_RAW = 0, R_LIN = 157286400, R_WA = 188743680, R_G = 356515840, R_Q = 398458880, R_K = 440401920, R_VT = 482344960,
                 R_YFB = 524288000, R_ZC = 608174080, R_POOLP = 650117120, R_YB = 692060160, R_ACT = 0,
                 R_GATES = 0  , R_M32 = 398458880  , R_MERGED = 566231040  ;
constexpr size_t SZ512 = (size_t)TP * 512;

struct Params { const float* in[29]; float* out; unsigned char* ws; };
struct Ctx { int tid, bid, nblk, wave_s; };
__device__ __forceinline__ int tid_now(int wave_s, int z) { return wave_s * 64 + (int)__builtin_amdgcn_mbcnt_hi(~0u, __builtin_amdgcn_mbcnt_lo(~0u, (unsigned)z)); }
typedef const float* const __attribute__((address_space(4)))* ptrtab_t;
struct PV { ptrtab_t tab; float* out; unsigned char* ws;
    __device__ __forceinline__ const float* inp(int i) const { return tab[i]; } };
constexpr int NT = 512, NWV = 8;
extern __shared__ __attribute__((aligned(16))) unsigned char dyn_smem[];
constexpr int LDS_BYTES = 131072 + 64;

__device__ __forceinline__ bf16_t f2bf(float f) { unsigned u = __float_as_uint(f); u += 0x7fffu + ((u >> 16) & 1u); return (bf16_t)(u >> 16); }
__device__ __forceinline__ float bf2f(bf16_t b) { return __uint_as_float(((unsigned)b) << 16); }
__device__ __forceinline__ unsigned pack2bf(float a, float b) { unsigned r; asm("v_cvt_pk_bf16_f32 %0, %1, %2" : "=v"(r) : "v"(a), "v"(b)); return r; }
__device__ __forceinline__ float wsum(float v) {
#pragma unroll
    for (int o = 32; o > 0; o >>= 1) v += __shfl_xor(v, o);
    return v;
}
__device__ __forceinline__ float sigmoidf_(float x) { return 1.0f / (1.0f + __expf(-x)); }
template <int CTRL> __device__ __forceinline__ float dppf(float v) { return __int_as_float(__builtin_amdgcn_update_dpp(0, __float_as_int(v), CTRL, 0xF, 0xF, true)); }
__device__ __forceinline__ float red8(float v) { v += dppf<0xB1>(v); v += dppf<0x4E>(v); v += dppf<0x141>(v); return v; }

__device__ __forceinline__ int grow_of(int pass, int lt) { return lt < 8192 ? pass * 8192 + lt : 16384 + pass * 32768 + (lt - 8192); }
__device__ __forceinline__ int brow_of(int pass, int lt) { return lt < 8192 ? pass : 2 + pass * 8 + ((lt - 8192) >> 12); }
__device__ __forceinline__ int pos_of(int lt) { return lt < 8192 ? lt : ((lt - 8192) & 4095); }
__device__ __forceinline__ int seqbase_of(int sq) { return sq == 0 ? 0 : 8192 + (sq - 1) * 4096; }
__device__ __forceinline__ int seqlen_of(int sq) { return sq == 0 ? 8192 : 4096; }

__device__ __forceinline__ bf16_t* wl(const PV& P, int layer) { return (bf16_t*)(P.ws + WS_W) + (size_t)layer * WL_TOTAL; }

template <int NJ, bool SWAP>
__device__ __forceinline__ void gemm_core(const Ctx& C, f32x4 (&acc)[4][NJ], const bf16_t* __restrict__ A, int lda, const bf16_t* __restrict__ B, int ldb, int K, unsigned char* smem) {
    const int tid = C.tid & 255, lane = tid & 63, wave = tid >> 6, wm = wave >> 1, wn = wave & 1, fr = lane & 15, fq = lane >> 4;
    smem += (C.tid >> 8) * 36864;
    u32x4 ra[4], rb[NJ];
#pragma unroll
    for (int i = 0; i < 4; ++i)
#pragma unroll
        for (int j = 0; j < NJ; ++j) acc[i][j] = (f32x4){0.f, 0.f, 0.f, 0.f};
    const int lrow = tid >> 3, lkc = (tid & 7) * 8;
#pragma unroll
    for (int i = 0; i < 4; ++i) ra[i] = *(const u32x4*)(A + (size_t)(lrow + 32 * i) * lda + lkc);
#pragma unroll
    for (int i = 0; i < NJ; ++i) rb[i] = *(const u32x4*)(B + (size_t)(lrow + 32 * i) * ldb + lkc);
    for (int k0 = 0; k0 < K; k0 += 64) {
        __syncthreads();
#pragma unroll
        for (int i = 0; i < 4; ++i) *(u32x4*)(smem + (lrow + 32 * i) * 144 + lkc * 2) = ra[i];
#pragma unroll
        for (int i = 0; i < NJ; ++i) *(u32x4*)(smem + 18432 + (lrow + 32 * i) * 144 + lkc * 2) = rb[i];
        __syncthreads();
        if (k0 + 64 < K) {
#pragma unroll
            for (int i = 0; i < 4; ++i) ra[i] = *(const u32x4*)(A + (size_t)(lrow + 32 * i) * lda + k0 + 64 + lkc);
#pragma unroll
            for (int i = 0; i < NJ; ++i) rb[i] = *(const u32x4*)(B + (size_t)(lrow + 32 * i) * ldb + k0 + 64 + lkc);
        }
#pragma unroll
        for (int ks = 0; ks < 2; ++ks) {
            bf16x8 af[4], bfr[NJ];
#pragma unroll
            for (int i = 0; i < 4; ++i) af[i] = *(const bf16x8*)(smem + (wm * 64 + i * 16 + fr) * 144 + (ks * 32 + fq * 8) * 2);
#pragma unroll
            for (int j = 0; j < NJ; ++j) bfr[j] = *(const bf16x8*)(smem + 18432 + (wn * NJ * 16 + j * 16 + fr) * 144 + (ks * 32 + fq * 8) * 2);
#pragma unroll
            for (int i = 0; i < 4; ++i)
#pragma unroll
                for (int j = 0; j < NJ; ++j)
                    acc[i][j] = SWAP ? __builtin_amdgcn_mfma_f32_16x16x32_bf16(bfr[j], af[i], acc[i][j], 0, 0, 0)
                                     : __builtin_amdgcn_mfma_f32_16x16x32_bf16(af[i], bfr[j], acc[i][j], 0, 0, 0);
        }
    }
}


namespace g256 {
constexpr int BK = 64, HALF = 128, HT = HALF * BK;
__device__ __forceinline__ int lds_byte(int r, int c) { int st = (r >> 4) * 2 + (c >> 5), rr = r & 15, cc = c & 31, ob = rr * 64 + cc * 2; return st * 1024 + (ob ^ (((ob >> 9) & 1) << 5)); }
__device__ __forceinline__ void stage_rc(unsigned b, unsigned& R, unsigned& Cc) { const unsigned st = b >> 10, sb = b & 1023u, swz = sb ^ (((sb >> 9) & 1u) << 5); R = (st >> 1) * 16u + (swz >> 6); Cc = (st & 1u) * 32u + ((swz & 63u) >> 1); }
}
__device__ __forceinline__ void gemm256(const Ctx& C, f32x4 (&acc)[2][2][4][2], const bf16_t* __restrict__ A, const bf16_t* __restrict__ Bt, const int K, const int brow, const int bcol) {
    using namespace g256;
    bf16_t* shm = (bf16_t*)dyn_smem;
    const int tidx = C.tid;
    #define SA(b,h) (shm+((b)*2+(h))*HT)
    #define SB(b,h) (shm+(4+(b)*2+(h))*HT)
    #define STAGE(Pp,BASE,br,kt) do{const char* _ub=(const char*)((BASE)+(long)(br)*K+(long)(kt)*BK); asm volatile("" : "+s"(_ub)); \
        __builtin_amdgcn_global_load_lds((const unsigned*)(_ub+goff0), \
          (__attribute__((address_space(3))) unsigned*)((__attribute__((address_space(3))) char*)(Pp)+tidx*16),16,0,0); \
        __builtin_amdgcn_global_load_lds((const unsigned*)(_ub+goff1), \
          (__attribute__((address_space(3))) unsigned*)((__attribute__((address_space(3))) char*)(Pp)+tidx*16+8192),16,0,0);}while(0)
    #define LDA(dst,b,h) for(int m=0;m<4;++m)for(int k=0;k<2;++k) \
      dst[m][k]=*reinterpret_cast<const bf16x8*>(a_ptr+((b)*2+(h))*16384+m*2048+k*1024)
    #define LDB(dst,b,h) for(int n=0;n<2;++n)for(int k=0;k<2;++k) \
      dst[n][k]=*reinterpret_cast<const bf16x8*>(b_ptr+((b)*2+(h))*16384+n*2048+k*1024)
    #define MMA(ai,bj,Atx,Btx) do{__builtin_amdgcn_s_setprio(1); \
      for(int m=0;m<4;++m)for(int n=0;n<2;++n)for(int k=0;k<2;++k) \
        acc[ai][bj][m][n]=__builtin_amdgcn_mfma_f32_16x16x32_bf16(Btx[n][k],Atx[m][k],acc[ai][bj][m][n],0,0,0); \
      __builtin_amdgcn_s_setprio(0);}while(0)
    #define WAIT_V(n) asm volatile("s_waitcnt vmcnt(" #n ")":::"memory")
    #define WAIT_L(n) asm volatile("s_waitcnt lgkmcnt(" #n ")":::"memory")
    #define BAR __builtin_amdgcn_s_barrier()
    #define SCHED __builtin_amdgcn_sched_barrier(0)
    const int wid = tidx >> 6, lane = tidx & 63, wr = wid >> 2, wc = wid & 3, fr = lane & 15, fq = lane >> 4;
    const int swz = (fr * 64 + fq * 16) ^ ((fr >> 3) << 5);
    const char* a_ptr = (const char*)dyn_smem + wr * 8192 + swz;
    const char* b_ptr = (const char*)dyn_smem + 65536 + wc * 4096 + swz;
#pragma unroll
    for (int a = 0; a < 2; ++a)
#pragma unroll
        for (int b = 0; b < 2; ++b)
#pragma unroll
            for (int m = 0; m < 4; ++m) { acc[a][b][m][0] = (f32x4){0.f, 0.f, 0.f, 0.f}; acc[a][b][m][1] = (f32x4){0.f, 0.f, 0.f, 0.f}; }
    bf16x8 At[4][2], B0[2][2], B1[2][2];
    const int nt = K / BK;
    unsigned goff0, goff1;
    { unsigned r0, c0, r1, c1; stage_rc((unsigned)tidx * 16u, r0, c0); stage_rc((unsigned)tidx * 16u + 8192u, r1, c1); goff0 = (r0 * (unsigned)K + c0) * 2u; goff1 = (r1 * (unsigned)K + c1) * 2u; }
    WAIT_V(0); __syncthreads();
    STAGE(SB(0,0),Bt,bcol,0); STAGE(SA(0,0),A,brow,0);
    STAGE(SB(0,1),Bt,bcol+HALF,0); STAGE(SA(0,1),A,brow+HALF,0);
    if(wr==1)BAR;
    WAIT_V(4); BAR;
    STAGE(SB(1,0),Bt,bcol,1); STAGE(SA(1,0),A,brow,1); STAGE(SB(1,1),Bt,bcol+HALF,1);
    WAIT_V(6); BAR;
    for(int t=0;t<nt-2;t+=2){
      LDB(B0,0,0); SCHED; LDA(At,0,0); STAGE(SA(1,1),A,brow+HALF,t+1);
      WAIT_L(8); BAR; WAIT_L(0); MMA(0,0,At,B0); BAR; SCHED;
      LDB(B1,0,1); STAGE(SB(0,0),Bt,bcol,t+2);
      BAR; WAIT_L(0); MMA(0,1,At,B1); BAR;
      LDA(At,0,1); STAGE(SA(0,0),A,brow,t+2);
      BAR; WAIT_L(0); MMA(1,0,At,B0); BAR; SCHED;
      STAGE(SB(0,1),Bt,bcol+HALF,t+2);
      WAIT_V(6); BAR; MMA(1,1,At,B1); BAR;
      LDB(B0,1,0); SCHED; LDA(At,1,0); STAGE(SA(0,1),A,brow+HALF,t+2);
      WAIT_L(8); BAR; WAIT_L(0); MMA(0,0,At,B0); BAR; SCHED;
      LDB(B1,1,1); STAGE(SB(1,0),Bt,bcol,t+3);
      BAR; WAIT_L(0); MMA(0,1,At,B1); BAR;
      LDA(At,1,1); STAGE(SA(1,0),A,brow,t+3);
      BAR; WAIT_L(0); MMA(1,0,At,B0); BAR; SCHED;
      STAGE(SB(1,1),Bt,bcol+HALF,t+3);
      WAIT_V(6); BAR; MMA(1,1,At,B1); BAR;
    }
    { LDB(B0,0,0); LDA(At,0,0); STAGE(SA(1,1),A,brow+HALF,nt-1);
      BAR; WAIT_L(0); MMA(0,0,At,B0); BAR;
      LDB(B1,0,1); BAR; WAIT_L(0); MMA(0,1,At,B1); BAR;
      LDA(At,0,1); WAIT_V(4); BAR; WAIT_L(0); MMA(1,0,At,B0); MMA(1,1,At,B1); BAR; }
    { LDB(B0,1,0); LDA(At,1,0); WAIT_V(2); BAR; WAIT_L(0); MMA(0,0,At,B0); BAR;
      LDB(B1,1,1); WAIT_V(0); BAR; WAIT_L(0); MMA(0,1,At,B1); BAR;
      LDA(At,1,1); BAR; WAIT_L(0); MMA(1,0,At,B0); MMA(1,1,At,B1); BAR; }
    if(wr==0)BAR;
    #undef SA
    #undef SB
    #undef STAGE
    #undef LDA
    #undef LDB
    #undef MMA
    #undef WAIT_V
    #undef WAIT_L
    #undef BAR
    #undef SCHED
}
__device__ __forceinline__ bool tile_order(int i, int G, int c, int nM, int nN, int& pm, int& pn) {
    const int nwg = nM * nN; const long L = (long)i * G + c; if (L >= nwg) return false;
    int wgid = (int)L; { const int q = nwg / 8, r = nwg % 8, xcd = wgid % 8, off = wgid / 8; wgid = (xcd < r ? xcd * (q + 1) : r * (q + 1) + (xcd - r) * q) + off; }
    const int nig = 8 * nN, gid = wgid / nig, fm = gid * 8, gsz = (nM - fm) < 8 ? (nM - fm) : 8;
    pm = fm + ((wgid % nig) % gsz); pn = (wgid % nig) / gsz; return true;
}

struct ConvJob { const float* src; int ld, K, nbegin, ncount, map; bf16_t* dst; };
__device__ __forceinline__ ConvJob conv_job(const PV& P, int j) {
    const int l = j >> 4, q = j & 15; bf16_t* W = wl(P, l); ConvJob c; c.map = 0; c.nbegin = 0;
    switch (q) {
        case 0: c.src = P.inp(8) + (size_t)l * 1024 * 5632; c.ld = 5632; c.K = 1024; c.ncount = 5632; c.dst = W + OW_FA_IN; c.map = 1; break;
        case 1: c.src = P.inp(9) + (size_t)l * 2816 * 1024; c.ld = 1024; c.K = 2816; c.ncount = 1024; c.dst = W + OW_FA_OUT; break;
        case 2: c.src = P.inp(10) + (size_t)l * 1024 * 5632; c.ld = 5632; c.K = 1024; c.ncount = 5632; c.dst = W + OW_FB_IN; c.map = 1; break;
        case 3: c.src = P.inp(11) + (size_t)l * 2816 * 1024; c.ld = 1024; c.K = 2816; c.ncount = 1024; c.dst = W + OW_FB_OUT; break;
        case 4: c.src = P.inp(12) + (size_t)l * 1024 * 8576; c.ld = 8576; c.K = 1024; c.ncount = 3456; c.dst = W + OW_WIN; break;
        case 5: c.src = P.inp(12) + (size_t)l * 1024 * 8576; c.ld = 8576; c.K = 1024; c.nbegin = 3968; c.ncount = 4608; c.dst = W + OW_WIN + (size_t)3968 * 1024; break;
        case 6: case 7: case 8: case 9: { const int n = q - 6; c.src = P.inp(27) + (size_t)(l * 4 + n) * 512 * 1024; c.ld = 1024; c.K = 512; c.ncount = 1024; c.dst = W + OW_WBR + (size_t)n * 1024 * 512; } break;
        case 10: c.src = P.inp(28) + (size_t)l * 1024 * 1024; c.ld = 1024; c.K = 1024; c.ncount = 1024; c.dst = W + OW_WOUT; break;
        case 11: case 12: { const int d = q - 11; c.src = P.inp(15) + (size_t)(l * 2 + d) * 64 * 512; c.ld = 512; c.K = 64; c.ncount = 512; c.dst = W + OW_W2T + (size_t)d * 512 * 64; } break;
        case 13: case 14: { const int d = q - 13; c.src = P.inp(17) + (size_t)(l * 2 + d) * 64 * 512; c.ld = 512; c.K = 64; c.ncount = 512; c.dst = W + OW_A2T + (size_t)d * 512 * 64; } break;
        default: c.src = P.inp(18) + (size_t)l * 128 * 512; c.ld = 512; c.K = 128; c.ncount = 512; c.dst = W + OW_G2T; break;
    }
    return c;
}

__device__ __forceinline__ void prep_phase(const Ctx& C, const PV& P, unsigned char* smem) {
    const int tid = C.tid;
    {
        int total = 0;
        for (int j = 0; j < 32; ++j) { ConvJob c = conv_job(P, j); total += (c.K >> 6) * (c.ncount >> 6); }
        float* tile = (float*)smem;
        const int tx = tid & 63, ty = tid >> 6;
        for (int t = C.bid; t < total; t += C.nblk) {
            int tt = t, j = 0; ConvJob c = conv_job(P, 0);
            for (;;) { const int n = (c.K >> 6) * (c.ncount >> 6); if (tt < n) break; tt -= n; ++j; c = conv_job(P, j); }
            const int nkt = c.K >> 6, kt = tt % nkt, nt = tt / nkt, k0 = kt * 64, n0 = nt * 64;
            int col = c.nbegin + n0 + tx;
            if (c.map) { const int np = n0 + tx, blk = np >> 5, w = np & 31, f = blk * 16 + (w & 15); col = (w < 16) ? f : 2816 + f; }
            __syncthreads();
#pragma unroll 4
            for (int i = 0; i < 8; ++i) { const int kk = ty + 8 * i; tile[kk * 65 + tx] = c.src[(size_t)(k0 + kk) * c.ld + col]; }
            __syncthreads();
#pragma unroll 4
            for (int i = 0; i < 8; ++i) { const int nn = ty + 8 * i; c.dst[(size_t)(n0 + nn) * c.K + k0 + tx] = f2bf(tile[tx * 65 + nn]); }
        }
        __syncthreads();
    }
    {
        float* wt = (float*)smem;
        float* cosT = (float*)(smem + 64 * 129 * 4);
        for (int it = C.bid; it < 2 * 4 * 16; it += C.nblk) {
            const int l = it >> 6, g = (it >> 4) & 3, kc = it & 15, k0 = kc * 64;
            const float* src = P.inp(12) + (size_t)l * 1024 * 8576 + 3456 + g * 128;
            __syncthreads();
            for (int e = tid; e < 64 * 128; e += NT) { const int kk = e >> 7, c = e & 127; wt[kk * 129 + c] = src[(size_t)(k0 + kk) * 8576 + c]; }
            if (tid < 128) cosT[tid] = cospif((float)tid * (1.0f / 64.0f));
            __syncthreads();
            bf16_t* dst = wl(P, l) + OW_WIN + (size_t)(3456 + g * 128) * 1024;
            const int kk = tid & 63;
            for (int i = 0; i < 16; ++i) {
                const int j2 = (tid >> 6) + 8 * i, cc = j2 >> 1, part = j2 & 1;
                float s = 0.f;
                if (cc == 0) {
                    if (part == 0) { for (int c = 0; c < 128; ++c) s += wt[kk * 129 + c]; }
                    else { for (int c = 0; c < 128; ++c) s += (c & 1) ? -wt[kk * 129 + c] : wt[kk * 129 + c]; }
                } else if (part == 0) {
                    for (int c = 0; c < 128; ++c) s += wt[kk * 129 + c] * cosT[(cc * c) & 127];
                } else {
                    for (int c = 0; c < 128; ++c) s -= wt[kk * 129 + c] * cosT[(cc * c - 32) & 127];
                }
                dst[(size_t)j2 * 1024 + k0 + kk] = f2bf(s);
            }
        }
        __syncthreads();
    }
    {
        float2* tw = (float2*)(P.ws + WS_TW);
        for (int m = C.bid * NT + tid; m < 4096; m += C.nblk * NT) { const float x = (float)m * (1.0f / 4096.0f); tw[m] = make_float2(cospif(x), -sinpif(x)); }
    }
    {
        float* sc = (float*)smem;
        float* red = (float*)(smem + 18 * 512 * 4);
        float* mod = (float*)(P.ws + WS_MOD);
        for (int it = C.bid; it < 2 * 144; it += C.nblk) {
            const int l = it / 144, n0 = (it % 144) * 64, nl = tid & 63, ks = tid >> 6;
            const float* aw = P.inp(4) + (size_t)l * 1024 * 9216;
            float acc[18];
#pragma unroll
            for (int b = 0; b < 18; ++b) acc[b] = 0.f;
            for (int half = 0; half < 2; ++half) {
                __syncthreads();
                for (int e = tid; e < 18 * 512; e += NT) {
                    const int b = e >> 9, kk = e & 511, k = half * 512 + kk;
                    const float cv = b < 2 ? P.inp(2)[b * 1024 + k] : P.inp(3)[(b - 2) * 1024 + k];
                    sc[e] = cv / (1.0f + __expf(-cv));
                }
                __syncthreads();
                for (int kk = ks * 64; kk < ks * 64 + 64; ++kk) {
                    const float w = aw[(size_t)(half * 512 + kk) * 9216 + n0 + nl];
#pragma unroll
                    for (int b = 0; b < 18; ++b) acc[b] += sc[b * 512 + kk] * w;
                }
            }
            __syncthreads();
#pragma unroll
            for (int b = 0; b < 18; ++b) red[(ks * 18 + b) * 64 + nl] = acc[b];
            __syncthreads();
            for (int e = tid; e < 18 * 64; e += NT) {
                const int b = e >> 6, n = e & 63;
                float s = 0.f;
#pragma unroll
                for (int k8 = 0; k8 < 8; ++k8) s += red[(k8 * 18 + b) * 64 + n];
                mod[((size_t)l * 18 + b) * 9216 + n0 + n] = s + P.inp(5)[(size_t)l * 9216 + n0 + n];
            }
        }
        __syncthreads();
    }
}

constexpr int NR = 4;
__device__ __forceinline__ void rowstats(const f32x4 (&v)[NR][4], float (&mu)[NR], float (&rs)[NR]) {
    float s[NR], q[NR];
#pragma unroll
    for (int u = 0; u < NR; ++u) { s[u] = 0.f;
#pragma unroll
        for (int i = 0; i < 4; ++i) s[u] += (v[u][i][0] + v[u][i][1]) + (v[u][i][2] + v[u][i][3]); }
#pragma unroll
    for (int o = 32; o > 0; o >>= 1) {
#pragma unroll
        for (int u = 0; u < NR; ++u) s[u] += __shfl_xor(s[u], o);
    }
#pragma unroll
    for (int u = 0; u < NR; ++u) { mu[u] = s[u] * (1.0f / 1024.0f); q[u] = 0.f;
#pragma unroll
        for (int i = 0; i < 4; ++i) { const f32x4 dd = v[u][i] - mu[u]; q[u] += (dd[0] * dd[0] + dd[1] * dd[1]) + (dd[2] * dd[2] + dd[3] * dd[3]); } }
#pragma unroll
    for (int o = 32; o > 0; o >>= 1) {
#pragma unroll
        for (int u = 0; u < NR; ++u) q[u] += __shfl_xor(q[u], o);
    }
#pragma unroll
    for (int u = 0; u < NR; ++u) rs[u] = rsqrtf(q[u] * (1.0f / 1024.0f) + 1e-5f);
}
__device__ __forceinline__ void norm_phase(const Ctx& C, const PV& P, int pass, const float* lng, const float* lnb, int mod_layer, int j, bool from_input, bool write_x) {
    const int lane = C.tid & 63, wave = C.tid >> 6;
    bf16_t* hmod = (bf16_t*)(P.ws + WS_HMOD);
    const float* mod = (const float*)(P.ws + WS_MOD);
    const int nw = C.nblk * NWV;
    for (int lt0 = C.bid * NWV + wave; lt0 < TP; lt0 += NR * nw) {
        f32x4 v[NR][4]; int gr[NR], bb[NR]; bool ok[NR];
#pragma unroll
        for (int u = 0; u < NR; ++u) {
            const int lt = lt0 + u * nw; ok[u] = lt < TP;
            const int ltc = ok[u] ? lt : lt0;
            gr[u] = grow_of(pass, ltc); bb[u] = brow_of(pass, ltc);
            const float* src = from_input ? (gr[u] < 16384 ? P.inp(0) + (size_t)gr[u] * 1024 : P.inp(1) + (size_t)(gr[u] - 16384) * 1024) : P.out + (size_t)gr[u] * 1024;
#pragma unroll
            for (int i = 0; i < 4; ++i) v[u][i] = *(const f32x4*)(src + i * 256 + lane * 4);
        }
        float mu[NR], rs[NR];
        if (lng) {
            rowstats(v, mu, rs);
#pragma unroll
            for (int u = 0; u < NR; ++u)
                if (ok[u] && lane == 0) *(f32x2*)(P.ws + WS_STATS + (size_t)(lt0 + u * nw) * 8) = (f32x2){mu[u], rs[u]};
#pragma unroll
            for (int i = 0; i < 4; ++i) {
                const f32x4 g = *(const f32x4*)(lng + i * 256 + lane * 4), be = *(const f32x4*)(lnb + i * 256 + lane * 4);
#pragma unroll
                for (int u = 0; u < NR; ++u) v[u][i] = (v[u][i] - mu[u]) * rs[u] * g + be;
            }
        }
        if (write_x) {
#pragma unroll
            for (int u = 0; u < NR; ++u) if (ok[u]) {
#pragma unroll
                for (int i = 0; i < 4; ++i) *(f32x4*)(P.out + (size_t)gr[u] * 1024 + i * 256 + lane * 4) = v[u][i];
            }
        }
        if (j >= 0) {
            rowstats(v, mu, rs);
#pragma unroll
            for (int u = 0; u < NR; ++u) {
                if (!ok[u]) continue;
                const float* mb = mod + ((size_t)mod_layer * 18 + bb[u]) * 9216 + (size_t)(3 * j) * 1024;
                const int lt = lt0 + u * nw;
#pragma unroll
                for (int i = 0; i < 4; ++i) {
                    const f32x4 sh = *(const f32x4*)(mb + i * 256 + lane * 4), scl = *(const f32x4*)(mb + 1024 + i * 256 + lane * 4);
                    const f32x4 hh = (v[u][i] - mu[u]) * rs[u] * (1.0f + scl) + sh;
                    u32x2 o; o.x = pack2bf(hh[0], hh[1]); o.y = pack2bf(hh[2], hh[3]);
                    *(u32x2*)(hmod + (size_t)lt * 1024 + i * 256 + lane * 4) = o;
                }
            }
        }
    }
}

__device__ __forceinline__ void ffn_up_phase(const Ctx& C, const PV& P, const bf16_t* Wt) {
    const bf16_t* hmod = (const bf16_t*)(P.ws + WS_HMOD);
    bf16_t* act = (bf16_t*)(P.ws + WS_R + R_ACT);
    int pm, pn;
    for (int it = 0; tile_order(it, C.nblk, C.bid, TP / 256, 22, pm, pn); ++it) {
        f32x4 acc[2][2][4][2];
        gemm256(C, acc, hmod, Wt, 1024, pm * 256, pn * 256);
        int z2 = 0; asm volatile("" : "+s"(z2));
        const int tid2 = tid_now(C.wave_s, z2), lane = tid2 & 63, wid = tid2 >> 6, wr = wid >> 2, wc = wid & 3, fr = lane & 15, fq = lane >> 4;
#pragma unroll
        for (int ai = 0; ai < 2; ++ai)
#pragma unroll
            for (int m = 0; m < 4; ++m) {
                const int row = pm * 256 + ai * 128 + wr * 64 + m * 16 + fr;
#pragma unroll
                for (int bj = 0; bj < 2; ++bj) {
                    const int colbase = pn * 256 + bj * 128 + wc * 32, f = (colbase >> 5) * 16 + fq * 4;
                    const f32x4 a = acc[ai][bj][m][0], bb = acc[ai][bj][m][1];
                    float o[4];
#pragma unroll
                    for (int r = 0; r < 4; ++r) o[r] = a[r] / (1.0f + __expf(-a[r])) * bb[r];
                    u32x2 w; w.x = pack2bf(o[0], o[1]); w.y = pack2bf(o[2], o[3]);
                    *(u32x2*)(act + (size_t)row * 2816 + f) = w;
                }
            }
    }
}

__device__ __forceinline__ void resid_gemm_phase(const Ctx& C, const PV& P, int pass, const bf16_t* A, int K, const bf16_t* Wt, int layer, int j, float scale, const float* xg, const float* xb) {
    const float* mod = (const float*)(P.ws + WS_MOD);
    int pm, pn;
    for (int it = 0; tile_order(it, C.nblk, C.bid, TP / 256, 4, pm, pn); ++it) {
        f32x4 acc[2][2][4][2];
        gemm256(C, acc, A, Wt, K, pm * 256, pn * 256);
        int z2 = 0; asm volatile("" : "+s"(z2));
        const int tid2 = tid_now(C.wave_s, z2), lane = tid2 & 63, wid = tid2 >> 6, wr = wid >> 2, wc = wid & 3, fr = lane & 15, fq = lane >> 4;
#pragma unroll
        for (int ai = 0; ai < 2; ++ai)
#pragma unroll
            for (int m = 0; m < 4; ++m) {
                const int lt = pm * 256 + ai * 128 + wr * 64 + m * 16 + fr;
                const int gr = grow_of(pass, lt), b = brow_of(pass, lt);
                const float* gate = mod + ((size_t)layer * 18 + b) * 9216 + (size_t)(3 * j + 2) * 1024;
                const float* xsrc = xg ? P.out + (size_t)gr * 1024 : (gr < 16384 ? P.inp(0) + (size_t)gr * 1024 : P.inp(1) + (size_t)(gr - 16384) * 1024);
                f32x2 st = (f32x2){0.f, 1.f};
                if (xg) st = *(const f32x2*)(P.ws + WS_STATS + (size_t)lt * 8);
#pragma unroll
                for (int bj = 0; bj < 2; ++bj)
#pragma unroll
                    for (int n = 0; n < 2; ++n) {
                        const int col = pn * 256 + bj * 128 + wc * 32 + n * 16 + fq * 4;
                        f32x4 x = *(const f32x4*)(xsrc + col);
                        if (xg) x = (x - st[0]) * st[1] * *(const f32x4*)(xg + col) + *(const f32x4*)(xb + col);
                        const f32x4 g = *(const f32x4*)(gate + col);
                        *(f32x4*)(P.out + (size_t)gr * 1024 + col) = ALPHA * x + (1.0f + g) * scale * acc[ai][bj][m][n];
                    }
                asm volatile("" ::: "memory");
            }
    }
}

__device__ __forceinline__ void win_phase(const Ctx& C, const PV& P, int layer) {
    const bf16_t* hmod = (const bf16_t*)(P.ws + WS_HMOD);
    const bf16_t* Wt = wl(P, layer) + OW_WIN;
    unsigned char* R = P.ws + WS_R;
    f16* raw = (f16*)(R + R_RAW); bf16_t* Qb = (bf16_t*)(R + R_Q); bf16_t* Kb = (bf16_t*)(R + R_K); bf16_t* Vt = (bf16_t*)(R + R_VT);
    f16* Zc = (f16*)(R + R_ZC); f16* poolp = (f16*)(R + R_POOLP);
    typedef f16 f16x4 __attribute__((ext_vector_type(4)));
    typedef f16 f16x2 __attribute__((ext_vector_type(2)));
    int pm, pn;
    for (int it = 0; tile_order(it, C.nblk, C.bid, TP / 256, 18, pm, pn); ++it) {
        const int lt_t = pm * 256, sq = lt_t < 8192 ? 0 : 1 + ((lt_t - 8192) >> 12), lt0 = seqbase_of(sq), S = seqlen_of(sq);
        f32x4 acc[2][2][4][2];
        gemm256(C, acc, hmod, Wt, 1024, pm * 256, pn * 256);
        int z2 = 0; asm volatile("" : "+s"(z2));
        const int tid2 = tid_now(C.wave_s, z2), lane = tid2 & 63, wid = tid2 >> 6, wr = wid >> 2, wc = wid & 3, fr = lane & 15, fq = lane >> 4;
#pragma unroll
        for (int bj = 0; bj < 2; ++bj) {
            const int tn = pn * 2 + bj;
            if (tn >= 35) continue;
#pragma unroll
            for (int ai = 0; ai < 2; ++ai)
#pragma unroll
                for (int m = 0; m < 4; ++m) {
                    const int lt = pm * 256 + ai * 128 + wr * 64 + m * 16 + fr, pos = lt - lt0;
#pragma unroll
                    for (int n = 0; n < 2; ++n) {
                        const int col = tn * 128 + wc * 32 + n * 16 + fq * 4;
                        f32x4 v = acc[ai][bj][m][n];
                        if (tn < 15) {
                            f16x4 h; h[0] = (f16)v[0]; h[1] = (f16)v[1]; h[2] = (f16)v[2]; h[3] = (f16)v[3];
                            *(f16x4*)(raw + (size_t)lt * 1920 + col) = h;
                        } else if (tn < 23) {
                            const int nq = (col - 1920) & 511, hc = nq >> 6, d = nq & 63;
                            if (n == 0 && (wc & 1) == 0) {
#pragma unroll
                                for (int r = 0; r < 4; ++r) {
                                    const float invlo = r == 0 ? 1.0f : r == 1 ? 0.1939227432012558f : r == 2 ? 0.03760603070259094f : 0.007292664609849453f;
                                    const float invhi = r == 0 ? 0.0014142135623842478f : r == 1 ? 0.00027424818836152554f : r == 2 ? 5.3182957344688475e-05f : 1.0313385246263351e-05f;
                                    const float ang = (float)pos * ((fq & 1) ? invhi : invlo);
                                    const float hi = ang * 0.15915493667125702f;
                                    const float lo = __builtin_fmaf(ang, 0.15915493667125702f, -hi) + ang * 6.4206382432985265e-09f;
                                    const float rr = (hi - floorf(hi)) + lo;
                                    const float cs = __builtin_amdgcn_cosf(rr), sn = __builtin_amdgcn_sinf(rr);
                                    const float other = __shfl_xor(v[r], 32);
                                    v[r] = (fq < 2) ? (v[r] * cs - other * sn) : (other * sn + v[r] * cs);
                                }
                            }
                            bf16_t* dst = (tn < 19) ? Qb : Kb;
                            const float sc = (tn < 19) ? 0.125f * 1.44269504088896f : 1.0f;
                            u32x2 w; w.x = pack2bf(v[0] * sc, v[1] * sc); w.y = pack2bf(v[2] * sc, v[3] * sc);
                            *(u32x2*)(dst + (size_t)lt0 * 512 + ((size_t)hc * S + pos) * 64 + d) = w;
                        } else if (tn < 27) {
                            const int nv = col - 2944;
                            bf16_t* vb = Vt + (size_t)lt0 * 512 + (size_t)nv * S + pos;
                            vb[0] = f2bf(v[0]); vb[(size_t)S] = f2bf(v[1]); vb[(size_t)2 * S] = f2bf(v[2]); vb[(size_t)3 * S] = f2bf(v[3]);
                        } else if (tn < 31) {
                            const int nz = col - 3456, g = nz >> 7, cc = (nz & 127) >> 1;
                            f16x2 z0, z1; z0[0] = (f16)v[0]; z0[1] = (f16)v[1]; z1[0] = (f16)v[2]; z1[1] = (f16)v[3];
                            f16x2* zb = (f16x2*)Zc + (size_t)lt0 * 256;
                            zb[(size_t)(g * 64 + cc) * S + pos] = z0;
                            zb[(size_t)(g * 64 + cc + 1) * S + pos] = z1;
                        } else {
                            f16x4 h; h[0] = (f16)v[0]; h[1] = (f16)v[1]; h[2] = (f16)v[2]; h[3] = (f16)v[3];
                            *(f16x4*)(poolp + (size_t)lt * 512 + (col - 3968)) = h;
                        }
                    }
                    asm volatile("" ::: "memory");
                }
        }
    }
}

__device__ __forceinline__ float shiftv(const f16* __restrict__ raw, int lt, int t, int S, int col, float mu) {
    const float p = (float)raw[(size_t)lt * 1920 + col];
    const float pr = t > 0 ? (float)raw[(size_t)(lt - 1) * 1920 + col] : 0.f;
    const float nx = t < S - 1 ? (float)raw[(size_t)(lt + 1) * 1920 + col] : 0.f;
    return p + (0.5f * (pr + nx) - p) * mu;
}

typedef f16 f16x4_t __attribute__((ext_vector_type(4)));
typedef f16 f16x8_t __attribute__((ext_vector_type(8)));
__device__ __forceinline__ void lin_pool_phase(const Ctx& C, const PV& P, int layer) {
    unsigned char* R = P.ws + WS_R;
    const f16* raw = (const f16*)(R + R_RAW); bf16_t* lin = (bf16_t*)(R + R_LIN);
    const f16* poolp = (const f16*)(R + R_POOLP); bf16_t* ypool = (bf16_t*)(R + R_YB) + 3 * SZ512;
    const float* mu = P.inp(13) + (size_t)layer * 1920; const float* pscale = P.inp(26) + (size_t)layer * 512;
    const int gsz = C.nblk * NT, gid = C.bid * NT + C.tid;
    for (int e0 = gid; e0 < TP * 96; e0 += 2 * gsz) {
        f16x4_t p0[2], pm[2], pp[2]; f32x4 m4[2]; int lt_[2], c_[2]; float wm_[2], wp_[2]; bool ok[2];
#pragma unroll
        for (int u = 0; u < 2; ++u) {
            const int e1 = e0 + u * gsz; ok[u] = e1 < TP * 96; const int e = ok[u] ? e1 : e0;
            const int lt = e / 96, c = (e % 96) * 4, col = 1536 + c;
            const int pos = pos_of(lt), S = lt < 8192 ? 8192 : 4096;
            lt_[u] = lt; c_[u] = c; wm_[u] = pos > 0 ? 0.5f : 0.f; wp_[u] = pos < S - 1 ? 0.5f : 0.f;
            p0[u] = *(const f16x4_t*)(raw + (size_t)lt * 1920 + col);
            pm[u] = *(const f16x4_t*)(raw + (size_t)(pos > 0 ? lt - 1 : lt) * 1920 + col);
            pp[u] = *(const f16x4_t*)(raw + (size_t)(pos < S - 1 ? lt + 1 : lt) * 1920 + col);
            m4[u] = *(const f32x4*)(mu + col);
        }
#pragma unroll
        for (int u = 0; u < 2; ++u) {
            float o[4];
#pragma unroll
            for (int r = 0; r < 4; ++r) {
                const float p = (float)p0[u][r];
                float v = p + (wm_[u] * (float)pm[u][r] + wp_[u] * (float)pp[u][r] - p) * m4[u][r];
                if (c_[u] < 128) v = 1.0f - 2.0f / (__expf(2.0f * v) + 1.0f);
                else if (c_[u] >= 256) v = sigmoidf_(v);
                o[r] = v;
            }
            u32x2 w; w.x = pack2bf(o[0], o[1]); w.y = pack2bf(o[2], o[3]);
            if (ok[u]) *(u32x2*)(lin + (size_t)lt_[u] * 384 + c_[u]) = w;
        }
    }
    for (int e0 = gid; e0 < TP * 128; e0 += 2 * gsz) {
        f16x4_t tv[2][16], xv[2]; int lt_[2], c_[2], cnt_[2]; bool ok[2];
#pragma unroll
        for (int u = 0; u < 2; ++u) {
            const int e1 = e0 + u * gsz; ok[u] = e1 < TP * 128; const int e = ok[u] ? e1 : e0;
            const int lt = e >> 7, c = (e & 127) * 4, g = c >> 7, half = 1 << g;
            const int pos = pos_of(lt), S = lt < 8192 ? 8192 : 4096;
            const int lo = max(pos - half, 0), hi = min(pos + half, S);
            lt_[u] = lt; c_[u] = c; cnt_[u] = hi - lo;
            const f16* base = poolp + (size_t)(lt - pos) * 512 + c;
#pragma unroll
            for (int o = -8; o < 8; ++o) {
                const int tt = pos + o;
                const bool in = (o >= -half) && (o < half) && tt >= 0 && tt < S;
                f16x4_t z; z[0] = (f16)0.f; z[1] = (f16)0.f; z[2] = (f16)0.f; z[3] = (f16)0.f;
                tv[u][o + 8] = in ? *(const f16x4_t*)(base + (size_t)tt * 512) : z;
            }
            xv[u] = *(const f16x4_t*)(base + (size_t)pos * 512);
        }
#pragma unroll
        for (int u = 0; u < 2; ++u) {
            float s0 = 0.f, s1 = 0.f, s2 = 0.f, s3 = 0.f;
#pragma unroll
            for (int o = 0; o < 16; ++o) { s0 += (float)tv[u][o][0]; s1 += (float)tv[u][o][1]; s2 += (float)tv[u][o][2]; s3 += (float)tv[u][o][3]; }
            const f32x4 ps = *(const f32x4*)(pscale + c_[u]);
            const float ic = 1.0f / (float)cnt_[u];
            u32x2 w; w.x = pack2bf((s0 * ic - (float)xv[u][0]) * ps[0], (s1 * ic - (float)xv[u][1]) * ps[1]); w.y = pack2bf((s2 * ic - (float)xv[u][2]) * ps[2], (s3 * ic - (float)xv[u][3]) * ps[3]);
            if (ok[u]) *(u32x2*)(ypool + (size_t)lt_[u] * 512 + c_[u]) = w;
        }
    }
    {
        float* invn = (float*)(P.ws + WS_INVN);
        const float* k_k = P.inp(19) + (size_t)layer * 512;
        const int lane = C.tid & 63, wave = C.tid >> 6;
        for (int lt = C.bid * NWV + wave; lt < TP; lt += C.nblk * NWV) {
            const int pos = pos_of(lt), S = lt < 8192 ? 8192 : 4096;
            float ss[8];
#pragma unroll
            for (int h = 0; h < 8; ++h) {
                const int c = h * 64 + lane;
                const float k = shiftv(raw, lt, pos, S, 512 + c, mu[512 + c]) * k_k[c];
                ss[h] = k * k;
            }
#pragma unroll
            for (int h = 0; h < 8; ++h) ss[h] = wsum(ss[h]);
            if (lane < 8) {
                float sel = ss[0];
#pragma unroll
                for (int h = 1; h < 8; ++h) sel = lane == h ? ss[h] : sel;
                invn[(size_t)lt * 8 + lane] = 1.0f / fmaxf(sqrtf(sel), 1e-12f);
            }
        }
    }
}

__device__ __forceinline__ void lora_phase(const Ctx& C, const PV& P, int layer, unsigned char* smem) {
    unsigned char* R = P.ws + WS_R;
    const bf16_t* lin = (const bf16_t*)(R + R_LIN); f16* wa = (f16*)(R + R_WA); f16* gbuf = (f16*)(R + R_G);
    const bf16_t* W = wl(P, layer);
    const int lane = C.tid & 63, wave = (C.tid >> 6) & 3, wm = wave >> 1, wn = wave & 1, fr = lane & 15, fq = lane >> 4;
    for (int t2 = C.bid; t2 < 5 * MT * 2; t2 += C.nblk) {
        const int t = t2 * 2 + (C.tid >> 8);
        const int which = t / (MT * 4), tt = t % (MT * 4), tm = tt >> 2, tn = tt & 3;
        const bf16_t* Bt; int K, acol; const float* bias = nullptr; f16* dst;
        if (which < 2) { Bt = W + OW_W2T + (size_t)which * 512 * 64; K = 64; acol = which * 64; bias = P.inp(14) + (size_t)(layer * 2 + which) * 512; dst = wa + (size_t)which * SZ512; }
        else if (which < 4) { const int d = which - 2; Bt = W + OW_A2T + (size_t)d * 512 * 64; K = 64; acol = 128 + d * 64; bias = P.inp(16) + (size_t)(layer * 2 + d) * 512; dst = wa + (size_t)which * SZ512; }
        else { Bt = W + OW_G2T; K = 128; acol = 256; dst = gbuf; }
        f32x4 acc[4][4];
        gemm_core<4, true>(C, acc, lin + (size_t)tm * 128 * 384 + acol, 384, Bt + (size_t)tn * 128 * K, K, K, smem);
#pragma unroll
        for (int i = 0; i < 4; ++i) {
            const int lt = tm * 128 + wm * 64 + i * 16 + fr;
#pragma unroll
            for (int jn = 0; jn < 4; ++jn) {
                const int n = tn * 128 + wn * 64 + jn * 16 + fq * 4;
                typedef f16 f16x4 __attribute__((ext_vector_type(4)));
                f16x4 h;
#pragma unroll
                for (int r = 0; r < 4; ++r) {
                    float v = acc[i][jn][r];
                    if (which < 2) {
                        const float z = bias[n + r] + v;
                        v = __expf(-0.6065306597126334f * sigmoidf_(z));
                    } else if (which < 4) { v = sigmoidf_(bias[n + r] + v); }
                    h[r] = (f16)v;
                }
                *(f16x4*)(dst + (size_t)lt * 512 + n) = h;
            }
        }
    }
}

__device__ __forceinline__ void attn_items(const Ctx& C, const PV& P, int layer, int ctr_idx, unsigned char* smem) {
    unsigned char* R = P.ws + WS_R;
    const bf16_t* Qall = (const bf16_t*)(R + R_Q); const bf16_t* Kall = (const bf16_t*)(R + R_K); const bf16_t* Vall = (const bf16_t*)(R + R_VT);
    bf16_t* ydiff = (bf16_t*)(R + R_YB) + 1 * SZ512;
    const int tid = C.tid, lane = tid & 63, wave = tid >> 6, comp = wave & 1, rg = wave >> 1, fr = lane & 15, fq = lane >> 4;
    const float lam_init = layer == 0 ? 0.2f : (0.8f - 0.6f * 0.7408182206817179f);
    float lam_full;
    {
        const float* lm = P.inp(24) + (size_t)layer * 256;
        float s1 = 0.f, s2 = 0.f;
        for (int i = 0; i < 64; ++i) { s1 += lm[i] * lm[64 + i]; s2 += lm[128 + i] * lm[192 + i]; }
        lam_full = expf(s1) - expf(s2) + lam_init;
    }
    const float* normg = P.inp(25) + (size_t)layer * 128;
    unsigned* ctr = (unsigned*)(P.ws + WS_CTR) + ctr_idx * 16;
    volatile unsigned* bc = (volatile unsigned*)(smem + 131088);
    for (;;) {
        __syncthreads();
        if (tid == 0) *bc = atomicAdd(ctr, 1u);
        __syncthreads();
        const int item = (int)*bc;
        if (item >= 1280) break;
        int sq, h, qb;
        if (item < 256) { sq = 0; h = item >> 6; qb = item & 63; } else { const int i2 = item - 256; sq = 1 + (i2 >> 7); h = (i2 >> 5) & 3; qb = i2 & 31; }
        const int lt0 = seqbase_of(sq), S = seqlen_of(sq);
        const bf16_t* Qb = Qall + (size_t)lt0 * 512; const bf16_t* Kb = Kall + (size_t)lt0 * 512; const bf16_t* Vb = Vall + (size_t)lt0 * 512 + (size_t)h * 128 * S;
        const int q0 = qb * 128 + rg * 32;
        bf16x8 bq[2][2];
#pragma unroll
        for (int qs = 0; qs < 2; ++qs)
#pragma unroll
            for (int ks = 0; ks < 2; ++ks) bq[qs][ks] = *(const bf16x8*)(Qb + ((size_t)(h * 2 + comp) * S + q0 + qs * 16 + fr) * 64 + ks * 32 + fq * 8);
        float m_run[2] = {-1e30f, -1e30f}, l_run[2] = {0.f, 0.f};
        f32x4 O[8][2];
#pragma unroll
        for (int a = 0; a < 8; ++a) { O[a][0] = (f32x4){0.f, 0.f, 0.f, 0.f}; O[a][1] = (f32x4){0.f, 0.f, 0.f, 0.f}; }
        u32x4 rk[2], rv[2];
        const int lrow = tid >> 3, lkc = (tid & 7) * 8;
        auto gload = [&](int kt0) {
#pragma unroll
            for (int i = 0; i < 2; ++i) {
                const int row = lrow + 64 * i, cm = row >> 6, key = row & 63;
                rk[i] = *(const u32x4*)(Kb + ((size_t)(h * 2 + cm) * S + kt0 + key) * 64 + lkc);
                rv[i] = *(const u32x4*)(Vb + (size_t)row * S + kt0 + lkc);
            }
        };
        auto lstore = [&](int b) {
            unsigned char* sb = smem + b * 36864;
#pragma unroll
            for (int i = 0; i < 2; ++i) {
                const int row = lrow + 64 * i;
                *(u32x4*)(sb + row * 144 + lkc * 2) = rk[i];
                *(u32x4*)(sb + 18432 + row * 144 + lkc * 2) = rv[i];
            }
        };
        bf16x8 pb[2][2];
        auto H1 = [&](int b) {
            const unsigned char* sb = smem + b * 36864;
            f32x4 st[4][2];
#pragma unroll
            for (int t = 0; t < 4; ++t) {
                st[t][0] = (f32x4){0.f, 0.f, 0.f, 0.f}; st[t][1] = (f32x4){0.f, 0.f, 0.f, 0.f};
#pragma unroll
                for (int ks = 0; ks < 2; ++ks) {
                    const bf16x8 kf = *(const bf16x8*)(sb + (comp * 64 + t * 16 + fr) * 144 + (ks * 32 + fq * 8) * 2);
                    st[t][0] = __builtin_amdgcn_mfma_f32_16x16x32_bf16(kf, bq[0][ks], st[t][0], 0, 0, 0);
                    st[t][1] = __builtin_amdgcn_mfma_f32_16x16x32_bf16(kf, bq[1][ks], st[t][1], 0, 0, 0);
                }
            }
#pragma unroll
            for (int qs = 0; qs < 2; ++qs) {
                float mx = -1e30f;
#pragma unroll
                for (int t = 0; t < 4; ++t)
#pragma unroll
                    for (int r = 0; r < 4; ++r) mx = fmaxf(mx, st[t][qs][r]);
                mx = fmaxf(mx, __shfl_xor(mx, 16)); mx = fmaxf(mx, __shfl_xor(mx, 32));
                const float mnew = fmaxf(m_run[qs], mx);
                const float alpha = __builtin_amdgcn_exp2f(m_run[qs] - mnew);
                m_run[qs] = mnew;
                float ls = 0.f;
                float pv[4][4];
#pragma unroll
                for (int t = 0; t < 4; ++t)
#pragma unroll
                    for (int r = 0; r < 4; ++r) { pv[t][r] = __builtin_amdgcn_exp2f(st[t][qs][r] - mnew); ls += pv[t][r]; }
                l_run[qs] = l_run[qs] * alpha + ls;
                if (__builtin_amdgcn_ballot_w64(alpha != 1.0f) != 0ull) {
#pragma unroll
                    for (int a = 0; a < 8; ++a) O[a][qs] = O[a][qs] * alpha;
                }
#pragma unroll
                for (int u = 0; u < 2; ++u) {
                    union { bf16x8 v; unsigned w[4]; } pk;
                    pk.w[0] = pack2bf(pv[2 * u][0], pv[2 * u][1]); pk.w[1] = pack2bf(pv[2 * u][2], pv[2 * u][3]);
                    pk.w[2] = pack2bf(pv[2 * u + 1][0], pv[2 * u + 1][1]); pk.w[3] = pack2bf(pv[2 * u + 1][2], pv[2 * u + 1][3]);
                    pb[qs][u] = pk.v;
                }
            }
        };
        auto H2 = [&](int b) {
            const unsigned char* sb = smem + b * 36864 + 18432;
#pragma unroll
            for (int u = 0; u < 2; ++u)
#pragma unroll
                for (int a = 0; a < 8; ++a) {
                    union { bf16x8 v; u32x2 h[2]; } vf;
                    vf.h[0] = *(const u32x2*)(sb + (a * 16 + fr) * 144 + (u * 32 + fq * 4) * 2);
                    vf.h[1] = *(const u32x2*)(sb + (a * 16 + fr) * 144 + (u * 32 + 16 + fq * 4) * 2);
                    O[a][0] = __builtin_amdgcn_mfma_f32_16x16x32_bf16(vf.v, pb[0][u], O[a][0], 0, 0, 0);
                    O[a][1] = __builtin_amdgcn_mfma_f32_16x16x32_bf16(vf.v, pb[1][u], O[a][1], 0, 0, 0);
                }
        };
        const int grp = wave >> 2, T = S >> 6;
        gload(0);
        lstore(0);
        __syncthreads();
        for (int t = 0; t < T; ++t) {
            if (t + 1 < T) gload((t + 1) * 64);
            if (grp == 0) H1(t & 1); else if (t > 0) H2((t - 1) & 1);
            __syncthreads();
            if (t + 1 < T) lstore((t + 1) & 1);
            if (grp == 0) H2(t & 1); else H1(t & 1);
            __syncthreads();
        }
        if (grp == 1) H2((T - 1) & 1);
#pragma unroll
        for (int qs = 0; qs < 2; ++qs) {
            float l = l_run[qs]; l += __shfl_xor(l, 16); l += __shfl_xor(l, 32);
            const float inv = 1.0f / l;
#pragma unroll
            for (int a = 0; a < 8; ++a) O[a][qs] = O[a][qs] * inv;
        }
        __syncthreads();
        float* Ox = (float*)smem;
        if (comp == 1) {
#pragma unroll
            for (int qs = 0; qs < 2; ++qs)
#pragma unroll
                for (int a = 0; a < 8; ++a)
#pragma unroll
                    for (int r = 0; r < 4; ++r) Ox[(rg * 128 + a * 16 + fq * 4 + r) * 32 + qs * 16 + fr] = O[a][qs][r];
        }
        __syncthreads();
        if (comp == 0) {
#pragma unroll
            for (int qs = 0; qs < 2; ++qs) {
                float ss = 0.f;
#pragma unroll
                for (int a = 0; a < 8; ++a)
#pragma unroll
                    for (int r = 0; r < 4; ++r) {
                        const float o = O[a][qs][r] - lam_full * Ox[(rg * 128 + a * 16 + fq * 4 + r) * 32 + qs * 16 + fr];
                        O[a][qs][r] = o; ss += o * o;
                    }
                ss += __shfl_xor(ss, 16); ss += __shfl_xor(ss, 32);
                const float sc = rsqrtf(ss * (1.0f / 128.0f) + 1e-5f) * (1.0f - lam_init);
                const int lt = lt0 + q0 + qs * 16 + fr;
#pragma unroll
                for (int a = 0; a < 8; ++a) {
                    const int dv = a * 16 + fq * 4;
                    const float4 g = *(const float4*)(normg + dv);
                    uint2 w; w.x = pack2bf(O[a][qs][0] * sc * g.x, O[a][qs][1] * sc * g.y); w.y = pack2bf(O[a][qs][2] * sc * g.z, O[a][qs][3] * sc * g.w);
                    *(uint2*)(ydiff + (size_t)lt * 512 + h * 128 + dv) = w;
                }
            }
        }
    }
    __syncthreads();
}

__device__ __forceinline__ void fft_items(const Ctx& C, const PV& P, unsigned char* smem) {
    unsigned char* R = P.ws + WS_R;
    typedef f16 f16x2 __attribute__((ext_vector_type(2)));
    const f16x2* Zall = (const f16x2*)(R + R_ZC);
    bf16_t* yf = (bf16_t*)(R + R_YB) + 2 * SZ512;
    const float2* tw = (const float2*)(P.ws + WS_TW);
    float2* sm = (float2*)smem;
    const int tid = C.tid;
    for (int item = C.bid; item < NSEQ * 256; item += C.nblk) {
        const int sq = item >> 8, col = item & 255, g = col >> 6, cc = col & 63;
        const int lt0 = seqbase_of(sq), S = seqlen_of(sq), lg = sq == 0 ? 13 : 12;
        const f16x2* z = Zall + (size_t)lt0 * 256 + (size_t)col * S;
        __syncthreads();
        for (int s = tid; s < S; s += NT) { const f16x2 v = z[s]; sm[__brev((unsigned)s) >> (32 - lg)] = make_float2((float)v[0], (float)v[1]); }
        __syncthreads();
        int st = 0;
        for (; st + 1 < lg; st += 2) {
            const int half = 1 << st;
            for (int gq = tid; gq < (S >> 2); gq += NT) {
                const int j = gq & (half - 1), p0 = ((gq >> st) << (st + 2)) + j, p1 = p0 + half, p2 = p1 + half, p3 = p2 + half;
                const float2 w1 = tw[j << (12 - st)], wa = tw[j << (11 - st)], wb = tw[(j + half) << (11 - st)];
                const float2 x0 = sm[p0], x1 = sm[p1], x2 = sm[p2], x3 = sm[p3];
                const float2 t1 = make_float2(w1.x * x1.x - w1.y * x1.y, w1.x * x1.y + w1.y * x1.x);
                const float2 t3 = make_float2(w1.x * x3.x - w1.y * x3.y, w1.x * x3.y + w1.y * x3.x);
                const float2 a0 = make_float2(x0.x + t1.x, x0.y + t1.y), a1 = make_float2(x0.x - t1.x, x0.y - t1.y);
                const float2 a2 = make_float2(x2.x + t3.x, x2.y + t3.y), a3 = make_float2(x2.x - t3.x, x2.y - t3.y);
                const float2 u2 = make_float2(wa.x * a2.x - wa.y * a2.y, wa.x * a2.y + wa.y * a2.x);
                const float2 u3 = make_float2(wb.x * a3.x - wb.y * a3.y, wb.x * a3.y + wb.y * a3.x);
                sm[p0] = make_float2(a0.x + u2.x, a0.y + u2.y); sm[p2] = make_float2(a0.x - u2.x, a0.y - u2.y);
                sm[p1] = make_float2(a1.x + u3.x, a1.y + u3.y); sm[p3] = make_float2(a1.x - u3.x, a1.y - u3.y);
            }
            __syncthreads();
        }
        for (; st < lg; ++st) {
            const int half = 1 << st, tshift = 12 - st;
            for (int b = tid; b < (S >> 1); b += NT) {
                const int j = b & (half - 1), i0 = ((b >> st) << (st + 1)) + j, i1 = i0 + half;
                const float2 w = tw[j << tshift], u = sm[i0], x = sm[i1];
                const float2 tv = make_float2(w.x * x.x - w.y * x.y, w.x * x.y + w.y * x.x);
                sm[i0] = make_float2(u.x + tv.x, u.y + tv.y); sm[i1] = make_float2(u.x - tv.x, u.y - tv.y);
            }
            __syncthreads();
        }
        const float nrm = rsqrtf((float)S * 128.0f);
        for (int k = tid; k < S; k += NT) {
            const float2 a = sm[k], b = sm[(S - k) & (S - 1)];
            bf16_t* row = yf + (size_t)(lt0 + k) * 512 + g * 128;
            if (cc == 0) { row[0] = f2bf(0.5f * (a.x + b.x) * nrm); row[64] = f2bf(0.5f * (a.y + b.y) * nrm); }
            else { row[cc] = f2bf(a.x * nrm); row[128 - cc] = f2bf(b.x * nrm); }
        }
    }
    __syncthreads();
}

template <int KT>
__device__ __forceinline__ void scan_block(const Ctx& C, const PV& P, int layer, int sq, int h, int d, int row0, unsigned char* smem) {
    constexpr int TPR = 64 / KT, ROWS = NT / TPR, CH = 16, YP = TPR / 4, NV = ROWS / 32;
    unsigned char* R = P.ws + WS_R;
    const f16* raw = (const f16*)(R + R_RAW); const f16* wa = (const f16*)(R + R_WA); f16* yfb = (f16*)(R + R_YFB);
    const float* invn = (const float*)(P.ws + WS_INVN);
    const float* mu = P.inp(13) + (size_t)layer * 1920; const float* k_k = P.inp(19) + (size_t)layer * 512; const float* k_a = P.inp(20) + (size_t)layer * 512;
    const int tid = C.tid, row = tid / TPR, q = tid % TPR;
    const int lt0 = seqbase_of(sq), S = seqlen_of(sq);
    const int ch = tid & 63, c = h * 64 + ch;
    const float mu_r = mu[c], mu_k = mu[512 + c], kkw = k_k[c], kaw = k_a[c];
    const int vr = (ROWS == 32) ? (tid & 31) : (tid & 63);
    const int vcol = 1024 + h * 64 + row0 + vr; const float mu_v = mu[vcol];
    const f16* wdec = wa + (size_t)d * SZ512; const f16* aact = wa + (size_t)(2 + d) * SZ512;
    f16* ydst = yfb + (size_t)d * SZ512;
    f32x2 s[KT / 2];
#pragma unroll
    for (int j = 0; j < KT / 2; ++j) s[j] = (f32x2){0.f, 0.f};
    f16 pr_[2][3], pk_[2][3], pa_[2], pw_[2], pv_[NV][3]; float pn_[2];
    auto prefetch = [&](int c0) {
#pragma unroll
        for (int j = 0; j < 2; ++j) {
            const int i = (tid >> 6) + 8 * j, tstep = c0 + i, t = d == 0 ? tstep : S - 1 - tstep, lt = lt0 + t;
            const int tm = t > 0 ? lt - 1 : lt, tp = t < S - 1 ? lt + 1 : lt;
            pr_[j][0] = raw[(size_t)tm * 1920 + c]; pr_[j][1] = raw[(size_t)lt * 1920 + c]; pr_[j][2] = raw[(size_t)tp * 1920 + c];
            pk_[j][0] = raw[(size_t)tm * 1920 + 512 + c]; pk_[j][1] = raw[(size_t)lt * 1920 + 512 + c]; pk_[j][2] = raw[(size_t)tp * 1920 + 512 + c];
            pa_[j] = aact[(size_t)lt * 512 + c]; pw_[j] = wdec[(size_t)lt * 512 + c]; pn_[j] = invn[(size_t)lt * 8 + h];
        }
#pragma unroll
        for (int j = 0; j < NV; ++j) {
            const int i = (ROWS == 32) ? (tid >> 5) : ((tid >> 6) + 8 * j), tstep = c0 + i, t = d == 0 ? tstep : S - 1 - tstep, lt = lt0 + t;
            const int tm = t > 0 ? lt - 1 : lt, tp = t < S - 1 ? lt + 1 : lt;
            pv_[j][0] = raw[(size_t)tm * 1920 + vcol]; pv_[j][1] = raw[(size_t)lt * 1920 + vcol]; pv_[j][2] = raw[(size_t)tp * 1920 + vcol];
        }
    };
    auto stage = [&](int c0, unsigned char* buf) {
        float* vec = (float*)buf; float* vbuf = (float*)(buf + 20480);
#pragma unroll
        for (int j = 0; j < 2; ++j) {
            const int i = (tid >> 6) + 8 * j, tstep = c0 + i, t = d == 0 ? tstep : S - 1 - tstep;
            const float rm = t > 0 ? (float)pr_[j][0] : 0.f, rp = t < S - 1 ? (float)pr_[j][2] : 0.f, km = t > 0 ? (float)pk_[j][0] : 0.f, kp = t < S - 1 ? (float)pk_[j][2] : 0.f;
            const float r1 = (float)pr_[j][1], k1 = (float)pk_[j][1];
            const float r = r1 + (0.5f * (rm + rp) - r1) * mu_r;
            const float k = k1 + (0.5f * (km + kp) - k1) * mu_k;
            const float kk = k * kkw * pn_[j], a = (float)pa_[j];
            vec[(0 * CH + i) * 64 + ch] = kk;
            vec[(1 * CH + i) * 64 + ch] = (float)pw_[j];
            vec[(2 * CH + i) * 64 + ch] = kk * a;
            vec[(3 * CH + i) * 64 + ch] = k * (1.0f + (a - 1.0f) * kaw);
            vec[(4 * CH + i) * 64 + ch] = r;
        }
#pragma unroll
        for (int j = 0; j < NV; ++j) {
            const int i = (ROWS == 32) ? (tid >> 5) : ((tid >> 6) + 8 * j), tstep = c0 + i, t = d == 0 ? tstep : S - 1 - tstep;
            const float vm = t > 0 ? (float)pv_[j][0] : 0.f, vp = t < S - 1 ? (float)pv_[j][2] : 0.f, v1 = (float)pv_[j][1];
            vbuf[i * 64 + vr] = v1 + (0.5f * (vm + vp) - v1) * mu_v;
        }
    };
    __syncthreads();
    prefetch(0);
    stage(0, smem);
    __syncthreads();
    const int nch = S / CH;
    for (int cix = 0; cix < nch; ++cix) {
        unsigned char* buf = smem + (cix & 1) * 32768;
        if (cix + 1 < nch) prefetch((cix + 1) * CH);
        {
            const float* vec = (const float*)buf; const float* vbuf = (const float*)(buf + 20480); float* ybuf = (float*)(buf + 24576);
            const f32x4* vp0 = (const f32x4*)(vec + q * KT);
            f32x4 nx[5][KT / 4]; float nvv;
#pragma unroll
            for (int u = 0; u < KT / 4; ++u)
#pragma unroll
                for (int a5 = 0; a5 < 5; ++a5) nx[a5][u] = vp0[a5 * CH * 16 + u];
            nvv = vbuf[row];
            float yv[CH];
#pragma unroll
            for (int i = 0; i < CH; ++i) {
                f32x2 kk2[KT / 2], w2[KT / 2], b2[KT / 2], kd2[KT / 2], r2[KT / 2];
#pragma unroll
                for (int u = 0; u < KT / 4; ++u) {
                    kk2[2 * u] = (f32x2){nx[0][u][0], nx[0][u][1]}; kk2[2 * u + 1] = (f32x2){nx[0][u][2], nx[0][u][3]};
                    w2[2 * u] = (f32x2){nx[1][u][0], nx[1][u][1]}; w2[2 * u + 1] = (f32x2){nx[1][u][2], nx[1][u][3]};
                    b2[2 * u] = (f32x2){nx[2][u][0], nx[2][u][1]}; b2[2 * u + 1] = (f32x2){nx[2][u][2], nx[2][u][3]};
                    kd2[2 * u] = (f32x2){nx[3][u][0], nx[3][u][1]}; kd2[2 * u + 1] = (f32x2){nx[3][u][2], nx[3][u][3]};
                    r2[2 * u] = (f32x2){nx[4][u][0], nx[4][u][1]}; r2[2 * u + 1] = (f32x2){nx[4][u][2], nx[4][u][3]};
                }
                const float vv = nvv;
                if (i + 1 < CH) {
#pragma unroll
                    for (int u = 0; u < KT / 4; ++u)
#pragma unroll
                        for (int a5 = 0; a5 < 5; ++a5) nx[a5][u] = vp0[(i + 1) * 16 + a5 * CH * 16 + u];
                    nvv = vbuf[(i + 1) * 64 + row];
                }
                f32x2 acc2 = s[0] * kk2[0];
#pragma unroll
                for (int j = 1; j < KT / 2; ++j) acc2 = __builtin_elementwise_fma(s[j], kk2[j], acc2);
                float sa = acc2[0] + acc2[1];
                sa += dppf<0xB1>(sa); sa += dppf<0x4E>(sa); sa += dppf<0x141>(sa);
                if (TPR == 16) sa += dppf<0x140>(sa);
                sa = -sa;
                const f32x2 sa2 = (f32x2){sa, sa}, vv2 = (f32x2){vv, vv};
                f32x2 y2 = (f32x2){0.f, 0.f};
#pragma unroll
                for (int j = 0; j < KT / 2; ++j) {
                    s[j] = __builtin_elementwise_fma(s[j], w2[j], __builtin_elementwise_fma(sa2, b2[j], vv2 * kd2[j]));
                    y2 = __builtin_elementwise_fma(s[j], r2[j], y2);
                }
                float y = y2[0] + y2[1];
                y += dppf<0xB1>(y); y += dppf<0x4E>(y);
                yv[i] = y;
            }
            if ((q & 3) == 0) {
#pragma unroll
                for (int i = 0; i < CH; ++i) ybuf[i * 128 + row * YP + (q >> 2)] = yv[i];
            }
        }
        if (cix + 1 < nch) stage((cix + 1) * CH, smem + ((cix + 1) & 1) * 32768);
        __syncthreads();
        {
            const float* ybuf = (const float*)(buf + 24576);
#pragma unroll
            for (int j = 0; j < NV; ++j) {
                const int i = (ROWS == 32) ? (tid >> 5) : ((tid >> 6) + 8 * j), rr = vr, tstep = cix * CH + i, t = d == 0 ? tstep : S - 1 - tstep;
                float y = 0.f;
#pragma unroll
                for (int p = 0; p < YP; ++p) y += ybuf[i * 128 + rr * YP + p];
                ydst[(size_t)(lt0 + t) * 512 + h * 64 + row0 + rr] = (f16)y;
            }
        }
    }
    __syncthreads();
}

__device__ __forceinline__ void finish_phase(const Ctx& C, const PV& P, int layer) {
    unsigned char* R = P.ws + WS_R;
    const f16* raw = (const f16*)(R + R_RAW); const f16* wa = (const f16*)(R + R_WA); const f16* gbuf = (const f16*)(R + R_G); const f16* yfb = (const f16*)(R + R_YFB);
    bf16_t* yr = (bf16_t*)(R + R_YB);
    const float* mu = P.inp(13) + (size_t)layer * 1920; const float* k_a = P.inp(20) + (size_t)layer * 512; const float* r_k = P.inp(21) + (size_t)layer * 512;
    const float* lg = P.inp(22) + (size_t)layer * 512; const float* lb = P.inp(23) + (size_t)layer * 512;
    const int lane = C.tid & 63, wave = C.tid >> 6, c = lane * 8;
    const int nw = C.nblk * NWV;
    for (int ltb = C.bid * NWV + wave; ltb < TP; ltb += 2 * nw) {
        f16x8_t rA[2], rB[2], rC[2], kA[2], kB[2], kC[2], vA[2], vB[2], vC[2], af[2], ab[2], gg[2], yF[2], yB[2]; float wm_[2], wp_[2]; bool ok[2];
#pragma unroll
        for (int u = 0; u < 2; ++u) {
            const int lt1 = ltb + u * nw; ok[u] = lt1 < TP; const int lt = ok[u] ? lt1 : ltb;
            const int pos = pos_of(lt), S = lt < 8192 ? 8192 : 4096;
            const size_t rm = (size_t)(pos > 0 ? lt - 1 : lt) * 1920, r0 = (size_t)lt * 1920, rp = (size_t)(pos < S - 1 ? lt + 1 : lt) * 1920;
            wm_[u] = pos > 0 ? 0.5f : 0.f; wp_[u] = pos < S - 1 ? 0.5f : 0.f;
            rA[u] = *(const f16x8_t*)(raw + rm + c); rB[u] = *(const f16x8_t*)(raw + r0 + c); rC[u] = *(const f16x8_t*)(raw + rp + c);
            kA[u] = *(const f16x8_t*)(raw + rm + 512 + c); kB[u] = *(const f16x8_t*)(raw + r0 + 512 + c); kC[u] = *(const f16x8_t*)(raw + rp + 512 + c);
            vA[u] = *(const f16x8_t*)(raw + rm + 1024 + c); vB[u] = *(const f16x8_t*)(raw + r0 + 1024 + c); vC[u] = *(const f16x8_t*)(raw + rp + 1024 + c);
            af[u] = *(const f16x8_t*)(wa + 2 * SZ512 + (size_t)lt * 512 + c); ab[u] = *(const f16x8_t*)(wa + 3 * SZ512 + (size_t)lt * 512 + c);
            gg[u] = *(const f16x8_t*)(gbuf + (size_t)lt * 512 + c);
            yF[u] = *(const f16x8_t*)(yfb + (size_t)lt * 512 + c); yB[u] = *(const f16x8_t*)(yfb + SZ512 + (size_t)lt * 512 + c);
        }
#pragma unroll
        for (int u = 0; u < 2; ++u) {
            float y[8], vv[8], bsum = 0.f, ysum = 0.f;
#pragma unroll
            for (int j = 0; j < 8; ++j) {
                const float r_ = (float)rB[u][j], k_ = (float)kB[u][j], v_ = (float)vB[u][j];
                const float r = r_ + (wm_[u] * (float)rA[u][j] + wp_[u] * (float)rC[u][j] - r_) * mu[c + j];
                const float k = k_ + (wm_[u] * (float)kA[u][j] + wp_[u] * (float)kC[u][j] - k_) * mu[512 + c + j];
                vv[j] = v_ + (wm_[u] * (float)vA[u][j] + wp_[u] * (float)vC[u][j] - v_) * mu[1024 + c + j];
                const float ka = k_a[c + j];
                const float ksum = k * (1.f + ((float)af[u][j] - 1.f) * ka) + k * (1.f + ((float)ab[u][j] - 1.f) * ka);
                bsum += r * (0.5f * ksum) * r_k[c + j];
                y[j] = (float)yF[u][j] + (float)yB[u][j]; ysum += y[j];
            }
            const float ym = red8(ysum) * (1.0f / 64.0f);
            float q = 0.f;
#pragma unroll
            for (int j = 0; j < 8; ++j) { const float dy = y[j] - ym; q += dy * dy; }
            const float rs = rsqrtf(red8(q) * (1.0f / 64.0f) + 64e-5f);
            const float bonus = red8(bsum);
            float o[8];
#pragma unroll
            for (int j = 0; j < 8; ++j) o[j] = ((y[j] - ym) * rs * lg[c + j] + lb[c + j] + bonus * vv[j]) * (float)gg[u][j];
            u32x4 w; w.x = pack2bf(o[0], o[1]); w.y = pack2bf(o[2], o[3]); w.z = pack2bf(o[4], o[5]); w.w = pack2bf(o[6], o[7]);
            if (ok[u]) *(u32x4*)(yr + (size_t)(ltb + u * nw) * 512 + c) = w;
        }
    }
}

__device__ __forceinline__ void gates_phase(const Ctx& C, const PV& P, int layer) {
    const bf16_t* hmod = (const bf16_t*)(P.ws + WS_HMOD);
    const bf16_t* Wt = wl(P, layer) + OW_WIN + (size_t)4480 * 1024;
    bf16_t* gates = (bf16_t*)(P.ws + WS_R + R_GATES);
    int pm, pn;
    for (int it = 0; tile_order(it, C.nblk, C.bid, TP / 256, 16, pm, pn); ++it) {
        f32x4 acc[2][2][4][2];
        gemm256(C, acc, hmod, Wt, 1024, pm * 256, pn * 256);
        int z2 = 0; asm volatile("" : "+s"(z2));
        const int tid2 = tid_now(C.wave_s, z2), lane = tid2 & 63, wid = tid2 >> 6, wr = wid >> 2, wc = wid & 3, fr = lane & 15, fq = lane >> 4;
#pragma unroll
        for (int ai = 0; ai < 2; ++ai)
#pragma unroll
            for (int m = 0; m < 4; ++m) {
                const int lt = pm * 256 + ai * 128 + wr * 64 + m * 16 + fr;
#pragma unroll
                for (int bj = 0; bj < 2; ++bj)
#pragma unroll
                    for (int n = 0; n < 2; ++n) {
                        const int col = pn * 256 + bj * 128 + wc * 32 + n * 16 + fq * 4;
                        const f32x4 v = acc[ai][bj][m][n];
                        u32x2 w; w.x = pack2bf(sigmoidf_(v[0]), sigmoidf_(v[1])); w.y = pack2bf(sigmoidf_(v[2]), sigmoidf_(v[3]));
                        *(u32x2*)(gates + (size_t)lt * 4096 + col) = w;
                    }
            }
    }
}
__device__ __forceinline__ void branch_phase(const Ctx& C, const PV& P, int layer) {
    unsigned char* R = P.ws + WS_R;
    const bf16_t* yb = (const bf16_t*)(R + R_YB); const bf16_t* gates = (const bf16_t*)(R + R_GATES);
    float* m32 = (float*)(R + R_M32); bf16_t* merged = (bf16_t*)(R + R_MERGED);
    const bf16_t* W = wl(P, layer) + OW_WBR;
    int pm, pn;
    for (int it = 0; tile_order(it, C.nblk, C.bid, TP / 256, 4, pm, pn); ++it) {
        for (int nb = 0; nb < 4; ++nb) {
            f32x4 acc[2][2][4][2];
            gemm256(C, acc, yb + (size_t)nb * SZ512, W + (size_t)nb * 1024 * 512, 512, pm * 256, pn * 256);
            int z2 = 0; asm volatile("" : "+s"(z2));
            const int tid2 = tid_now(C.wave_s, z2), lane = tid2 & 63, wid = tid2 >> 6, wr = wid >> 2, wc = wid & 3, fr = lane & 15, fq = lane >> 4;
#pragma unroll
            for (int ai = 0; ai < 2; ++ai)
#pragma unroll
                for (int m = 0; m < 4; ++m) {
                    const int lt = pm * 256 + ai * 128 + wr * 64 + m * 16 + fr;
#pragma unroll
                    for (int bj = 0; bj < 2; ++bj)
#pragma unroll
                        for (int n = 0; n < 2; ++n) {
                            const int col = pn * 256 + bj * 128 + wc * 32 + n * 16 + fq * 4;
                            const u32x2 gw = *(const u32x2*)(gates + (size_t)lt * 4096 + nb * 1024 + col);
                            f32x4 g; g[0] = __uint_as_float(gw.x << 16); g[1] = __uint_as_float(gw.x & 0xffff0000u); g[2] = __uint_as_float(gw.y << 16); g[3] = __uint_as_float(gw.y & 0xffff0000u);
                            f32x4 mv = g * acc[ai][bj][m][n];
                            f32x4* mp = (f32x4*)(m32 + (size_t)lt * 1024 + col);
                            if (nb > 0) mv += *mp;
                            if (nb < 3) *mp = mv;
                            else { u32x2 w; w.x = pack2bf(mv[0], mv[1]); w.y = pack2bf(mv[2], mv[3]); *(u32x2*)(merged + (size_t)lt * 1024 + col) = w; }
                        }
                    asm volatile("" ::: "memory");
                }
        }
    }
}


#define XB_TMO      128
#define XB_XCNT(j)  (256  + 64 * (j))
#define XB_XSUB(j)  (1280 + 64 * (j))
#define XB_XGEN(j)  (2304 + 64 * (j))
#define XB_TOP      3328
#define XB_TOPGEN   3392
#define XCD_BAR_WORDS 3456
#define XB_SPIN_CAP (1u << 21)
#define LAS __attribute__((address_space(3)))
__device__ __forceinline__ unsigned xb_ld(unsigned* p)              { return __hip_atomic_load(p, __ATOMIC_RELAXED, __HIP_MEMORY_SCOPE_AGENT); }
__device__ __forceinline__ unsigned xb_add(unsigned* p, unsigned v) { return __hip_atomic_fetch_add(p, v, __ATOMIC_RELAXED, __HIP_MEMORY_SCOPE_AGENT); }
__device__ __forceinline__ unsigned xb_xcc_id() { return (unsigned)__builtin_amdgcn_s_getreg((3 << 11) | 20) & 0xFu; }
#define XB_SPIN(cond, bar) do { unsigned _sp = 0; while (cond) { __builtin_amdgcn_s_sleep(1); \
    if ((++_sp & 255u) == 0u) { if (xb_ld(&(bar)[XB_TMO])) break; if (_sp > XB_SPIN_CAP) { atomicAdd(&(bar)[XB_TMO], 1u); break; } } } } while (0)
struct XcdBarrier { unsigned* bar; unsigned x; volatile LAS unsigned* st; };
__device__ __forceinline__ XcdBarrier xcd_barrier_post(unsigned* bar, volatile LAS unsigned* st) {
    XcdBarrier b; b.bar = bar; b.x = xb_xcc_id(); b.st = st;
    if (threadIdx.x == 0) (void)xb_add(&bar[XB_XCNT(b.x)], 1u);
    return b;
}
__device__ __forceinline__ void xcd_barrier_complete(unsigned* bar, unsigned x, unsigned& nloc, unsigned& nx) {
    const unsigned G = gridDim.x * gridDim.y * gridDim.z;
    unsigned sum, cnt, mine, sp = 0u;
    for (;;) {
        sum = 0u; cnt = 0u; mine = 0u;
#pragma unroll
        for (unsigned j = 0; j < 16; ++j) { const unsigned c = xb_ld(&bar[XB_XCNT(j)]); sum += c; cnt += (c > 0u) ? 1u : 0u; mine = (j == x) ? c : mine; }
        if (sum == G) break;
        __builtin_amdgcn_s_sleep(1);
        if ((++sp & 255u) == 0u) { if (xb_ld(&bar[XB_TMO])) break; if (sp > XB_SPIN_CAP) { atomicAdd(&bar[XB_TMO], 1u); break; } }
    }
    nloc = mine > 0u ? mine : 1u; nx = cnt > 0u ? cnt : 1u;
}
__device__ __forceinline__ void xcd_barrier(const XcdBarrier& b) {
    asm volatile("s_waitcnt vmcnt(0)" ::: "memory");
    __syncthreads();
    if (threadIdx.x == 0) {
        unsigned* bar = b.bar;
        __builtin_amdgcn_s_waitcnt(0);
        unsigned nloc = b.st[0], nx = b.st[1];
        if (nloc == 0u) { xcd_barrier_complete(bar, b.x, nloc, nx); b.st[0] = nloc; b.st[1] = nx; }
        const unsigned old = xb_add(&bar[XB_XSUB(b.x)], 1u);
        const unsigned gen = old / nloc;
        if (old + 1u == (gen + 1u) * nloc) {
            __builtin_amdgcn_fence(__ATOMIC_RELEASE, "agent");
            asm volatile("s_waitcnt vmcnt(0)" ::: "memory");
            const unsigned og = xb_add(&bar[XB_TOP], 1u);
            const unsigned tg = og / nx;
            if (og + 1u == (tg + 1u) * nx) xb_add(&bar[XB_TOPGEN], 1u);
            else XB_SPIN(xb_ld(&bar[XB_TOPGEN]) == tg, bar);
            __builtin_amdgcn_fence(__ATOMIC_ACQUIRE, "agent");
            xb_add(&bar[XB_XGEN(b.x)], 1u);
            asm volatile("s_waitcnt vmcnt(0)" ::: "memory");
        } else {
            XB_SPIN(xb_ld(&bar[XB_XGEN(b.x)]) == gen, bar);
            __builtin_amdgcn_fence(__ATOMIC_ACQUIRE, "agent");
            asm volatile("s_waitcnt vmcnt(0)" ::: "memory");
        }
    }
    __syncthreads();
}

constexpr int PH_PER_LAYER = 15, PH_PER_PASS = 2 * PH_PER_LAYER + 1, NPHASE = 1 + NPASS * PH_PER_PASS;

__global__ void __launch_bounds__(512, 2) mk_forward(Params P0, int ph_lo, int ph_hi) {
    unsigned char* smem = dyn_smem;
    const int wave_s = __builtin_amdgcn_readfirstlane((int)threadIdx.x >> 6);
    volatile LAS unsigned* xst = (volatile LAS unsigned*)(LAS unsigned char*)(dyn_smem + 131072);
    if (threadIdx.x == 0) { xst[0] = 0u; xst[1] = 0u; }
    __syncthreads();
    const XcdBarrier xb = xcd_barrier_post((unsigned*)(P0.ws + WS_BAR), xst);
    for (int it_ = 2 * ph_lo; it_ < 2 * ph_hi; ++it_) {
        const int ph = it_ >> 1;
        if (it_ & 1) {
            if (PROBE_MASK == 0 || ph == 0) continue;
            const int r_ = (ph - 1) % PH_PER_PASS;
            if (r_ == PH_PER_PASS - 1 || !((PROBE_MASK >> (r_ % PH_PER_LAYER)) & 1)) continue;
        }
        if (it_ > 2 * ph_lo) { if (it_ == 2 * ph_lo + 2) cg::this_grid().sync(); else xcd_barrier(xb); }
        int z = 0; asm volatile("" : "+s"(z));
        Ctx C; C.tid = tid_now(wave_s, z); C.bid = (int)blockIdx.x + z; C.nblk = (int)gridDim.x + z; C.wave_s = wave_s;
        ptrtab_t tab = (ptrtab_t)__builtin_amdgcn_kernarg_segment_ptr();
        asm volatile("" : "+s"(tab));
        const PV P{tab, (float*)tab[29], (unsigned char*)tab[30]};
        if (ph == 0) { prep_phase(C, P, smem); continue; }
        const int q = ph - 1, pass = q / PH_PER_PASS, r = q % PH_PER_PASS;
        if (r == PH_PER_PASS - 1) { norm_phase(C, P, pass, P.inp(6) + (size_t)(1 * 3 + 2) * 1024, P.inp(7) + (size_t)(1 * 3 + 2) * 1024, 0, -1, false, true); continue; }
        const int layer = r / PH_PER_LAYER, lp = r % PH_PER_LAYER;
        const bf16_t* W = wl(P, layer);
        const float* lng = P.inp(6) + (size_t)layer * 3 * 1024; const float* lnb = P.inp(7) + (size_t)layer * 3 * 1024;
        const float* lngp = P.inp(6) + (size_t)((layer > 0 ? layer - 1 : 0) * 3 + 2) * 1024; const float* lnbp = P.inp(7) + (size_t)((layer > 0 ? layer - 1 : 0) * 3 + 2) * 1024;
        unsigned char* R = P.ws + WS_R;
        switch (lp) {
            case 0:
                if (layer == 0) norm_phase(C, P, pass, nullptr, nullptr, 0, 0, true, false);
                else norm_phase(C, P, pass, lngp, lnbp, layer, 0, false, false);
                break;
            case 1: ffn_up_phase(C, P, W + OW_FA_IN); break;
            case 2: resid_gemm_phase(C, P, pass, (const bf16_t*)(R + R_ACT), 2816, W + OW_FA_OUT, layer, 0, 0.5f, layer == 0 ? nullptr : lngp, lnbp); break;
            case 3: norm_phase(C, P, pass, lng, lnb, layer, 1, false, false); break;
            case 4: win_phase(C, P, layer); break;
            case 5: lin_pool_phase(C, P, layer); break;
            case 6: lora_phase(C, P, layer, smem); break;
            case 7:
                if (C.bid < 32) scan_block<4>(C, P, layer, 0, C.bid >> 2, (C.bid >> 1) & 1, (C.bid & 1) * 32, smem);
                else if (C.bid < 160) { const int i2 = C.bid - 32; scan_block<8>(C, P, layer, 1 + (i2 >> 4), (i2 >> 1) & 7, i2 & 1, 0, smem); }
                attn_items(C, P, layer, pass * 2 + layer, smem); fft_items(C, P, smem); break;
            case 8: finish_phase(C, P, layer); break;
            case 9: gates_phase(C, P, layer); break;
            case 10: branch_phase(C, P, layer); break;
            case 11: resid_gemm_phase(C, P, pass, (const bf16_t*)(R + R_MERGED), 1024, W + OW_WOUT, layer, 1, 1.0f, lng, lnb); break;
            case 12: norm_phase(C, P, pass, lng + 1024, lnb + 1024, layer, 2, false, false); break;
            case 13: ffn_up_phase(C, P, W + OW_FB_IN); break;
            default: resid_gemm_phase(C, P, pass, (const bf16_t*)(R + R_ACT), 2816, W + OW_FB_OUT, layer, 2, 0.5f, lng + 1024, lnb + 1024); break;
        }
    }
}

extern "C" void kernel_launch(void* const* d_in, const int* in_sizes, int n_in, void* d_out, int out_size, void* d_ws, size_t ws_size, hipStream_t stream) {
    static int grid_blocks = 0;
    if (!grid_blocks) {
        int dev = 0, cus = 0, per_cu = 0;
        (void)hipGetDevice(&dev);
        (void)hipDeviceGetAttribute(&cus, hipDeviceAttributeMultiprocessorCount, dev);
        (void)hipFuncSetAttribute((const void*)mk_forward, hipFuncAttributeMaxDynamicSharedMemorySize, LDS_BYTES);
        (void)hipOccupancyMaxActiveBlocksPerMultiprocessor(&per_cu, mk_forward, NT, LDS_BYTES);
        if (per_cu < 1) per_cu = 1;
        if (per_cu > 1) per_cu = 1;
        grid_blocks = cus * per_cu;
    }
    Params p{};
    for (int i = 0; i < 29; ++i) p.in[i] = (const float*)d_in[i];
    p.out = (float*)d_out; p.ws = (unsigned char*)d_ws;
    (void)hipMemsetAsync((unsigned char*)d_ws + WS_BAR, 0, XCD_BAR_WORDS * 4 + 256, stream);
#if ONE_LAUNCH
    int lo = 0, hi = NPHASE;
    void* args[] = {&p, &lo, &hi};
    hipError_t e = hipLaunchCooperativeKernel((void*)mk_forward, dim3(grid_blocks), dim3(NT), args, LDS_BYTES, stream);
    if (e != hipSuccess) fprintf(stderr, "cooperative launch failed: %s (grid %d)\n", hipGetErrorString(e), grid_blocks);
#else
    for (int ph = 0; ph < NPHASE; ++ph) {
        int lo = ph, hi = ph + 1;
        void* args[] = {&p, &lo, &hi};
        (void)hipLaunchCooperativeKernel((void*)mk_forward, dim3(grid_blocks), dim3(NT), args, LDS_BYTES, stream);
    }
#endif
}
```

```cpp
#include <hip/hip_runtime.h>
#include <hip/hip_cooperative_groups.h>
#include <cstdio>
#include <cstdint>
namespace cg = cooperative_groups;

typedef unsigned short bf16_t;
typedef _Float16 f16;
typedef short bf16x8 __attribute__((ext_vector_type(8)));
typedef float f32x4 __attribute__((ext_vector_type(4)));
typedef unsigned u32x4 __attribute__((ext_vector_type(4)));
typedef unsigned u32x2 __attribute__((ext_vector_type(2)));
typedef float f32x2 __attribute__((ext_vector_type(2)));

#ifndef ONE_LAUNCH
#define ONE_LAUNCH 1
#endif
#ifndef PROBE_MASK
#define PROBE_MASK 0
#endif

constexpr int TP = 40960;
constexpr int NPASS = 2;
constexpr int NSEQ = 9;
constexpr int MT = TP / 128;
constexpr int N_IN_FULL = 8576;
constexpr float ALPHA = 1.41421356237f;

constexpr size_t OW_FA_IN = 0, OW_FA_OUT = 5767168, OW_FB_IN = 8650752, OW_FB_OUT = 14417920, OW_WIN = 17301504,
                 OW_WBR = 26083328, OW_WOUT = 28180480, OW_W2T = 29229056, OW_A2T = 29294592, OW_G2T = 29360128, WL_TOTAL = 29425664;
constexpr size_t WS_W = 0, WS_TW = 117702656, WS_MOD = 117735424, WS_HMOD = 119062528, WS_R = 202948608, WS_INVN = 1062780928, WS_STATS = 1064091904, WS_BAR = 1064419584, WS_CTR = 1064433408  ;
constexpr size_t R_RAW = 0, R_LIN = 157286400, R_WA = 188743680, R_G = 356515840, R_Q = 398458880, R_K = 440401920, R_VT = 482344960,
                 R_YFB = 524288000, R_ZC = 608174080, R_POOLP = 650117120, R_YB = 692060160, R_ACT = 0,
                 R_GATES = 0  , R_M32 = 398458880  , R_MERGED = 566231040  ;
constexpr size_t SZ512 = (size_t)TP * 512;

struct Params { const float* in[29]; float* out; unsigned char* ws; };
struct Ctx { int tid, bid, nblk, wave_s; };
__device__ __forceinline__ int tid_now(int wave_s, int z) { return wave_s * 64 + (int)__builtin_amdgcn_mbcnt_hi(~0u, __builtin_amdgcn_mbcnt_lo(~0u, (unsigned)z)); }
typedef const float* const __attribute__((address_space(4)))* ptrtab_t;
struct PV { ptrtab_t tab; float* out; unsigned char* ws;
    __device__ __forceinline__ const float* inp(int i) const { return tab[i]; } };
constexpr int NT = 512, NWV = 8;
extern __shared__ __attribute__((aligned(16))) unsigned char dyn_smem[];
constexpr int LDS_BYTES = 131072 + 64;

__device__ __forceinline__ bf16_t f2bf(float f) { unsigned u = __float_as_uint(f); u += 0x7fffu + ((u >> 16) & 1u); return (bf16_t)(u >> 16); }
__device__ __forceinline__ float bf2f(bf16_t b) { return __uint_as_float(((unsigned)b) << 16); }
typedef __bf16 bf16x2_t __attribute__((ext_vector_type(2)));
__device__ __forceinline__ unsigned pack2bf(float a, float b) { const f32x2 v = (f32x2){a, b}; const bf16x2_t h = __builtin_convertvector(v, bf16x2_t); return __builtin_bit_cast(unsigned, h); }
__device__ __forceinline__ float wsum(float v) {
#pragma unroll
    for (int o = 32; o > 0; o >>= 1) v += __shfl_xor(v, o);
    return v;
}
__device__ __forceinline__ float sigmoidf_(float x) { return __builtin_amdgcn_rcpf(1.0f + __expf(-x)); }
template <int CTRL> __device__ __forceinline__ float dppf(float v) { return __int_as_float(__builtin_amdgcn_update_dpp(0, __float_as_int(v), CTRL, 0xF, 0xF, true)); }
__device__ __forceinline__ float red8(float v) { v += dppf<0xB1>(v); v += dppf<0x4E>(v); v += dppf<0x141>(v); return v; }

__device__ __forceinline__ int grow_of(int pass, int lt) { return lt < 8192 ? pass * 8192 + lt : 16384 + pass * 32768 + (lt - 8192); }
__device__ __forceinline__ int brow_of(int pass, int lt) { return lt < 8192 ? pass : 2 + pass * 8 + ((lt - 8192) >> 12); }
__device__ __forceinline__ int pos_of(int lt) { return lt < 8192 ? lt : ((lt - 8192) & 4095); }
__device__ __forceinline__ int seqbase_of(int sq) { return sq == 0 ? 0 : 8192 + (sq - 1) * 4096; }
__device__ __forceinline__ int seqlen_of(int sq) { return sq == 0 ? 8192 : 4096; }

__device__ __forceinline__ bf16_t* wl(const PV& P, int layer) { return (bf16_t*)(P.ws + WS_W) + (size_t)layer * WL_TOTAL; }

template <int NJ, bool SWAP>
__device__ __forceinline__ void gemm_core(const Ctx& C, f32x4 (&acc)[4][NJ], const bf16_t* __restrict__ A, int lda, const bf16_t* __restrict__ B, int ldb, int K, unsigned char* smem) {
    const int tid = C.tid & 255, lane = tid & 63, wave = tid >> 6, wm = wave >> 1, wn = wave & 1, fr = lane & 15, fq = lane >> 4;
    smem += (C.tid >> 8) * 36864;
    u32x4 ra[4], rb[NJ];
#pragma unroll
    for (int i = 0; i < 4; ++i)
#pragma unroll
        for (int j = 0; j < NJ; ++j) acc[i][j] = (f32x4){0.f, 0.f, 0.f, 0.f};
    const int lrow = tid >> 3, lkc = (tid & 7) * 8;
#pragma unroll
    for (int i = 0; i < 4; ++i) ra[i] = *(const u32x4*)(A + (size_t)(lrow + 32 * i) * lda + lkc);
#pragma unroll
    for (int i = 0; i < NJ; ++i) rb[i] = *(const u32x4*)(B + (size_t)(lrow + 32 * i) * ldb + lkc);
    for (int k0 = 0; k0 < K; k0 += 64) {
        __syncthreads();
#pragma unroll
        for (int i = 0; i < 4; ++i) *(u32x4*)(smem + (lrow + 32 * i) * 144 + lkc * 2) = ra[i];
#pragma unroll
        for (int i = 0; i < NJ; ++i) *(u32x4*)(smem + 18432 + (lrow + 32 * i) * 144 + lkc * 2) = rb[i];
        __syncthreads();
        if (k0 + 64 < K) {
#pragma unroll
            for (int i = 0; i < 4; ++i) ra[i] = *(const u32x4*)(A + (size_t)(lrow + 32 * i) * lda + k0 + 64 + lkc);
#pragma unroll
            for (int i = 0; i < NJ; ++i) rb[i] = *(const u32x4*)(B + (size_t)(lrow + 32 * i) * ldb + k0 + 64 + lkc);
        }
#pragma unroll
        for (int ks = 0; ks < 2; ++ks) {
            bf16x8 af[4], bfr[NJ];
#pragma unroll
            for (int i = 0; i < 4; ++i) af[i] = *(const bf16x8*)(smem + (wm * 64 + i * 16 + fr) * 144 + (ks * 32 + fq * 8) * 2);
#pragma unroll
            for (int j = 0; j < NJ; ++j) bfr[j] = *(const bf16x8*)(smem + 18432 + (wn * NJ * 16 + j * 16 + fr) * 144 + (ks * 32 + fq * 8) * 2);
#pragma unroll
            for (int i = 0; i < 4; ++i)
#pragma unroll
                for (int j = 0; j < NJ; ++j)
                    acc[i][j] = SWAP ? __builtin_amdgcn_mfma_f32_16x16x32_bf16(bfr[j], af[i], acc[i][j], 0, 0, 0)
                                     : __builtin_amdgcn_mfma_f32_16x16x32_bf16(af[i], bfr[j], acc[i][j], 0, 0, 0);
        }
    }
}


namespace g256 {
constexpr int BK = 64, HALF = 128, HT = HALF * BK;
__device__ __forceinline__ int lds_byte(int r, int c) { int st = (r >> 4) * 2 + (c >> 5), rr = r & 15, cc = c & 31, ob = rr * 64 + cc * 2; return st * 1024 + (ob ^ (((ob >> 9) & 1) << 5)); }
__device__ __forceinline__ void stage_rc(unsigned b, unsigned& R, unsigned& Cc) { const unsigned st = b >> 10, sb = b & 1023u, swz = sb ^ (((sb >> 9) & 1u) << 5); R = (st >> 1) * 16u + (swz >> 6); Cc = (st & 1u) * 32u + ((swz & 63u) >> 1); }
}
__device__ __forceinline__ void gemm256(const Ctx& C, f32x4 (&acc)[2][2][4][2], const bf16_t* __restrict__ A, const bf16_t* __restrict__ Bt, const int K, const int brow, const int bcol) {
    using namespace g256;
    bf16_t* shm = (bf16_t*)dyn_smem;
    const int tidx = C.tid;
    #define SA(b,h) (shm+((b)*2+(h))*HT)
    #define SB(b,h) (shm+(4+(b)*2+(h))*HT)
    #define STAGE(Pp,BASE,br,kt) do{const char* _ub=(const char*)((BASE)+(long)(br)*K+(long)(kt)*BK); asm volatile("" : "+s"(_ub)); \
        __builtin_amdgcn_global_load_lds((const unsigned*)(_ub+goff0), \
          (__attribute__((address_space(3))) unsigned*)((__attribute__((address_space(3))) char*)(Pp)+tidx*16),16,0,0); \
        __builtin_amdgcn_global_load_lds((const unsigned*)(_ub+goff1), \
          (__attribute__((address_space(3))) unsigned*)((__attribute__((address_space(3))) char*)(Pp)+tidx*16+8192),16,0,0);}while(0)
    #define LDA(dst,b,h) for(int m=0;m<4;++m)for(int k=0;k<2;++k) \
      dst[m][k]=*reinterpret_cast<const bf16x8*>(a_ptr+((b)*2+(h))*16384+m*2048+k*1024)
    #define LDB(dst,b,h) for(int n=0;n<2;++n)for(int k=0;k<2;++k) \
      dst[n][k]=*reinterpret_cast<const bf16x8*>(b_ptr+((b)*2+(h))*16384+n*2048+k*1024)
    #define MMA(ai,bj,Atx,Btx) do{__builtin_amdgcn_s_setprio(1); \
      for(int m=0;m<4;++m)for(int n=0;n<2;++n)for(int k=0;k<2;++k) \
        acc[ai][bj][m][n]=__builtin_amdgcn_mfma_f32_16x16x32_bf16(Btx[n][k],Atx[m][k],acc[ai][bj][m][n],0,0,0); \
      __builtin_amdgcn_s_setprio(0);}while(0)
    #define WAIT_V(n) asm volatile("s_waitcnt vmcnt(" #n ")":::"memory")
    #define WAIT_L(n) asm volatile("s_waitcnt lgkmcnt(" #n ")":::"memory")
    #define BAR __builtin_amdgcn_s_barrier()
    #define SCHED __builtin_amdgcn_sched_barrier(0)
    const int wid = tidx >> 6, lane = tidx & 63, wr = wid >> 2, wc = wid & 3, fr = lane & 15, fq = lane >> 4;
    const int swz = (fr * 64 + fq * 16) ^ ((fr >> 3) << 5);
    const char* a_ptr = (const char*)dyn_smem + wr * 8192 + swz;
    const char* b_ptr = (const char*)dyn_smem + 65536 + wc * 4096 + swz;
#pragma unroll
    for (int a = 0; a < 2; ++a)
#pragma unroll
        for (int b = 0; b < 2; ++b)
#pragma unroll
            for (int m = 0; m < 4; ++m) { acc[a][b][m][0] = (f32x4){0.f, 0.f, 0.f, 0.f}; acc[a][b][m][1] = (f32x4){0.f, 0.f, 0.f, 0.f}; }
    bf16x8 At[4][2], B0[2][2], B1[2][2];
    const int nt = K / BK;
    unsigned goff0, goff1;
    { unsigned r0, c0, r1, c1; stage_rc((unsigned)tidx * 16u, r0, c0); stage_rc((unsigned)tidx * 16u + 8192u, r1, c1); goff0 = (r0 * (unsigned)K + c0) * 2u; goff1 = (r1 * (unsigned)K + c1) * 2u; }
    WAIT_V(0); __syncthreads();
    STAGE(SB(0,0),Bt,bcol,0); STAGE(SA(0,0),A,brow,0);
    STAGE(SB(0,1),Bt,bcol+HALF,0); STAGE(SA(0,1),A,brow+HALF,0);
    if(wr==1)BAR;
    WAIT_V(4); BAR;
    STAGE(SB(1,0),Bt,bcol,1); STAGE(SA(1,0),A,brow,1); STAGE(SB(1,1),Bt,bcol+HALF,1);
    WAIT_V(6); BAR;
    for(int t=0;t<nt-2;t+=2){
      LDB(B0,0,0); SCHED; LDA(At,0,0); STAGE(SA(1,1),A,brow+HALF,t+1);
      WAIT_L(8); BAR; WAIT_L(0); MMA(0,0,At,B0); BAR; SCHED;
      LDB(B1,0,1); STAGE(SB(0,0),Bt,bcol,t+2);
      BAR; WAIT_L(0); MMA(0,1,At,B1); BAR;
      LDA(At,0,1); STAGE(SA(0,0),A,brow,t+2);
      BAR; WAIT_L(0); MMA(1,0,At,B0); BAR; SCHED;
      STAGE(SB(0,1),Bt,bcol+HALF,t+2);
      WAIT_V(6); BAR; MMA(1,1,At,B1); BAR;
      LDB(B0,1,0); SCHED; LDA(At,1,0); STAGE(SA(0,1),A,brow+HALF,t+2);
      WAIT_L(8); BAR; WAIT_L(0); MMA(0,0,At,B0); BAR; SCHED;
      LDB(B1,1,1); STAGE(SB(1,0),Bt,bcol,t+3);
      BAR; WAIT_L(0); MMA(0,1,At,B1); BAR;
      LDA(At,1,1); STAGE(SA(1,0),A,brow,t+3);
      BAR; WAIT_L(0); MMA(1,0,At,B0); BAR; SCHED;
      STAGE(SB(1,1),Bt,bcol+HALF,t+3);
      WAIT_V(6); BAR; MMA(1,1,At,B1); BAR;
    }
    { LDB(B0,0,0); LDA(At,0,0); STAGE(SA(1,1),A,brow+HALF,nt-1);
      BAR; WAIT_L(0); MMA(0,0,At,B0); BAR;
      LDB(B1,0,1); BAR; WAIT_L(0); MMA(0,1,At,B1); BAR;
      LDA(At,0,1); WAIT_V(4); BAR; WAIT_L(0); MMA(1,0,At,B0); MMA(1,1,At,B1); BAR; }
    { LDB(B0,1,0); LDA(At,1,0); WAIT_V(2); BAR; WAIT_L(0); MMA(0,0,At,B0); BAR;
      LDB(B1,1,1); WAIT_V(0); BAR; WAIT_L(0); MMA(0,1,At,B1); BAR;
      LDA(At,1,1); BAR; WAIT_L(0); MMA(1,0,At,B0); MMA(1,1,At,B1); BAR; }
    if(wr==0)BAR;
    #undef SA
    #undef SB
    #undef STAGE
    #undef LDA
    #undef LDB
    #undef MMA
    #undef WAIT_V
    #undef WAIT_L
    #undef BAR
    #undef SCHED
}
__device__ __forceinline__ bool tile_order(int i, int G, int c, int nM, int nN, int& pm, int& pn) {
    const int nwg = nM * nN; const long L = (long)i * G + c; if (L >= nwg) return false;
    int wgid = (int)L; { const int q = nwg / 8, r = nwg % 8, xcd = wgid % 8, off = wgid / 8; wgid = (xcd < r ? xcd * (q + 1) : r * (q + 1) + (xcd - r) * q) + off; }
    const int nig = 8 * nN, gid = wgid / nig, fm = gid * 8, gsz = (nM - fm) < 8 ? (nM - fm) : 8;
    pm = fm + ((wgid % nig) % gsz); pn = (wgid % nig) / gsz; return true;
}

struct ConvJob { const float* src; int ld, K, nbegin, ncount, map; bf16_t* dst; };
__device__ __forceinline__ ConvJob conv_job(const PV& P, int j) {
    const int l = j >> 4, q = j & 15; bf16_t* W = wl(P, l); ConvJob c; c.map = 0; c.nbegin = 0;
    switch (q) {
        case 0: c.src = P.inp(8) + (size_t)l * 1024 * 5632; c.ld = 5632; c.K = 1024; c.ncount = 5632; c.dst = W + OW_FA_IN; c.map = 1; break;
        case 1: c.src = P.inp(9) + (size_t)l * 2816 * 1024; c.ld = 1024; c.K = 2816; c.ncount = 1024; c.dst = W + OW_FA_OUT; break;
        case 2: c.src = P.inp(10) + (size_t)l * 1024 * 5632; c.ld = 5632; c.K = 1024; c.ncount = 5632; c.dst = W + OW_FB_IN; c.map = 1; break;
        case 3: c.src = P.inp(11) + (size_t)l * 2816 * 1024; c.ld = 1024; c.K = 2816; c.ncount = 1024; c.dst = W + OW_FB_OUT; break;
        case 4: c.src = P.inp(12) + (size_t)l * 1024 * 8576; c.ld = 8576; c.K = 1024; c.ncount = 3456; c.dst = W + OW_WIN; break;
        case 5: c.src = P.inp(12) + (size_t)l * 1024 * 8576; c.ld = 8576; c.K = 1024; c.nbegin = 3968; c.ncount = 4608; c.dst = W + OW_WIN + (size_t)3968 * 1024; break;
        case 6: case 7: case 8: case 9: { const int n = q - 6; c.src = P.inp(27) + (size_t)(l * 4 + n) * 512 * 1024; c.ld = 1024; c.K = 512; c.ncount = 1024; c.dst = W + OW_WBR + (size_t)n * 1024 * 512; } break;
        case 10: c.src = P.inp(28) + (size_t)l * 1024 * 1024; c.ld = 1024; c.K = 1024; c.ncount = 1024; c.dst = W + OW_WOUT; break;
        case 11: case 12: { const int d = q - 11; c.src = P.inp(15) + (size_t)(l * 2 + d) * 64 * 512; c.ld = 512; c.K = 64; c.ncount = 512; c.dst = W + OW_W2T + (size_t)d * 512 * 64; } break;
        case 13: case 14: { const int d = q - 13; c.src = P.inp(17) + (size_t)(l * 2 + d) * 64 * 512; c.ld = 512; c.K = 64; c.ncount = 512; c.dst = W + OW_A2T + (size_t)d * 512 * 64; } break;
        default: c.src = P.inp(18) + (size_t)l * 128 * 512; c.ld = 512; c.K = 128; c.ncount = 512; c.dst = W + OW_G2T; break;
    }
    return c;
}

__device__ __forceinline__ void prep_phase(const Ctx& C, const PV& P, unsigned char* smem) {
    const int tid = C.tid;
    {
        int total = 0;
        for (int j = 0; j < 32; ++j) { ConvJob c = conv_job(P, j); total += (c.K >> 6) * (c.ncount >> 6); }
        float* tile = (float*)smem;
        const int tx = tid & 63, ty = tid >> 6;
        for (int t = C.bid; t < total; t += C.nblk) {
            int tt = t, j = 0; ConvJob c = conv_job(P, 0);
            for (;;) { const int n = (c.K >> 6) * (c.ncount >> 6); if (tt < n) break; tt -= n; ++j; c = conv_job(P, j); }
            const int nkt = c.K >> 6, kt = tt % nkt, nt = tt / nkt, k0 = kt * 64, n0 = nt * 64;
            int col = c.nbegin + n0 + tx;
            if (c.map) { const int np = n0 + tx, blk = np >> 5, w = np & 31, f = blk * 16 + (w & 15); col = (w < 16) ? f : 2816 + f; }
            __syncthreads();
#pragma unroll 4
            for (int i = 0; i < 8; ++i) { const int kk = ty + 8 * i; tile[kk * 65 + tx] = c.src[(size_t)(k0 + kk) * c.ld + col]; }
            __syncthreads();
#pragma unroll 4
            for (int i = 0; i < 8; ++i) { const int nn = ty + 8 * i; c.dst[(size_t)(n0 + nn) * c.K + k0 + tx] = f2bf(tile[tx * 65 + nn]); }
        }
        __syncthreads();
    }
    {
        float* wt = (float*)smem;
        float* cosT = (float*)(smem + 64 * 129 * 4);
        for (int it = C.bid; it < 2 * 4 * 16; it += C.nblk) {
            const int l = it >> 6, g = (it >> 4) & 3, kc = it & 15, k0 = kc * 64;
            const float* src = P.inp(12) + (size_t)l * 1024 * 8576 + 3456 + g * 128;
            __syncthreads();
            for (int e = tid; e < 64 * 128; e += NT) { const int kk = e >> 7, c = e & 127; wt[kk * 129 + c] = src[(size_t)(k0 + kk) * 8576 + c]; }
            if (tid < 128) cosT[tid] = cospif((float)tid * (1.0f / 64.0f));
            __syncthreads();
            bf16_t* dst = wl(P, l) + OW_WIN + (size_t)(3456 + g * 128) * 1024;
            const int kk = tid & 63;
            for (int i = 0; i < 16; ++i) {
                const int j2 = (tid >> 6) + 8 * i, cc = j2 >> 1, part = j2 & 1;
                float s = 0.f;
                if (cc == 0) {
                    if (part == 0) { for (int c = 0; c < 128; ++c) s += wt[kk * 129 + c]; }
                    else { for (int c = 0; c < 128; ++c) s += (c & 1) ? -wt[kk * 129 + c] : wt[kk * 129 + c]; }
                } else if (part == 0) {
                    for (int c = 0; c < 128; ++c) s += wt[kk * 129 + c] * cosT[(cc * c) & 127];
                } else {
                    for (int c = 0; c < 128; ++c) s -= wt[kk * 129 + c] * cosT[(cc * c - 32) & 127];
                }
                dst[(size_t)j2 * 1024 + k0 + kk] = f2bf(s);
            }
        }
        __syncthreads();
    }
    {
        float2* tw = (float2*)(P.ws + WS_TW);
        for (int m = C.bid * NT + tid; m < 4096; m += C.nblk * NT) { const float x = (float)m * (1.0f / 4096.0f); tw[m] = make_float2(cospif(x), -sinpif(x)); }
    }
    {
        float* sc = (float*)smem;
        float* red = (float*)(smem + 18 * 512 * 4);
        float* mod = (float*)(P.ws + WS_MOD);
        for (int it = C.bid; it < 2 * 144; it += C.nblk) {
            const int l = it / 144, n0 = (it % 144) * 64, nl = tid & 63, ks = tid >> 6;
            const float* aw = P.inp(4) + (size_t)l * 1024 * 9216;
            float acc[18];
#pragma unroll
            for (int b = 0; b < 18; ++b) acc[b] = 0.f;
            for (int half = 0; half < 2; ++half) {
                __syncthreads();
                for (int e = tid; e < 18 * 512; e += NT) {
                    const int b = e >> 9, kk = e & 511, k = half * 512 + kk;
                    const float cv = b < 2 ? P.inp(2)[b * 1024 + k] : P.inp(3)[(b - 2) * 1024 + k];
                    sc[e] = cv / (1.0f + __expf(-cv));
                }
                __syncthreads();
                for (int kk = ks * 64; kk < ks * 64 + 64; ++kk) {
                    const float w = aw[(size_t)(half * 512 + kk) * 9216 + n0 + nl];
#pragma unroll
                    for (int b = 0; b < 18; ++b) acc[b] += sc[b * 512 + kk] * w;
                }
            }
            __syncthreads();
#pragma unroll
            for (int b = 0; b < 18; ++b) red[(ks * 18 + b) * 64 + nl] = acc[b];
            __syncthreads();
            for (int e = tid; e < 18 * 64; e += NT) {
                const int b = e >> 6, n = e & 63;
                float s = 0.f;
#pragma unroll
                for (int k8 = 0; k8 < 8; ++k8) s += red[(k8 * 18 + b) * 64 + n];
                mod[((size_t)l * 18 + b) * 9216 + n0 + n] = s + P.inp(5)[(size_t)l * 9216 + n0 + n];
            }
        }
        __syncthreads();
    }
}

constexpr int NR = 4;
__device__ __forceinline__ void rowstats(const f32x4 (&v)[NR][4], float (&mu)[NR], float (&rs)[NR]) {
    float s[NR], q[NR];
#pragma unroll
    for (int u = 0; u < NR; ++u) { s[u] = 0.f;
#pragma unroll
        for (int i = 0; i < 4; ++i) s[u] += (v[u][i][0] + v[u][i][1]) + (v[u][i][2] + v[u][i][3]); }
#pragma unroll
    for (int o = 32; o > 0; o >>= 1) {
#pragma unroll
        for (int u = 0; u < NR; ++u) s[u] += __shfl_xor(s[u], o);
    }
#pragma unroll
    for (int u = 0; u < NR; ++u) { mu[u] = s[u] * (1.0f / 1024.0f); q[u] = 0.f;
#pragma unroll
        for (int i = 0; i < 4; ++i) { const f32x4 dd = v[u][i] - mu[u]; q[u] += (dd[0] * dd[0] + dd[1] * dd[1]) + (dd[2] * dd[2] + dd[3] * dd[3]); } }
#pragma unroll
    for (int o = 32; o > 0; o >>= 1) {
#pragma unroll
        for (int u = 0; u < NR; ++u) q[u] += __shfl_xor(q[u], o);
    }
#pragma unroll
    for (int u = 0; u < NR; ++u) rs[u] = rsqrtf(q[u] * (1.0f / 1024.0f) + 1e-5f);
}
__device__ __forceinline__ void norm_phase(const Ctx& C, const PV& P, int pass, const float* lng, const float* lnb, int mod_layer, int j, bool from_input, bool write_x) {
    const int lane = C.tid & 63, wave = C.tid >> 6;
    bf16_t* hmod = (bf16_t*)(P.ws + WS_HMOD);
    const float* mod = (const float*)(P.ws + WS_MOD);
    const int nw = C.nblk * NWV;
    for (int lt0 = C.bid * NWV + wave; lt0 < TP; lt0 += NR * nw) {
        f32x4 v[NR][4]; int gr[NR], bb[NR]; bool ok[NR];
#pragma unroll
        for (int u = 0; u < NR; ++u) {
            const int lt = lt0 + u * nw; ok[u] = lt < TP;
            const int ltc = ok[u] ? lt : lt0;
            gr[u] = grow_of(pass, ltc); bb[u] = brow_of(pass, ltc);
            const float* src = from_input ? (gr[u] < 16384 ? P.inp(0) + (size_t)gr[u] * 1024 : P.inp(1) + (size_t)(gr[u] - 16384) * 1024) : P.out + (size_t)gr[u] * 1024;
#pragma unroll
            for (int i = 0; i < 4; ++i) v[u][i] = *(const f32x4*)(src + i * 256 + lane * 4);
        }
        float mu[NR], rs[NR];
        if (lng) {
            rowstats(v, mu, rs);
#pragma unroll
            for (int u = 0; u < NR; ++u)
                if (ok[u] && lane == 0) *(f32x2*)(P.ws + WS_STATS + (size_t)(lt0 + u * nw) * 8) = (f32x2){mu[u], rs[u]};
#pragma unroll
            for (int i = 0; i < 4; ++i) {
                const f32x4 g = *(const f32x4*)(lng + i * 256 + lane * 4), be = *(const f32x4*)(lnb + i * 256 + lane * 4);
#pragma unroll
                for (int u = 0; u < NR; ++u) v[u][i] = (v[u][i] - mu[u]) * rs[u] * g + be;
            }
        }
        if (write_x) {
#pragma unroll
            for (int u = 0; u < NR; ++u) if (ok[u]) {
#pragma unroll
                for (int i = 0; i < 4; ++i) *(f32x4*)(P.out + (size_t)gr[u] * 1024 + i * 256 + lane * 4) = v[u][i];
            }
        }
        if (j >= 0) {
            rowstats(v, mu, rs);
#pragma unroll
            for (int u = 0; u < NR; ++u) {
                if (!ok[u]) continue;
                const float* mb = mod + ((size_t)mod_layer * 18 + bb[u]) * 9216 + (size_t)(3 * j) * 1024;
                const int lt = lt0 + u * nw;
#pragma unroll
                for (int i = 0; i < 4; ++i) {
                    const f32x4 sh = *(const f32x4*)(mb + i * 256 + lane * 4), scl = *(const f32x4*)(mb + 1024 + i * 256 + lane * 4);
                    const f32x4 hh = (v[u][i] - mu[u]) * rs[u] * (1.0f + scl) + sh;
                    u32x2 o; o.x = pack2bf(hh[0], hh[1]); o.y = pack2bf(hh[2], hh[3]);
                    *(u32x2*)(hmod + (size_t)lt * 1024 + i * 256 + lane * 4) = o;
                }
            }
        }
    }
}

__device__ __forceinline__ void ffn_up_phase(const Ctx& C, const PV& P, const bf16_t* Wt) {
    const bf16_t* hmod = (const bf16_t*)(P.ws + WS_HMOD);
    bf16_t* act = (bf16_t*)(P.ws + WS_R + R_ACT);
    int pm, pn;
    for (int it = 0; tile_order(it, C.nblk, C.bid, TP / 256, 22, pm, pn); ++it) {
        f32x4 acc[2][2][4][2];
        gemm256(C, acc, hmod, Wt, 1024, pm * 256, pn * 256);
        int z2 = 0; asm volatile("" : "+s"(z2));
        const int tid2 = tid_now(C.wave_s, z2), lane = tid2 & 63, wid = tid2 >> 6, wr = wid >> 2, wc = wid & 3, fr = lane & 15, fq = lane >> 4;
#pragma unroll
        for (int ai = 0; ai < 2; ++ai)
#pragma unroll
            for (int m = 0; m < 4; ++m) {
                const int row = pm * 256 + ai * 128 + wr * 64 + m * 16 + fr;
#pragma unroll
                for (int bj = 0; bj < 2; ++bj) {
                    const int colbase = pn * 256 + bj * 128 + wc * 32, f = (colbase >> 5) * 16 + fq * 4;
                    const f32x4 a = acc[ai][bj][m][0], bb = acc[ai][bj][m][1];
                    float o[4];
#pragma unroll
                    for (int r = 0; r < 4; ++r) o[r] = a[r] * sigmoidf_(a[r]) * bb[r];
                    u32x2 w; w.x = pack2bf(o[0], o[1]); w.y = pack2bf(o[2], o[3]);
                    *(u32x2*)(act + (size_t)row * 2816 + f) = w;
                }
            }
    }
}

__device__ __forceinline__ void resid_gemm_phase(const Ctx& C, const PV& P, int pass, const bf16_t* A, int K, const bf16_t* Wt, int layer, int j, float scale, const float* xg, const float* xb) {
    const float* mod = (const float*)(P.ws + WS_MOD);
    int pm, pn;
    for (int it = 0; tile_order(it, C.nblk, C.bid, TP / 256, 4, pm, pn); ++it) {
        f32x4 acc[2][2][4][2];
        gemm256(C, acc, A, Wt, K, pm * 256, pn * 256);
        int z2 = 0; asm volatile("" : "+s"(z2));
        const int tid2 = tid_now(C.wave_s, z2), lane = tid2 & 63, wid = tid2 >> 6, wr = wid >> 2, wc = wid & 3, fr = lane & 15, fq = lane >> 4;
#pragma unroll
        for (int ai = 0; ai < 2; ++ai)
#pragma unroll
            for (int m = 0; m < 4; ++m) {
                const int lt = pm * 256 + ai * 128 + wr * 64 + m * 16 + fr;
                const int gr = grow_of(pass, lt), b = brow_of(pass, lt);
                const float* gate = mod + ((size_t)layer * 18 + b) * 9216 + (size_t)(3 * j + 2) * 1024;
                const float* xsrc = xg ? P.out + (size_t)gr * 1024 : (gr < 16384 ? P.inp(0) + (size_t)gr * 1024 : P.inp(1) + (size_t)(gr - 16384) * 1024);
                f32x2 st = (f32x2){0.f, 1.f};
                if (xg) st = *(const f32x2*)(P.ws + WS_STATS + (size_t)lt * 8);
#pragma unroll
                for (int bj = 0; bj < 2; ++bj)
#pragma unroll
                    for (int n = 0; n < 2; ++n) {
                        const int col = pn * 256 + bj * 128 + wc * 32 + n * 16 + fq * 4;
                        f32x4 x = *(const f32x4*)(xsrc + col);
                        if (xg) x = (x - st[0]) * st[1] * *(const f32x4*)(xg + col) + *(const f32x4*)(xb + col);
                        const f32x4 g = *(const f32x4*)(gate + col);
                        *(f32x4*)(P.out + (size_t)gr * 1024 + col) = ALPHA * x + (1.0f + g) * scale * acc[ai][bj][m][n];
                    }
                asm volatile("" ::: "memory");
            }
    }
}

__device__ __forceinline__ void win_phase(const Ctx& C, const PV& P, int layer) {
    const bf16_t* hmod = (const bf16_t*)(P.ws + WS_HMOD);
    const bf16_t* Wt = wl(P, layer) + OW_WIN;
    unsigned char* R = P.ws + WS_R;
    f16* raw = (f16*)(R + R_RAW); bf16_t* Qb = (bf16_t*)(R + R_Q); bf16_t* Kb = (bf16_t*)(R + R_K); bf16_t* Vt = (bf16_t*)(R + R_VT);
    f16* Zc = (f16*)(R + R_ZC); f16* poolp = (f16*)(R + R_POOLP);
    typedef f16 f16x4 __attribute__((ext_vector_type(4)));
    typedef f16 f16x2 __attribute__((ext_vector_type(2)));
    int pm, pn;
    for (int it = 0; tile_order(it, C.nblk, C.bid, TP / 256, 18, pm, pn); ++it) {
        const int lt_t = pm * 256, sq = lt_t < 8192 ? 0 : 1 + ((lt_t - 8192) >> 12), lt0 = seqbase_of(sq), S = seqlen_of(sq);
        f32x4 acc[2][2][4][2];
        gemm256(C, acc, hmod, Wt, 1024, pm * 256, pn * 256);
        int z2 = 0; asm volatile("" : "+s"(z2));
        const int tid2 = tid_now(C.wave_s, z2), lane = tid2 & 63, wid = tid2 >> 6, wr = wid >> 2, wc = wid & 3, fr = lane & 15, fq = lane >> 4;
#pragma unroll
        for (int bj = 0; bj < 2; ++bj) {
            const int tn = pn * 2 + bj;
            if (tn >= 35) continue;
#pragma unroll
            for (int ai = 0; ai < 2; ++ai)
#pragma unroll
                for (int m = 0; m < 4; ++m) {
                    const int lt = pm * 256 + ai * 128 + wr * 64 + m * 16 + fr, pos = lt - lt0;
#pragma unroll
                    for (int n = 0; n < 2; ++n) {
                        const int col = tn * 128 + wc * 32 + n * 16 + fq * 4;
                        f32x4 v = acc[ai][bj][m][n];
                        if (tn < 15) {
                            f16x4 h; h[0] = (f16)v[0]; h[1] = (f16)v[1]; h[2] = (f16)v[2]; h[3] = (f16)v[3];
                            *(f16x4*)(raw + (size_t)lt * 1920 + col) = h;
                        } else if (tn < 23) {
                            const int nq = (col - 1920) & 511, hc = nq >> 6, d = nq & 63;
                            if (n == 0 && (wc & 1) == 0) {
#pragma unroll
                                for (int r = 0; r < 4; ++r) {
                                    const float invlo = r == 0 ? 1.0f : r == 1 ? 0.1939227432012558f : r == 2 ? 0.03760603070259094f : 0.007292664609849453f;
                                    const float invhi = r == 0 ? 0.0014142135623842478f : r == 1 ? 0.00027424818836152554f : r == 2 ? 5.3182957344688475e-05f : 1.0313385246263351e-05f;
                                    const float ang = (float)pos * ((fq & 1) ? invhi : invlo);
                                    const float hi = ang * 0.15915493667125702f;
                                    const float lo = __builtin_fmaf(ang, 0.15915493667125702f, -hi) + ang * 6.4206382432985265e-09f;
                                    const float rr = (hi - floorf(hi)) + lo;
                                    const float cs = __builtin_amdgcn_cosf(rr), sn = __builtin_amdgcn_sinf(rr);
                                    const float other = __shfl_xor(v[r], 32);
                                    v[r] = (fq < 2) ? (v[r] * cs - other * sn) : (other * sn + v[r] * cs);
                                }
                            }
                            bf16_t* dst = (tn < 19) ? Qb : Kb;
                            const float sc = (tn < 19) ? 0.125f * 1.44269504088896f : 1.0f;
                            u32x2 w; w.x = pack2bf(v[0] * sc, v[1] * sc); w.y = pack2bf(v[2] * sc, v[3] * sc);
                            *(u32x2*)(dst + (size_t)lt0 * 512 + ((size_t)hc * S + pos) * 64 + d) = w;
                        } else if (tn < 27) {
                            const int nv = col - 2944;
                            bf16_t* vb = Vt + (size_t)lt0 * 512 + (size_t)nv * S + pos;
                            vb[0] = f2bf(v[0]); vb[(size_t)S] = f2bf(v[1]); vb[(size_t)2 * S] = f2bf(v[2]); vb[(size_t)3 * S] = f2bf(v[3]);
                        } else if (tn < 31) {
                            const int nz = col - 3456, g = nz >> 7, cc = (nz & 127) >> 1;
                            f16x2 z0, z1; z0[0] = (f16)v[0]; z0[1] = (f16)v[1]; z1[0] = (f16)v[2]; z1[1] = (f16)v[3];
                            f16x2* zb = (f16x2*)Zc + (size_t)lt0 * 256;
                            zb[(size_t)(g * 64 + cc) * S + pos] = z0;
                            zb[(size_t)(g * 64 + cc + 1) * S + pos] = z1;
                        } else {
                            f16x4 h; h[0] = (f16)v[0]; h[1] = (f16)v[1]; h[2] = (f16)v[2]; h[3] = (f16)v[3];
                            *(f16x4*)(poolp + (size_t)lt * 512 + (col - 3968)) = h;
                        }
                    }
                    asm volatile("" ::: "memory");
                }
        }
    }
}

__device__ __forceinline__ float shiftv(const f16* __restrict__ raw, int lt, int t, int S, int col, float mu) {
    const float p = (float)raw[(size_t)lt * 1920 + col];
    const float pr = t > 0 ? (float)raw[(size_t)(lt - 1) * 1920 + col] : 0.f;
    const float nx = t < S - 1 ? (float)raw[(size_t)(lt + 1) * 1920 + col] : 0.f;
    return p + (0.5f * (pr + nx) - p) * mu;
}

typedef f16 f16x4_t __attribute__((ext_vector_type(4)));
typedef f16 f16x8_t __attribute__((ext_vector_type(8)));
__device__ __forceinline__ void lin_pool_phase(const Ctx& C, const PV& P, int layer) {
    unsigned char* R = P.ws + WS_R;
    const f16* raw = (const f16*)(R + R_RAW); bf16_t* lin = (bf16_t*)(R + R_LIN);
    const f16* poolp = (const f16*)(R + R_POOLP); bf16_t* ypool = (bf16_t*)(R + R_YB) + 3 * SZ512;
    const float* mu = P.inp(13) + (size_t)layer * 1920; const float* pscale = P.inp(26) + (size_t)layer * 512;
    const int gsz = C.nblk * NT, gid = C.bid * NT + C.tid;
    for (int e0 = gid; e0 < TP * 96; e0 += 2 * gsz) {
        f16x4_t p0[2], pm[2], pp[2]; f32x4 m4[2]; int lt_[2], c_[2]; float wm_[2], wp_[2]; bool ok[2];
#pragma unroll
        for (int u = 0; u < 2; ++u) {
            const int e1 = e0 + u * gsz; ok[u] = e1 < TP * 96; const int e = ok[u] ? e1 : e0;
            const int lt = e / 96, c = (e % 96) * 4, col = 1536 + c;
            const int pos = pos_of(lt), S = lt < 8192 ? 8192 : 4096;
            lt_[u] = lt; c_[u] = c; wm_[u] = pos > 0 ? 0.5f : 0.f; wp_[u] = pos < S - 1 ? 0.5f : 0.f;
            p0[u] = *(const f16x4_t*)(raw + (size_t)lt * 1920 + col);
            pm[u] = *(const f16x4_t*)(raw + (size_t)(pos > 0 ? lt - 1 : lt) * 1920 + col);
            pp[u] = *(const f16x4_t*)(raw + (size_t)(pos < S - 1 ? lt + 1 : lt) * 1920 + col);
            m4[u] = *(const f32x4*)(mu + col);
        }
#pragma unroll
        for (int u = 0; u < 2; ++u) {
            float o[4];
#pragma unroll
            for (int r = 0; r < 4; ++r) {
                const float p = (float)p0[u][r];
                float v = p + (wm_[u] * (float)pm[u][r] + wp_[u] * (float)pp[u][r] - p) * m4[u][r];
                if (c_[u] < 128) v = 1.0f - 2.0f * __builtin_amdgcn_rcpf(__expf(2.0f * v) + 1.0f);
                else if (c_[u] >= 256) v = sigmoidf_(v);
                o[r] = v;
            }
            u32x2 w; w.x = pack2bf(o[0], o[1]); w.y = pack2bf(o[2], o[3]);
            if (ok[u]) *(u32x2*)(lin + (size_t)lt_[u] * 384 + c_[u]) = w;
        }
    }
    for (int e0 = gid; e0 < TP * 128; e0 += 2 * gsz) {
        f16x4_t tv[2][16], xv[2]; int lt_[2], c_[2], cnt_[2]; bool ok[2];
#pragma unroll
        for (int u = 0; u < 2; ++u) {
            const int e1 = e0 + u * gsz; ok[u] = e1 < TP * 128; const int e = ok[u] ? e1 : e0;
            const int lt = e >> 7, c = (e & 127) * 4, g = c >> 7, half = 1 << g;
            const int pos = pos_of(lt), S = lt < 8192 ? 8192 : 4096;
            const int lo = max(pos - half, 0), hi = min(pos + half, S);
            lt_[u] = lt; c_[u] = c; cnt_[u] = hi - lo;
            const f16* base = poolp + (size_t)(lt - pos) * 512 + c;
#pragma unroll
            for (int o = -8; o < 8; ++o) {
                const int tt = pos + o;
                const bool in = (o >= -half) && (o < half) && tt >= 0 && tt < S;
                f16x4_t z; z[0] = (f16)0.f; z[1] = (f16)0.f; z[2] = (f16)0.f; z[3] = (f16)0.f;
                tv[u][o + 8] = in ? *(const f16x4_t*)(base + (size_t)tt * 512) : z;
            }
            xv[u] = *(const f16x4_t*)(base + (size_t)pos * 512);
        }
#pragma unroll
        for (int u = 0; u < 2; ++u) {
            float s0 = 0.f, s1 = 0.f, s2 = 0.f, s3 = 0.f;
#pragma unroll
            for (int o = 0; o < 16; ++o) { s0 += (float)tv[u][o][0]; s1 += (float)tv[u][o][1]; s2 += (float)tv[u][o][2]; s3 += (float)tv[u][o][3]; }
            const f32x4 ps = *(const f32x4*)(pscale + c_[u]);
            const float ic = 1.0f / (float)cnt_[u];
            u32x2 w; w.x = pack2bf((s0 * ic - (float)xv[u][0]) * ps[0], (s1 * ic - (float)xv[u][1]) * ps[1]); w.y = pack2bf((s2 * ic - (float)xv[u][2]) * ps[2], (s3 * ic - (float)xv[u][3]) * ps[3]);
            if (ok[u]) *(u32x2*)(ypool + (size_t)lt_[u] * 512 + c_[u]) = w;
        }
    }
    {
        float* invn = (float*)(P.ws + WS_INVN);
        const float* k_k = P.inp(19) + (size_t)layer * 512;
        const int lane = C.tid & 63, wave = C.tid >> 6;
        for (int lt = C.bid * NWV + wave; lt < TP; lt += C.nblk * NWV) {
            const int pos = pos_of(lt), S = lt < 8192 ? 8192 : 4096;
            float ss[8];
#pragma unroll
            for (int h = 0; h < 8; ++h) {
                const int c = h * 64 + lane;
                const float k = shiftv(raw, lt, pos, S, 512 + c, mu[512 + c]) * k_k[c];
                ss[h] = k * k;
            }
#pragma unroll
            for (int h = 0; h < 8; ++h) ss[h] = wsum(ss[h]);
            if (lane < 8) {
                float sel = ss[0];
#pragma unroll
                for (int h = 1; h < 8; ++h) sel = lane == h ? ss[h] : sel;
                invn[(size_t)lt * 8 + lane] = 1.0f / fmaxf(sqrtf(sel), 1e-12f);
            }
        }
    }
}

__device__ __forceinline__ void lora_phase(const Ctx& C, const PV& P, int layer, unsigned char* smem) {
    unsigned char* R = P.ws + WS_R;
    const bf16_t* lin = (const bf16_t*)(R + R_LIN); f16* wa = (f16*)(R + R_WA); f16* gbuf = (f16*)(R + R_G);
    const bf16_t* W = wl(P, layer);
    const int lane = C.tid & 63, wave = (C.tid >> 6) & 3, wm = wave >> 1, wn = wave & 1, fr = lane & 15, fq = lane >> 4;
    for (int t2 = C.bid; t2 < 5 * MT * 2; t2 += C.nblk) {
        const int t = t2 * 2 + (C.tid >> 8);
        const int which = t / (MT * 4), tt = t % (MT * 4), tm = tt >> 2, tn = tt & 3;
        const bf16_t* Bt; int K, acol; const float* bias = nullptr; f16* dst;
        if (which < 2) { Bt = W + OW_W2T + (size_t)which * 512 * 64; K = 64; acol = which * 64; bias = P.inp(14) + (size_t)(layer * 2 + which) * 512; dst = wa + (size_t)which * SZ512; }
        else if (which < 4) { const int d = which - 2; Bt = W + OW_A2T + (size_t)d * 512 * 64; K = 64; acol = 128 + d * 64; bias = P.inp(16) + (size_t)(layer * 2 + d) * 512; dst = wa + (size_t)which * SZ512; }
        else { Bt = W + OW_G2T; K = 128; acol = 256; dst = gbuf; }
        f32x4 acc[4][4];
        gemm_core<4, true>(C, acc, lin + (size_t)tm * 128 * 384 + acol, 384, Bt + (size_t)tn * 128 * K, K, K, smem);
#pragma unroll
        for (int i = 0; i < 4; ++i) {
            const int lt = tm * 128 + wm * 64 + i * 16 + fr;
#pragma unroll
            for (int jn = 0; jn < 4; ++jn) {
                const int n = tn * 128 + wn * 64 + jn * 16 + fq * 4;
                typedef f16 f16x4 __attribute__((ext_vector_type(4)));
                f16x4 h;
#pragma unroll
                for (int r = 0; r < 4; ++r) {
                    float v = acc[i][jn][r];
                    if (which < 2) {
                        const float z = bias[n + r] + v;
                        v = __expf(-0.6065306597126334f * sigmoidf_(z));
                    } else if (which < 4) { v = sigmoidf_(bias[n + r] + v); }
                    h[r] = (f16)v;
                }
                *(f16x4*)(dst + (size_t)lt * 512 + n) = h;
            }
        }
    }
}

__device__ __forceinline__ void attn_items(const Ctx& C, const PV& P, int layer, int ctr_idx, unsigned char* smem) {
    unsigned char* R = P.ws + WS_R;
    const bf16_t* Qall = (const bf16_t*)(R + R_Q); const bf16_t* Kall = (const bf16_t*)(R + R_K); const bf16_t* Vall = (const bf16_t*)(R + R_VT);
    bf16_t* ydiff = (bf16_t*)(R + R_YB) + 1 * SZ512;
    const int tid = C.tid, lane = tid & 63, wave = tid >> 6, comp = wave & 1, rg = wave >> 1, fr = lane & 15, fq = lane >> 4;
    const float lam_init = layer == 0 ? 0.2f : (0.8f - 0.6f * 0.7408182206817179f);
    float lam_full;
    {
        const float* lm = P.inp(24) + (size_t)layer * 256;
        float s1 = 0.f, s2 = 0.f;
        for (int i = 0; i < 64; ++i) { s1 += lm[i] * lm[64 + i]; s2 += lm[128 + i] * lm[192 + i]; }
        lam_full = expf(s1) - expf(s2) + lam_init;
    }
    const float* normg = P.inp(25) + (size_t)layer * 128;
    unsigned* ctr = (unsigned*)(P.ws + WS_CTR) + ctr_idx * 16;
    volatile unsigned* bc = (volatile unsigned*)(smem + 131088);
    for (;;) {
        __syncthreads();
        if (tid == 0) *bc = atomicAdd(ctr, 1u);
        __syncthreads();
        const int item = (int)*bc;
        if (item >= 1280) break;
        int sq, h, qb;
        if (item < 256) { sq = 0; h = item >> 6; qb = item & 63; } else { const int i2 = item - 256; sq = 1 + (i2 >> 7); h = (i2 >> 5) & 3; qb = i2 & 31; }
        const int lt0 = seqbase_of(sq), S = seqlen_of(sq);
        const bf16_t* Qb = Qall + (size_t)lt0 * 512; const bf16_t* Kb = Kall + (size_t)lt0 * 512; const bf16_t* Vb = Vall + (size_t)lt0 * 512 + (size_t)h * 128 * S;
        const int q0 = qb * 128 + rg * 32;
        bf16x8 bq[2][2];
#pragma unroll
        for (int qs = 0; qs < 2; ++qs)
#pragma unroll
            for (int ks = 0; ks < 2; ++ks) bq[qs][ks] = *(const bf16x8*)(Qb + ((size_t)(h * 2 + comp) * S + q0 + qs * 16 + fr) * 64 + ks * 32 + fq * 8);
        float m_run[2] = {-1e30f, -1e30f}, l_run[2] = {0.f, 0.f};
        f32x4 O[8][2];
#pragma unroll
        for (int a = 0; a < 8; ++a) { O[a][0] = (f32x4){0.f, 0.f, 0.f, 0.f}; O[a][1] = (f32x4){0.f, 0.f, 0.f, 0.f}; }
        u32x4 rk[2], rv[2];
        const int lrow = tid >> 3, lkc = (tid & 7) * 8;
        auto gload = [&](int kt0) {
#pragma unroll
            for (int i = 0; i < 2; ++i) {
                const int row = lrow + 64 * i, cm = row >> 6, key = row & 63;
                rk[i] = *(const u32x4*)(Kb + ((size_t)(h * 2 + cm) * S + kt0 + key) * 64 + lkc);
                rv[i] = *(const u32x4*)(Vb + (size_t)row * S + kt0 + lkc);
            }
        };
        auto lstore = [&](int b) {
            unsigned char* sb = smem + b * 36864;
#pragma unroll
            for (int i = 0; i < 2; ++i) {
                const int row = lrow + 64 * i;
                *(u32x4*)(sb + row * 144 + lkc * 2) = rk[i];
                *(u32x4*)(sb + 18432 + row * 144 + lkc * 2) = rv[i];
            }
        };
        bf16x8 pb[2][2];
        auto H1 = [&](int b) {
            const unsigned char* sb = smem + b * 36864;
            f32x4 st[4][2];
#pragma unroll
            for (int t = 0; t < 4; ++t) {
                st[t][0] = (f32x4){0.f, 0.f, 0.f, 0.f}; st[t][1] = (f32x4){0.f, 0.f, 0.f, 0.f};
#pragma unroll
                for (int ks = 0; ks < 2; ++ks) {
                    const bf16x8 kf = *(const bf16x8*)(sb + (comp * 64 + t * 16 + fr) * 144 + (ks * 32 + fq * 8) * 2);
                    st[t][0] = __builtin_amdgcn_mfma_f32_16x16x32_bf16(kf, bq[0][ks], st[t][0], 0, 0, 0);
                    st[t][1] = __builtin_amdgcn_mfma_f32_16x16x32_bf16(kf, bq[1][ks], st[t][1], 0, 0, 0);
                }
            }
#pragma unroll
            for (int qs = 0; qs < 2; ++qs) {
                float mx = -1e30f;
#pragma unroll
                for (int t = 0; t < 4; ++t)
#pragma unroll
                    for (int r = 0; r < 4; ++r) mx = fmaxf(mx, st[t][qs][r]);
                mx = fmaxf(mx, __shfl_xor(mx, 16)); mx = fmaxf(mx, __shfl_xor(mx, 32));
                const float mnew = fmaxf(m_run[qs], mx);
                const float alpha = __builtin_amdgcn_exp2f(m_run[qs] - mnew);
                m_run[qs] = mnew;
                float ls = 0.f;
                float pv[4][4];
#pragma unroll
                for (int t = 0; t < 4; ++t)
#pragma unroll
                    for (int r = 0; r < 4; ++r) { pv[t][r] = __builtin_amdgcn_exp2f(st[t][qs][r] - mnew); ls += pv[t][r]; }
                l_run[qs] = l_run[qs] * alpha + ls;
                if (__builtin_amdgcn_ballot_w64(alpha != 1.0f) != 0ull) {
#pragma unroll
                    for (int a = 0; a < 8; ++a) O[a][qs] = O[a][qs] * alpha;
                }
#pragma unroll
                for (int u = 0; u < 2; ++u) {
                    union { bf16x8 v; unsigned w[4]; } pk;
                    pk.w[0] = pack2bf(pv[2 * u][0], pv[2 * u][1]); pk.w[1] = pack2bf(pv[2 * u][2], pv[2 * u][3]);
                    pk.w[2] = pack2bf(pv[2 * u + 1][0], pv[2 * u + 1][1]); pk.w[3] = pack2bf(pv[2 * u + 1][2], pv[2 * u + 1][3]);
                    pb[qs][u] = pk.v;
                }
            }
        };
        auto H2 = [&](int b) {
            const unsigned char* sb = smem + b * 36864 + 18432;
#pragma unroll
            for (int u = 0; u < 2; ++u)
#pragma unroll
                for (int a = 0; a < 8; ++a) {
                    union { bf16x8 v; u32x2 h[2]; } vf;
                    vf.h[0] = *(const u32x2*)(sb + (a * 16 + fr) * 144 + (u * 32 + fq * 4) * 2);
                    vf.h[1] = *(const u32x2*)(sb + (a * 16 + fr) * 144 + (u * 32 + 16 + fq * 4) * 2);
                    O[a][0] = __builtin_amdgcn_mfma_f32_16x16x32_bf16(vf.v, pb[0][u], O[a][0], 0, 0, 0);
                    O[a][1] = __builtin_amdgcn_mfma_f32_16x16x32_bf16(vf.v, pb[1][u], O[a][1], 0, 0, 0);
                }
        };
        const int grp = wave >> 2, T = S >> 6;
        gload(0);
        lstore(0);
        __syncthreads();
        for (int t = 0; t < T; ++t) {
            if (t + 1 < T) gload((t + 1) * 64);
            if (grp == 0) H1(t & 1); else if (t > 0) H2((t - 1) & 1);
            __syncthreads();
            if (t + 1 < T) lstore((t + 1) & 1);
            if (grp == 0) H2(t & 1); else H1(t & 1);
            __syncthreads();
        }
        if (grp == 1) H2((T - 1) & 1);
#pragma unroll
        for (int qs = 0; qs < 2; ++qs) {
            float l = l_run[qs]; l += __shfl_xor(l, 16); l += __shfl_xor(l, 32);
            const float inv = 1.0f / l;
#pragma unroll
            for (int a = 0; a < 8; ++a) O[a][qs] = O[a][qs] * inv;
        }
        __syncthreads();
        float* Ox = (float*)smem;
        if (comp == 1) {
#pragma unroll
            for (int qs = 0; qs < 2; ++qs)
#pragma unroll
                for (int a = 0; a < 8; ++a)
#pragma unroll
                    for (int r = 0; r < 4; ++r) Ox[(rg * 128 + a * 16 + fq * 4 + r) * 32 + qs * 16 + fr] = O[a][qs][r];
        }
        __syncthreads();
        if (comp == 0) {
#pragma unroll
            for (int qs = 0; qs < 2; ++qs) {
                float ss = 0.f;
#pragma unroll
                for (int a = 0; a < 8; ++a)
#pragma unroll
                    for (int r = 0; r < 4; ++r) {
                        const float o = O[a][qs][r] - lam_full * Ox[(rg * 128 + a * 16 + fq * 4 + r) * 32 + qs * 16 + fr];
                        O[a][qs][r] = o; ss += o * o;
                    }
                ss += __shfl_xor(ss, 16); ss += __shfl_xor(ss, 32);
                const float sc = rsqrtf(ss * (1.0f / 128.0f) + 1e-5f) * (1.0f - lam_init);
                const int lt = lt0 + q0 + qs * 16 + fr;
#pragma unroll
                for (int a = 0; a < 8; ++a) {
                    const int dv = a * 16 + fq * 4;
                    const float4 g = *(const float4*)(normg + dv);
                    uint2 w; w.x = pack2bf(O[a][qs][0] * sc * g.x, O[a][qs][1] * sc * g.y); w.y = pack2bf(O[a][qs][2] * sc * g.z, O[a][qs][3] * sc * g.w);
                    *(uint2*)(ydiff + (size_t)lt * 512 + h * 128 + dv) = w;
                }
            }
        }
    }
    __syncthreads();
}

__device__ __forceinline__ void fft_items(const Ctx& C, const PV& P, unsigned char* smem) {
    unsigned char* R = P.ws + WS_R;
    typedef f16 f16x2 __attribute__((ext_vector_type(2)));
    const f16x2* Zall = (const f16x2*)(R + R_ZC);
    bf16_t* yf = (bf16_t*)(R + R_YB) + 2 * SZ512;
    const float2* tw = (const float2*)(P.ws + WS_TW);
    float2* sm = (float2*)smem;
    const int tid = C.tid;
    for (int item = C.bid; item < NSEQ * 256; item += C.nblk) {
        const int sq = item >> 8, col = item & 255, g = col >> 6, cc = col & 63;
        const int lt0 = seqbase_of(sq), S = seqlen_of(sq), lg = sq == 0 ? 13 : 12;
        const f16x2* z = Zall + (size_t)lt0 * 256 + (size_t)col * S;
        __syncthreads();
        for (int s = tid; s < S; s += NT) { const f16x2 v = z[s]; sm[__brev((unsigned)s) >> (32 - lg)] = make_float2((float)v[0], (float)v[1]); }
        __syncthreads();
        int st = 0;
        for (; st + 1 < lg; st += 2) {
            const int half = 1 << st;
            for (int gq = tid; gq < (S >> 2); gq += NT) {
                const int j = gq & (half - 1), p0 = ((gq >> st) << (st + 2)) + j, p1 = p0 + half, p2 = p1 + half, p3 = p2 + half;
                const float2 w1 = tw[j << (12 - st)], wa = tw[j << (11 - st)], wb = tw[(j + half) << (11 - st)];
                const float2 x0 = sm[p0], x1 = sm[p1], x2 = sm[p2], x3 = sm[p3];
                const float2 t1 = make_float2(w1.x * x1.x - w1.y * x1.y, w1.x * x1.y + w1.y * x1.x);
                const float2 t3 = make_float2(w1.x * x3.x - w1.y * x3.y, w1.x * x3.y + w1.y * x3.x);
                const float2 a0 = make_float2(x0.x + t1.x, x0.y + t1.y), a1 = make_float2(x0.x - t1.x, x0.y - t1.y);
                const float2 a2 = make_float2(x2.x + t3.x, x2.y + t3.y), a3 = make_float2(x2.x - t3.x, x2.y - t3.y);
                const float2 u2 = make_float2(wa.x * a2.x - wa.y * a2.y, wa.x * a2.y + wa.y * a2.x);
                const float2 u3 = make_float2(wb.x * a3.x - wb.y * a3.y, wb.x * a3.y + wb.y * a3.x);
                sm[p0] = make_float2(a0.x + u2.x, a0.y + u2.y); sm[p2] = make_float2(a0.x - u2.x, a0.y - u2.y);
                sm[p1] = make_float2(a1.x + u3.x, a1.y + u3.y); sm[p3] = make_float2(a1.x - u3.x, a1.y - u3.y);
            }
            __syncthreads();
        }
        for (; st < lg; ++st) {
            const int half = 1 << st, tshift = 12 - st;
            for (int b = tid; b < (S >> 1); b += NT) {
                const int j = b & (half - 1), i0 = ((b >> st) << (st + 1)) + j, i1 = i0 + half;
                const float2 w = tw[j << tshift], u = sm[i0], x = sm[i1];
                const float2 tv = make_float2(w.x * x.x - w.y * x.y, w.x * x.y + w.y * x.x);
                sm[i0] = make_float2(u.x + tv.x, u.y + tv.y); sm[i1] = make_float2(u.x - tv.x, u.y - tv.y);
            }
            __syncthreads();
        }
        const float nrm = rsqrtf((float)S * 128.0f);
        for (int k = tid; k < S; k += NT) {
            const float2 a = sm[k], b = sm[(S - k) & (S - 1)];
            bf16_t* row = yf + (size_t)(lt0 + k) * 512 + g * 128;
            if (cc == 0) { row[0] = f2bf(0.5f * (a.x + b.x) * nrm); row[64] = f2bf(0.5f * (a.y + b.y) * nrm); }
            else { row[cc] = f2bf(a.x * nrm); row[128 - cc] = f2bf(b.x * nrm); }
        }
    }
    __syncthreads();
}

template <int KT>
__device__ __forceinline__ void scan_block(const Ctx& C, const PV& P, int layer, int sq, int h, int d, int row0, unsigned char* smem) {
    constexpr int TPR = 64 / KT, ROWS = NT / TPR, CH = 16, YP = TPR / 4, NV = ROWS / 32;
    unsigned char* R = P.ws + WS_R;
    const f16* raw = (const f16*)(R + R_RAW); const f16* wa = (const f16*)(R + R_WA); f16* yfb = (f16*)(R + R_YFB);
    const float* invn = (const float*)(P.ws + WS_INVN);
    const float* mu = P.inp(13) + (size_t)layer * 1920; const float* k_k = P.inp(19) + (size_t)layer * 512; const float* k_a = P.inp(20) + (size_t)layer * 512;
    const int tid = C.tid, row = tid / TPR, q = tid % TPR;
    const int lt0 = seqbase_of(sq), S = seqlen_of(sq);
    const int ch = tid & 63, c = h * 64 + ch;
    const float mu_r = mu[c], mu_k = mu[512 + c], kkw = k_k[c], kaw = k_a[c];
    const int vr = (ROWS == 32) ? (tid & 31) : (tid & 63);
    const int vcol = 1024 + h * 64 + row0 + vr; const float mu_v = mu[vcol];
    const f16* wdec = wa + (size_t)d * SZ512; const f16* aact = wa + (size_t)(2 + d) * SZ512;
    f16* ydst = yfb + (size_t)d * SZ512;
    f32x2 s[KT / 2];
#pragma unroll
    for (int j = 0; j < KT / 2; ++j) s[j] = (f32x2){0.f, 0.f};
    f16 pr_[2][3], pk_[2][3], pa_[2], pw_[2], pv_[NV][3]; float pn_[2];
    auto prefetch = [&](int c0) {
#pragma unroll
        for (int j = 0; j < 2; ++j) {
            const int i = (tid >> 6) + 8 * j, tstep = c0 + i, t = d == 0 ? tstep : S - 1 - tstep, lt = lt0 + t;
            const int tm = t > 0 ? lt - 1 : lt, tp = t < S - 1 ? lt + 1 : lt;
            pr_[j][0] = raw[(size_t)tm * 1920 + c]; pr_[j][1] = raw[(size_t)lt * 1920 + c]; pr_[j][2] = raw[(size_t)tp * 1920 + c];
            pk_[j][0] = raw[(size_t)tm * 1920 + 512 + c]; pk_[j][1] = raw[(size_t)lt * 1920 + 512 + c]; pk_[j][2] = raw[(size_t)tp * 1920 + 512 + c];
            pa_[j] = aact[(size_t)lt * 512 + c]; pw_[j] = wdec[(size_t)lt * 512 + c]; pn_[j] = invn[(size_t)lt * 8 + h];
        }
#pragma unroll
        for (int j = 0; j < NV; ++j) {
            const int i = (ROWS == 32) ? (tid >> 5) : ((tid >> 6) + 8 * j), tstep = c0 + i, t = d == 0 ? tstep : S - 1 - tstep, lt = lt0 + t;
            const int tm = t > 0 ? lt - 1 : lt, tp = t < S - 1 ? lt + 1 : lt;
            pv_[j][0] = raw[(size_t)tm * 1920 + vcol]; pv_[j][1] = raw[(size_t)lt * 1920 + vcol]; pv_[j][2] = raw[(size_t)tp * 1920 + vcol];
        }
    };
    auto stage = [&](int c0, unsigned char* buf) {
        float* vec = (float*)buf; float* vbuf = (float*)(buf + 20480);
#pragma unroll
        for (int j = 0; j < 2; ++j) {
            const int i = (tid >> 6) + 8 * j, tstep = c0 + i, t = d == 0 ? tstep : S - 1 - tstep;
            const float rm = t > 0 ? (float)pr_[j][0] : 0.f, rp = t < S - 1 ? (float)pr_[j][2] : 0.f, km = t > 0 ? (float)pk_[j][0] : 0.f, kp = t < S - 1 ? (float)pk_[j][2] : 0.f;
            const float r1 = (float)pr_[j][1], k1 = (float)pk_[j][1];
            const float r = r1 + (0.5f * (rm + rp) - r1) * mu_r;
            const float k = k1 + (0.5f * (km + kp) - k1) * mu_k;
            const float kk = k * kkw * pn_[j], a = (float)pa_[j];
            vec[(0 * CH + i) * 64 + ch] = kk;
            vec[(1 * CH + i) * 64 + ch] = (float)pw_[j];
            vec[(2 * CH + i) * 64 + ch] = kk * a;
            vec[(3 * CH + i) * 64 + ch] = k * (1.0f + (a - 1.0f) * kaw);
            vec[(4 * CH + i) * 64 + ch] = r;
        }
#pragma unroll
        for (int j = 0; j < NV; ++j) {
            const int i = (ROWS == 32) ? (tid >> 5) : ((tid >> 6) + 8 * j), tstep = c0 + i, t = d == 0 ? tstep : S - 1 - tstep;
            const float vm = t > 0 ? (float)pv_[j][0] : 0.f, vp = t < S - 1 ? (float)pv_[j][2] : 0.f, v1 = (float)pv_[j][1];
            vbuf[i * 64 + vr] = v1 + (0.5f * (vm + vp) - v1) * mu_v;
        }
    };
    __syncthreads();
    prefetch(0);
    stage(0, smem);
    __syncthreads();
    const int nch = S / CH;
    for (int cix = 0; cix < nch; ++cix) {
        unsigned char* buf = smem + (cix & 1) * 32768;
        if (cix + 1 < nch) prefetch((cix + 1) * CH);
        {
            const float* vec = (const float*)buf; const float* vbuf = (const float*)(buf + 20480); float* ybuf = (float*)(buf + 24576);
            const f32x4* vp0 = (const f32x4*)(vec + q * KT);
            f32x4 nx[5][KT / 4]; float nvv;
#pragma unroll
            for (int u = 0; u < KT / 4; ++u)
#pragma unroll
                for (int a5 = 0; a5 < 5; ++a5) nx[a5][u] = vp0[a5 * CH * 16 + u];
            nvv = vbuf[row];
            float yv[CH];
#pragma unroll
            for (int i = 0; i < CH; ++i) {
                f32x2 kk2[KT / 2], w2[KT / 2], b2[KT / 2], kd2[KT / 2], r2[KT / 2];
#pragma unroll
                for (int u = 0; u < KT / 4; ++u) {
                    kk2[2 * u] = (f32x2){nx[0][u][0], nx[0][u][1]}; kk2[2 * u + 1] = (f32x2){nx[0][u][2], nx[0][u][3]};
                    w2[2 * u] = (f32x2){nx[1][u][0], nx[1][u][1]}; w2[2 * u + 1] = (f32x2){nx[1][u][2], nx[1][u][3]};
                    b2[2 * u] = (f32x2){nx[2][u][0], nx[2][u][1]}; b2[2 * u + 1] = (f32x2){nx[2][u][2], nx[2][u][3]};
                    kd2[2 * u] = (f32x2){nx[3][u][0], nx[3][u][1]}; kd2[2 * u + 1] = (f32x2){nx[3][u][2], nx[3][u][3]};
                    r2[2 * u] = (f32x2){nx[4][u][0], nx[4][u][1]}; r2[2 * u + 1] = (f32x2){nx[4][u][2], nx[4][u][3]};
                }
                const float vv = nvv;
                if (i + 1 < CH) {
#pragma unroll
                    for (int u = 0; u < KT / 4; ++u)
#pragma unroll
                        for (int a5 = 0; a5 < 5; ++a5) nx[a5][u] = vp0[(i + 1) * 16 + a5 * CH * 16 + u];
                    nvv = vbuf[(i + 1) * 64 + row];
                }
                f32x2 acc2 = s[0] * kk2[0];
#pragma unroll
                for (int j = 1; j < KT / 2; ++j) acc2 = __builtin_elementwise_fma(s[j], kk2[j], acc2);
                float sa = acc2[0] + acc2[1];
                sa += dppf<0xB1>(sa); sa += dppf<0x4E>(sa); sa += dppf<0x141>(sa);
                if (TPR == 16) sa += dppf<0x140>(sa);
                sa = -sa;
                const f32x2 sa2 = (f32x2){sa, sa}, vv2 = (f32x2){vv, vv};
                f32x2 y2 = (f32x2){0.f, 0.f};
#pragma unroll
                for (int j = 0; j < KT / 2; ++j) {
                    s[j] = __builtin_elementwise_fma(s[j], w2[j], __builtin_elementwise_fma(sa2, b2[j], vv2 * kd2[j]));
                    y2 = __builtin_elementwise_fma(s[j], r2[j], y2);
                }
                float y = y2[0] + y2[1];
                y += dppf<0xB1>(y); y += dppf<0x4E>(y);
                yv[i] = y;
            }
            if ((q & 3) == 0) {
#pragma unroll
                for (int i = 0; i < CH; ++i) ybuf[i * 128 + row * YP + (q >> 2)] = yv[i];
            }
        }
        if (cix + 1 < nch) stage((cix + 1) * CH, smem + ((cix + 1) & 1) * 32768);
        __syncthreads();
        {
            const float* ybuf = (const float*)(buf + 24576);
#pragma unroll
            for (int j = 0; j < NV; ++j) {
                const int i = (ROWS == 32) ? (tid >> 5) : ((tid >> 6) + 8 * j), rr = vr, tstep = cix * CH + i, t = d == 0 ? tstep : S - 1 - tstep;
                float y = 0.f;
#pragma unroll
                for (int p = 0; p < YP; ++p) y += ybuf[i * 128 + rr * YP + p];
                ydst[(size_t)(lt0 + t) * 512 + h * 64 + row0 + rr] = (f16)y;
            }
        }
    }
    __syncthreads();
}

__device__ __forceinline__ void finish_phase(const Ctx& C, const PV& P, int layer) {
    unsigned char* R = P.ws + WS_R;
    const f16* raw = (const f16*)(R + R_RAW); const f16* wa = (const f16*)(R + R_WA); const f16* gbuf = (const f16*)(R + R_G); const f16* yfb = (const f16*)(R + R_YFB);
    bf16_t* yr = (bf16_t*)(R + R_YB);
    const float* mu = P.inp(13) + (size_t)layer * 1920; const float* k_a = P.inp(20) + (size_t)layer * 512; const float* r_k = P.inp(21) + (size_t)layer * 512;
    const float* lg = P.inp(22) + (size_t)layer * 512; const float* lb = P.inp(23) + (size_t)layer * 512;
    const int lane = C.tid & 63, wave = C.tid >> 6, c = lane * 8;
    const int nw = C.nblk * NWV;
    for (int ltb = C.bid * NWV + wave; ltb < TP; ltb += 2 * nw) {
        f16x8_t rA[2], rB[2], rC[2], kA[2], kB[2], kC[2], vA[2], vB[2], vC[2], af[2], ab[2], gg[2], yF[2], yB[2]; float wm_[2], wp_[2]; bool ok[2];
#pragma unroll
        for (int u = 0; u < 2; ++u) {
            const int lt1 = ltb + u * nw; ok[u] = lt1 < TP; const int lt = ok[u] ? lt1 : ltb;
            const int pos = pos_of(lt), S = lt < 8192 ? 8192 : 4096;
            const size_t rm = (size_t)(pos > 0 ? lt - 1 : lt) * 1920, r0 = (size_t)lt * 1920, rp = (size_t)(pos < S - 1 ? lt + 1 : lt) * 1920;
            wm_[u] = pos > 0 ? 0.5f : 0.f; wp_[u] = pos < S - 1 ? 0.5f : 0.f;
            rA[u] = *(const f16x8_t*)(raw + rm + c); rB[u] = *(const f16x8_t*)(raw + r0 + c); rC[u] = *(const f16x8_t*)(raw + rp + c);
            kA[u] = *(const f16x8_t*)(raw + rm + 512 + c); kB[u] = *(const f16x8_t*)(raw + r0 + 512 + c); kC[u] = *(const f16x8_t*)(raw + rp + 512 + c);
            vA[u] = *(const f16x8_t*)(raw + rm + 1024 + c); vB[u] = *(const f16x8_t*)(raw + r0 + 1024 + c); vC[u] = *(const f16x8_t*)(raw + rp + 1024 + c);
            af[u] = *(const f16x8_t*)(wa + 2 * SZ512 + (size_t)lt * 512 + c); ab[u] = *(const f16x8_t*)(wa + 3 * SZ512 + (size_t)lt * 512 + c);
            gg[u] = *(const f16x8_t*)(gbuf + (size_t)lt * 512 + c);
            yF[u] = *(const f16x8_t*)(yfb + (size_t)lt * 512 + c); yB[u] = *(const f16x8_t*)(yfb + SZ512 + (size_t)lt * 512 + c);
        }
#pragma unroll
        for (int u = 0; u < 2; ++u) {
            float y[8], vv[8], bsum = 0.f, ysum = 0.f;
#pragma unroll
            for (int j = 0; j < 8; ++j) {
                const float r_ = (float)rB[u][j], k_ = (float)kB[u][j], v_ = (float)vB[u][j];
                const float r = r_ + (wm_[u] * (float)rA[u][j] + wp_[u] * (float)rC[u][j] - r_) * mu[c + j];
                const float k = k_ + (wm_[u] * (float)kA[u][j] + wp_[u] * (float)kC[u][j] - k_) * mu[512 + c + j];
                vv[j] = v_ + (wm_[u] * (float)vA[u][j] + wp_[u] * (float)vC[u][j] - v_) * mu[1024 + c + j];
                const float ka = k_a[c + j];
                const float ksum = k * (1.f + ((float)af[u][j] - 1.f) * ka) + k * (1.f + ((float)ab[u][j] - 1.f) * ka);
                bsum += r * (0.5f * ksum) * r_k[c + j];
                y[j] = (float)yF[u][j] + (float)yB[u][j]; ysum += y[j];
            }
            const float ym = red8(ysum) * (1.0f / 64.0f);
            float q = 0.f;
#pragma unroll
            for (int j = 0; j < 8; ++j) { const float dy = y[j] - ym; q += dy * dy; }
            const float rs = rsqrtf(red8(q) * (1.0f / 64.0f) + 64e-5f);
            const float bonus = red8(bsum);
            float o[8];
#pragma unroll
            for (int j = 0; j < 8; ++j) o[j] = ((y[j] - ym) * rs * lg[c + j] + lb[c + j] + bonus * vv[j]) * (float)gg[u][j];
            u32x4 w; w.x = pack2bf(o[0], o[1]); w.y = pack2bf(o[2], o[3]); w.z = pack2bf(o[4], o[5]); w.w = pack2bf(o[6], o[7]);
            if (ok[u]) *(u32x4*)(yr + (size_t)(ltb + u * nw) * 512 + c) = w;
        }
    }
}

__device__ __forceinline__ void gates_phase(const Ctx& C, const PV& P, int layer) {
    const bf16_t* hmod = (const bf16_t*)(P.ws + WS_HMOD);
    const bf16_t* Wt = wl(P, layer) + OW_WIN + (size_t)4480 * 1024;
    bf16_t* gates = (bf16_t*)(P.ws + WS_R + R_GATES);
    int pm, pn;
    for (int it = 0; tile_order(it, C.nblk, C.bid, TP / 256, 16, pm, pn); ++it) {
        f32x4 acc[2][2][4][2];
        gemm256(C, acc, hmod, Wt, 1024, pm * 256, pn * 256);
        int z2 = 0; asm volatile("" : "+s"(z2));
        const int tid2 = tid_now(C.wave_s, z2), lane = tid2 & 63, wid = tid2 >> 6, wr = wid >> 2, wc = wid & 3, fr = lane & 15, fq = lane >> 4;
#pragma unroll
        for (int ai = 0; ai < 2; ++ai)
#pragma unroll
            for (int m = 0; m < 4; ++m) {
                const int lt = pm * 256 + ai * 128 + wr * 64 + m * 16 + fr;
#pragma unroll
                for (int bj = 0; bj < 2; ++bj)
#pragma unroll
                    for (int n = 0; n < 2; ++n) {
                        const int col = pn * 256 + bj * 128 + wc * 32 + n * 16 + fq * 4;
                        const f32x4 v = acc[ai][bj][m][n];
                        u32x2 w; w.x = pack2bf(sigmoidf_(v[0]), sigmoidf_(v[1])); w.y = pack2bf(sigmoidf_(v[2]), sigmoidf_(v[3]));
                        *(u32x2*)(gates + (size_t)lt * 4096 + col) = w;
                    }
            }
    }
}
__device__ __forceinline__ void branch_phase(const Ctx& C, const PV& P, int layer) {
    unsigned char* R = P.ws + WS_R;
    const bf16_t* yb = (const bf16_t*)(R + R_YB); const bf16_t* gates = (const bf16_t*)(R + R_GATES);
    float* m32 = (float*)(R + R_M32); bf16_t* merged = (bf16_t*)(R + R_MERGED);
    const bf16_t* W = wl(P, layer) + OW_WBR;
    int pm, pn;
    for (int it = 0; tile_order(it, C.nblk, C.bid, TP / 256, 4, pm, pn); ++it) {
        for (int nb = 0; nb < 4; ++nb) {
            f32x4 acc[2][2][4][2];
            gemm256(C, acc, yb + (size_t)nb * SZ512, W + (size_t)nb * 1024 * 512, 512, pm * 256, pn * 256);
            int z2 = 0; asm volatile("" : "+s"(z2));
            const int tid2 = tid_now(C.wave_s, z2), lane = tid2 & 63, wid = tid2 >> 6, wr = wid >> 2, wc = wid & 3, fr = lane & 15, fq = lane >> 4;
#pragma unroll
            for (int ai = 0; ai < 2; ++ai)
#pragma unroll
                for (int m = 0; m < 4; ++m) {
                    const int lt = pm * 256 + ai * 128 + wr * 64 + m * 16 + fr;
#pragma unroll
                    for (int bj = 0; bj < 2; ++bj)
#pragma unroll
                        for (int n = 0; n < 2; ++n) {
                            const int col = pn * 256 + bj * 128 + wc * 32 + n * 16 + fq * 4;
                            const u32x2 gw = *(const u32x2*)(gates + (size_t)lt * 4096 + nb * 1024 + col);
                            f32x4 g; g[0] = __uint_as_float(gw.x << 16); g[1] = __uint_as_float(gw.x & 0xffff0000u); g[2] = __uint_as_float(gw.y << 16); g[3] = __uint_as_float(gw.y & 0xffff0000u);
                            f32x4 mv = g * acc[ai][bj][m][n];
                            f32x4* mp = (f32x4*)(m32 + (size_t)lt * 1024 + col);
                            if (nb > 0) mv += *mp;
                            if (nb < 3) *mp = mv;
                            else { u32x2 w; w.x = pack2bf(mv[0], mv[1]); w.y = pack2bf(mv[2], mv[3]); *(u32x2*)(merged + (size_t)lt * 1024 + col) = w; }
                        }
                    asm volatile("" ::: "memory");
                }
        }
    }
}


#define XB_TMO      128
#define XB_XCNT(j)  (256  + 64 * (j))
#define XB_XSUB(j)  (1280 + 64 * (j))
#define XB_XGEN(j)  (2304 + 64 * (j))
#define XB_TOP      3328
#define XB_TOPGEN   3392
#define XCD_BAR_WORDS 3456
#define XB_SPIN_CAP (1u << 21)
#define LAS __attribute__((address_space(3)))
__device__ __forceinline__ unsigned xb_ld(unsigned* p)              { return __hip_atomic_load(p, __ATOMIC_RELAXED, __HIP_MEMORY_SCOPE_AGENT); }
__device__ __forceinline__ unsigned xb_add(unsigned* p, unsigned v) { return __hip_atomic_fetch_add(p, v, __ATOMIC_RELAXED, __HIP_MEMORY_SCOPE_AGENT); }
__device__ __forceinline__ unsigned xb_xcc_id() { return (unsigned)__builtin_amdgcn_s_getreg((3 << 11) | 20) & 0xFu; }
#define XB_SPIN(cond, bar) do { unsigned _sp = 0; while (cond) { __builtin_amdgcn_s_sleep(1); \
    if ((++_sp & 255u) == 0u) { if (xb_ld(&(bar)[XB_TMO])) break; if (_sp > XB_SPIN_CAP) { atomicAdd(&(bar)[XB_TMO], 1u); break; } } } } while (0)
struct XcdBarrier { unsigned* bar; unsigned x; volatile LAS unsigned* st; };
__device__ __forceinline__ XcdBarrier xcd_barrier_post(unsigned* bar, volatile LAS unsigned* st) {
    XcdBarrier b; b.bar = bar; b.x = xb_xcc_id(); b.st = st;
    if (threadIdx.x == 0) (void)xb_add(&bar[XB_XCNT(b.x)], 1u);
    return b;
}
__device__ __forceinline__ void xcd_barrier_complete(unsigned* bar, unsigned x, unsigned& nloc, unsigned& nx) {
    const unsigned G = gridDim.x * gridDim.y * gridDim.z;
    unsigned sum, cnt, mine, sp = 0u;
    for (;;) {
        sum = 0u; cnt = 0u; mine = 0u;
#pragma unroll
        for (unsigned j = 0; j < 16; ++j) { const unsigned c = xb_ld(&bar[XB_XCNT(j)]); sum += c; cnt += (c > 0u) ? 1u : 0u; mine = (j == x) ? c : mine; }
        if (sum == G) break;
        __builtin_amdgcn_s_sleep(1);
        if ((++sp & 255u) == 0u) { if (xb_ld(&bar[XB_TMO])) break; if (sp > XB_SPIN_CAP) { atomicAdd(&bar[XB_TMO], 1u); break; } }
    }
    nloc = mine > 0u ? mine : 1u; nx = cnt > 0u ? cnt : 1u;
}
__device__ __forceinline__ void xcd_barrier(const XcdBarrier& b) {
    asm volatile("s_waitcnt vmcnt(0)" ::: "memory");
    __syncthreads();
    if (threadIdx.x == 0) {
        unsigned* bar = b.bar;
        __builtin_amdgcn_s_waitcnt(0);
        unsigned nloc = b.st[0], nx = b.st[1];
        if (nloc == 0u) { xcd_barrier_complete(bar, b.x, nloc, nx); b.st[0] = nloc; b.st[1] = nx; }
        const unsigned old = xb_add(&bar[XB_XSUB(b.x)], 1u);
        const unsigned gen = old / nloc;
        if (old + 1u == (gen + 1u) * nloc) {
            __builtin_amdgcn_fence(__ATOMIC_RELEASE, "agent");
            asm volatile("s_waitcnt vmcnt(0)" ::: "memory");
            const unsigned og = xb_add(&bar[XB_TOP], 1u);
            const unsigned tg = og / nx;
            if (og + 1u == (tg + 1u) * nx) xb_add(&bar[XB_TOPGEN], 1u);
            else XB_SPIN(xb_ld(&bar[XB_TOPGEN]) == tg, bar);
            __builtin_amdgcn_fence(__ATOMIC_ACQUIRE, "agent");
            xb_add(&bar[XB_XGEN(b.x)], 1u);
            asm volatile("s_waitcnt vmcnt(0)" ::: "memory");
        } else {
            XB_SPIN(xb_ld(&bar[XB_XGEN(b.x)]) == gen, bar);
            __builtin_amdgcn_fence(__ATOMIC_ACQUIRE, "agent");
            asm volatile("s_waitcnt vmcnt(0)" ::: "memory");
        }
    }
    __syncthreads();
}

constexpr int PH_PER_LAYER = 15, PH_PER_PASS = 2 * PH_PER_LAYER + 1, NPHASE = 1 + NPASS * PH_PER_PASS;

__global__ void __launch_bounds__(512, 2) mk_forward(Params P0, int ph_lo, int ph_hi) {
    unsigned char* smem = dyn_smem;
    const int wave_s = __builtin_amdgcn_readfirstlane((int)threadIdx.x >> 6);
    volatile LAS unsigned* xst = (volatile LAS unsigned*)(LAS unsigned char*)(dyn_smem + 131072);
    if (threadIdx.x == 0) { xst[0] = 0u; xst[1] = 0u; }
    __syncthreads();
    const XcdBarrier xb = xcd_barrier_post((unsigned*)(P0.ws + WS_BAR), xst);
    for (int it_ = 2 * ph_lo; it_ < 2 * ph_hi; ++it_) {
        const int ph = it_ >> 1;
        if (it_ & 1) {
            if (PROBE_MASK == 0 || ph == 0) continue;
            const int r_ = (ph - 1) % PH_PER_PASS;
            if (r_ == PH_PER_PASS - 1 || !((PROBE_MASK >> (r_ % PH_PER_LAYER)) & 1)) continue;
        }
        if (it_ > 2 * ph_lo) { if (it_ == 2 * ph_lo + 2) cg::this_grid().sync(); else xcd_barrier(xb); }
        int z = 0; asm volatile("" : "+s"(z));
        Ctx C; C.tid = tid_now(wave_s, z); C.bid = (int)blockIdx.x + z; C.nblk = (int)gridDim.x + z; C.wave_s = wave_s;
        ptrtab_t tab = (ptrtab_t)__builtin_amdgcn_kernarg_segment_ptr();
        asm volatile("" : "+s"(tab));
        const PV P{tab, (float*)tab[29], (unsigned char*)tab[30]};
        if (ph == 0) { prep_phase(C, P, smem); continue; }
        const int q = ph - 1, pass = q / PH_PER_PASS, r = q % PH_PER_PASS;
        if (r == PH_PER_PASS - 1) { norm_phase(C, P, pass, P.inp(6) + (size_t)(1 * 3 + 2) * 1024, P.inp(7) + (size_t)(1 * 3 + 2) * 1024, 0, -1, false, true); continue; }
        const int layer = r / PH_PER_LAYER, lp = r % PH_PER_LAYER;
        const bf16_t* W = wl(P, layer);
        const float* lng = P.inp(6) + (size_t)layer * 3 * 1024; const float* lnb = P.inp(7) + (size_t)layer * 3 * 1024;
        const float* lngp = P.inp(6) + (size_t)((layer > 0 ? layer - 1 : 0) * 3 + 2) * 1024; const float* lnbp = P.inp(7) + (size_t)((layer > 0 ? layer - 1 : 0) * 3 + 2) * 1024;
        unsigned char* R = P.ws + WS_R;
        switch (lp) {
            case 0:
                if (layer == 0) norm_phase(C, P, pass, nullptr, nullptr, 0, 0, true, false);
                else norm_phase(C, P, pass, lngp, lnbp, layer, 0, false, false);
                break;
            case 1: ffn_up_phase(C, P, W + OW_FA_IN); break;
            case 2: resid_gemm_phase(C, P, pass, (const bf16_t*)(R + R_ACT), 2816, W + OW_FA_OUT, layer, 0, 0.5f, layer == 0 ? nullptr : lngp, lnbp); break;
            case 3: norm_phase(C, P, pass, lng, lnb, layer, 1, false, false); break;
            case 4: win_phase(C, P, layer); break;
            case 5: lin_pool_phase(C, P, layer); break;
            case 6: lora_phase(C, P, layer, smem); break;
            case 7:
                if (C.bid < 32) scan_block<4>(C, P, layer, 0, C.bid >> 2, (C.bid >> 1) & 1, (C.bid & 1) * 32, smem);
                else if (C.bid < 160) { const int i2 = C.bid - 32; scan_block<8>(C, P, layer, 1 + (i2 >> 4), (i2 >> 1) & 7, i2 & 1, 0, smem); }
                attn_items(C, P, layer, pass * 2 + layer, smem); fft_items(C, P, smem); break;
            case 8: finish_phase(C, P, layer); break;
            case 9: gates_phase(C, P, layer); break;
            case 10: branch_phase(C, P, layer); break;
            case 11: resid_gemm_phase(C, P, pass, (const bf16_t*)(R + R_MERGED), 1024, W + OW_WOUT, layer, 1, 1.0f, lng, lnb); break;
            case 12: norm_phase(C, P, pass, lng + 1024, lnb + 1024, layer, 2, false, false); break;
            case 13: ffn_up_phase(C, P, W + OW_FB_IN); break;
            default: resid_gemm_phase(C, P, pass, (const bf16_t*)(R + R_ACT), 2816, W + OW_FB_OUT, layer, 2, 0.5f, lng + 1024, lnb + 1024); break;
        }
    }
}

extern "C" void kernel_launch(void* const* d_in, const int* in_sizes, int n_in, void* d_out, int out_size, void* d_ws, size_t ws_size, hipStream_t stream) {
    static int grid_blocks = 0;
    if (!grid_blocks) {
        int dev = 0, cus = 0, per_cu = 0;
        (void)hipGetDevice(&dev);
        (void)hipDeviceGetAttribute(&cus, hipDeviceAttributeMultiprocessorCount, dev);
        (void)hipFuncSetAttribute((const void*)mk_forward, hipFuncAttributeMaxDynamicSharedMemorySize, LDS_BYTES);
        (void)hipOccupancyMaxActiveBlocksPerMultiprocessor(&per_cu, mk_forward, NT, LDS_BYTES);
        if (per_cu < 1) per_cu = 1;
        if (per_cu > 1) per_cu = 1;
        grid_blocks = cus * per_cu;
    }
    Params p{};
    for (int i = 0; i < 29; ++i) p.in[i] = (const float*)d_in[i];
    p.out = (float*)d_out; p.ws = (unsigned char*)d_ws;
    (void)hipMemsetAsync((unsigned char*)d_ws + WS_BAR, 0, XCD_BAR_WORDS * 4 + 256, stream);
#if ONE_LAUNCH
    int lo = 0, hi = NPHASE;
    void* args[] = {&p, &lo, &hi};
    hipError_t e = hipLaunchCooperativeKernel((void*)mk_forward, dim3(grid_blocks), dim3(NT), args, LDS_BYTES, stream);
    if (e != hipSuccess) fprintf(stderr, "cooperative launch failed: %s (grid %d)\n", hipGetErrorString(e), grid_blocks);
#else
    for (int ph = 0; ph < NPHASE; ++ph) {
        int lo = ph, hi = ph + 1;
        void* args[] = {&p, &lo, &hi};
        (void)hipLaunchCooperativeKernel((void*)mk_forward, dim3(grid_blocks), dim3(NT), args, LDS_BYTES, stream);
    }
#endif
}
```

```cpp
#include <hip/hip_runtime.h>
#include <hip/hip_cooperative_groups.h>
#include <cstdio>
#include <cstdint>
namespace cg = cooperative_groups;

typedef unsigned short bf16_t;
typedef _Float16 f16;
typedef short bf16x8 __attribute__((ext_vector_type(8)));
typedef float f32x4 __attribute__((ext_vector_type(4)));
typedef unsigned u32x4 __attribute__((ext_vector_type(4)));
typedef unsigned u32x2 __attribute__((ext_vector_type(2)));
typedef float f32x2 __attribute__((ext_vector_type(2)));

#ifndef ONE_LAUNCH
#define ONE_LAUNCH 1
#endif
#ifndef PROBE_MASK
#define PROBE_MASK 0
#endif

constexpr int TP = 40960;
constexpr int NPASS = 2;
constexpr int NSEQ = 9;
constexpr int MT = TP / 128;
constexpr int N_IN_FULL = 8576;
constexpr float ALPHA = 1.41421356237f;

constexpr size_t OW_FA_IN = 0, OW_FA_OUT = 5767168, OW_FB_IN = 8650752, OW_FB_OUT = 14417920, OW_WIN = 17301504,
                 OW_WBR = 26083328, OW_WOUT = 28180480, OW_W2T = 29229056, OW_A2T = 29294592, OW_G2T = 29360128, WL_TOTAL = 29425664;
constexpr size_t WS_W = 0, WS_TW = 117702656, WS_MOD = 117735424, WS_HMOD = 119062528, WS_R = 202948608, WS_INVN = 1062780928, WS_STATS = 1064091904, WS_BAR = 1064419584, WS_CTR = 1064433408  ;
constexpr size_t R_RAW = 0, R_LIN = 157286400, R_WA = 188743680, R_G = 356515840, R_Q = 398458880, R_K = 440401920, R_VT = 482344960,
                 R_YFB = 524288000, R_ZC = 608174080, R_POOLP = 650117120, R_YB = 692060160, R_ACT = 0,
                 R_GATES = 0  , R_M32 = 398458880  , R_MERGED = 566231040  ;
constexpr size_t SZ512 = (size_t)TP * 512;

struct Params { const float* in[29]; float* out; unsigned char* ws; };
struct Ctx { int tid, bid, nblk, wave_s; };
__device__ __forceinline__ int tid_now(int wave_s, int z) { return wave_s * 64 + (int)__builtin_amdgcn_mbcnt_hi(~0u, __builtin_amdgcn_mbcnt_lo(~0u, (unsigned)z)); }
typedef const float* const __attribute__((address_space(4)))* ptrtab_t;
struct PV { ptrtab_t tab; float* out; unsigned char* ws;
    __device__ __forceinline__ const float* inp(int i) const { return tab[i]; } };
constexpr int NT = 512, NWV = 8;
extern __shared__ __attribute__((aligned(16))) unsigned char dyn_smem[];
constexpr int LDS_BYTES = 131072 + 64;

__device__ __forceinline__ bf16_t f2bf(float f) { unsigned u = __float_as_uint(f); u += 0x7fffu + ((u >> 16) & 1u); return (bf16_t)(u >> 16); }
__device__ __forceinline__ float bf2f(bf16_t b) { return __uint_as_float(((unsigned)b) << 16); }
typedef __bf16 bf16x2_t __attribute__((ext_vector_type(2)));
__device__ __forceinline__ unsigned pack2bf(float a, float b) { const f32x2 v = (f32x2){a, b}; const bf16x2_t h = __builtin_convertvector(v, bf16x2_t); return __builtin_bit_cast(unsigned, h); }
__device__ __forceinline__ float wsum(float v) {
#pragma unroll
    for (int o = 32; o > 0; o >>= 1) v += __shfl_xor(v, o);
    return v;
}
__device__ __forceinline__ float sigmoidf_(float x) { return __builtin_amdgcn_rcpf(1.0f + __expf(-x)); }
template <int CTRL> __device__ __forceinline__ float dppf(float v) { return __int_as_float(__builtin_amdgcn_update_dpp(0, __float_as_int(v), CTRL, 0xF, 0xF, true)); }
__device__ __forceinline__ float red8(float v) { v += dppf<0xB1>(v); v += dppf<0x4E>(v); v += dppf<0x141>(v); return v; }

__device__ __forceinline__ int grow_of(int pass, int lt) { return lt < 8192 ? pass * 8192 + lt : 16384 + pass * 32768 + (lt - 8192); }
__device__ __forceinline__ int brow_of(int pass, int lt) { return lt < 8192 ? pass : 2 + pass * 8 + ((lt - 8192) >> 12); }
__device__ __forceinline__ int pos_of(int lt) { return lt < 8192 ? lt : ((lt - 8192) & 4095); }
__device__ __forceinline__ int seqbase_of(int sq) { return sq == 0 ? 0 : 8192 + (sq - 1) * 4096; }
__device__ __forceinline__ int seqlen_of(int sq) { return sq == 0 ? 8192 : 4096; }

__device__ __forceinline__ bf16_t* wl(const PV& P, int layer) { return (bf16_t*)(P.ws + WS_W) + (size_t)layer * WL_TOTAL; }

template <int NJ, bool SWAP>
__device__ __forceinline__ void gemm_core(const Ctx& C, f32x4 (&acc)[4][NJ], const bf16_t* __restrict__ A, int lda, const bf16_t* __restrict__ B, int ldb, int K, unsigned char* smem) {
    const int tid = C.tid & 255, lane = tid & 63, wave = tid >> 6, wm = wave >> 1, wn = wave & 1, fr = lane & 15, fq = lane >> 4;
    smem += (C.tid >> 8) * 36864;
    u32x4 ra[4], rb[NJ];
#pragma unroll
    for (int i = 0; i < 4; ++i)
#pragma unroll
        for (int j = 0; j < NJ; ++j) acc[i][j] = (f32x4){0.f, 0.f, 0.f, 0.f};
    const int lrow = tid >> 3, lkc = (tid & 7) * 8;
#pragma unroll
    for (int i = 0; i < 4; ++i) ra[i] = *(const u32x4*)(A + (size_t)(lrow + 32 * i) * lda + lkc);
#pragma unroll
    for (int i = 0; i < NJ; ++i) rb[i] = *(const u32x4*)(B + (size_t)(lrow + 32 * i) * ldb + lkc);
    for (int k0 = 0; k0 < K; k0 += 64) {
        __syncthreads();
#pragma unroll
        for (int i = 0; i < 4; ++i) *(u32x4*)(smem + (lrow + 32 * i) * 144 + lkc * 2) = ra[i];
#pragma unroll
        for (int i = 0; i < NJ; ++i) *(u32x4*)(smem + 18432 + (lrow + 32 * i) * 144 + lkc * 2) = rb[i];
        __syncthreads();
        if (k0 + 64 < K) {
#pragma unroll
            for (int i = 0; i < 4; ++i) ra[i] = *(const u32x4*)(A + (size_t)(lrow + 32 * i) * lda + k0 + 64 + lkc);
#pragma unroll
            for (int i = 0; i < NJ; ++i) rb[i] = *(const u32x4*)(B + (size_t)(lrow + 32 * i) * ldb + k0 + 64 + lkc);
        }
#pragma unroll
        for (int ks = 0; ks < 2; ++ks) {
            bf16x8 af[4], bfr[NJ];
#pragma unroll
            for (int i = 0; i < 4; ++i) af[i] = *(const bf16x8*)(smem + (wm * 64 + i * 16 + fr) * 144 + (ks * 32 + fq * 8) * 2);
#pragma unroll
            for (int j = 0; j < NJ; ++j) bfr[j] = *(const bf16x8*)(smem + 18432 + (wn * NJ * 16 + j * 16 + fr) * 144 + (ks * 32 + fq * 8) * 2);
#pragma unroll
            for (int i = 0; i < 4; ++i)
#pragma unroll
                for (int j = 0; j < NJ; ++j)
                    acc[i][j] = SWAP ? __builtin_amdgcn_mfma_f32_16x16x32_bf16(bfr[j], af[i], acc[i][j], 0, 0, 0)
                                     : __builtin_amdgcn_mfma_f32_16x16x32_bf16(af[i], bfr[j], acc[i][j], 0, 0, 0);
        }
    }
}


namespace g256 {
constexpr int BK = 64, HALF = 128, HT = HALF * BK;
__device__ __forceinline__ int lds_byte(int r, int c) { int st = (r >> 4) * 2 + (c >> 5), rr = r & 15, cc = c & 31, ob = rr * 64 + cc * 2; return st * 1024 + (ob ^ (((ob >> 9) & 1) << 5)); }
__device__ __forceinline__ void stage_rc(unsigned b, unsigned& R, unsigned& Cc) { const unsigned st = b >> 10, sb = b & 1023u, swz = sb ^ (((sb >> 9) & 1u) << 5); R = (st >> 1) * 16u + (swz >> 6); Cc = (st & 1u) * 32u + ((swz & 63u) >> 1); }
}
__device__ __forceinline__ void gemm256(const Ctx& C, f32x4 (&acc)[2][2][4][2], const bf16_t* __restrict__ A, const bf16_t* __restrict__ Bt, const int K, const int brow, const int bcol) {
    using namespace g256;
    bf16_t* shm = (bf16_t*)dyn_smem;
    const int tidx = C.tid;
    #define SA(b,h) (shm+((b)*2+(h))*HT)
    #define SB(b,h) (shm+(4+(b)*2+(h))*HT)
    #define STAGE(Pp,BASE,br,kt) do{const char* _ub=(const char*)((BASE)+(long)(br)*K+(long)(kt)*BK); asm volatile("" : "+s"(_ub)); \
        __builtin_amdgcn_global_load_lds((const unsigned*)(_ub+goff0), \
          (__attribute__((address_space(3))) unsigned*)((__attribute__((address_space(3))) char*)(Pp)+tidx*16),16,0,0); \
        __builtin_amdgcn_global_load_lds((const unsigned*)(_ub+goff1), \
          (__attribute__((address_space(3))) unsigned*)((__attribute__((address_space(3))) char*)(Pp)+tidx*16+8192),16,0,0);}while(0)
    #define LDA(dst,b,h) for(int m=0;m<4;++m)for(int k=0;k<2;++k) \
      dst[m][k]=*reinterpret_cast<const bf16x8*>(a_ptr+((b)*2+(h))*16384+m*2048+k*1024)
    #define LDB(dst,b,h) for(int n=0;n<2;++n)for(int k=0;k<2;++k) \
      dst[n][k]=*reinterpret_cast<const bf16x8*>(b_ptr+((b)*2+(h))*16384+n*2048+k*1024)
    #define MMA(ai,bj,Atx,Btx) do{__builtin_amdgcn_s_setprio(1); \
      for(int m=0;m<4;++m)for(int n=0;n<2;++n)for(int k=0;k<2;++k) \
        acc[ai][bj][m][n]=__builtin_amdgcn_mfma_f32_16x16x32_bf16(Btx[n][k],Atx[m][k],acc[ai][bj][m][n],0,0,0); \
      __builtin_amdgcn_s_setprio(0);}while(0)
    #define WAIT_V(n) asm volatile("s_waitcnt vmcnt(" #n ")":::"memory")
    #define WAIT_L(n) asm volatile("s_waitcnt lgkmcnt(" #n ")":::"memory")
    #define BAR __builtin_amdgcn_s_barrier()
    #define SCHED __builtin_amdgcn_sched_barrier(0)
    const int wid = tidx >> 6, lane = tidx & 63, wr = wid >> 2, wc = wid & 3, fr = lane & 15, fq = lane >> 4;
    const int swz = (fr * 64 + fq * 16) ^ ((fr >> 3) << 5);
    const char* a_ptr = (const char*)dyn_smem + wr * 8192 + swz;
    const char* b_ptr = (const char*)dyn_smem + 65536 + wc * 4096 + swz;
#pragma unroll
    for (int a = 0; a < 2; ++a)
#pragma unroll
        for (int b = 0; b < 2; ++b)
#pragma unroll
            for (int m = 0; m < 4; ++m) { acc[a][b][m][0] = (f32x4){0.f, 0.f, 0.f, 0.f}; acc[a][b][m][1] = (f32x4){0.f, 0.f, 0.f, 0.f}; }
    bf16x8 At[4][2], B0[2][2], B1[2][2];
    const int nt = K / BK;
    unsigned goff0, goff1;
    { unsigned r0, c0, r1, c1; stage_rc((unsigned)tidx * 16u, r0, c0); stage_rc((unsigned)tidx * 16u + 8192u, r1, c1); goff0 = (r0 * (unsigned)K + c0) * 2u; goff1 = (r1 * (unsigned)K + c1) * 2u; }
    WAIT_V(0); __syncthreads();
    STAGE(SB(0,0),Bt,bcol,0); STAGE(SA(0,0),A,brow,0);
    STAGE(SB(0,1),Bt,bcol+HALF,0); STAGE(SA(0,1),A,brow+HALF,0);
    if(wr==1)BAR;
    WAIT_V(4); BAR;
    STAGE(SB(1,0),Bt,bcol,1); STAGE(SA(1,0),A,brow,1); STAGE(SB(1,1),Bt,bcol+HALF,1);
    WAIT_V(6); BAR;
    for(int t=0;t<nt-2;t+=2){
      LDB(B0,0,0); SCHED; LDA(At,0,0); STAGE(SA(1,1),A,brow+HALF,t+1);
      WAIT_L(8); BAR; WAIT_L(0); MMA(0,0,At,B0); BAR; SCHED;
      LDB(B1,0,1); STAGE(SB(0,0),Bt,bcol,t+2);
      BAR; WAIT_L(0); MMA(0,1,At,B1); BAR;
      LDA(At,0,1); STAGE(SA(0,0),A,brow,t+2);
      BAR; WAIT_L(0); MMA(1,0,At,B0); BAR; SCHED;
      STAGE(SB(0,1),Bt,bcol+HALF,t+2);
      WAIT_V(6); BAR; MMA(1,1,At,B1); BAR;
      LDB(B0,1,0); SCHED; LDA(At,1,0); STAGE(SA(0,1),A,brow+HALF,t+2);
      WAIT_L(8); BAR; WAIT_L(0); MMA(0,0,At,B0); BAR; SCHED;
      LDB(B1,1,1); STAGE(SB(1,0),Bt,bcol,t+3);
      BAR; WAIT_L(0); MMA(0,1,At,B1); BAR;
      LDA(At,1,1); STAGE(SA(1,0),A,brow,t+3);
      BAR; WAIT_L(0); MMA(1,0,At,B0); BAR; SCHED;
      STAGE(SB(1,1),Bt,bcol+HALF,t+3);
      WAIT_V(6); BAR; MMA(1,1,At,B1); BAR;
    }
    { LDB(B0,0,0); LDA(At,0,0); STAGE(SA(1,1),A,brow+HALF,nt-1);
      BAR; WAIT_L(0); MMA(0,0,At,B0); BAR;
      LDB(B1,0,1); BAR; WAIT_L(0); MMA(0,1,At,B1); BAR;
      LDA(At,0,1); WAIT_V(4); BAR; WAIT_L(0); MMA(1,0,At,B0); MMA(1,1,At,B1); BAR; }
    { LDB(B0,1,0); LDA(At,1,0); WAIT_V(2); BAR; WAIT_L(0); MMA(0,0,At,B0); BAR;
      LDB(B1,1,1); WAIT_V(0); BAR; WAIT_L(0); MMA(0,1,At,B1); BAR;
      LDA(At,1,1); BAR; WAIT_L(0); MMA(1,0,At,B0); MMA(1,1,At,B1); BAR; }
    if(wr==0)BAR;
    #undef SA
    #undef SB
    #undef STAGE
    #undef LDA
    #undef LDB
    #undef MMA
    #undef WAIT_V
    #undef WAIT_L
    #undef BAR
    #undef SCHED
}
__device__ __forceinline__ bool tile_order(int i, int G, int c, int nM, int nN, int& pm, int& pn) {
    const int nwg = nM * nN; const long L = (long)i * G + c; if (L >= nwg) return false;
    int wgid = (int)L; { const int q = nwg / 8, r = nwg % 8, xcd = wgid % 8, off = wgid / 8; wgid = (xcd < r ? xcd * (q + 1) : r * (q + 1) + (xcd - r) * q) + off; }
    const int nig = 8 * nN, gid = wgid / nig, fm = gid * 8, gsz = (nM - fm) < 8 ? (nM - fm) : 8;
    pm = fm + ((wgid % nig) % gsz); pn = (wgid % nig) / gsz; return true;
}

struct ConvJob { const float* src; int ld, K, nbegin, ncount, map; bf16_t* dst; };
__device__ __forceinline__ ConvJob conv_job(const PV& P, int j) {
    const int l = j >> 4, q = j & 15; bf16_t* W = wl(P, l); ConvJob c; c.map = 0; c.nbegin = 0;
    switch (q) {
        case 0: c.src = P.inp(8) + (size_t)l * 1024 * 5632; c.ld = 5632; c.K = 1024; c.ncount = 5632; c.dst = W + OW_FA_IN; c.map = 1; break;
        case 1: c.src = P.inp(9) + (size_t)l * 2816 * 1024; c.ld = 1024; c.K = 2816; c.ncount = 1024; c.dst = W + OW_FA_OUT; break;
        case 2: c.src = P.inp(10) + (size_t)l * 1024 * 5632; c.ld = 5632; c.K = 1024; c.ncount = 5632; c.dst = W + OW_FB_IN; c.map = 1; break;
        case 3: c.src = P.inp(11) + (size_t)l * 2816 * 1024; c.ld = 1024; c.K = 2816; c.ncount = 1024; c.dst = W + OW_FB_OUT; break;
        case 4: c.src = P.inp(12) + (size_t)l * 1024 * 8576; c.ld = 8576; c.K = 1024; c.ncount = 3456; c.dst = W + OW_WIN; break;
        case 5: c.src = P.inp(12) + (size_t)l * 1024 * 8576; c.ld = 8576; c.K = 1024; c.nbegin = 3968; c.ncount = 4608; c.dst = W + OW_WIN + (size_t)3968 * 1024; break;
        case 6: case 7: case 8: case 9: { const int n = q - 6; c.src = P.inp(27) + (size_t)(l * 4 + n) * 512 * 1024; c.ld = 1024; c.K = 512; c.ncount = 1024; c.dst = W + OW_WBR + (size_t)n * 1024 * 512; } break;
        case 10: c.src = P.inp(28) + (size_t)l * 1024 * 1024; c.ld = 1024; c.K = 1024; c.ncount = 1024; c.dst = W + OW_WOUT; break;
        case 11: case 12: { const int d = q - 11; c.src = P.inp(15) + (size_t)(l * 2 + d) * 64 * 512; c.ld = 512; c.K = 64; c.ncount = 512; c.dst = W + OW_W2T + (size_t)d * 512 * 64; } break;
        case 13: case 14: { const int d = q - 13; c.src = P.inp(17) + (size_t)(l * 2 + d) * 64 * 512; c.ld = 512; c.K = 64; c.ncount = 512; c.dst = W + OW_A2T + (size_t)d * 512 * 64; } break;
        default: c.src = P.inp(18) + (size_t)l * 128 * 512; c.ld = 512; c.K = 128; c.ncount = 512; c.dst = W + OW_G2T; break;
    }
    return c;
}

__device__ __forceinline__ void prep_phase(const Ctx& C, const PV& P, unsigned char* smem) {
    const int tid = C.tid;
    {
        int total = 0;
        for (int j = 0; j < 32; ++j) { ConvJob c = conv_job(P, j); total += (c.K >> 6) * (c.ncount >> 6); }
        float* tile = (float*)smem;
        const int tx = tid & 63, ty = tid >> 6;
        for (int t = C.bid; t < total; t += C.nblk) {
            int tt = t, j = 0; ConvJob c = conv_job(P, 0);
            for (;;) { const int n = (c.K >> 6) * (c.ncount >> 6); if (tt < n) break; tt -= n; ++j; c = conv_job(P, j); }
            const int nkt = c.K >> 6, kt = tt % nkt, nt = tt / nkt, k0 = kt * 64, n0 = nt * 64;
            int col = c.nbegin + n0 + tx;
            if (c.map) { const int np = n0 + tx, blk = np >> 5, w = np & 31, f = blk * 16 + (w & 15); col = (w < 16) ? f : 2816 + f; }
            __syncthreads();
#pragma unroll 4
            for (int i = 0; i < 8; ++i) { const int kk = ty + 8 * i; tile[kk * 65 + tx] = c.src[(size_t)(k0 + kk) * c.ld + col]; }
            __syncthreads();
#pragma unroll 4
            for (int i = 0; i < 8; ++i) { const int nn = ty + 8 * i; c.dst[(size_t)(n0 + nn) * c.K + k0 + tx] = f2bf(tile[tx * 65 + nn]); }
        }
        __syncthreads();
    }
    {
        float* wt = (float*)smem;
        float* cosT = (float*)(smem + 64 * 129 * 4);
        for (int it = C.bid; it < 2 * 4 * 16; it += C.nblk) {
            const int l = it >> 6, g = (it >> 4) & 3, kc = it & 15, k0 = kc * 64;
            const float* src = P.inp(12) + (size_t)l * 1024 * 8576 + 3456 + g * 128;
            __syncthreads();
            for (int e = tid; e < 64 * 128; e += NT) { const int kk = e >> 7, c = e & 127; wt[kk * 129 + c] = src[(size_t)(k0 + kk) * 8576 + c]; }
            if (tid < 128) cosT[tid] = cospif((float)tid * (1.0f / 64.0f));
            __syncthreads();
            bf16_t* dst = wl(P, l) + OW_WIN + (size_t)(3456 + g * 128) * 1024;
            const int kk = tid & 63;
            for (int i = 0; i < 16; ++i) {
                const int j2 = (tid >> 6) + 8 * i, cc = j2 >> 1, part = j2 & 1;
                float s = 0.f;
                if (cc == 0) {
                    if (part == 0) { for (int c = 0; c < 128; ++c) s += wt[kk * 129 + c]; }
                    else { for (int c = 0; c < 128; ++c) s += (c & 1) ? -wt[kk * 129 + c] : wt[kk * 129 + c]; }
                } else if (part == 0) {
                    for (int c = 0; c < 128; ++c) s += wt[kk * 129 + c] * cosT[(cc * c) & 127];
                } else {
                    for (int c = 0; c < 128; ++c) s -= wt[kk * 129 + c] * cosT[(cc * c - 32) & 127];
                }
                dst[(size_t)j2 * 1024 + k0 + kk] = f2bf(s);
            }
        }
        __syncthreads();
    }
    {
        float2* tw = (float2*)(P.ws + WS_TW);
        for (int m = C.bid * NT + tid; m < 4096; m += C.nblk * NT) { const float x = (float)m * (1.0f / 4096.0f); tw[m] = make_float2(cospif(x), -sinpif(x)); }
    }
    {
        float* sc = (float*)smem;
        float* red = (float*)(smem + 18 * 512 * 4);
        float* mod = (float*)(P.ws + WS_MOD);
        for (int it = C.bid; it < 2 * 144; it += C.nblk) {
            const int l = it / 144, n0 = (it % 144) * 64, nl = tid & 63, ks = tid >> 6;
            const float* aw = P.inp(4) + (size_t)l * 1024 * 9216;
            float acc[18];
#pragma unroll
            for (int b = 0; b < 18; ++b) acc[b] = 0.f;
            for (int half = 0; half < 2; ++half) {
                __syncthreads();
                for (int e = tid; e < 18 * 512; e += NT) {
                    const int b = e >> 9, kk = e & 511, k = half * 512 + kk;
                    const float cv = b < 2 ? P.inp(2)[b * 1024 + k] : P.inp(3)[(b - 2) * 1024 + k];
                    sc[e] = cv / (1.0f + __expf(-cv));
                }
                __syncthreads();
                for (int kk = ks * 64; kk < ks * 64 + 64; ++kk) {
                    const float w = aw[(size_t)(half * 512 + kk) * 9216 + n0 + nl];
#pragma unroll
                    for (int b = 0; b < 18; ++b) acc[b] += sc[b * 512 + kk] * w;
                }
            }
            __syncthreads();
#pragma unroll
            for (int b = 0; b < 18; ++b) red[(ks * 18 + b) * 64 + nl] = acc[b];
            __syncthreads();
            for (int e = tid; e < 18 * 64; e += NT) {
                const int b = e >> 6, n = e & 63;
                float s = 0.f;
#pragma unroll
                for (int k8 = 0; k8 < 8; ++k8) s += red[(k8 * 18 + b) * 64 + n];
                mod[((size_t)l * 18 + b) * 9216 + n0 + n] = s + P.inp(5)[(size_t)l * 9216 + n0 + n];
            }
        }
        __syncthreads();
    }
}

constexpr int NR = 4;
__device__ __forceinline__ void rowstats(const f32x4 (&v)[NR][4], float (&mu)[NR], float (&rs)[NR]) {
    float s[NR], q[NR];
#pragma unroll
    for (int u = 0; u < NR; ++u) { s[u] = 0.f;
#pragma unroll
        for (int i = 0; i < 4; ++i) s[u] += (v[u][i][0] + v[u][i][1]) + (v[u][i][2] + v[u][i][3]); }
#pragma unroll
    for (int o = 32; o > 0; o >>= 1) {
#pragma unroll
        for (int u = 0; u < NR; ++u) s[u] += __shfl_xor(s[u], o);
    }
#pragma unroll
    for (int u = 0; u < NR; ++u) { mu[u] = s[u] * (1.0f / 1024.0f); q[u] = 0.f;
#pragma unroll
        for (int i = 0; i < 4; ++i) { const f32x4 dd = v[u][i] - mu[u]; q[u] += (dd[0] * dd[0] + dd[1] * dd[1]) + (dd[2] * dd[2] + dd[3] * dd[3]); } }
#pragma unroll
    for (int o = 32; o > 0; o >>= 1) {
#pragma unroll
        for (int u = 0; u < NR; ++u) q[u] += __shfl_xor(q[u], o);
    }
#pragma unroll
    for (int u = 0; u < NR; ++u) rs[u] = rsqrtf(q[u] * (1.0f / 1024.0f) + 1e-5f);
}
__device__ __forceinline__ void norm_phase(const Ctx& C, const PV& P, int pass, const float* lng, const float* lnb, int mod_layer, int j, bool from_input, bool write_x) {
    const int lane = C.tid & 63, wave = C.tid >> 6;
    bf16_t* hmod = (bf16_t*)(P.ws + WS_HMOD);
    const float* mod = (const float*)(P.ws + WS_MOD);
    const int nw = C.nblk * NWV;
    for (int lt0 = C.bid * NWV + wave; lt0 < TP; lt0 += NR * nw) {
        f32x4 v[NR][4]; int gr[NR], bb[NR]; bool ok[NR];
#pragma unroll
        for (int u = 0; u < NR; ++u) {
            const int lt = lt0 + u * nw; ok[u] = lt < TP;
            const int ltc = ok[u] ? lt : lt0;
            gr[u] = grow_of(pass, ltc); bb[u] = brow_of(pass, ltc);
            const float* src = from_input ? (gr[u] < 16384 ? P.inp(0) + (size_t)gr[u] * 1024 : P.inp(1) + (size_t)(gr[u] - 16384) * 1024) : P.out + (size_t)gr[u] * 1024;
#pragma unroll
            for (int i = 0; i < 4; ++i) v[u][i] = *(const f32x4*)(src + i * 256 + lane * 4);
        }
        float mu[NR], rs[NR];
        if (lng) {
            rowstats(v, mu, rs);
#pragma unroll
            for (int u = 0; u < NR; ++u)
                if (ok[u] && lane == 0) *(f32x2*)(P.ws + WS_STATS + (size_t)(lt0 + u * nw) * 8) = (f32x2){mu[u], rs[u]};
#pragma unroll
            for (int i = 0; i < 4; ++i) {
                const f32x4 g = *(const f32x4*)(lng + i * 256 + lane * 4), be = *(const f32x4*)(lnb + i * 256 + lane * 4);
#pragma unroll
                for (int u = 0; u < NR; ++u) v[u][i] = (v[u][i] - mu[u]) * rs[u] * g + be;
            }
        }
        if (write_x) {
#pragma unroll
            for (int u = 0; u < NR; ++u) if (ok[u]) {
#pragma unroll
                for (int i = 0; i < 4; ++i) *(f32x4*)(P.out + (size_t)gr[u] * 1024 + i * 256 + lane * 4) = v[u][i];
            }
        }
        if (j >= 0) {
            rowstats(v, mu, rs);
#pragma unroll
            for (int u = 0; u < NR; ++u) {
                if (!ok[u]) continue;
                const float* mb = mod + ((size_t)mod_layer * 18 + bb[u]) * 9216 + (size_t)(3 * j) * 1024;
                const int lt = lt0 + u * nw;
#pragma unroll
                for (int i = 0; i < 4; ++i) {
                    const f32x4 sh = *(const f32x4*)(mb + i * 256 + lane * 4), scl = *(const f32x4*)(mb + 1024 + i * 256 + lane * 4);
                    const f32x4 hh = (v[u][i] - mu[u]) * rs[u] * (1.0f + scl) + sh;
                    u32x2 o; o.x = pack2bf(hh[0], hh[1]); o.y = pack2bf(hh[2], hh[3]);
                    *(u32x2*)(hmod + (size_t)lt * 1024 + i * 256 + lane * 4) = o;
                }
            }
        }
    }
}

__device__ __forceinline__ void ffn_up_phase(const Ctx& C, const PV& P, const bf16_t* Wt) {
    const bf16_t* hmod = (const bf16_t*)(P.ws + WS_HMOD);
    bf16_t* act = (bf16_t*)(P.ws + WS_R + R_ACT);
    int pm, pn;
    for (int it = 0; tile_order(it, C.nblk, C.bid, TP / 256, 22, pm, pn); ++it) {
        f32x4 acc[2][2][4][2];
        gemm256(C, acc, hmod, Wt, 1024, pm * 256, pn * 256);
        int z2 = 0; asm volatile("" : "+s"(z2));
        const int tid2 = tid_now(C.wave_s, z2), lane = tid2 & 63, wid = tid2 >> 6, wr = wid >> 2, wc = wid & 3, fr = lane & 15, fq = lane >> 4;
#pragma unroll
        for (int ai = 0; ai < 2; ++ai)
#pragma unroll
            for (int m = 0; m < 4; ++m) {
                const int row = pm * 256 + ai * 128 + wr * 64 + m * 16 + fr;
#pragma unroll
                for (int bj = 0; bj < 2; ++bj) {
                    const int colbase = pn * 256 + bj * 128 + wc * 32, f = (colbase >> 5) * 16 + fq * 4;
                    const f32x4 a = acc[ai][bj][m][0], bb = acc[ai][bj][m][1];
                    float o[4];
#pragma unroll
                    for (int r = 0; r < 4; ++r) o[r] = a[r] * sigmoidf_(a[r]) * bb[r];
                    u32x2 w; w.x = pack2bf(o[0], o[1]); w.y = pack2bf(o[2], o[3]);
                    *(u32x2*)(act + (size_t)row * 2816 + f) = w;
                }
            }
    }
}

__device__ __forceinline__ void resid_gemm_phase(const Ctx& C, const PV& P, int pass, const bf16_t* A, int K, const bf16_t* Wt, int layer, int j, float scale, const float* xg, const float* xb) {
    const float* mod = (const float*)(P.ws + WS_MOD);
    int pm, pn;
    for (int it = 0; tile_order(it, C.nblk, C.bid, TP / 256, 4, pm, pn); ++it) {
        f32x4 acc[2][2][4][2];
        gemm256(C, acc, A, Wt, K, pm * 256, pn * 256);
        int z2 = 0; asm volatile("" : "+s"(z2));
        const int tid2 = tid_now(C.wave_s, z2), lane = tid2 & 63, wid = tid2 >> 6, wr = wid >> 2, wc = wid & 3, fr = lane & 15, fq = lane >> 4;
#pragma unroll
        for (int ai = 0; ai < 2; ++ai)
#pragma unroll
            for (int m = 0; m < 4; ++m) {
                const int lt = pm * 256 + ai * 128 + wr * 64 + m * 16 + fr;
                const int gr = grow_of(pass, lt), b = brow_of(pass, lt);
                const float* gate = mod + ((size_t)layer * 18 + b) * 9216 + (size_t)(3 * j + 2) * 1024;
                const float* xsrc = xg ? P.out + (size_t)gr * 1024 : (gr < 16384 ? P.inp(0) + (size_t)gr * 1024 : P.inp(1) + (size_t)(gr - 16384) * 1024);
                f32x2 st = (f32x2){0.f, 1.f};
                if (xg) st = *(const f32x2*)(P.ws + WS_STATS + (size_t)lt * 8);
#pragma unroll
                for (int bj = 0; bj < 2; ++bj)
#pragma unroll
                    for (int n = 0; n < 2; ++n) {
                        const int col = pn * 256 + bj * 128 + wc * 32 + n * 16 + fq * 4;
                        f32x4 x = *(const f32x4*)(xsrc + col);
                        if (xg) x = (x - st[0]) * st[1] * *(const f32x4*)(xg + col) + *(const f32x4*)(xb + col);
                        const f32x4 g = *(const f32x4*)(gate + col);
                        *(f32x4*)(P.out + (size_t)gr * 1024 + col) = ALPHA * x + (1.0f + g) * scale * acc[ai][bj][m][n];
                    }
                asm volatile("" ::: "memory");
            }
    }
}

__device__ __forceinline__ void win_phase(const Ctx& C, const PV& P, int layer) {
    const bf16_t* hmod = (const bf16_t*)(P.ws + WS_HMOD);
    const bf16_t* Wt = wl(P, layer) + OW_WIN;
    unsigned char* R = P.ws + WS_R;
    f16* raw = (f16*)(R + R_RAW); bf16_t* Qb = (bf16_t*)(R + R_Q); bf16_t* Kb = (bf16_t*)(R + R_K); bf16_t* Vt = (bf16_t*)(R + R_VT);
    f16* Zc = (f16*)(R + R_ZC); f16* poolp = (f16*)(R + R_POOLP);
    typedef f16 f16x4 __attribute__((ext_vector_type(4)));
    typedef f16 f16x2 __attribute__((ext_vector_type(2)));
    int pm, pn;
    for (int it = 0; tile_order(it, C.nblk, C.bid, TP / 256, 18, pm, pn); ++it) {
        const int lt_t = pm * 256, sq = lt_t < 8192 ? 0 : 1 + ((lt_t - 8192) >> 12), lt0 = seqbase_of(sq), S = seqlen_of(sq);
        f32x4 acc[2][2][4][2];
        gemm256(C, acc, hmod, Wt, 1024, pm * 256, pn * 256);
        int z2 = 0; asm volatile("" : "+s"(z2));
        const int tid2 = tid_now(C.wave_s, z2), lane = tid2 & 63, wid = tid2 >> 6, wr = wid >> 2, wc = wid & 3, fr = lane & 15, fq = lane >> 4;
#pragma unroll
        for (int bj = 0; bj < 2; ++bj) {
            const int tn = pn * 2 + bj;
            if (tn >= 35) continue;
#pragma unroll
            for (int ai = 0; ai < 2; ++ai)
#pragma unroll
                for (int m = 0; m < 4; ++m) {
                    const int lt = pm * 256 + ai * 128 + wr * 64 + m * 16 + fr, pos = lt - lt0;
#pragma unroll
                    for (int n = 0; n < 2; ++n) {
                        const int col = tn * 128 + wc * 32 + n * 16 + fq * 4;
                        f32x4 v = acc[ai][bj][m][n];
                        if (tn < 15) {
                            f16x4 h; h[0] = (f16)v[0]; h[1] = (f16)v[1]; h[2] = (f16)v[2]; h[3] = (f16)v[3];
                            *(f16x4*)(raw + (size_t)lt * 1920 + col) = h;
                        } else if (tn < 23) {
                            const int nq = (col - 1920) & 511, hc = nq >> 6, d = nq & 63;
                            if (n == 0 && (wc & 1) == 0) {
#pragma unroll
                                for (int r = 0; r < 4; ++r) {
                                    const float invlo = r == 0 ? 1.0f : r == 1 ? 0.1939227432012558f : r == 2 ? 0.03760603070259094f : 0.007292664609849453f;
                                    const float invhi = r == 0 ? 0.0014142135623842478f : r == 1 ? 0.00027424818836152554f : r == 2 ? 5.3182957344688475e-05f : 1.0313385246263351e-05f;
                                    const float ang = (float)pos * ((fq & 1) ? invhi : invlo);
                                    const float hi = ang * 0.15915493667125702f;
                                    const float lo = __builtin_fmaf(ang, 0.15915493667125702f, -hi) + ang * 6.4206382432985265e-09f;
                                    const float rr = (hi - floorf(hi)) + lo;
                                    const float cs = __builtin_amdgcn_cosf(rr), sn = __builtin_amdgcn_sinf(rr);
                                    const float other = __shfl_xor(v[r], 32);
                                    v[r] = (fq < 2) ? (v[r] * cs - other * sn) : (other * sn + v[r] * cs);
                                }
                            }
                            bf16_t* dst = (tn < 19) ? Qb : Kb;
                            const float sc = (tn < 19) ? 0.125f * 1.44269504088896f : 1.0f;
                            u32x2 w; w.x = pack2bf(v[0] * sc, v[1] * sc); w.y = pack2bf(v[2] * sc, v[3] * sc);
                            *(u32x2*)(dst + (size_t)lt0 * 512 + ((size_t)hc * S + pos) * 64 + d) = w;
                        } else if (tn < 27) {
                            const int nv = col - 2944;
                            bf16_t* vb = Vt + (size_t)lt0 * 512 + (size_t)nv * S + pos;
                            vb[0] = f2bf(v[0]); vb[(size_t)S] = f2bf(v[1]); vb[(size_t)2 * S] = f2bf(v[2]); vb[(size_t)3 * S] = f2bf(v[3]);
                        } else if (tn < 31) {
                            const int nz = col - 3456, g = nz >> 7, cc = (nz & 127) >> 1;
                            f16x2 z0, z1; z0[0] = (f16)v[0]; z0[1] = (f16)v[1]; z1[0] = (f16)v[2]; z1[1] = (f16)v[3];
                            f16x2* zb = (f16x2*)Zc + (size_t)lt0 * 256;
                            zb[(size_t)(g * 64 + cc) * S + pos] = z0;
                            zb[(size_t)(g * 64 + cc + 1) * S + pos] = z1;
                        } else {
                            f16x4 h; h[0] = (f16)v[0]; h[1] = (f16)v[1]; h[2] = (f16)v[2]; h[3] = (f16)v[3];
                            *(f16x4*)(poolp + (size_t)lt * 512 + (col - 3968)) = h;
                        }
                    }
                    asm volatile("" ::: "memory");
                }
        }
    }
}

__device__ __forceinline__ float shiftv(const f16* __restrict__ raw, int lt, int t, int S, int col, float mu) {
    const float p = (float)raw[(size_t)lt * 1920 + col];
    const float pr = t > 0 ? (float)raw[(size_t)(lt - 1) * 1920 + col] : 0.f;
    const float nx = t < S - 1 ? (float)raw[(size_t)(lt + 1) * 1920 + col] : 0.f;
    return p + (0.5f * (pr + nx) - p) * mu;
}

typedef f16 f16x4_t __attribute__((ext_vector_type(4)));
typedef f16 f16x8_t __attribute__((ext_vector_type(8)));
__device__ __forceinline__ void lin_pool_phase(const Ctx& C, const PV& P, int layer) {
    unsigned char* R = P.ws + WS_R;
    const f16* raw = (const f16*)(R + R_RAW); bf16_t* lin = (bf16_t*)(R + R_LIN);
    const f16* poolp = (const f16*)(R + R_POOLP); bf16_t* ypool = (bf16_t*)(R + R_YB) + 3 * SZ512;
    const float* mu = P.inp(13) + (size_t)layer * 1920; const float* pscale = P.inp(26) + (size_t)layer * 512;
    const int gsz = C.nblk * NT, gid = C.bid * NT + C.tid;
    for (int e0 = gid; e0 < TP * 96; e0 += 2 * gsz) {
        f16x4_t p0[2], pm[2], pp[2]; f32x4 m4[2]; int lt_[2], c_[2]; float wm_[2], wp_[2]; bool ok[2];
#pragma unroll
        for (int u = 0; u < 2; ++u) {
            const int e1 = e0 + u * gsz; ok[u] = e1 < TP * 96; const int e = ok[u] ? e1 : e0;
            const int lt = e / 96, c = (e % 96) * 4, col = 1536 + c;
            const int pos = pos_of(lt), S = lt < 8192 ? 8192 : 4096;
            lt_[u] = lt; c_[u] = c; wm_[u] = pos > 0 ? 0.5f : 0.f; wp_[u] = pos < S - 1 ? 0.5f : 0.f;
            p0[u] = *(const f16x4_t*)(raw + (size_t)lt * 1920 + col);
            pm[u] = *(const f16x4_t*)(raw + (size_t)(pos > 0 ? lt - 1 : lt) * 1920 + col);
            pp[u] = *(const f16x4_t*)(raw + (size_t)(pos < S - 1 ? lt + 1 : lt) * 1920 + col);
            m4[u] = *(const f32x4*)(mu + col);
        }
#pragma unroll
        for (int u = 0; u < 2; ++u) {
            float o[4];
#pragma unroll
            for (int r = 0; r < 4; ++r) {
                const float p = (float)p0[u][r];
                float v = p + (wm_[u] * (float)pm[u][r] + wp_[u] * (float)pp[u][r] - p) * m4[u][r];
                if (c_[u] < 128) v = 1.0f - 2.0f * __builtin_amdgcn_rcpf(__expf(2.0f * v) + 1.0f);
                else if (c_[u] >= 256) v = sigmoidf_(v);
                o[r] = v;
            }
            u32x2 w; w.x = pack2bf(o[0], o[1]); w.y = pack2bf(o[2], o[3]);
            if (ok[u]) *(u32x2*)(lin + (size_t)lt_[u] * 384 + c_[u]) = w;
        }
    }
    for (int e0 = gid; e0 < TP * 128; e0 += 2 * gsz) {
        f16x4_t tv[2][16], xv[2]; int lt_[2], c_[2], cnt_[2]; bool ok[2];
#pragma unroll
        for (int u = 0; u < 2; ++u) {
            const int e1 = e0 + u * gsz; ok[u] = e1 < TP * 128; const int e = ok[u] ? e1 : e0;
            const int lt = e >> 7, c = (e & 127) * 4, g = c >> 7, half = 1 << g;
            const int pos = pos_of(lt), S = lt < 8192 ? 8192 : 4096;
            const int lo = max(pos - half, 0), hi = min(pos + half, S);
            lt_[u] = lt; c_[u] = c; cnt_[u] = hi - lo;
            const f16* base = poolp + (size_t)(lt - pos) * 512 + c;
#pragma unroll
            for (int o = -8; o < 8; ++o) {
                const int tt = pos + o;
                const bool in = (o >= -half) && (o < half) && tt >= 0 && tt < S;
                f16x4_t z; z[0] = (f16)0.f; z[1] = (f16)0.f; z[2] = (f16)0.f; z[3] = (f16)0.f;
                tv[u][o + 8] = in ? *(const f16x4_t*)(base + (size_t)tt * 512) : z;
            }
            xv[u] = *(const f16x4_t*)(base + (size_t)pos * 512);
        }
#pragma unroll
        for (int u = 0; u < 2; ++u) {
            float s0 = 0.f, s1 = 0.f, s2 = 0.f, s3 = 0.f;
#pragma unroll
            for (int o = 0; o < 16; ++o) { s0 += (float)tv[u][o][0]; s1 += (float)tv[u][o][1]; s2 += (float)tv[u][o][2]; s3 += (float)tv[u][o][3]; }
            const f32x4 ps = *(const f32x4*)(pscale + c_[u]);
            const float ic = 1.0f / (float)cnt_[u];
            u32x2 w; w.x = pack2bf((s0 * ic - (float)xv[u][0]) * ps[0], (s1 * ic - (float)xv[u][1]) * ps[1]); w.y = pack2bf((s2 * ic - (float)xv[u][2]) * ps[2], (s3 * ic - (float)xv[u][3]) * ps[3]);
            if (ok[u]) *(u32x2*)(ypool + (size_t)lt_[u] * 512 + c_[u]) = w;
        }
    }
    {
        float* invn = (float*)(P.ws + WS_INVN);
        const float* k_k = P.inp(19) + (size_t)layer * 512;
        const int lane = C.tid & 63, wave = C.tid >> 6;
        for (int lt = C.bid * NWV + wave; lt < TP; lt += C.nblk * NWV) {
            const int pos = pos_of(lt), S = lt < 8192 ? 8192 : 4096;
            float ss[8];
#pragma unroll
            for (int h = 0; h < 8; ++h) {
                const int c = h * 64 + lane;
                const float k = shiftv(raw, lt, pos, S, 512 + c, mu[512 + c]) * k_k[c];
                ss[h] = k * k;
            }
#pragma unroll
            for (int h = 0; h < 8; ++h) ss[h] = wsum(ss[h]);
            if (lane < 8) {
                float sel = ss[0];
#pragma unroll
                for (int h = 1; h < 8; ++h) sel = lane == h ? ss[h] : sel;
                invn[(size_t)lt * 8 + lane] = 1.0f / fmaxf(sqrtf(sel), 1e-12f);
            }
        }
    }
}

__device__ __forceinline__ void lora_phase(const Ctx& C, const PV& P, int layer, unsigned char* smem) {
    unsigned char* R = P.ws + WS_R;
    const bf16_t* lin = (const bf16_t*)(R + R_LIN); f16* wa = (f16*)(R + R_WA); f16* gbuf = (f16*)(R + R_G);
    const bf16_t* W = wl(P, layer);
    const int lane = C.tid & 63, wave = (C.tid >> 6) & 3, wm = wave >> 1, wn = wave & 1, fr = lane & 15, fq = lane >> 4;
    for (int t2 = C.bid; t2 < 5 * MT * 2; t2 += C.nblk) {
        const int t = t2 * 2 + (C.tid >> 8);
        const int which = t / (MT * 4), tt = t % (MT * 4), tm = tt >> 2, tn = tt & 3;
        const bf16_t* Bt; int K, acol; const float* bias = nullptr; f16* dst;
        if (which < 2) { Bt = W + OW_W2T + (size_t)which * 512 * 64; K = 64; acol = which * 64; bias = P.inp(14) + (size_t)(layer * 2 + which) * 512; dst = wa + (size_t)which * SZ512; }
        else if (which < 4) { const int d = which - 2; Bt = W + OW_A2T + (size_t)d * 512 * 64; K = 64; acol = 128 + d * 64; bias = P.inp(16) + (size_t)(layer * 2 + d) * 512; dst = wa + (size_t)which * SZ512; }
        else { Bt = W + OW_G2T; K = 128; acol = 256; dst = gbuf; }
        f32x4 acc[4][4];
        gemm_core<4, true>(C, acc, lin + (size_t)tm * 128 * 384 + acol, 384, Bt + (size_t)tn * 128 * K, K, K, smem);
#pragma unroll
        for (int i = 0; i < 4; ++i) {
            const int lt = tm * 128 + wm * 64 + i * 16 + fr;
#pragma unroll
            for (int jn = 0; jn < 4; ++jn) {
                const int n = tn * 128 + wn * 64 + jn * 16 + fq * 4;
                typedef f16 f16x4 __attribute__((ext_vector_type(4)));
                f16x4 h;
#pragma unroll
                for (int r = 0; r < 4; ++r) {
                    float v = acc[i][jn][r];
                    if (which < 2) {
                        const float z = bias[n + r] + v;
                        v = __expf(-0.6065306597126334f * sigmoidf_(z));
                    } else if (which < 4) { v = sigmoidf_(bias[n + r] + v); }
                    h[r] = (f16)v;
                }
                *(f16x4*)(dst + (size_t)lt * 512 + n) = h;
            }
        }
    }
}

__device__ __forceinline__ void attn_items(const Ctx& C, const PV& P, int layer, int ctr_idx, unsigned char* smem) {
    unsigned char* R = P.ws + WS_R;
    const bf16_t* Qall = (const bf16_t*)(R + R_Q); const bf16_t* Kall = (const bf16_t*)(R + R_K); const bf16_t* Vall = (const bf16_t*)(R + R_VT);
    bf16_t* ydiff = (bf16_t*)(R + R_YB) + 1 * SZ512;
    const int tid = C.tid, lane = tid & 63, wave = tid >> 6, comp = wave & 1, rg = wave >> 1, fr = lane & 15, fq = lane >> 4;
    const float lam_init = layer == 0 ? 0.2f : (0.8f - 0.6f * 0.7408182206817179f);
    float lam_full;
    {
        const float* lm = P.inp(24) + (size_t)layer * 256;
        float s1 = 0.f, s2 = 0.f;
        for (int i = 0; i < 64; ++i) { s1 += lm[i] * lm[64 + i]; s2 += lm[128 + i] * lm[192 + i]; }
        lam_full = expf(s1) - expf(s2) + lam_init;
    }
    const float* normg = P.inp(25) + (size_t)layer * 128;
    unsigned* ctr = (unsigned*)(P.ws + WS_CTR) + ctr_idx * 16;
    volatile unsigned* bc = (volatile unsigned*)(smem + 131088);
    for (;;) {
        __syncthreads();
        if (tid == 0) *bc = atomicAdd(ctr, 1u);
        __syncthreads();
        const int item = (int)*bc;
        if (item >= 1280) break;
        int sq, h, qb;
        if (item < 256) { sq = 0; h = item >> 6; qb = item & 63; } else { const int i2 = item - 256; sq = 1 + (i2 >> 7); h = (i2 >> 5) & 3; qb = i2 & 31; }
        const int lt0 = seqbase_of(sq), S = seqlen_of(sq);
        const bf16_t* Qb = Qall + (size_t)lt0 * 512; const bf16_t* Kb = Kall + (size_t)lt0 * 512; const bf16_t* Vb = Vall + (size_t)lt0 * 512 + (size_t)h * 128 * S;
        const int q0 = qb * 128 + rg * 32;
        bf16x8 bq[2][2];
#pragma unroll
        for (int qs = 0; qs < 2; ++qs)
#pragma unroll
            for (int ks = 0; ks < 2; ++ks) bq[qs][ks] = *(const bf16x8*)(Qb + ((size_t)(h * 2 + comp) * S + q0 + qs * 16 + fr) * 64 + ks * 32 + fq * 8);
        float m_run[2] = {-1e30f, -1e30f}, l_run[2] = {0.f, 0.f};
        f32x4 O[8][2];
#pragma unroll
        for (int a = 0; a < 8; ++a) { O[a][0] = (f32x4){0.f, 0.f, 0.f, 0.f}; O[a][1] = (f32x4){0.f, 0.f, 0.f, 0.f}; }
        u32x4 rk[2], rv[2];
        const int lrow = tid >> 3, lkc = (tid & 7) * 8;
        auto gload = [&](int kt0) {
#pragma unroll
            for (int i = 0; i < 2; ++i) {
                const int row = lrow + 64 * i, cm = row >> 6, key = row & 63;
                rk[i] = *(const u32x4*)(Kb + ((size_t)(h * 2 + cm) * S + kt0 + key) * 64 + lkc);
                rv[i] = *(const u32x4*)(Vb + (size_t)row * S + kt0 + lkc);
            }
        };
        auto lstore = [&](int b) {
            unsigned char* sb = smem + b * 36864;
#pragma unroll
            for (int i = 0; i < 2; ++i) {
                const int row = lrow + 64 * i;
                *(u32x4*)(sb + row * 144 + lkc * 2) = rk[i];
                *(u32x4*)(sb + 18432 + row * 144 + lkc * 2) = rv[i];
            }
        };
        bf16x8 pb[2][2];
        auto H1 = [&](int b) {
            const unsigned char* sb = smem + b * 36864;
            f32x4 st[4][2];
#pragma unroll
            for (int t = 0; t < 4; ++t) {
                st[t][0] = (f32x4){0.f, 0.f, 0.f, 0.f}; st[t][1] = (f32x4){0.f, 0.f, 0.f, 0.f};
#pragma unroll
                for (int ks = 0; ks < 2; ++ks) {
                    const bf16x8 kf = *(const bf16x8*)(sb + (comp * 64 + t * 16 + fr) * 144 + (ks * 32 + fq * 8) * 2);
                    st[t][0] = __builtin_amdgcn_mfma_f32_16x16x32_bf16(kf, bq[0][ks], st[t][0], 0, 0, 0);
                    st[t][1] = __builtin_amdgcn_mfma_f32_16x16x32_bf16(kf, bq[1][ks], st[t][1], 0, 0, 0);
                }
            }
            float mxq[2];
#pragma unroll
            for (int qs = 0; qs < 2; ++qs) {
                float mx = -1e30f;
#pragma unroll
                for (int t = 0; t < 4; ++t)
#pragma unroll
                    for (int r = 0; r < 4; ++r) mx = fmaxf(mx, st[t][qs][r]);
                mxq[qs] = mx;
            }
            { const float a0 = __shfl_xor(mxq[0], 16), a1 = __shfl_xor(mxq[1], 16); mxq[0] = fmaxf(mxq[0], a0); mxq[1] = fmaxf(mxq[1], a1);
              const float b0 = __shfl_xor(mxq[0], 32), b1 = __shfl_xor(mxq[1], 32); mxq[0] = fmaxf(mxq[0], b0); mxq[1] = fmaxf(mxq[1], b1); }
#pragma unroll
            for (int qs = 0; qs < 2; ++qs) {
                const float mx = mxq[qs];
                const float mnew = fmaxf(m_run[qs], mx);
                const float alpha = __builtin_amdgcn_exp2f(m_run[qs] - mnew);
                m_run[qs] = mnew;
                float ls = 0.f;
                float pv[4][4];
#pragma unroll
                for (int t = 0; t < 4; ++t)
#pragma unroll
                    for (int r = 0; r < 4; ++r) { pv[t][r] = __builtin_amdgcn_exp2f(st[t][qs][r] - mnew); ls += pv[t][r]; }
                l_run[qs] = l_run[qs] * alpha + ls;
                if (__builtin_amdgcn_ballot_w64(alpha != 1.0f) != 0ull) {
#pragma unroll
                    for (int a = 0; a < 8; ++a) O[a][qs] = O[a][qs] * alpha;
                }
#pragma unroll
                for (int u = 0; u < 2; ++u) {
                    union { bf16x8 v; unsigned w[4]; } pk;
                    pk.w[0] = pack2bf(pv[2 * u][0], pv[2 * u][1]); pk.w[1] = pack2bf(pv[2 * u][2], pv[2 * u][3]);
                    pk.w[2] = pack2bf(pv[2 * u + 1][0], pv[2 * u + 1][1]); pk.w[3] = pack2bf(pv[2 * u + 1][2], pv[2 * u + 1][3]);
                    pb[qs][u] = pk.v;
                }
            }
        };
        auto H2 = [&](int b) {
            const unsigned char* sb = smem + b * 36864 + 18432;
#pragma unroll
            for (int u = 0; u < 2; ++u)
#pragma unroll
                for (int a = 0; a < 8; ++a) {
                    union { bf16x8 v; u32x2 h[2]; } vf;
                    vf.h[0] = *(const u32x2*)(sb + (a * 16 + fr) * 144 + (u * 32 + fq * 4) * 2);
                    vf.h[1] = *(const u32x2*)(sb + (a * 16 + fr) * 144 + (u * 32 + 16 + fq * 4) * 2);
                    O[a][0] = __builtin_amdgcn_mfma_f32_16x16x32_bf16(vf.v, pb[0][u], O[a][0], 0, 0, 0);
                    O[a][1] = __builtin_amdgcn_mfma_f32_16x16x32_bf16(vf.v, pb[1][u], O[a][1], 0, 0, 0);
                }
        };
        const int grp = wave >> 2, T = S >> 6;
        gload(0);
        lstore(0);
        __syncthreads();
        for (int t = 0; t < T; ++t) {
            if (t + 1 < T) gload((t + 1) * 64);
            if (grp == 0) H1(t & 1); else if (t > 0) H2((t - 1) & 1);
            __syncthreads();
            if (t + 1 < T) lstore((t + 1) & 1);
            if (grp == 0) H2(t & 1); else H1(t & 1);
            __syncthreads();
        }
        if (grp == 1) H2((T - 1) & 1);
#pragma unroll
        for (int qs = 0; qs < 2; ++qs) {
            float l = l_run[qs]; l += __shfl_xor(l, 16); l += __shfl_xor(l, 32);
            const float inv = 1.0f / l;
#pragma unroll
            for (int a = 0; a < 8; ++a) O[a][qs] = O[a][qs] * inv;
        }
        __syncthreads();
        float* Ox = (float*)smem;
        if (comp == 1) {
#pragma unroll
            for (int qs = 0; qs < 2; ++qs)
#pragma unroll
                for (int a = 0; a < 8; ++a)
#pragma unroll
                    for (int r = 0; r < 4; ++r) Ox[(rg * 128 + a * 16 + fq * 4 + r) * 32 + qs * 16 + fr] = O[a][qs][r];
        }
        __syncthreads();
        if (comp == 0) {
#pragma unroll
            for (int qs = 0; qs < 2; ++qs) {
                float ss = 0.f;
#pragma unroll
                for (int a = 0; a < 8; ++a)
#pragma unroll
                    for (int r = 0; r < 4; ++r) {
                        const float o = O[a][qs][r] - lam_full * Ox[(rg * 128 + a * 16 + fq * 4 + r) * 32 + qs * 16 + fr];
                        O[a][qs][r] = o; ss += o * o;
                    }
                ss += __shfl_xor(ss, 16); ss += __shfl_xor(ss, 32);
                const float sc = rsqrtf(ss * (1.0f / 128.0f) + 1e-5f) * (1.0f - lam_init);
                const int lt = lt0 + q0 + qs * 16 + fr;
#pragma unroll
                for (int a = 0; a < 8; ++a) {
                    const int dv = a * 16 + fq * 4;
                    const float4 g = *(const float4*)(normg + dv);
                    uint2 w; w.x = pack2bf(O[a][qs][0] * sc * g.x, O[a][qs][1] * sc * g.y); w.y = pack2bf(O[a][qs][2] * sc * g.z, O[a][qs][3] * sc * g.w);
                    *(uint2*)(ydiff + (size_t)lt * 512 + h * 128 + dv) = w;
                }
            }
        }
    }
    __syncthreads();
}

__device__ __forceinline__ void fft_items(const Ctx& C, const PV& P, unsigned char* smem) {
    unsigned char* R = P.ws + WS_R;
    typedef f16 f16x2 __attribute__((ext_vector_type(2)));
    const f16x2* Zall = (const f16x2*)(R + R_ZC);
    bf16_t* yf = (bf16_t*)(R + R_YB) + 2 * SZ512;
    const float2* tw = (const float2*)(P.ws + WS_TW);
    float2* sm = (float2*)smem;
    const int tid = C.tid;
    for (int item = C.bid; item < NSEQ * 256; item += C.nblk) {
        const int sq = item >> 8, col = item & 255, g = col >> 6, cc = col & 63;
        const int lt0 = seqbase_of(sq), S = seqlen_of(sq), lg = sq == 0 ? 13 : 12;
        const f16x2* z = Zall + (size_t)lt0 * 256 + (size_t)col * S;
        __syncthreads();
        for (int s = tid; s < S; s += NT) { const f16x2 v = z[s]; sm[__brev((unsigned)s) >> (32 - lg)] = make_float2((float)v[0], (float)v[1]); }
        __syncthreads();
        int st = 0;
        for (; st + 1 < lg; st += 2) {
            const int half = 1 << st;
            for (int gq = tid; gq < (S >> 2); gq += NT) {
                const int j = gq & (half - 1), p0 = ((gq >> st) << (st + 2)) + j, p1 = p0 + half, p2 = p1 + half, p3 = p2 + half;
                const float2 w1 = tw[j << (12 - st)], wa = tw[j << (11 - st)], wb = tw[(j + half) << (11 - st)];
                const float2 x0 = sm[p0], x1 = sm[p1], x2 = sm[p2], x3 = sm[p3];
                const float2 t1 = make_float2(w1.x * x1.x - w1.y * x1.y, w1.x * x1.y + w1.y * x1.x);
                const float2 t3 = make_float2(w1.x * x3.x - w1.y * x3.y, w1.x * x3.y + w1.y * x3.x);
                const float2 a0 = make_float2(x0.x + t1.x, x0.y + t1.y), a1 = make_float2(x0.x - t1.x, x0.y - t1.y);
                const float2 a2 = make_float2(x2.x + t3.x, x2.y + t3.y), a3 = make_float2(x2.x - t3.x, x2.y - t3.y);
                const float2 u2 = make_float2(wa.x * a2.x - wa.y * a2.y, wa.x * a2.y + wa.y * a2.x);
                const float2 u3 = make_float2(wb.x * a3.x - wb.y * a3.y, wb.x * a3.y + wb.y * a3.x);
                sm[p0] = make_float2(a0.x + u2.x, a0.y + u2.y); sm[p2] = make_float2(a0.x - u2.x, a0.y - u2.y);
                sm[p1] = make_float2(a1.x + u3.x, a1.y + u3.y); sm[p3] = make_float2(a1.x - u3.x, a1.y - u3.y);
            }
            __syncthreads();
        }
        for (; st < lg; ++st) {
            const int half = 1 << st, tshift = 12 - st;
            for (int b = tid; b < (S >> 1); b += NT) {
                const int j = b & (half - 1), i0 = ((b >> st) << (st + 1)) + j, i1 = i0 + half;
                const float2 w = tw[j << tshift], u = sm[i0], x = sm[i1];
                const float2 tv = make_float2(w.x * x.x - w.y * x.y, w.x * x.y + w.y * x.x);
                sm[i0] = make_float2(u.x + tv.x, u.y + tv.y); sm[i1] = make_float2(u.x - tv.x, u.y - tv.y);
            }
            __syncthreads();
        }
        const float nrm = rsqrtf((float)S * 128.0f);
        for (int k = tid; k < S; k += NT) {
            const float2 a = sm[k], b = sm[(S - k) & (S - 1)];
            bf16_t* row = yf + (size_t)(lt0 + k) * 512 + g * 128;
            if (cc == 0) { row[0] = f2bf(0.5f * (a.x + b.x) * nrm); row[64] = f2bf(0.5f * (a.y + b.y) * nrm); }
            else { row[cc] = f2bf(a.x * nrm); row[128 - cc] = f2bf(b.x * nrm); }
        }
    }
    __syncthreads();
}

template <int KT>
__device__ __forceinline__ void scan_block(const Ctx& C, const PV& P, int layer, int sq, int h, int d, int row0, unsigned char* smem) {
    constexpr int TPR = 64 / KT, ROWS = NT / TPR, CH = 16, YP = TPR / 4, NV = ROWS / 32;
    unsigned char* R = P.ws + WS_R;
    const f16* raw = (const f16*)(R + R_RAW); const f16* wa = (const f16*)(R + R_WA); f16* yfb = (f16*)(R + R_YFB);
    const float* invn = (const float*)(P.ws + WS_INVN);
    const float* mu = P.inp(13) + (size_t)layer * 1920; const float* k_k = P.inp(19) + (size_t)layer * 512; const float* k_a = P.inp(20) + (size_t)layer * 512;
    const int tid = C.tid, row = tid / TPR, q = tid % TPR;
    const int lt0 = seqbase_of(sq), S = seqlen_of(sq);
    const int ch = tid & 63, c = h * 64 + ch;
    const float mu_r = mu[c], mu_k = mu[512 + c], kkw = k_k[c], kaw = k_a[c];
    const int vr = (ROWS == 32) ? (tid & 31) : (tid & 63);
    const int vcol = 1024 + h * 64 + row0 + vr; const float mu_v = mu[vcol];
    const f16* wdec = wa + (size_t)d * SZ512; const f16* aact = wa + (size_t)(2 + d) * SZ512;
    f16* ydst = yfb + (size_t)d * SZ512;
    f32x2 s[KT / 2];
#pragma unroll
    for (int j = 0; j < KT / 2; ++j) s[j] = (f32x2){0.f, 0.f};
    f16 pr_[2][3], pk_[2][3], pa_[2], pw_[2], pv_[NV][3]; float pn_[2];
    auto prefetch = [&](int c0) {
#pragma unroll
        for (int j = 0; j < 2; ++j) {
            const int i = (tid >> 6) + 8 * j, tstep = c0 + i, t = d == 0 ? tstep : S - 1 - tstep, lt = lt0 + t;
            const int tm = t > 0 ? lt - 1 : lt, tp = t < S - 1 ? lt + 1 : lt;
            pr_[j][0] = raw[(size_t)tm * 1920 + c]; pr_[j][1] = raw[(size_t)lt * 1920 + c]; pr_[j][2] = raw[(size_t)tp * 1920 + c];
            pk_[j][0] = raw[(size_t)tm * 1920 + 512 + c]; pk_[j][1] = raw[(size_t)lt * 1920 + 512 + c]; pk_[j][2] = raw[(size_t)tp * 1920 + 512 + c];
            pa_[j] = aact[(size_t)lt * 512 + c]; pw_[j] = wdec[(size_t)lt * 512 + c]; pn_[j] = invn[(size_t)lt * 8 + h];
        }
#pragma unroll
        for (int j = 0; j < NV; ++j) {
            const int i = (ROWS == 32) ? (tid >> 5) : ((tid >> 6) + 8 * j), tstep = c0 + i, t = d == 0 ? tstep : S - 1 - tstep, lt = lt0 + t;
            const int tm = t > 0 ? lt - 1 : lt, tp = t < S - 1 ? lt + 1 : lt;
            pv_[j][0] = raw[(size_t)tm * 1920 + vcol]; pv_[j][1] = raw[(size_t)lt * 1920 + vcol]; pv_[j][2] = raw[(size_t)tp * 1920 + vcol];
        }
    };
    auto stage = [&](int c0, unsigned char* buf) {
        float* vec = (float*)buf; float* vbuf = (float*)(buf + 20480);
#pragma unroll
        for (int j = 0; j < 2; ++j) {
            const int i = (tid >> 6) + 8 * j, tstep = c0 + i, t = d == 0 ? tstep : S - 1 - tstep;
            const float rm = t > 0 ? (float)pr_[j][0] : 0.f, rp = t < S - 1 ? (float)pr_[j][2] : 0.f, km = t > 0 ? (float)pk_[j][0] : 0.f, kp = t < S - 1 ? (float)pk_[j][2] : 0.f;
            const float r1 = (float)pr_[j][1], k1 = (float)pk_[j][1];
            const float r = r1 + (0.5f * (rm + rp) - r1) * mu_r;
            const float k = k1 + (0.5f * (km + kp) - k1) * mu_k;
            const float kk = k * kkw * pn_[j], a = (float)pa_[j];
            vec[(0 * CH + i) * 64 + ch] = kk;
            vec[(1 * CH + i) * 64 + ch] = (float)pw_[j];
            vec[(2 * CH + i) * 64 + ch] = kk * a;
            vec[(3 * CH + i) * 64 + ch] = k * (1.0f + (a - 1.0f) * kaw);
            vec[(4 * CH + i) * 64 + ch] = r;
        }
#pragma unroll
        for (int j = 0; j < NV; ++j) {
            const int i = (ROWS == 32) ? (tid >> 5) : ((tid >> 6) + 8 * j), tstep = c0 + i, t = d == 0 ? tstep : S - 1 - tstep;
            const float vm = t > 0 ? (float)pv_[j][0] : 0.f, vp = t < S - 1 ? (float)pv_[j][2] : 0.f, v1 = (float)pv_[j][1];
            vbuf[i * 64 + vr] = v1 + (0.5f * (vm + vp) - v1) * mu_v;
        }
    };
    __syncthreads();
    prefetch(0);
    stage(0, smem);
    __syncthreads();
    const int nch = S / CH;
    for (int cix = 0; cix < nch; ++cix) {
        unsigned char* buf = smem + (cix & 1) * 32768;
        if (cix + 1 < nch) prefetch((cix + 1) * CH);
        {
            const float* vec = (const float*)buf; const float* vbuf = (const float*)(buf + 20480); float* ybuf = (float*)(buf + 24576);
            const f32x4* vp0 = (const f32x4*)(vec + q * KT);
            f32x4 nx[5][KT / 4]; float nvv;
#pragma unroll
            for (int u = 0; u < KT / 4; ++u)
#pragma unroll
                for (int a5 = 0; a5 < 5; ++a5) nx[a5][u] = vp0[a5 * CH * 16 + u];
            nvv = vbuf[row];
            float yv[CH];
#pragma unroll
            for (int i = 0; i < CH; ++i) {
                f32x2 kk2[KT / 2], w2[KT / 2], b2[KT / 2], kd2[KT / 2], r2[KT / 2];
#pragma unroll
                for (int u = 0; u < KT / 4; ++u) {
                    kk2[2 * u] = (f32x2){nx[0][u][0], nx[0][u][1]}; kk2[2 * u + 1] = (f32x2){nx[0][u][2], nx[0][u][3]};
                    w2[2 * u] = (f32x2){nx[1][u][0], nx[1][u][1]}; w2[2 * u + 1] = (f32x2){nx[1][u][2], nx[1][u][3]};
                    b2[2 * u] = (f32x2){nx[2][u][0], nx[2][u][1]}; b2[2 * u + 1] = (f32x2){nx[2][u][2], nx[2][u][3]};
                    kd2[2 * u] = (f32x2){nx[3][u][0], nx[3][u][1]}; kd2[2 * u + 1] = (f32x2){nx[3][u][2], nx[3][u][3]};
                    r2[2 * u] = (f32x2){nx[4][u][0], nx[4][u][1]}; r2[2 * u + 1] = (f32x2){nx[4][u][2], nx[4][u][3]};
                }
                const float vv = nvv;
                if (i + 1 < CH) {
#pragma unroll
                    for (int u = 0; u < KT / 4; ++u)
#pragma unroll
                        for (int a5 = 0; a5 < 5; ++a5) nx[a5][u] = vp0[(i + 1) * 16 + a5 * CH * 16 + u];
                    nvv = vbuf[(i + 1) * 64 + row];
                }
                f32x2 acc2 = s[0] * kk2[0];
#pragma unroll
                for (int j = 1; j < KT / 2; ++j) acc2 = __builtin_elementwise_fma(s[j], kk2[j], acc2);
                float sa = acc2[0] + acc2[1];
                sa += dppf<0xB1>(sa); sa += dppf<0x4E>(sa); sa += dppf<0x141>(sa);
                if (TPR == 16) sa += dppf<0x140>(sa);
                sa = -sa;
                const f32x2 sa2 = (f32x2){sa, sa}, vv2 = (f32x2){vv, vv};
                f32x2 y2 = (f32x2){0.f, 0.f};
#pragma unroll
                for (int j = 0; j < KT / 2; ++j) {
                    s[j] = __builtin_elementwise_fma(s[j], w2[j], __builtin_elementwise_fma(sa2, b2[j], vv2 * kd2[j]));
                    y2 = __builtin_elementwise_fma(s[j], r2[j], y2);
                }
                float y = y2[0] + y2[1];
                y += dppf<0xB1>(y); y += dppf<0x4E>(y);
                yv[i] = y;
            }
            if ((q & 3) == 0) {
#pragma unroll
                for (int i = 0; i < CH; ++i) ybuf[i * 128 + row * YP + (q >> 2)] = yv[i];
            }
        }
        if (cix + 1 < nch) stage((cix + 1) * CH, smem + ((cix + 1) & 1) * 32768);
        __syncthreads();
        {
            const float* ybuf = (const float*)(buf + 24576);
#pragma unroll
            for (int j = 0; j < NV; ++j) {
                const int i = (ROWS == 32) ? (tid >> 5) : ((tid >> 6) + 8 * j), rr = vr, tstep = cix * CH + i, t = d == 0 ? tstep : S - 1 - tstep;
                float y = 0.f;
#pragma unroll
                for (int p = 0; p < YP; ++p) y += ybuf[i * 128 + rr * YP + p];
                ydst[(size_t)(lt0 + t) * 512 + h * 64 + row0 + rr] = (f16)y;
            }
        }
    }
    __syncthreads();
}

__device__ __forceinline__ void finish_phase(const Ctx& C, const PV& P, int layer) {
    unsigned char* R = P.ws + WS_R;
    const f16* raw = (const f16*)(R + R_RAW); const f16* wa = (const f16*)(R + R_WA); const f16* gbuf = (const f16*)(R + R_G); const f16* yfb = (const f16*)(R + R_YFB);
    bf16_t* yr = (bf16_t*)(R + R_YB);
    const float* mu = P.inp(13) + (size_t)layer * 1920; const float* k_a = P.inp(20) + (size_t)layer * 512; const float* r_k = P.inp(21) + (size_t)layer * 512;
    const float* lg = P.inp(22) + (size_t)layer * 512; const float* lb = P.inp(23) + (size_t)layer * 512;
    const int lane = C.tid & 63, wave = C.tid >> 6, c = lane * 8;
    const int nw = C.nblk * NWV;
    for (int ltb = C.bid * NWV + wave; ltb < TP; ltb += 2 * nw) {
        f16x8_t rA[2], rB[2], rC[2], kA[2], kB[2], kC[2], vA[2], vB[2], vC[2], af[2], ab[2], gg[2], yF[2], yB[2]; float wm_[2], wp_[2]; bool ok[2];
#pragma unroll
        for (int u = 0; u < 2; ++u) {
            const int lt1 = ltb + u * nw; ok[u] = lt1 < TP; const int lt = ok[u] ? lt1 : ltb;
            const int pos = pos_of(lt), S = lt < 8192 ? 8192 : 4096;
            const size_t rm = (size_t)(pos > 0 ? lt - 1 : lt) * 1920, r0 = (size_t)lt * 1920, rp = (size_t)(pos < S - 1 ? lt + 1 : lt) * 1920;
            wm_[u] = pos > 0 ? 0.5f : 0.f; wp_[u] = pos < S - 1 ? 0.5f : 0.f;
            rA[u] = *(const f16x8_t*)(raw + rm + c); rB[u] = *(const f16x8_t*)(raw + r0 + c); rC[u] = *(const f16x8_t*)(raw + rp + c);
            kA[u] = *(const f16x8_t*)(raw + rm + 512 + c); kB[u] = *(const f16x8_t*)(raw + r0 + 512 + c); kC[u] = *(const f16x8_t*)(raw + rp + 512 + c);
            vA[u] = *(const f16x8_t*)(raw + rm + 1024 + c); vB[u] = *(const f16x8_t*)(raw + r0 + 1024 + c); vC[u] = *(const f16x8_t*)(raw + rp + 1024 + c);
            af[u] = *(const f16x8_t*)(wa + 2 * SZ512 + (size_t)lt * 512 + c); ab[u] = *(const f16x8_t*)(wa + 3 * SZ512 + (size_t)lt * 512 + c);
            gg[u] = *(const f16x8_t*)(gbuf + (size_t)lt * 512 + c);
            yF[u] = *(const f16x8_t*)(yfb + (size_t)lt * 512 + c); yB[u] = *(const f16x8_t*)(yfb + SZ512 + (size_t)lt * 512 + c);
        }
#pragma unroll
        for (int u = 0; u < 2; ++u) {
            float y[8], vv[8], bsum = 0.f, ysum = 0.f;
#pragma unroll
            for (int j = 0; j < 8; ++j) {
                const float r_ = (float)rB[u][j], k_ = (float)kB[u][j], v_ = (float)vB[u][j];
                const float r = r_ + (wm_[u] * (float)rA[u][j] + wp_[u] * (float)rC[u][j] - r_) * mu[c + j];
                const float k = k_ + (wm_[u] * (float)kA[u][j] + wp_[u] * (float)kC[u][j] - k_) * mu[512 + c + j];
                vv[j] = v_ + (wm_[u] * (float)vA[u][j] + wp_[u] * (float)vC[u][j] - v_) * mu[1024 + c + j];
                const float ka = k_a[c + j];
                const float ksum = k * (1.f + ((float)af[u][j] - 1.f) * ka) + k * (1.f + ((float)ab[u][j] - 1.f) * ka);
                bsum += r * (0.5f * ksum) * r_k[c + j];
                y[j] = (float)yF[u][j] + (float)yB[u][j]; ysum += y[j];
            }
            const float ym = red8(ysum) * (1.0f / 64.0f);
            float q = 0.f;
#pragma unroll
            for (int j = 0; j < 8; ++j) { const float dy = y[j] - ym; q += dy * dy; }
            const float rs = rsqrtf(red8(q) * (1.0f / 64.0f) + 64e-5f);
            const float bonus = red8(bsum);
            float o[8];
#pragma unroll
            for (int j = 0; j < 8; ++j) o[j] = ((y[j] - ym) * rs * lg[c + j] + lb[c + j] + bonus * vv[j]) * (float)gg[u][j];
            u32x4 w; w.x = pack2bf(o[0], o[1]); w.y = pack2bf(o[2], o[3]); w.z = pack2bf(o[4], o[5]); w.w = pack2bf(o[6], o[7]);
            if (ok[u]) *(u32x4*)(yr + (size_t)(ltb + u * nw) * 512 + c) = w;
        }
    }
}

__device__ __forceinline__ void gates_phase(const Ctx& C, const PV& P, int layer) {
    const bf16_t* hmod = (const bf16_t*)(P.ws + WS_HMOD);
    const bf16_t* Wt = wl(P, layer) + OW_WIN + (size_t)4480 * 1024;
    bf16_t* gates = (bf16_t*)(P.ws + WS_R + R_GATES);
    int pm, pn;
    for (int it = 0; tile_order(it, C.nblk, C.bid, TP / 256, 16, pm, pn); ++it) {
        f32x4 acc[2][2][4][2];
        gemm256(C, acc, hmod, Wt, 1024, pm * 256, pn * 256);
        int z2 = 0; asm volatile("" : "+s"(z2));
        const int tid2 = tid_now(C.wave_s, z2), lane = tid2 & 63, wid = tid2 >> 6, wr = wid >> 2, wc = wid & 3, fr = lane & 15, fq = lane >> 4;
#pragma unroll
        for (int ai = 0; ai < 2; ++ai)
#pragma unroll
            for (int m = 0; m < 4; ++m) {
                const int lt = pm * 256 + ai * 128 + wr * 64 + m * 16 + fr;
#pragma unroll
                for (int bj = 0; bj < 2; ++bj)
#pragma unroll
                    for (int n = 0; n < 2; ++n) {
                        const int col = pn * 256 + bj * 128 + wc * 32 + n * 16 + fq * 4;
                        const f32x4 v = acc[ai][bj][m][n];
                        u32x2 w; w.x = pack2bf(sigmoidf_(v[0]), sigmoidf_(v[1])); w.y = pack2bf(sigmoidf_(v[2]), sigmoidf_(v[3]));
                        *(u32x2*)(gates + (size_t)lt * 4096 + col) = w;
                    }
            }
    }
}
__device__ __forceinline__ void branch_phase(const Ctx& C, const PV& P, int layer) {
    unsigned char* R = P.ws + WS_R;
    const bf16_t* yb = (const bf16_t*)(R + R_YB); const bf16_t* gates = (const bf16_t*)(R + R_GATES);
    float* m32 = (float*)(R + R_M32); bf16_t* merged = (bf16_t*)(R + R_MERGED);
    const bf16_t* W = wl(P, layer) + OW_WBR;
    int pm, pn;
    for (int it = 0; tile_order(it, C.nblk, C.bid, TP / 256, 4, pm, pn); ++it) {
        for (int nb = 0; nb < 4; ++nb) {
            f32x4 acc[2][2][4][2];
            gemm256(C, acc, yb + (size_t)nb * SZ512, W + (size_t)nb * 1024 * 512, 512, pm * 256, pn * 256);
            int z2 = 0; asm volatile("" : "+s"(z2));
            const int tid2 = tid_now(C.wave_s, z2), lane = tid2 & 63, wid = tid2 >> 6, wr = wid >> 2, wc = wid & 3, fr = lane & 15, fq = lane >> 4;
#pragma unroll
            for (int ai = 0; ai < 2; ++ai)
#pragma unroll
                for (int m = 0; m < 4; ++m) {
                    const int lt = pm * 256 + ai * 128 + wr * 64 + m * 16 + fr;
#pragma unroll
                    for (int bj = 0; bj < 2; ++bj)
#pragma unroll
                        for (int n = 0; n < 2; ++n) {
                            const int col = pn * 256 + bj * 128 + wc * 32 + n * 16 + fq * 4;
                            const u32x2 gw = *(const u32x2*)(gates + (size_t)lt * 4096 + nb * 1024 + col);
                            f32x4 g; g[0] = __uint_as_float(gw.x << 16); g[1] = __uint_as_float(gw.x & 0xffff0000u); g[2] = __uint_as_float(gw.y << 16); g[3] = __uint_as_float(gw.y & 0xffff0000u);
                            f32x4 mv = g * acc[ai][bj][m][n];
                            f32x4* mp = (f32x4*)(m32 + (size_t)lt * 1024 + col);
                            if (nb > 0) mv += *mp;
                            if (nb < 3) *mp = mv;
                            else { u32x2 w; w.x = pack2bf(mv[0], mv[1]); w.y = pack2bf(mv[2], mv[3]); *(u32x2*)(merged + (size_t)lt * 1024 + col) = w; }
                        }
                    asm volatile("" ::: "memory");
                }
        }
    }
}


#define XB_TMO      128
#define XB_XCNT(j)  (256  + 64 * (j))
#define XB_XSUB(j)  (1280 + 64 * (j))
#define XB_XGEN(j)  (2304 + 64 * (j))
#define XB_TOP      3328
#define XB_TOPGEN   3392
#define XCD_BAR_WORDS 3456
#define XB_SPIN_CAP (1u << 21)
#define LAS __attribute__((address_space(3)))
__device__ __forceinline__ unsigned xb_ld(unsigned* p)              { return __hip_atomic_load(p, __ATOMIC_RELAXED, __HIP_MEMORY_SCOPE_AGENT); }
__device__ __forceinline__ unsigned xb_add(unsigned* p, unsigned v) { return __hip_atomic_fetch_add(p, v, __ATOMIC_RELAXED, __HIP_MEMORY_SCOPE_AGENT); }
__device__ __forceinline__ unsigned xb_xcc_id() { return (unsigned)__builtin_amdgcn_s_getreg((3 << 11) | 20) & 0xFu; }
#define XB_SPIN(cond, bar) do { unsigned _sp = 0; while (cond) { __builtin_amdgcn_s_sleep(1); \
    if ((++_sp & 255u) == 0u) { if (xb_ld(&(bar)[XB_TMO])) break; if (_sp > XB_SPIN_CAP) { atomicAdd(&(bar)[XB_TMO], 1u); break; } } } } while (0)
struct XcdBarrier { unsigned* bar; unsigned x; volatile LAS unsigned* st; };
__device__ __forceinline__ XcdBarrier xcd_barrier_post(unsigned* bar, volatile LAS unsigned* st) {
    XcdBarrier b; b.bar = bar; b.x = xb_xcc_id(); b.st = st;
    if (threadIdx.x == 0) (void)xb_add(&bar[XB_XCNT(b.x)], 1u);
    return b;
}
__device__ __forceinline__ void xcd_barrier_complete(unsigned* bar, unsigned x, unsigned& nloc, unsigned& nx) {
    const unsigned G = gridDim.x * gridDim.y * gridDim.z;
    unsigned sum, cnt, mine, sp = 0u;
    for (;;) {
        sum = 0u; cnt = 0u; mine = 0u;
#pragma unroll
        for (unsigned j = 0; j < 16; ++j) { const unsigned c = xb_ld(&bar[XB_XCNT(j)]); sum += c; cnt += (c > 0u) ? 1u : 0u; mine = (j == x) ? c : mine; }
        if (sum == G) break;
        __builtin_amdgcn_s_sleep(1);
        if ((++sp & 255u) == 0u) { if (xb_ld(&bar[XB_TMO])) break; if (sp > XB_SPIN_CAP) { atomicAdd(&bar[XB_TMO], 1u); break; } }
    }
    nloc = mine > 0u ? mine : 1u; nx = cnt > 0u ? cnt : 1u;
}
__device__ __forceinline__ void xcd_barrier(const XcdBarrier& b) {
    asm volatile("s_waitcnt vmcnt(0)" ::: "memory");
    __syncthreads();
    if (threadIdx.x == 0) {
        unsigned* bar = b.bar;
        __builtin_amdgcn_s_waitcnt(0);
        unsigned nloc = b.st[0], nx = b.st[1];
        if (nloc == 0u) { xcd_barrier_complete(bar, b.x, nloc, nx); b.st[0] = nloc; b.st[1] = nx; }
        const unsigned old = xb_add(&bar[XB_XSUB(b.x)], 1u);
        const unsigned gen = old / nloc;
        if (old + 1u == (gen + 1u) * nloc) {
            __builtin_amdgcn_fence(__ATOMIC_RELEASE, "agent");
            asm volatile("s_waitcnt vmcnt(0)" ::: "memory");
            const unsigned og = xb_add(&bar[XB_TOP], 1u);
            const unsigned tg = og / nx;
            if (og + 1u == (tg + 1u) * nx) xb_add(&bar[XB_TOPGEN], 1u);
            else XB_SPIN(xb_ld(&bar[XB_TOPGEN]) == tg, bar);
            __builtin_amdgcn_fence(__ATOMIC_ACQUIRE, "agent");
            xb_add(&bar[XB_XGEN(b.x)], 1u);
            asm volatile("s_waitcnt vmcnt(0)" ::: "memory");
        } else {
            XB_SPIN(xb_ld(&bar[XB_XGEN(b.x)]) == gen, bar);
            __builtin_amdgcn_fence(__ATOMIC_ACQUIRE, "agent");
            asm volatile("s_waitcnt vmcnt(0)" ::: "memory");
        }
    }
    __syncthreads();
}

constexpr int PH_PER_LAYER = 15, PH_PER_PASS = 2 * PH_PER_LAYER + 1, NPHASE = 1 + NPASS * PH_PER_PASS;

__global__ void __launch_bounds__(512, 2) mk_forward(Params P0, int ph_lo, int ph_hi) {
    unsigned char* smem = dyn_smem;
    const int wave_s = __builtin_amdgcn_readfirstlane((int)threadIdx.x >> 6);
    volatile LAS unsigned* xst = (volatile LAS unsigned*)(LAS unsigned char*)(dyn_smem + 131072);
    if (threadIdx.x == 0) { xst[0] = 0u; xst[1] = 0u; }
    __syncthreads();
    const XcdBarrier xb = xcd_barrier_post((unsigned*)(P0.ws + WS_BAR), xst);
    for (int it_ = 2 * ph_lo; it_ < 2 * ph_hi; ++it_) {
        const int ph = it_ >> 1;
        if (it_ & 1) {
            if (PROBE_MASK == 0 || ph == 0) continue;
            const int r_ = (ph - 1) % PH_PER_PASS;
            if (r_ == PH_PER_PASS - 1 || !((PROBE_MASK >> (r_ % PH_PER_LAYER)) & 1)) continue;
        }
        if (it_ > 2 * ph_lo) { if (it_ == 2 * ph_lo + 2) cg::this_grid().sync(); else xcd_barrier(xb); }
        int z = 0; asm volatile("" : "+s"(z));
        Ctx C; C.tid = tid_now(wave_s, z); C.bid = (int)blockIdx.x + z; C.nblk = (int)gridDim.x + z; C.wave_s = wave_s;
        ptrtab_t tab = (ptrtab_t)__builtin_amdgcn_kernarg_segment_ptr();
        asm volatile("" : "+s"(tab));
        const PV P{tab, (float*)tab[29], (unsigned char*)tab[30]};
        if (ph == 0) { prep_phase(C, P, smem); continue; }
        const int q = ph - 1, pass = q / PH_PER_PASS, r = q % PH_PER_PASS;
        if (r == PH_PER_PASS - 1) { norm_phase(C, P, pass, P.inp(6) + (size_t)(1 * 3 + 2) * 1024, P.inp(7) + (size_t)(1 * 3 + 2) * 1024, 0, -1, false, true); continue; }
        const int layer = r / PH_PER_LAYER, lp = r % PH_PER_LAYER;
        const bf16_t* W = wl(P, layer);
        const float* lng = P.inp(6) + (size_t)layer * 3 * 1024; const float* lnb = P.inp(7) + (size_t)layer * 3 * 1024;
        const float* lngp = P.inp(6) + (size_t)((layer > 0 ? layer - 1 : 0) * 3 + 2) * 1024; const float* lnbp = P.inp(7) + (size_t)((layer > 0 ? layer - 1 : 0) * 3 + 2) * 1024;
        unsigned char* R = P.ws + WS_R;
        switch (lp) {
            case 0:
                if (layer == 0) norm_phase(C, P, pass, nullptr, nullptr, 0, 0, true, false);
                else norm_phase(C, P, pass, lngp, lnbp, layer, 0, false, false);
                break;
            case 1: ffn_up_phase(C, P, W + OW_FA_IN); break;
            case 2: resid_gemm_phase(C, P, pass, (const bf16_t*)(R + R_ACT), 2816, W + OW_FA_OUT, layer, 0, 0.5f, layer == 0 ? nullptr : lngp, lnbp); break;
            case 3: norm_phase(C, P, pass, lng, lnb, layer, 1, false, false); break;
            case 4: win_phase(C, P, layer); break;
            case 5: lin_pool_phase(C, P, layer); break;
            case 6: lora_phase(C, P, layer, smem); break;
            case 7:
                if (C.bid < 32) scan_block<4>(C, P, layer, 0, C.bid >> 2, (C.bid >> 1) & 1, (C.bid & 1) * 32, smem);
                else if (C.bid < 160) { const int i2 = C.bid - 32; scan_block<8>(C, P, layer, 1 + (i2 >> 4), (i2 >> 1) & 7, i2 & 1, 0, smem); }
                attn_items(C, P, layer, pass * 2 + layer, smem); fft_items(C, P, smem); break;
            case 8: finish_phase(C, P, layer); break;
            case 9: gates_phase(C, P, layer); break;
            case 10: branch_phase(C, P, layer); break;
            case 11: resid_gemm_phase(C, P, pass, (const bf16_t*)(R + R_MERGED), 1024, W + OW_WOUT, layer, 1, 1.0f, lng, lnb); break;
            case 12: norm_phase(C, P, pass, lng + 1024, lnb + 1024, layer, 2, false, false); break;
            case 13: ffn_up_phase(C, P, W + OW_FB_IN); break;
            default: resid_gemm_phase(C, P, pass, (const bf16_t*)(R + R_ACT), 2816, W + OW_FB_OUT, layer, 2, 0.5f, lng + 1024, lnb + 1024); break;
        }
    }
}

extern "C" void kernel_launch(void* const* d_in, const int* in_sizes, int n_in, void* d_out, int out_size, void* d_ws, size_t ws_size, hipStream_t stream) {
    static int grid_blocks = 0;
    if (!grid_blocks) {
        int dev = 0, cus = 0, per_cu = 0;
        (void)hipGetDevice(&dev);
        (void)hipDeviceGetAttribute(&cus, hipDeviceAttributeMultiprocessorCount, dev);
        (void)hipFuncSetAttribute((const void*)mk_forward, hipFuncAttributeMaxDynamicSharedMemorySize, LDS_BYTES);
        (void)hipOccupancyMaxActiveBlocksPerMultiprocessor(&per_cu, mk_forward, NT, LDS_BYTES);
        if (per_cu < 1) per_cu = 1;
        if (per_cu > 1) per_cu = 1;
        grid_blocks = cus * per_cu;
    }
    Params p{};
    for (int i = 0; i < 29; ++i) p.in[i] = (const float*)d_in[i];
    p.out = (float*)d_out; p.ws = (unsigned char*)d_ws;
    (void)hipMemsetAsync((unsigned char*)d_ws + WS_BAR, 0, XCD_BAR_WORDS * 4 + 256, stream);
#if ONE_LAUNCH
    int lo = 0, hi = NPHASE;
    void* args[] = {&p, &lo, &hi};
    hipError_t e = hipLaunchCooperativeKernel((void*)mk_forward, dim3(grid_blocks), dim3(NT), args, LDS_BYTES, stream);
    if (e != hipSuccess) fprintf(stderr, "cooperative launch failed: %s (grid %d)\n", hipGetErrorString(e), grid_blocks);
#else
    for (int ph = 0; ph < NPHASE; ++ph) {
        int lo = ph, hi = ph + 1;
        void* args[] = {&p, &lo, &hi};
        (void)hipLaunchCooperativeKernel((void*)mk_forward, dim3(grid_blocks), dim3(NT), args, LDS_BYTES, stream);
    }
#endif
}
```
